# Optimizing an MI355X kernel written in HIP

```python
import jax, jax.numpy as jnp
from jax import lax
import numpy as np

D_MODEL = 1024
BATCH = 8
SEQ = 4096
DEPTH = 1

D_MIX = D_MODEL
D_CONV = D_MIX // 2
CONV_GROUPS = 8
CONV_WIDTH = 31
D_HGRN = D_MIX - D_CONV
HGRN_HEADS = 4
HGRN_HEAD_DIM = D_HGRN // HGRN_HEADS
HGRN_CHUNK = 64
D_IN = 2 * D_CONV + 4 * D_HGRN
PEER_HEADS = 8
PEER_KEY_DIM = 256
PEER_N_KEYS = 128
PEER_N_EXPERTS = PEER_N_KEYS * PEER_N_KEYS
PEER_TOPK = 16
PEER_BLOCK = 128
EPS = 1e-6

kernel_name = "hybrid_conv_hgrn2_peer_block"


def rmsnorm(x, g):
    xf = x.astype(jnp.float32)
    xf = xf * lax.rsqrt(jnp.mean(xf * xf, axis=-1, keepdims=True) + EPS)
    return (xf * g.astype(jnp.float32)).astype(x.dtype)


def conformer_conv(a, gate, conv_w, conv_b, norm_g, norm_b):
    bsz, s, _ = a.shape
    h = a * jax.nn.sigmoid(gate)
    h = lax.conv_general_dilated(
        h, conv_w[:, None, :].astype(h.dtype), window_strides=(1,),
        padding=[(CONV_WIDTH - 1, 0)],
        dimension_numbers=('NWC', 'WIO', 'NWC'),
        feature_group_count=D_CONV) + conv_b.astype(h.dtype)
    hf = h.astype(jnp.float32).reshape(bsz, s, CONV_GROUPS, D_CONV // CONV_GROUPS)
    mu = jnp.mean(hf, axis=-1, keepdims=True)
    var = jnp.mean(jnp.square(hf - mu), axis=-1, keepdims=True)
    hf = ((hf - mu) * lax.rsqrt(var + EPS)).reshape(bsz, s, D_CONV)
    hf = hf * norm_g.astype(jnp.float32) + norm_b.astype(jnp.float32)
    return jax.nn.silu(hf).astype(a.dtype)


def _hgrn2_chunk(state, inp):
    q, k, v, log_f = inp
    b = jnp.cumsum(log_f, axis=2)
    inter = jnp.einsum('bhtk,bhkv->bhtv', q * jnp.exp(b), state)
    tri = jnp.tril(jnp.ones((HGRN_CHUNK, HGRN_CHUNK), dtype=bool))
    diff = b[:, :, :, None, :] - b[:, :, None, :, :]
    decay = jnp.exp(jnp.where(tri[:, :, None], diff, -jnp.inf))
    scores = jnp.einsum('bhtk,bhsk,bhtsk->bhts', q, k, decay)
    intra = jnp.einsum('bhts,bhsv->bhtv', scores, v)
    b_last = b[:, :, -1, :]
    state = (jnp.exp(b_last)[..., None] * state
             + jnp.einsum('bhsk,bhsv->bhkv', k * jnp.exp(b_last[:, :, None, :] - b), v))
    return state, inter + intra


def hgrn2(q_in, f_in, i_in, g_in, lb, norm_g):
    bsz, s, _ = q_in.shape
    shp = (bsz, s, HGRN_HEADS, HGRN_HEAD_DIM)
    lbh = lb.reshape(HGRN_HEADS, HGRN_HEAD_DIM)
    z = f_in.astype(jnp.float32).reshape(shp)
    f = lbh + (1.0 - lbh) * jax.nn.sigmoid(z)
    log_f = jnp.log(f)
    k = (1.0 - lbh) * jax.nn.sigmoid(-z)
    q = jax.nn.silu(q_in.astype(jnp.float32)).reshape(shp)
    v = i_in.astype(jnp.float32).reshape(shp)
    nc = s // HGRN_CHUNK

    def to_chunks(t):
        return t.reshape(bsz, nc, HGRN_CHUNK, HGRN_HEADS, HGRN_HEAD_DIM).transpose(1, 0, 3, 2, 4)

    state0 = jnp.zeros((bsz, HGRN_HEADS, HGRN_HEAD_DIM, HGRN_HEAD_DIM), jnp.float32)
    _, o = lax.scan(_hgrn2_chunk, state0,
                    (to_chunks(q), to_chunks(k), to_chunks(v), to_chunks(log_f)))
    o = o.transpose(1, 0, 3, 2, 4).reshape(shp)
    o = o * lax.rsqrt(jnp.mean(o * o, axis=-1, keepdims=True) + EPS)
    o = o.reshape(bsz, s, D_HGRN) * norm_g.astype(jnp.float32)
    o = o * jax.nn.silu(g_in.astype(jnp.float32))
    return o.astype(q_in.dtype)


def peer(xn, w_query, sub_keys, u_tab, v_tab):
    bsz, s, d = xn.shape
    xt = xn.reshape(-1, d)
    t = xt.shape[0]
    q = (xt @ w_query).reshape(t, PEER_HEADS, 2, PEER_KEY_DIM // 2)
    sc = jnp.einsum('thpd,hpnd->thpn', q, sub_keys).astype(jnp.float32)
    s1, i1 = lax.top_k(sc[:, :, 0], PEER_TOPK)
    s2, i2 = lax.top_k(sc[:, :, 1], PEER_TOPK)
    cand = (s1[..., :, None] + s2[..., None, :]).reshape(t, PEER_HEADS, PEER_TOPK * PEER_TOPK)
    top_s, ci = lax.top_k(cand, PEER_TOPK)
    experts = (jnp.take_along_axis(i1, ci // PEER_TOPK, axis=-1) * PEER_N_KEYS
               + jnp.take_along_axis(i2, ci % PEER_TOPK, axis=-1))
    gate = jax.nn.softmax(top_s, axis=-1).astype(xn.dtype)
    nb = t // PEER_BLOCK

    def block(args):
        xb, eb, gb = args
        u = u_tab[eb]
        act = jax.nn.gelu(jnp.einsum('thkd,td->thk', u, xb), approximate=False)
        return jnp.einsum('thk,thkd->td', gb * act, v_tab[eb])

    y = lax.map(block, (xt.reshape(nb, PEER_BLOCK, d),
                        experts.reshape(nb, PEER_BLOCK, PEER_HEADS, PEER_TOPK),
                        gate.reshape(nb, PEER_BLOCK, PEER_HEADS, PEER_TOPK)))
    return y.reshape(bsz, s, d)


def setup_inputs(seed: int = 0) -> dict:
    key = jax.random.key(seed)
    ks = jax.random.split(key, 16)
    f32 = jnp.float32
    nrm = lambda k, shp, sc: jax.random.normal(k, shp, f32) * sc
    return {
        "x": jax.random.normal(ks[0], (BATCH, SEQ, D_MODEL), f32),
        "norm_mix_g": 1.0 + nrm(ks[1], (DEPTH, D_MODEL), 0.02),
        "w_in": nrm(ks[2], (DEPTH, D_MODEL, D_IN), D_MODEL ** -0.5),
        "conv_w": nrm(ks[3], (DEPTH, CONV_WIDTH, D_CONV), CONV_WIDTH ** -0.5),
        "conv_b": nrm(ks[4], (DEPTH, D_CONV), 0.02),
        "conv_norm_g": 1.0 + nrm(ks[5], (DEPTH, D_CONV), 0.02),
        "conv_norm_b": nrm(ks[6], (DEPTH, D_CONV), 0.02),
        "hgrn_lb_logits": nrm(ks[7], (DEPTH + 1, D_HGRN), 0.1),
        "hgrn_norm_g": 1.0 + nrm(ks[8], (DEPTH, D_HGRN), 0.02),
        "w_out": nrm(ks[9], (DEPTH, D_MIX, D_MODEL), D_MIX ** -0.5),
        "norm_ffn_g": 1.0 + nrm(ks[10], (DEPTH, D_MODEL), 0.02),
        "peer_w_query": nrm(ks[11], (DEPTH, D_MODEL, PEER_HEADS * PEER_KEY_DIM), D_MODEL ** -0.5),
        "peer_sub_keys": nrm(ks[12], (DEPTH, PEER_HEADS, 2, PEER_N_KEYS, PEER_KEY_DIM // 2),
                             (PEER_KEY_DIM // 2) ** -0.5),
        "peer_u": nrm(ks[13], (DEPTH, PEER_N_EXPERTS, D_MODEL), D_MODEL ** -0.5),
        "peer_v": nrm(ks[14], (DEPTH, PEER_N_EXPERTS, D_MODEL), 0.5),
        "final_norm_g": 1.0 + nrm(ks[15], (D_MODEL,), 0.02),
    }


def reference(x, norm_mix_g, w_in, conv_w, conv_b, conv_norm_g, conv_norm_b, hgrn_lb_logits,
              hgrn_norm_g, w_out, norm_ffn_g, peer_w_query, peer_sub_keys, peer_u, peer_v,
              final_norm_g):
    lb_all = jnp.cumsum(jax.nn.softmax(hgrn_lb_logits.astype(jnp.float32), axis=0), axis=0)
    splits = [D_CONV, 2 * D_CONV, 2 * D_CONV + D_HGRN, 2 * D_CONV + 2 * D_HGRN,
              2 * D_CONV + 3 * D_HGRN]
    h = x
    for l in range(DEPTH):
        xn = rmsnorm(h, norm_mix_g[l])
        proj = xn @ w_in[l]
        a, a_gate, qh, fh, ih, gh = jnp.split(proj, splits, axis=-1)
        y_conv = conformer_conv(a, a_gate, conv_w[l], conv_b[l], conv_norm_g[l], conv_norm_b[l])
        y_hgrn = hgrn2(qh, fh, ih, gh, lb_all[l], hgrn_norm_g[l])
        h = h + jnp.concatenate([y_conv, y_hgrn], axis=-1) @ w_out[l]
        h = h + peer(rmsnorm(h, norm_ffn_g[l]), peer_w_query[l], peer_sub_keys[l],
                     peer_u[l], peer_v[l])
    return rmsnorm(h, final_norm_g)
```

```cpp
#include <hip/hip_runtime.h>
#include <cstdio>
#include <cstdint>
#include <cmath>

namespace nv {
constexpr int D = 1024, BATCH = 8, SEQ = 4096, M = BATCH * SEQ;
constexpr int DCONV = 512, CW = 31, DH = 512, NH = 4, HD = 128, DIN = 3072;
constexpr int PH = 8, PK = 256, NKEY = 128, TOPK = 16, NEXP = NKEY * NKEY;
constexpr float EPS = 1e-6f;

__device__ __forceinline__ float wsum(float v) {
#pragma unroll
    for (int o = 1; o < 64; o <<= 1) v += __shfl_xor(v, o);
    return v;
}
__device__ __forceinline__ float sigmoidf_(float x) { return 1.f / (1.f + __expf(-x)); }
__device__ __forceinline__ float siluf_(float x) { return x * sigmoidf_(x); }

__global__ void __launch_bounds__(256) k_rmsnorm(const float* __restrict__ x, const float* __restrict__ g, float* __restrict__ out, int rows) {
    const int lane = threadIdx.x & 63, w = threadIdx.x >> 6;
    const int row = blockIdx.x * 4 + w;
    if (row >= rows) return;
    const float4* xr = (const float4*)(x + (size_t)row * D);
    float4 v[4]; float s = 0.f;
#pragma unroll
    for (int j = 0; j < 4; ++j) { v[j] = xr[lane + 64 * j]; s += v[j].x * v[j].x + v[j].y * v[j].y + v[j].z * v[j].z + v[j].w * v[j].w; }
    s = wsum(s);
    const float r = rsqrtf(s * (1.f / D) + EPS);
    float4* o = (float4*)(out + (size_t)row * D);
    const float4* g4 = (const float4*)g;
#pragma unroll
    for (int j = 0; j < 4; ++j) { const float4 gg = g4[lane + 64 * j]; float4 t; t.x = v[j].x * r * gg.x; t.y = v[j].y * r * gg.y; t.z = v[j].z * r * gg.z; t.w = v[j].w * r * gg.w; o[lane + 64 * j] = t; }
}

template <bool RES>
__global__ void __launch_bounds__(256) k_gemm(const float* __restrict__ A, const float* __restrict__ B, float* __restrict__ C, const float* __restrict__ R, int Mm, int N, int K) {
    __shared__ float As[16][68];
    __shared__ float Bs[16][64];
    const int tid = threadIdx.x, tx = tid & 15, ty = tid >> 4;
    const int m0 = blockIdx.y * 64, n0 = blockIdx.x * 64;
    float acc[4][4];
#pragma unroll
    for (int i = 0; i < 4; ++i)
#pragma unroll
        for (int j = 0; j < 4; ++j) acc[i][j] = 0.f;
    for (int k0 = 0; k0 < K; k0 += 16) {
#pragma unroll
        for (int i = 0; i < 4; ++i) { const int idx = tid + i * 256, r = idx >> 4, kk = idx & 15; As[kk][r] = A[(size_t)(m0 + r) * K + k0 + kk]; }
#pragma unroll
        for (int i = 0; i < 4; ++i) { const int idx = tid + i * 256, kk = idx >> 6, c = idx & 63; Bs[kk][c] = B[(size_t)(k0 + kk) * N + n0 + c]; }
        __syncthreads();
#pragma unroll
        for (int kk = 0; kk < 16; ++kk) {
            float a[4], b[4];
#pragma unroll
            for (int i = 0; i < 4; ++i) a[i] = As[kk][ty * 4 + i];
#pragma unroll
            for (int j = 0; j < 4; ++j) b[j] = Bs[kk][tx * 4 + j];
#pragma unroll
            for (int i = 0; i < 4; ++i)
#pragma unroll
                for (int j = 0; j < 4; ++j) acc[i][j] = fmaf(a[i], b[j], acc[i][j]);
        }
        __syncthreads();
    }
#pragma unroll
    for (int i = 0; i < 4; ++i) {
        const size_t off = (size_t)(m0 + ty * 4 + i) * N + n0 + tx * 4;
        float4 o; o.x = acc[i][0]; o.y = acc[i][1]; o.z = acc[i][2]; o.w = acc[i][3];
        if (RES) { const float4 r = *(const float4*)(R + off); o.x += r.x; o.y += r.y; o.z += r.z; o.w += r.w; }
        *(float4*)(C + off) = o;
    }
}

__global__ void __launch_bounds__(512) k_conv(const float* __restrict__ proj, const float* __restrict__ cw, const float* __restrict__ cb, const float* __restrict__ ng, const float* __restrict__ nb, float* __restrict__ Y) {
    const int t = blockIdx.x;
    const int s = t % SEQ, c = threadIdx.x;
    float acc = cb[c];
    for (int j = 0; j < CW; ++j) {
        const int ss = s - (CW - 1) + j;
        if (ss >= 0) {
            const float* pr = proj + (size_t)(t - (CW - 1) + j) * DIN;
            const float a = pr[c], gt = pr[DCONV + c];
            acc = fmaf(cw[j * DCONV + c], a * sigmoidf_(gt), acc);
        }
    }
    const float mu = wsum(acc) * (1.f / 64.f);
    const float d = acc - mu;
    const float var = wsum(d * d) * (1.f / 64.f);
    const float hn = d * rsqrtf(var + EPS) * ng[c] + nb[c];
    Y[(size_t)t * D + c] = siluf_(hn);
}

__global__ void __launch_bounds__(128) k_hgrn(const float* __restrict__ proj, const float* __restrict__ lbl, const float* __restrict__ hng, float* __restrict__ Y) {
    __shared__ float fs[HD], ks[HD], qs[HD], red[2];
    const int b = blockIdx.x / NH, h = blockIdx.x % NH, v = threadIdx.x;
    const int col = h * HD + v;
    const float l0 = lbl[col], l1 = lbl[DH + col];
    const float lb = 1.f / (1.f + __expf(l1 - l0));
    const float gn = hng[col];
    float S[HD];
#pragma unroll
    for (int k = 0; k < HD; ++k) S[k] = 0.f;
    for (int s = 0; s < SEQ; ++s) {
        const float* pr = proj + (size_t)(b * SEQ + s) * DIN + 2 * DCONV;
        const float qv = pr[col], z = pr[DH + col], iv = pr[2 * DH + col], gv = pr[3 * DH + col];
        const float sg = sigmoidf_(z);
        fs[v] = lb + (1.f - lb) * sg;
        ks[v] = (1.f - lb) * (1.f - sg);
        qs[v] = siluf_(qv);
        __syncthreads();
        float o = 0.f;
#pragma unroll
        for (int k = 0; k < HD; ++k) { S[k] = fmaf(fs[k], S[k], ks[k] * iv); o = fmaf(S[k], qs[k], o); }
        float sq = wsum(o * o);
        if ((v & 63) == 0) red[v >> 6] = sq;
        __syncthreads();
        const float ms = (red[0] + red[1]) * (1.f / HD);
        const float y = o * rsqrtf(ms + EPS) * gn * siluf_(gv);
        Y[(size_t)(b * SEQ + s) * D + DCONV + col] = y;
        __syncthreads();
    }
}

__global__ void __launch_bounds__(256) k_scores(const float* __restrict__ Q, const float* __restrict__ sk, float* __restrict__ SC) {
    __shared__ float qs[2048];
    const int t = blockIdx.x;
    for (int i = threadIdx.x; i < 2048; i += 256) qs[i] = Q[(size_t)t * 2048 + i];
    __syncthreads();
    for (int o = threadIdx.x; o < 2048; o += 256) {
        const int hp = o >> 7;
        const float* kr = sk + (size_t)o * 128;
        const float* qq = qs + hp * 128;
        float a = 0.f;
        for (int j = 0; j < 128; ++j) a = fmaf(qq[j], kr[j], a);
        SC[(size_t)t * 2048 + o] = a;
    }
}

__device__ __forceinline__ void wave_argmax(float& v, int& i) {
#pragma unroll
    for (int o = 1; o < 64; o <<= 1) {
        const float ov = __shfl_xor(v, o); const int oi = __shfl_xor(i, o);
        if (ov > v || (ov == v && oi < i)) { v = ov; i = oi; }
    }
}

__global__ void __launch_bounds__(64) k_topk(const float* __restrict__ SC, int* __restrict__ EIDX, float* __restrict__ GATE) {
    __shared__ float s1[16], s2[16]; __shared__ int i1[16], i2[16];
    const int t = blockIdx.x >> 3, h = blockIdx.x & 7, lane = threadIdx.x;
    const float* sc = SC + (size_t)t * 2048 + h * 256;
    for (int p = 0; p < 2; ++p) {
        float a0 = sc[p * 128 + lane], a1 = sc[p * 128 + 64 + lane];
        for (int r = 0; r < 16; ++r) {
            float v; int i;
            if (a0 >= a1) { v = a0; i = lane; } else { v = a1; i = lane + 64; }
            wave_argmax(v, i);
            if (lane == 0) { if (p == 0) { s1[r] = v; i1[r] = i; } else { s2[r] = v; i2[r] = i; } }
            if (i == lane) a0 = -INFINITY;
            if (i == lane + 64) a1 = -INFINITY;
        }
    }
    __syncthreads();
    float c[4];
#pragma unroll
    for (int e = 0; e < 4; ++e) { const int ci = lane * 4 + e; c[e] = s1[ci >> 4] + s2[ci & 15]; }
    float ts = 0.f; int te = 0; float tmax = 0.f;
    float myts = 0.f; int mye = 0;
    for (int r = 0; r < 16; ++r) {
        float v = c[0]; int i = lane * 4;
#pragma unroll
        for (int e = 1; e < 4; ++e) if (c[e] > v) { v = c[e]; i = lane * 4 + e; }
        wave_argmax(v, i);
#pragma unroll
        for (int e = 0; e < 4; ++e) if (i == lane * 4 + e) c[e] = -INFINITY;
        if (r == 0) tmax = v;
        if (lane == r) { myts = v; mye = i1[i >> 4] * NKEY + i2[i & 15]; }
    }
    (void)ts; (void)te;
    float ex = (lane < 16) ? __expf(myts - tmax) : 0.f;
    const float den = wsum(ex);
    if (lane < 16) { EIDX[(size_t)t * 128 + h * 16 + lane] = mye; GATE[(size_t)t * 128 + h * 16 + lane] = ex / den; }
}

__global__ void __launch_bounds__(256) k_peer(const float* __restrict__ XN2, const int* __restrict__ EIDX, const float* __restrict__ GATE, const float* __restrict__ U, const float* __restrict__ V,
                                              const float* H2, const float* __restrict__ fg, float* out) {
    const int lane = threadIdx.x & 63, w = threadIdx.x >> 6;
    const int t = blockIdx.x * 4 + w;
    const float4* xr = (const float4*)(XN2 + (size_t)t * D);
    float4 x[4], y[4];
#pragma unroll
    for (int j = 0; j < 4; ++j) { x[j] = xr[lane + 64 * j]; y[j] = make_float4(0.f, 0.f, 0.f, 0.f); }
    for (int e = 0; e < 128; ++e) {
        const int ei = EIDX[(size_t)t * 128 + e]; const float g = GATE[(size_t)t * 128 + e];
        const float4* ur = (const float4*)(U + (size_t)ei * D);
        float d = 0.f;
#pragma unroll
        for (int j = 0; j < 4; ++j) { const float4 u = ur[lane + 64 * j]; d += u.x * x[j].x + u.y * x[j].y + u.z * x[j].z + u.w * x[j].w; }
        d = wsum(d);
        const float act = 0.5f * d * (1.f + erff(d * 0.70710678118654752f));
        const float wgt = g * act;
        const float4* vr = (const float4*)(V + (size_t)ei * D);
#pragma unroll
        for (int j = 0; j < 4; ++j) { const float4 vv = vr[lane + 64 * j]; y[j].x = fmaf(wgt, vv.x, y[j].x); y[j].y = fmaf(wgt, vv.y, y[j].y); y[j].z = fmaf(wgt, vv.z, y[j].z); y[j].w = fmaf(wgt, vv.w, y[j].w); }
    }
    const float4* hr = (const float4*)(H2 + (size_t)t * D);
    float s = 0.f;
#pragma unroll
    for (int j = 0; j < 4; ++j) { const float4 hh = hr[lane + 64 * j]; y[j].x += hh.x; y[j].y += hh.y; y[j].z += hh.z; y[j].w += hh.w; s += y[j].x * y[j].x + y[j].y * y[j].y + y[j].z * y[j].z + y[j].w * y[j].w; }
    s = wsum(s);
    const float r = rsqrtf(s * (1.f / D) + EPS);
    float4* o = (float4*)(out + (size_t)t * D);
    const float4* g4 = (const float4*)fg;
#pragma unroll
    for (int j = 0; j < 4; ++j) { const float4 gg = g4[lane + 64 * j]; float4 q; q.x = y[j].x * r * gg.x; q.y = y[j].y * r * gg.y; q.z = y[j].z * r * gg.z; q.w = y[j].w * r * gg.w; o[lane + 64 * j] = q; }
}
}

extern "C" void kernel_launch(void* const* d_in, const int* in_sizes, int n_in, void* d_out, int out_size, void* d_ws, size_t ws_size, hipStream_t stream) {
    using namespace nv;
    const float* x = (const float*)d_in[0];
    const float* g1 = (const float*)d_in[1];
    const float* w_in = (const float*)d_in[2];
    const float* conv_w = (const float*)d_in[3];
    const float* conv_b = (const float*)d_in[4];
    const float* cng = (const float*)d_in[5];
    const float* cnb = (const float*)d_in[6];
    const float* lbl = (const float*)d_in[7];
    const float* hng = (const float*)d_in[8];
    const float* w_out = (const float*)d_in[9];
    const float* g2 = (const float*)d_in[10];
    const float* wq = (const float*)d_in[11];
    const float* sk = (const float*)d_in[12];
    const float* pu = (const float*)d_in[13];
    const float* pv = (const float*)d_in[14];
    const float* fg = (const float*)d_in[15];
    float* out = (float*)d_out;
    char* ws = (char*)d_ws;
    const size_t MiB = 1u << 20;
    float* XN = (float*)(ws);
    float* PROJ = (float*)(ws + 128 * MiB);
    float* Y = (float*)(ws);
    float* H2 = out;
    float* XN2 = (float*)(ws + 128 * MiB);
    float* Qh = (float*)(ws + 256 * MiB);
    float* SCh = (float*)(ws + 384 * MiB);
    int* EIDX = (int*)(ws);
    float* GATE = (float*)(ws + 16 * MiB);
    if (ws_size < 512 * MiB) { fprintf(stderr, "ws too small %zu\n", ws_size); return; }

    k_rmsnorm<<<M / 4, 256, 0, stream>>>(x, g1, XN, M);
    k_gemm<false><<<dim3(DIN / 64, M / 64), 256, 0, stream>>>(XN, w_in, PROJ, nullptr, M, DIN, D);
    k_conv<<<M, 512, 0, stream>>>(PROJ, conv_w, conv_b, cng, cnb, Y);
    k_hgrn<<<BATCH * NH, 128, 0, stream>>>(PROJ, lbl, hng, Y);
    k_gemm<true><<<dim3(D / 64, M / 64), 256, 0, stream>>>(Y, w_out, H2, x, M, D, D);
    k_rmsnorm<<<M / 4, 256, 0, stream>>>(H2, g2, XN2, M);
    for (int hf = 0; hf < 2; ++hf) {
        const int Mh = M / 2;
        k_gemm<false><<<dim3(2048 / 64, Mh / 64), 256, 0, stream>>>(XN2 + (size_t)hf * Mh * D, wq, Qh, nullptr, Mh, 2048, D);
        k_scores<<<Mh, 256, 0, stream>>>(Qh, sk, SCh);
        k_topk<<<Mh * 8, 64, 0, stream>>>(SCh, EIDX + (size_t)hf * Mh * 128, GATE + (size_t)hf * Mh * 128);
    }
    k_peer<<<M / 4, 256, 0, stream>>>(XN2, EIDX, GATE, pu, pv, H2, fg, out);
}
```

```cpp
#include <hip/hip_runtime.h>
#include <hip/hip_cooperative_groups.h>
#include <cstdio>
#include <cstdint>
#include <cmath>
namespace cg = cooperative_groups;
namespace pg8 {
#define PG8_LAS __attribute__((address_space(3)))
typedef unsigned short bf16_t;
typedef short bf16x8 __attribute__((ext_vector_type(8)));
typedef float f32x4 __attribute__((ext_vector_type(4)));
typedef unsigned u32x4 __attribute__((ext_vector_type(4)));
constexpr int BM = 256, BK = 64, HALF = 128, HTB = HALF * BK * 2  , STAGE_BYTES = 8 * HTB, NXCD = 8, WGM = 8;

__host__ __device__ __forceinline__ int lds_byte(int r, int c) { const int st = (r >> 4) * 2 + (c >> 5), rr = r & 15, cc = c & 31, ob = rr * 64 + cc * 2; return st * 1024 + (ob ^ (((ob >> 9) & 1) << 5)); }
__host__ __device__ __forceinline__ void stage_rc(int b, int& R, int& C) { const int st = b / 1024, sb = b % 1024, swz = sb ^ (((sb >> 9) & 1) << 5); R = (st >> 1) * 16 + swz / 64; C = (st & 1) * 32 + (swz % 64) / 2; }
__host__ __device__ __forceinline__ int perm32(int rho) { const int n = rho >> 4, i = rho & 15; return 8 * (i >> 2) + 4 * n + (i & 3); }

struct Unit { int pm, pn; };
struct Gemm { const bf16_t* A; const bf16_t* Bt; int M, N, K; };

struct StaticOrder {
    int nM, nN, nwg, G, c;
    __host__ __device__ void init(int M, int N, int G_, int c_) { nM = M / BM; nN = N / BM; nwg = nM * nN; G = G_; c = c_; }
    __host__ __device__ bool next(int i, Unit& u) const {
        const long L = (long)i * G + c; if (L >= nwg) return false;
        int wgid = (int)L; { const int q = nwg / NXCD, r = nwg % NXCD, xcd = wgid % NXCD, off = wgid / NXCD; wgid = (xcd < r ? xcd * (q + 1) : r * (q + 1) + (xcd - r) * q) + off; }
        const int nig = WGM * nN, gid = wgid / nig, fm = gid * WGM, gsz = (nM - fm) < WGM ? (nM - fm) : WGM;
        u.pm = fm + ((wgid % nig) % gsz); u.pn = (wgid % nig) / gsz; return true;
    }
    __device__ __forceinline__ void a_ready(const Unit&) const {}
    __device__ __forceinline__ void done(const Unit&) const {}
};

__device__ __forceinline__ unsigned cvt_pk_bf16(float lo, float hi) { unsigned r; asm volatile("v_cvt_pk_bf16_f32 %0, %1, %2" : "=v"(r) : "v"(lo), "v"(hi)); return r; }
__device__ __forceinline__ float fsigmoid(float x) { return __builtin_amdgcn_rcpf(1.f + __builtin_amdgcn_exp2f(-1.4426950408889634f * x)); }

struct EpiProj {
    static constexpr bool PERM = true, AFTER_DRAIN = false;
    bf16_t* GLU; bf16_t* HG;
    __device__ __forceinline__ void operator()(const f32x4 (&acc)[2][2][4][2], const Unit& u, int wr, int wc, int fr, int fq) const {
        const int row0 = u.pm * BM + wr * 64 + fr;
        if (u.pn < 4) {
            const int col = u.pn * 128 + wc * 32 + 8 * fq;
#pragma unroll
            for (int ai = 0; ai < 2; ++ai)
#pragma unroll
                for (int m = 0; m < 4; ++m) {
                    const f32x4 a0 = acc[ai][0][m][0], a1 = acc[ai][0][m][1], g0 = acc[ai][1][m][0], g1 = acc[ai][1][m][1];
                    u32x4 w;
                    w.x = cvt_pk_bf16(a0[0] * fsigmoid(g0[0]), a0[1] * fsigmoid(g0[1])); w.y = cvt_pk_bf16(a0[2] * fsigmoid(g0[2]), a0[3] * fsigmoid(g0[3]));
                    w.z = cvt_pk_bf16(a1[0] * fsigmoid(g1[0]), a1[1] * fsigmoid(g1[1])); w.w = cvt_pk_bf16(a1[2] * fsigmoid(g1[2]), a1[3] * fsigmoid(g1[3]));
                    *(u32x4*)(GLU + (size_t)(row0 + ai * HALF + m * 16) * 512 + col) = w;
                }
        } else {
            const int t = u.pn - 4;
            const bool act = (t < 2) || (t >= 6);
            const int col = t * 256 + wc * 32 + 8 * fq;
#pragma unroll
            for (int ai = 0; ai < 2; ++ai)
#pragma unroll
                for (int m = 0; m < 4; ++m) {
                    bf16_t* rowp = HG + (size_t)(row0 + ai * HALF + m * 16) * 2048 + col;
#pragma unroll
                    for (int bj = 0; bj < 2; ++bj) {
                        f32x4 v0 = acc[ai][bj][m][0], v1 = acc[ai][bj][m][1];
                        if (act) {
#pragma unroll
                            for (int i = 0; i < 4; ++i) { v0[i] = v0[i] * fsigmoid(v0[i]); v1[i] = v1[i] * fsigmoid(v1[i]); }
                        }
                        u32x4 w; w.x = cvt_pk_bf16(v0[0], v0[1]); w.y = cvt_pk_bf16(v0[2], v0[3]); w.z = cvt_pk_bf16(v1[0], v1[1]); w.w = cvt_pk_bf16(v1[2], v1[3]);
                        *(u32x4*)(rowp + bj * HALF) = w;
                    }
                }
        }
    }
};

struct EpiResF32 {
    static constexpr bool PERM = false, AFTER_DRAIN = false;
    float* C; const float* R; int ldc;
    __device__ __forceinline__ void operator()(const f32x4 (&acc)[2][2][4][2], const Unit& u, int wr, int wc, int fr, int fq) const {
        const int row0 = u.pm * BM + wr * 64 + fr, col0 = u.pn * BM + wc * 32 + 4 * fq;
#pragma unroll
        for (int ai = 0; ai < 2; ++ai)
#pragma unroll
            for (int m = 0; m < 4; ++m) { const size_t off = (size_t)(row0 + ai * HALF + m * 16) * ldc + col0;
#pragma unroll
                for (int bj = 0; bj < 2; ++bj)
#pragma unroll
                    for (int n = 0; n < 2; ++n) { const f32x4 r = *(const f32x4*)(R + off + bj * HALF + n * 16); *(f32x4*)(C + off + bj * HALF + n * 16) = acc[ai][bj][m][n] + r; } }
    }
};

__device__ __forceinline__ unsigned f2key(float f) { const unsigned u = __builtin_bit_cast(unsigned, f); return (u & 0x80000000u) ? ~u : (u | 0x80000000u); }
__device__ __forceinline__ float key2f(unsigned k) { const unsigned u = (k & 0x80000000u) ? (k & 0x7fffffffu) : ~k; return __builtin_bit_cast(float, u); }
__device__ __forceinline__ unsigned umax_(unsigned a, unsigned b) { return a > b ? a : b; }
__device__ __forceinline__ unsigned umin_(unsigned a, unsigned b) { return a < b ? a : b; }
__device__ __forceinline__ void sort16_desc(unsigned (&v)[16]) {
#pragma unroll
    for (int k = 2; k <= 16; k <<= 1)
#pragma unroll
        for (int j = k >> 1; j > 0; j >>= 1)
#pragma unroll
            for (int i = 0; i < 16; ++i) { const int l = i ^ j; if (l > i) { const unsigned hi = umax_(v[i], v[l]), lo = umin_(v[i], v[l]); if ((i & k) == 0) { v[i] = hi; v[l] = lo; } else { v[i] = lo; v[l] = hi; } } }
}
__device__ __forceinline__ void bmerge16_desc(unsigned (&v)[16]) {
#pragma unroll
    for (int j = 8; j > 0; j >>= 1)
#pragma unroll
        for (int i = 0; i < 16; ++i) { const int l = i ^ j; if (l > i) { const unsigned hi = umax_(v[i], v[l]), lo = umin_(v[i], v[l]); v[i] = hi; v[l] = lo; } }
}
struct EpiTopK {
    static constexpr bool PERM = false, AFTER_DRAIN = true;
    int* EIDX; float* GATE;
    __device__ __forceinline__ void fused(f32x4 (&acc)[2][2][4][2], const Unit& u, int wr, int wc, int fr, int fq, PG8_LAS unsigned char* lds, int wid, int lane) const {
        PG8_LAS unsigned* T = (PG8_LAS unsigned*)lds;
        PG8_LAS unsigned* LB = (PG8_LAS unsigned*)(lds + 131072);
        const int h = u.pn;
#pragma unroll
        for (int ai = 0; ai < 2; ++ai) {
            const int rl = wr * 64 + fr;
#pragma unroll
            for (int bj = 0; bj < 2; ++bj)
#pragma unroll
                for (int m = 0; m < 4; ++m)
#pragma unroll
                    for (int n = 0; n < 2; ++n)
#pragma unroll
                        for (int i = 0; i < 4; ++i) {
                            const int c = bj * 128 + wc * 32 + n * 16 + fq * 4 + i;
                            const float v = acc[ai][bj][m][n][i];
                            T[c * 128 + rl + m * 16] = (f2key(v) & ~127u) | (unsigned)(127 - (c & 127));
                        }
            asm volatile("s_waitcnt lgkmcnt(0)" ::: "memory"); __builtin_amdgcn_s_barrier(); asm volatile("" ::: "memory");
            {
                const int p = wid >> 2, q = (wid >> 1) & 1, r = (wid & 1) * 64 + lane, base = p * 128 + q * 64;
                unsigned run[16], grp[16];
#pragma unroll
                for (int j = 0; j < 16; ++j) run[j] = T[(base + j) * 128 + r];
                sort16_desc(run);
#pragma unroll
                for (int gI = 1; gI < 4; ++gI) {
#pragma unroll
                    for (int j = 0; j < 16; ++j) grp[j] = T[(base + 16 * gI + j) * 128 + r];
                    sort16_desc(grp);
#pragma unroll
                    for (int j = 0; j < 16; ++j) run[j] = umax_(run[j], grp[15 - j]);
                    bmerge16_desc(run);
                }
#pragma unroll
                for (int j = 0; j < 16; ++j) LB[((p * 2 + q) * 16 + j) * 128 + r] = run[j];
            }
            asm volatile("s_waitcnt lgkmcnt(0)" ::: "memory"); __builtin_amdgcn_s_barrier(); asm volatile("" ::: "memory");
            if (wid < 4) {
                const int p = wid >> 1, r = (wid & 1) * 64 + lane;
                unsigned a[16];
#pragma unroll
                for (int j = 0; j < 16; ++j) a[j] = umax_(LB[((p * 2) * 16 + j) * 128 + r], LB[((p * 2 + 1) * 16 + (15 - j)) * 128 + r]);
                bmerge16_desc(a);
#pragma unroll
                for (int j = 0; j < 16; ++j) LB[((p * 2) * 16 + j) * 128 + r] = a[j];
            }
            asm volatile("s_waitcnt lgkmcnt(0)" ::: "memory"); __builtin_amdgcn_s_barrier(); asm volatile("" ::: "memory");
            if (wid < 2) {
                const int r = wid * 64 + lane;
                float v1[16], v2[16];
#pragma unroll
                for (int j = 0; j < 16; ++j) { v1[j] = key2f(LB[j * 128 + r] & ~127u); v2[j] = key2f(LB[(32 + j) * 128 + r] & ~127u); }
                unsigned lst[16];
#pragma unroll
                for (int j = 0; j < 16; ++j) lst[j] = (f2key(v1[0] + v2[j]) & ~255u) | (unsigned)(255 - j);
#pragma unroll
                for (int i = 1; i < 16; ++i)
#pragma unroll
                    for (int j = 0; j < 16; ++j) if ((i + 1) * (j + 1) <= 16) {
                        unsigned x = (f2key(v1[i] + v2[j]) & ~255u) | (unsigned)(255 - (i * 16 + j));
#pragma unroll
                        for (int t = 0; t < 16; ++t) if (t >= (i + 1) * (j + 1) - 1) { const unsigned hi = umax_(lst[t], x); x = umin_(lst[t], x); lst[t] = hi; }
                    }
                float e[16]; float sum = 0.f; const float mx = key2f(lst[0] & ~255u);
                int ex[16];
#pragma unroll
                for (int t = 0; t < 16; ++t) {
                    e[t] = __expf(key2f(lst[t] & ~255u) - mx); sum += e[t];
                    const int ci = 255 - (int)(lst[t] & 255u), a = ci >> 4, b = ci & 15;
                    const int i1 = 127 - (int)(LB[a * 128 + r] & 127u), i2 = 127 - (int)(LB[(32 + b) * 128 + r] & 127u);
                    ex[t] = i1 * 128 + i2;
                }
                const float inv = 1.f / sum;
                const size_t o = (size_t)(u.pm * BM + ai * 128 + r) * 128 + h * 16;
#pragma unroll
                for (int t4 = 0; t4 < 4; ++t4) {
                    *(f32x4*)(GATE + o + 4 * t4) = (f32x4){e[4 * t4] * inv, e[4 * t4 + 1] * inv, e[4 * t4 + 2] * inv, e[4 * t4 + 3] * inv};
                    *(u32x4*)(EIDX + o + 4 * t4) = (u32x4){(unsigned)ex[4 * t4], (unsigned)ex[4 * t4 + 1], (unsigned)ex[4 * t4 + 2], (unsigned)ex[4 * t4 + 3]};
                }
            }
            asm volatile("s_waitcnt lgkmcnt(0)" ::: "memory"); __builtin_amdgcn_s_barrier(); asm volatile("" ::: "memory");
        }
    }
};
struct OneUnit {
    Unit u;
    __device__ __forceinline__ bool next(int i, Unit& o) const { if (i) return false; o = u; return true; }
    __device__ __forceinline__ void a_ready(const Unit&) const {}
    __device__ __forceinline__ void done(const Unit&) const {}
};

template <class Epi, class Sched, bool ALIGN_EPI = false, bool SP2 = false>
__device__ __forceinline__ void gemm_phase(PG8_LAS unsigned char* lds, const Gemm g, const Sched& S, const Epi& E) {
    const int tid = threadIdx.x, wid = __builtin_amdgcn_readfirstlane(tid >> 6), lane = tid & 63, wr = wid >> 2, wc = wid & 3, fr = lane & 15, fq = lane >> 4;
    const int K = g.K, nt = K / BK;
    unsigned voffA[2], voffB[2];
#pragma unroll
    for (int i = 0; i < 2; ++i) { int R, C; stage_rc(tid * 16 + i * 8192, R, C); const int Rb = Epi::PERM ? ((R & ~31) + perm32(R & 31)) : R;
        voffA[i] = (unsigned)(R * K + C) * 2u; voffB[i] = (unsigned)(Rb * K + C) * 2u; }
    const size_t kstep = (size_t)(BK * 2);
    const size_t hstep = (size_t)HALF * K * 2;
    const size_t tstep = 2 * hstep;
    const unsigned ldsw = (unsigned)wid * 1024u;
    const int aoff = lds_byte(wr * 64 + fr, fq * 8), boff = lds_byte(wc * 32 + fr, fq * 8);
#define PG8_SA(b, h) (((b) * 2 + (h)) * HTB)
#define PG8_SB(b, h) ((4 + (b) * 2 + (h)) * HTB)
#define PG8_STAGE(bufoff, gbase, voff) do { _Pragma("unroll") for (int _i = 0; _i < 2; ++_i) \
        __builtin_amdgcn_global_load_lds((const unsigned*)((const char*)(gbase) + (voff)[_i]), (PG8_LAS unsigned*)(lds + (bufoff) + ldsw + _i * 8192), 16, 0, 0); } while (0)
#define PG8_LDA(dst, b, h) do { _Pragma("unroll") for (int m = 0; m < 4; ++m) _Pragma("unroll") for (int k = 0; k < 2; ++k) dst[m][k] = *(const PG8_LAS bf16x8*)(lds + PG8_SA(b, h) + aoff + m * 2048 + k * 1024); } while (0)
#define PG8_LDB(dst, b, h) do { _Pragma("unroll") for (int n = 0; n < 2; ++n) _Pragma("unroll") for (int k = 0; k < 2; ++k) dst[n][k] = *(const PG8_LAS bf16x8*)(lds + PG8_SB(b, h) + boff + n * 2048 + k * 1024); } while (0)
#define PG8_MMA(ai, bj, At, Bt) do { __builtin_amdgcn_s_setprio(1); _Pragma("unroll") for (int m = 0; m < 4; ++m) _Pragma("unroll") for (int n = 0; n < 2; ++n) _Pragma("unroll") for (int k = 0; k < 2; ++k) \
        acc[ai][bj][m][n] = __builtin_amdgcn_mfma_f32_16x16x32_bf16(Bt[n][k], At[m][k], acc[ai][bj][m][n], 0, 0, 0); __builtin_amdgcn_s_setprio(0); } while (0)
#define PG8_WAIT_V(n) asm volatile("s_waitcnt vmcnt(" #n ")" ::: "memory")
#define PG8_WAIT_L(n) asm volatile("s_waitcnt lgkmcnt(" #n ")" ::: "memory")
#define PG8_BAR __builtin_amdgcn_s_barrier()
#define PG8_SCHED __builtin_amdgcn_sched_barrier(0)
    Unit cur, nxt; int ui = 0;
    if (!S.next(0, cur)) return;
    f32x4 acc[2][2][4][2];
#pragma unroll
    for (int a = 0; a < 2; ++a)
#pragma unroll
        for (int b = 0; b < 2; ++b)
#pragma unroll
            for (int m = 0; m < 4; ++m)
#pragma unroll
                for (int n = 0; n < 2; ++n) acc[a][b][m][n] = (f32x4){0.f, 0.f, 0.f, 0.f};
    bf16x8 At[4][2], B0[2][2], B1[2][2];
    const char* cA = (const char*)g.A + (size_t)cur.pm * tstep; const char* cB = (const char*)g.Bt + (size_t)cur.pn * tstep;
    S.a_ready(cur);
    if constexpr (SP2) {
        PG8_STAGE(PG8_SB(0, 0), cB, voffB); PG8_STAGE(PG8_SB(0, 1), cB + hstep, voffB); PG8_STAGE(PG8_SA(0, 0), cA, voffA); PG8_STAGE(PG8_SA(0, 1), cA + hstep, voffA);
        if (wr == 1) PG8_BAR;
        PG8_WAIT_V(2); PG8_BAR;
        PG8_STAGE(PG8_SB(1, 0), cB + kstep, voffB); PG8_STAGE(PG8_SA(1, 0), cA + kstep, voffA); PG8_STAGE(PG8_SB(1, 1), cB + hstep + kstep, voffB);
        PG8_WAIT_V(6); PG8_BAR;
    } else {
        PG8_STAGE(PG8_SB(0, 0), cB, voffB); PG8_STAGE(PG8_SA(0, 0), cA, voffA); PG8_STAGE(PG8_SB(0, 1), cB + hstep, voffB); PG8_STAGE(PG8_SA(0, 1), cA + hstep, voffA);
        if (wr == 1) PG8_BAR;
        PG8_WAIT_V(4); PG8_BAR;
        PG8_STAGE(PG8_SB(1, 0), cB + kstep, voffB); PG8_STAGE(PG8_SA(1, 0), cA + kstep, voffA); PG8_STAGE(PG8_SB(1, 1), cB + hstep + kstep, voffB);
        PG8_WAIT_V(6); PG8_BAR;
    }
    for (;;) {
        const bool has_next = S.next(ui + 1, nxt);
        const char* nA = has_next ? (const char*)g.A + (size_t)nxt.pm * tstep : cA; const char* nB = has_next ? (const char*)g.Bt + (size_t)nxt.pn * tstep : cB;
        for (int t = 0; t < nt; t += 2) {
            const bool last = (t == nt - 2);
            const char* a1 = cA + (size_t)(t + 1) * kstep;
            const char* a2 = last ? nA : cA + (size_t)(t + 2) * kstep; const char* b2 = last ? nB : cB + (size_t)(t + 2) * kstep;
            const char* a3 = a2 + kstep; const char* b3 = b2 + kstep;
            if (last && has_next) S.a_ready(nxt);
            if constexpr (SP2) {
            PG8_LDB(B0, 0, 0); PG8_LDB(B1, 0, 1); PG8_SCHED; PG8_LDA(At, 0, 0); PG8_STAGE(PG8_SA(1, 1), a1 + hstep, voffA);
            PG8_WAIT_V(8); PG8_WAIT_L(0); PG8_BAR; PG8_MMA(0, 0, At, B0); PG8_MMA(0, 1, At, B1); PG8_BAR; PG8_SCHED;
            PG8_LDA(At, 0, 1); PG8_STAGE(PG8_SB(0, 0), b2, voffB); PG8_STAGE(PG8_SB(0, 1), b2 + hstep, voffB); PG8_STAGE(PG8_SA(0, 0), a2, voffA);
            PG8_WAIT_V(8); PG8_WAIT_L(0); PG8_BAR; PG8_MMA(1, 0, At, B0); PG8_MMA(1, 1, At, B1); PG8_BAR; PG8_SCHED;
            PG8_LDB(B0, 1, 0); PG8_LDB(B1, 1, 1); PG8_SCHED; PG8_LDA(At, 1, 0); PG8_STAGE(PG8_SA(0, 1), a2 + hstep, voffA);
            PG8_WAIT_V(8); PG8_WAIT_L(0); PG8_BAR; PG8_MMA(0, 0, At, B0); PG8_MMA(0, 1, At, B1); PG8_BAR; PG8_SCHED;
            PG8_LDA(At, 1, 1); PG8_STAGE(PG8_SB(1, 0), b3, voffB); PG8_STAGE(PG8_SB(1, 1), b3 + hstep, voffB); PG8_STAGE(PG8_SA(1, 0), a3, voffA);
            PG8_WAIT_V(8); PG8_WAIT_L(0); PG8_BAR; PG8_MMA(1, 0, At, B0); PG8_MMA(1, 1, At, B1); PG8_BAR; PG8_SCHED;
            } else {
            PG8_LDB(B0, 0, 0); PG8_SCHED; PG8_LDA(At, 0, 0); PG8_STAGE(PG8_SA(1, 1), a1 + hstep, voffA);
            PG8_WAIT_L(8); PG8_BAR; PG8_WAIT_L(0); PG8_MMA(0, 0, At, B0); PG8_BAR; PG8_SCHED;
            PG8_LDB(B1, 0, 1); PG8_STAGE(PG8_SB(0, 0), b2, voffB);
            PG8_BAR; PG8_WAIT_L(0); PG8_MMA(0, 1, At, B1); PG8_BAR;
            PG8_LDA(At, 0, 1); PG8_STAGE(PG8_SA(0, 0), a2, voffA);
            PG8_BAR; PG8_WAIT_L(0); PG8_MMA(1, 0, At, B0); PG8_BAR; PG8_SCHED;
            PG8_STAGE(PG8_SB(0, 1), b2 + hstep, voffB);
            PG8_WAIT_V(6); PG8_BAR; PG8_MMA(1, 1, At, B1); PG8_BAR;
            PG8_LDB(B0, 1, 0); PG8_SCHED; PG8_LDA(At, 1, 0); PG8_STAGE(PG8_SA(0, 1), a2 + hstep, voffA);
            PG8_WAIT_L(8); PG8_BAR; PG8_WAIT_L(0); PG8_MMA(0, 0, At, B0); PG8_BAR; PG8_SCHED;
            PG8_LDB(B1, 1, 1); PG8_STAGE(PG8_SB(1, 0), b3, voffB);
            PG8_BAR; PG8_WAIT_L(0); PG8_MMA(0, 1, At, B1); PG8_BAR;
            PG8_LDA(At, 1, 1); PG8_STAGE(PG8_SA(1, 0), a3, voffA);
            PG8_BAR; PG8_WAIT_L(0); PG8_MMA(1, 0, At, B0); PG8_BAR; PG8_SCHED;
            PG8_STAGE(PG8_SB(1, 1), b3 + hstep, voffB);
            PG8_WAIT_V(6); PG8_BAR; PG8_MMA(1, 1, At, B1); PG8_BAR;
            }
        }
        if constexpr (ALIGN_EPI) { if (wr == 0) PG8_BAR; }
        if constexpr (!Epi::AFTER_DRAIN) { E(acc, cur, wr, wc, fr, fq); S.done(cur); }
        if (!has_next) break;
#pragma unroll
        for (int a = 0; a < 2; ++a)
#pragma unroll
            for (int b = 0; b < 2; ++b)
#pragma unroll
                for (int m = 0; m < 4; ++m)
#pragma unroll
                    for (int n = 0; n < 2; ++n) acc[a][b][m][n] = (f32x4){0.f, 0.f, 0.f, 0.f};
        cur = nxt; cA = nA; cB = nB; ++ui;
        if constexpr (ALIGN_EPI) { if (wr == 1) PG8_BAR; }
    }
    PG8_WAIT_V(0);
    if constexpr (!ALIGN_EPI) { if (wr == 0) PG8_BAR; }
    PG8_BAR;
    if constexpr (Epi::AFTER_DRAIN) { E.fused(acc, cur, wr, wc, fr, fq, lds, wid, lane); S.done(cur); }
#undef PG8_SA
#undef PG8_SB
#undef PG8_STAGE
#undef PG8_LDA
#undef PG8_LDB
#undef PG8_MMA
#undef PG8_WAIT_V
#undef PG8_WAIT_L
#undef PG8_BAR
#undef PG8_SCHED
}
}

namespace mk {
using pg8::bf16_t; using pg8::bf16x8; using pg8::f32x4; using pg8::u32x4; using pg8::cvt_pk_bf16; using pg8::fsigmoid;
#define LAS __attribute__((address_space(3)))
typedef unsigned u32x2 __attribute__((ext_vector_type(2)));
typedef float f32x2 __attribute__((ext_vector_type(2)));
typedef short bf16x4 __attribute__((ext_vector_type(4)));
constexpr int NWAVES = 8, NT = 512;
constexpr int D = 1024, BATCH = 8, SEQ = 4096, M = BATCH * SEQ, DCONV = 512, CW = 31, DH = 512, NH = 4, HD = 128, DIN = 3072, NQ = 2048, NEXP = 16384;
constexpr int SEGS = 8, SEGLEN = SEQ / SEGS, NCH = SEGLEN / 64;
constexpr float EPS = 1e-6f;
constexpr size_t MiB = 1u << 20;
constexpr size_t WS_WIN = 2 * MiB, WS_WOUT = 8 * MiB, WS_WEFF = 10 * MiB, WS_HS = 14 * MiB, WS_HLD = 30 * MiB, WS_U = 32 * MiB, WS_V = 64 * MiB, WS_XN = 96 * MiB,
                 WS_GLU = 160 * MiB, WS_HG = 192 * MiB, WS_Y = 320 * MiB, WS_EIDX = 416 * MiB, WS_GATE = 432 * MiB, WS_END = 448 * MiB;
constexpr int LDS_BYTES = 163840;

#define LDS_WAIT() asm volatile("s_waitcnt lgkmcnt(0)" ::: "memory")
#define BLOCK_BAR() do { asm volatile("s_waitcnt lgkmcnt(0)" ::: "memory"); __builtin_amdgcn_s_barrier(); asm volatile("" ::: "memory"); } while (0)
__device__ __forceinline__ float wave_sum(float v) {
#pragma unroll
    for (int o = 1; o < 64; o <<= 1) v += __shfl_xor(v, o);
    return v;
}
__device__ __forceinline__ float bf_lo(unsigned u) { return __builtin_bit_cast(float, u << 16); }
__device__ __forceinline__ float bf_hi(unsigned u) { return __builtin_bit_cast(float, u & 0xffff0000u); }
__device__ __forceinline__ float bf1(bf16_t u) { return __builtin_bit_cast(float, (unsigned)u << 16); }
__device__ __forceinline__ float fsilu(float x) { return x * fsigmoid(x); }

struct Args { const float* in[16]; float* out; unsigned char* ws; int ph_lo, ph_hi; };

__device__ __forceinline__ void p0_transpose_item(const float* __restrict__ W, int K, int N, bf16_t* __restrict__ WT, int out_row0, const float* __restrict__ gk, LAS float* scr, int k0, int n0, int lane) {
#pragma unroll 8
    for (int i = 0; i < 32; ++i) { const int kk = 2 * i + (lane >> 5); const float s = gk ? gk[k0 + kk] : 1.f; scr[kk * 33 + (lane & 31)] = W[(size_t)(k0 + kk) * N + n0 + (lane & 31)] * s; }
    LDS_WAIT();
    const int c = lane & 7;
#pragma unroll
    for (int j = 0; j < 4; ++j) { const int n = (lane >> 3) + 8 * j; const LAS float* s = scr + (8 * c) * 33 + n;
        u32x4 o; o.x = cvt_pk_bf16(s[0 * 33], s[1 * 33]); o.y = cvt_pk_bf16(s[2 * 33], s[3 * 33]); o.z = cvt_pk_bf16(s[4 * 33], s[5 * 33]); o.w = cvt_pk_bf16(s[6 * 33], s[7 * 33]);
        *(u32x4*)(WT + (size_t)(out_row0 + n) * K + k0 + 8 * c) = o; }
    LDS_WAIT();
}
__device__ __forceinline__ void row_to_bf16(const float* __restrict__ src, bf16_t* __restrict__ dst, const float* __restrict__ gv, bool norm, int lane) {
    const f32x4* xr = (const f32x4*)src + lane;
    f32x4 v[4]; float s = 0.f;
#pragma unroll
    for (int j = 0; j < 4; ++j) { v[j] = xr[64 * j]; s += (v[j].x * v[j].x + v[j].y * v[j].y) + (v[j].z * v[j].z + v[j].w * v[j].w); }
    float r = 1.f;
    if (norm) r = rsqrtf(wave_sum(s) * (1.f / D) + EPS);
    u32x2* o8 = (u32x2*)dst + lane;
#pragma unroll
    for (int j = 0; j < 4; ++j) {
        f32x4 t = v[j] * r;
        if (gv) t = t * ((const f32x4*)gv)[lane + 64 * j];
        u32x2 w; w.x = cvt_pk_bf16(t.x, t.y); w.y = cvt_pk_bf16(t.z, t.w); o8[64 * j] = w;
    }
}
__device__ __forceinline__ void weff_unit(LAS unsigned char* lds, const float* __restrict__ wq, const float* __restrict__ sk, const float* __restrict__ g2, bf16_t* __restrict__ WE, int unit, int tid) {
    LAS float* SK = (LAS float*)lds;
    LAS float* WQ = (LAS float*)(lds + 128 * 129 * 4);
    const int hp = unit >> 5, d0 = (unit & 31) * 32;
#pragma unroll 4
    for (int i = 0; i < 32; ++i) { const int idx = tid + i * NT; SK[(idx >> 7) * 129 + (idx & 127)] = sk[(size_t)hp * 16384 + idx]; }
#pragma unroll
    for (int i = 0; i < 8; ++i) { const int idx = tid + i * NT; WQ[idx] = wq[(size_t)(d0 + (idx >> 7)) * NQ + hp * 128 + (idx & 127)]; }
    __syncthreads();
    const int n = tid & 127, dq = tid >> 7;
    float acc[8];
#pragma unroll
    for (int e = 0; e < 8; ++e) acc[e] = 0.f;
    for (int j4 = 0; j4 < 32; ++j4) {
        float s[4];
#pragma unroll
        for (int q = 0; q < 4; ++q) s[q] = SK[n * 129 + 4 * j4 + q];
#pragma unroll
        for (int e = 0; e < 8; ++e) { const f32x4 w = *(const LAS f32x4*)(WQ + (dq * 8 + e) * 128 + 4 * j4); acc[e] = fmaf(s[0], w.x, acc[e]); acc[e] = fmaf(s[1], w.y, acc[e]); acc[e] = fmaf(s[2], w.z, acc[e]); acc[e] = fmaf(s[3], w.w, acc[e]); }
    }
    const float* gp = g2 + d0 + dq * 8;
    u32x4 o; o.x = cvt_pk_bf16(acc[0] * gp[0], acc[1] * gp[1]); o.y = cvt_pk_bf16(acc[2] * gp[2], acc[3] * gp[3]); o.z = cvt_pk_bf16(acc[4] * gp[4], acc[5] * gp[5]); o.w = cvt_pk_bf16(acc[6] * gp[6], acc[7] * gp[7]);
    *(u32x4*)(WE + (size_t)(hp * 128 + n) * D + d0 + dq * 8) = o;
    __syncthreads();
}
__device__ __forceinline__ void p0_prologue(const Args& a, LAS unsigned char* lds, int tid, int lane, int wave, int G) {
    unsigned char* ws = a.ws;
    for (int u = blockIdx.x; u < 512; u += G) weff_unit(lds, a.in[11], a.in[12], a.in[10], (bf16_t*)(ws + WS_WEFF), u, tid);
    LAS float* scr = (LAS float*)(lds + wave * 16384);
    const int gw = blockIdx.x * NWAVES + wave, NGW = G * NWAVES;
    constexpr int I_IN = (D / 64) * (DIN / 32), I_OUT = (D / 64) * (D / 32);
    for (int it = gw; it < I_IN + I_OUT; it += NGW) {
        if (it < I_IN) {
            const int kb = it / (DIN / 32), nb = it % (DIN / 32), n0 = nb * 32;
            int r0;
            if (n0 < 512) r0 = 256 * (n0 >> 7) + (n0 & 127); else if (n0 < 1024) r0 = 256 * ((n0 - 512) >> 7) + 128 + ((n0 - 512) & 127); else r0 = n0;
            p0_transpose_item(a.in[2], D, DIN, (bf16_t*)(ws + WS_WIN), r0, a.in[1], scr, kb * 64, n0, lane);
        } else {
            const int r = it - I_IN, kb = r / (D / 32), nb = r % (D / 32);
            p0_transpose_item(a.in[9], D, D, (bf16_t*)(ws + WS_WOUT), nb * 32, nullptr, scr, kb * 64, nb * 32, lane);
        }
    }
    for (int r = gw; r < 2 * NEXP + M; r += NGW) {
        if (r < NEXP) row_to_bf16(a.in[13] + (size_t)r * D, (bf16_t*)(ws + WS_U) + (size_t)r * D, a.in[10], false, lane);
        else if (r < 2 * NEXP) row_to_bf16(a.in[14] + (size_t)(r - NEXP) * D, (bf16_t*)(ws + WS_V) + (size_t)(r - NEXP) * D, nullptr, false, lane);
        else row_to_bf16(a.in[0] + (size_t)(r - 2 * NEXP) * D, (bf16_t*)(ws + WS_XN) + (size_t)(r - 2 * NEXP) * D, nullptr, true, lane);
    }
}

__device__ __forceinline__ void conv_wave_unit(const bf16_t* __restrict__ GLU, const float* __restrict__ cw, const float* __restrict__ cb, const float* __restrict__ ng, const float* __restrict__ nb,
                                               bf16_t* __restrict__ Y, int wu, int lane) {
    const int grp = wu & 7, tb = wu >> 3, b = tb >> 5, s0 = (tb & 31) * 128, c = grp * 64 + lane;
    float w[CW];
#pragma unroll
    for (int j = 0; j < CW; ++j) w[j] = cw[j * DCONV + c];
    const float bias = cb[c], gam = ng[c], bet = nb[c];
    const size_t rowb = (size_t)b * SEQ;
    float win[38];
#pragma unroll
    for (int i = 0; i < 30; ++i) { const int s = s0 - 30 + i; win[i] = (s >= 0) ? bf1(GLU[(rowb + s) * DCONV + c]) : 0.f; }
#pragma unroll 1
    for (int it = 0; it < 16; ++it) {
        const int s = s0 + it * 8;
#pragma unroll
        for (int i = 0; i < 8; ++i) win[30 + i] = bf1(GLU[(rowb + s + i) * DCONV + c]);
#pragma unroll
        for (int i = 0; i < 8; ++i) {
            float acc = bias;
#pragma unroll
            for (int j = 0; j < CW; ++j) acc = fmaf(w[j], win[i + j], acc);
            const float mu = wave_sum(acc) * (1.f / 64.f), d = acc - mu, var = wave_sum(d * d) * (1.f / 64.f);
            const float hn = d * rsqrtf(var + EPS) * gam + bet;
            Y[(rowb + s + i) * D + c] = (bf16_t)(cvt_pk_bf16(fsilu(hn), 0.f) & 0xffffu);
        }
#pragma unroll
        for (int i = 0; i < 30; ++i) win[i] = win[i + 8];
    }
}

constexpr int HQ_OFF = 0, HK_OFF = 17408, HKH_OFF = 34816, HV_OFF = 53248, HP_OFF = 71680, HDC_OFF = 80896, HTOT_OFF = 81408, HO_OFF = 85504;
template <bool P3>
__device__ __forceinline__ void hgrn_unit(LAS unsigned char* lds, int unit, const bf16_t* __restrict__ HG, const float* __restrict__ lbl, const float* __restrict__ hng, float* __restrict__ HS, float* __restrict__ HLD,
                                          bf16_t* __restrict__ Y, int tid, int lane, int w) {
    const int seg = unit & (SEGS - 1), bh = unit >> 3, h = bh & 3, b = bh >> 2;
    const int g = lane >> 4, fr = lane & 15, kp = lane;
    const int c0 = h * HD + 2 * kp;
    const float lb0 = __builtin_amdgcn_rcpf(1.f + __expf(lbl[DH + c0] - lbl[c0])), lb1 = __builtin_amdgcn_rcpf(1.f + __expf(lbl[DH + c0 + 1] - lbl[c0 + 1]));
    f32x4 S[8];
#pragma unroll
    for (int i = 0; i < 8; ++i) S[i] = (f32x4){0.f, 0.f, 0.f, 0.f};
    if (P3) {
        for (int i = 0; i < seg; ++i) {
            const float* sp = HS + (size_t)(bh * SEGS + i) * 16384 + w * 2048 + lane;
            const float* ld = HLD + (size_t)(bh * SEGS + i) * 128 + 4 * g;
#pragma unroll
            for (int t = 0; t < 8; ++t) { const f32x4 dd = *(const f32x4*)(ld + 16 * t);
#pragma unroll
                for (int r = 0; r < 4; ++r) S[t][r] = fmaf(__expf(dd[r]), S[t][r], sp[(t * 4 + r) * 64]); }
        }
    }
    float ldsum0 = 0.f, ldsum1 = 0.f;
    const size_t row_base = (size_t)b * SEQ + (size_t)seg * SEGLEN;
    const unsigned* HGw = (const unsigned*)HG;
    unsigned zq[8], qq[8], vq[8];
#define HG_LOAD(c) do { _Pragma("unroll") for (int i = 0; i < 8; ++i) { const size_t ro = (row_base + (c) * 64 + 8 * w + i) * 1024 + (h * 64 + kp); \
        zq[i] = HGw[ro + 256]; vq[i] = HGw[ro + 512]; if (P3) qq[i] = HGw[ro]; } } while (0)
    HG_LOAD(0);
    float gn[16];
    const int nt_t = tid >> 3, nt_v = (tid & 7) * 16;
    if (P3) {
#pragma unroll
        for (int e = 0; e < 16; ++e) gn[e] = hng[h * HD + nt_v + e];
    }
#pragma unroll 1
    for (int c = 0; c < NCH; ++c) {
        float cs0[8], cs1[8], kk0[8], kk1[8];
        float cum0 = 0.f, cum1 = 0.f;
#pragma unroll
        for (int i = 0; i < 8; ++i) {
            const float sg0 = fsigmoid(bf_lo(zq[i])), sg1 = fsigmoid(bf_hi(zq[i]));
            cum0 += __logf(lb0 + (1.f - lb0) * sg0); cum1 += __logf(lb1 + (1.f - lb1) * sg1);
            cs0[i] = cum0; cs1[i] = cum1; kk0[i] = (1.f - lb0) * (1.f - sg0); kk1[i] = (1.f - lb1) * (1.f - sg1);
        }
        LAS float* tot = (LAS float*)(lds + HTOT_OFF);
        *(LAS f32x2*)(tot + w * 128 + 2 * kp) = (f32x2){cum0, cum1};
        BLOCK_BAR();
        float off0 = 0.f, off1 = 0.f, all0 = 0.f, all1 = 0.f;
#pragma unroll
        for (int ww = 0; ww < 8; ++ww) { const f32x2 tt = *(const LAS f32x2*)(tot + ww * 128 + 2 * kp); if (ww < w) { off0 += tt.x; off1 += tt.y; } all0 += tt.x; all1 += tt.y; }
        ldsum0 += all0; ldsum1 += all1;
        unsigned kh0[4], kh1[4], vt0[4], vt1[4];
#pragma unroll
        for (int i = 0; i < 8; i += 2) {
            float a0[2], a1[2];
#pragma unroll
            for (int e = 0; e < 2; ++e) {
                const float B0 = off0 + cs0[i + e], B1 = off1 + cs1[i + e];
                if (P3) {
                    const float q0 = bf_lo(qq[i + e]) * __expf(B0), q1 = bf_hi(qq[i + e]) * __expf(B1);
                    const float k0 = kk0[i + e] * __expf(-B0), k1 = kk1[i + e] * __expf(-B1);
                    *(LAS unsigned*)(lds + HQ_OFF + (8 * w + i + e) * 272 + 4 * kp) = cvt_pk_bf16(q0, q1);
                    *(LAS unsigned*)(lds + HK_OFF + (8 * w + i + e) * 272 + 4 * kp) = cvt_pk_bf16(k0, k1);
                }
                a0[e] = kk0[i + e] * __expf(all0 - B0); a1[e] = kk1[i + e] * __expf(all1 - B1);
            }
            kh0[i >> 1] = cvt_pk_bf16(a0[0], a0[1]); kh1[i >> 1] = cvt_pk_bf16(a1[0], a1[1]);
            vt0[i >> 1] = (vq[i] & 0xffffu) | (vq[i + 1] << 16); vt1[i >> 1] = (vq[i] >> 16) | (vq[i + 1] & 0xffff0000u);
        }
        *(LAS u32x4*)(lds + HKH_OFF + (2 * kp) * 144 + 16 * w) = (u32x4){kh0[0], kh0[1], kh0[2], kh0[3]};
        *(LAS u32x4*)(lds + HKH_OFF + (2 * kp + 1) * 144 + 16 * w) = (u32x4){kh1[0], kh1[1], kh1[2], kh1[3]};
        *(LAS u32x4*)(lds + HV_OFF + (2 * kp) * 144 + 16 * w) = (u32x4){vt0[0], vt0[1], vt0[2], vt0[3]};
        *(LAS u32x4*)(lds + HV_OFF + (2 * kp + 1) * 144 + 16 * w) = (u32x4){vt1[0], vt1[1], vt1[2], vt1[3]};
        if (w == 0) *(LAS f32x2*)(lds + HDC_OFF + 8 * kp) = (f32x2){__expf(all0), __expf(all1)};
        BLOCK_BAR();
        if (c + 1 < NCH) HG_LOAD(c + 1);
        bf16x8 vfrag[2];
#pragma unroll
        for (int ks = 0; ks < 2; ++ks) vfrag[ks] = *(const LAS bf16x8*)(lds + HV_OFF + (16 * w + fr) * 144 + 64 * ks + 16 * g);
        if (P3) {
            u32x4 gq[2];
            { const u32x4* gp = (const u32x4*)(HG + (row_base + c * 64 + nt_t) * 2048 + 1536 + h * HD + nt_v); gq[0] = gp[0]; gq[1] = gp[1]; }
            {
                const int mt = w >> 1;
#pragma unroll
                for (int nti = 0; nti < 2; ++nti) {
                    const int nt = 2 * (w & 1) + nti;
                    f32x4 p = (f32x4){0.f, 0.f, 0.f, 0.f};
                    if (nt <= mt) {
#pragma unroll
                        for (int ks = 0; ks < 4; ++ks) {
                            const bf16x8 af = *(const LAS bf16x8*)(lds + HQ_OFF + (16 * mt + fr) * 272 + 64 * ks + 16 * g);
                            const bf16x8 bf = *(const LAS bf16x8*)(lds + HK_OFF + (16 * nt + fr) * 272 + 64 * ks + 16 * g);
                            p = __builtin_amdgcn_mfma_f32_16x16x32_bf16(af, bf, p, 0, 0, 0);
                        }
                    }
#pragma unroll
                    for (int r = 0; r < 4; ++r) {
                        const int t = 16 * mt + 4 * g + r, s = 16 * nt + fr;
                        const float pv = (s <= t) ? p[r] : 0.f;
                        *(LAS bf16_t*)(lds + HP_OFF + t * 144 + 2 * s) = (bf16_t)(cvt_pk_bf16(pv, 0.f) & 0xffffu);
                    }
                }
            }
            BLOCK_BAR();
            f32x4 o[4];
#pragma unroll
            for (int mt = 0; mt < 4; ++mt) o[mt] = (f32x4){0.f, 0.f, 0.f, 0.f};
#pragma unroll
            for (int ks = 0; ks < 4; ++ks) {
                u32x4 sb; sb.x = cvt_pk_bf16(S[2 * ks][0], S[2 * ks][1]); sb.y = cvt_pk_bf16(S[2 * ks][2], S[2 * ks][3]); sb.z = cvt_pk_bf16(S[2 * ks + 1][0], S[2 * ks + 1][1]); sb.w = cvt_pk_bf16(S[2 * ks + 1][2], S[2 * ks + 1][3]);
                const bf16x8 bfrag = __builtin_bit_cast(bf16x8, sb);
#pragma unroll
                for (int mt = 0; mt < 4; ++mt) {
                    const u32x2 alo = *(const LAS u32x2*)(lds + HQ_OFF + (16 * mt + fr) * 272 + 64 * ks + 8 * g);
                    const u32x2 ahi = *(const LAS u32x2*)(lds + HQ_OFF + (16 * mt + fr) * 272 + 64 * ks + 32 + 8 * g);
                    const bf16x8 af = __builtin_bit_cast(bf16x8, (u32x4){alo.x, alo.y, ahi.x, ahi.y});
                    o[mt] = __builtin_amdgcn_mfma_f32_16x16x32_bf16(af, bfrag, o[mt], 0, 0, 0);
                }
            }
#pragma unroll
            for (int ks = 0; ks < 2; ++ks)
#pragma unroll
                for (int mt = 0; mt < 4; ++mt) {
                    const bf16x8 af = *(const LAS bf16x8*)(lds + HP_OFF + (16 * mt + fr) * 144 + 64 * ks + 16 * g);
                    o[mt] = __builtin_amdgcn_mfma_f32_16x16x32_bf16(af, vfrag[ks], o[mt], 0, 0, 0);
                }
#pragma unroll
            for (int mt = 0; mt < 4; ++mt)
#pragma unroll
                for (int r = 0; r < 4; ++r) *(LAS float*)(lds + HO_OFF + ((16 * mt + 4 * g + r) * 132 + 16 * w + fr) * 4) = o[mt][r];
#pragma unroll
            for (int i = 0; i < 8; ++i) {
                const f32x4 dd = *(const LAS f32x4*)(lds + HDC_OFF + (16 * i + 4 * g) * 4);
                S[i] = S[i] * dd;
#pragma unroll
                for (int ks = 0; ks < 2; ++ks) { const bf16x8 af = *(const LAS bf16x8*)(lds + HKH_OFF + (16 * i + fr) * 144 + 64 * ks + 16 * g); S[i] = __builtin_amdgcn_mfma_f32_16x16x32_bf16(af, vfrag[ks], S[i], 0, 0, 0); }
            }
            BLOCK_BAR();
            {
                f32x4 ov[4]; float ss = 0.f;
#pragma unroll
                for (int q = 0; q < 4; ++q) { ov[q] = *(const LAS f32x4*)(lds + HO_OFF + (nt_t * 132 + nt_v + 4 * q) * 4); ss += (ov[q].x * ov[q].x + ov[q].y * ov[q].y) + (ov[q].z * ov[q].z + ov[q].w * ov[q].w); }
                ss += __shfl_xor(ss, 1); ss += __shfl_xor(ss, 2); ss += __shfl_xor(ss, 4);
                const float rs = rsqrtf(ss * (1.f / HD) + EPS);
                u32x4 ow[2];
#pragma unroll
                for (int q = 0; q < 4; ++q) {
                    const unsigned g01 = (q & 1) ? gq[q >> 1].z : gq[q >> 1].x, g23 = (q & 1) ? gq[q >> 1].w : gq[q >> 1].y;
                    const float y0 = ov[q].x * rs * gn[4 * q] * bf_lo(g01), y1 = ov[q].y * rs * gn[4 * q + 1] * bf_hi(g01), y2 = ov[q].z * rs * gn[4 * q + 2] * bf_lo(g23), y3 = ov[q].w * rs * gn[4 * q + 3] * bf_hi(g23);
                    if (q & 1) { ow[q >> 1].z = cvt_pk_bf16(y0, y1); ow[q >> 1].w = cvt_pk_bf16(y2, y3); } else { ow[q >> 1].x = cvt_pk_bf16(y0, y1); ow[q >> 1].y = cvt_pk_bf16(y2, y3); }
                }
                u32x4* yp = (u32x4*)(Y + (row_base + c * 64 + nt_t) * D + DCONV + h * HD + nt_v); yp[0] = ow[0]; yp[1] = ow[1];
            }
        } else {
#pragma unroll
            for (int i = 0; i < 8; ++i) {
                const f32x4 dd = *(const LAS f32x4*)(lds + HDC_OFF + (16 * i + 4 * g) * 4);
                S[i] = S[i] * dd;
#pragma unroll
                for (int ks = 0; ks < 2; ++ks) { const bf16x8 af = *(const LAS bf16x8*)(lds + HKH_OFF + (16 * i + fr) * 144 + 64 * ks + 16 * g); S[i] = __builtin_amdgcn_mfma_f32_16x16x32_bf16(af, vfrag[ks], S[i], 0, 0, 0); }
            }
        }
    }
#undef HG_LOAD
    if (!P3) {
        float* sp = HS + (size_t)unit * 16384 + w * 2048 + lane;
#pragma unroll
        for (int t = 0; t < 8; ++t)
#pragma unroll
            for (int r = 0; r < 4; ++r) sp[(t * 4 + r) * 64] = S[t][r];
        if (w == 0) *(f32x2*)(HLD + (size_t)unit * 128 + 2 * kp) = (f32x2){ldsum0, ldsum1};
    }
    BLOCK_BAR();
}

__device__ __forceinline__ float gelu_erf(float v) { return 0.5f * v * (1.f + erff(v * 0.70710678118654752f)); }
__device__ __forceinline__ void peer_token(int t, const bf16_t* __restrict__ XN2, const int* __restrict__ EIDX, const float* __restrict__ GATE, const bf16_t* __restrict__ Ub, const bf16_t* __restrict__ Vb,
                                           const float* H2, const float* __restrict__ fg, float* out, int lane) {
    float x[16], y[16];
    {
        const u32x4 xa = *((const u32x4*)(XN2 + (size_t)t * D) + lane), xb = *((const u32x4*)(XN2 + (size_t)t * D + 512) + lane);
        x[0] = bf_lo(xa.x); x[1] = bf_hi(xa.x); x[2] = bf_lo(xa.y); x[3] = bf_hi(xa.y); x[4] = bf_lo(xa.z); x[5] = bf_hi(xa.z); x[6] = bf_lo(xa.w); x[7] = bf_hi(xa.w);
        x[8] = bf_lo(xb.x); x[9] = bf_hi(xb.x); x[10] = bf_lo(xb.y); x[11] = bf_hi(xb.y); x[12] = bf_lo(xb.z); x[13] = bf_hi(xb.z); x[14] = bf_lo(xb.w); x[15] = bf_hi(xb.w);
    }
#pragma unroll
    for (int j = 0; j < 16; ++j) y[j] = 0.f;
    const int ev0 = EIDX[(size_t)t * 128 + lane], ev1 = EIDX[(size_t)t * 128 + 64 + lane];
    const float gv0 = GATE[(size_t)t * 128 + lane], gv1 = GATE[(size_t)t * 128 + 64 + lane];
#pragma unroll 1
    for (int eb = 0; eb < 16; ++eb) {
        u32x4 ua[8], ub[8];
        int ei[8]; float gt[8];
#pragma unroll
        for (int i = 0; i < 8; ++i) {
            const int src = (eb & 7) * 8 + i;
            ei[i] = __shfl(eb < 8 ? ev0 : ev1, src); gt[i] = __shfl(eb < 8 ? gv0 : gv1, src);
            const u32x4* up = (const u32x4*)(Ub + (size_t)ei[i] * D);
            ua[i] = up[lane]; ub[i] = up[64 + lane];
        }
        float wgt[8];
#pragma unroll
        for (int i = 0; i < 8; ++i) {
            float d = bf_lo(ua[i].x) * x[0];
            d = fmaf(bf_hi(ua[i].x), x[1], d); d = fmaf(bf_lo(ua[i].y), x[2], d); d = fmaf(bf_hi(ua[i].y), x[3], d); d = fmaf(bf_lo(ua[i].z), x[4], d); d = fmaf(bf_hi(ua[i].z), x[5], d); d = fmaf(bf_lo(ua[i].w), x[6], d); d = fmaf(bf_hi(ua[i].w), x[7], d);
            d = fmaf(bf_lo(ub[i].x), x[8], d); d = fmaf(bf_hi(ub[i].x), x[9], d); d = fmaf(bf_lo(ub[i].y), x[10], d); d = fmaf(bf_hi(ub[i].y), x[11], d); d = fmaf(bf_lo(ub[i].z), x[12], d); d = fmaf(bf_hi(ub[i].z), x[13], d); d = fmaf(bf_lo(ub[i].w), x[14], d); d = fmaf(bf_hi(ub[i].w), x[15], d);
            d = wave_sum(d);
            wgt[i] = gt[i] * gelu_erf(d);
        }
#pragma unroll
        for (int i = 0; i < 8; ++i) { const u32x4* vp = (const u32x4*)(Vb + (size_t)ei[i] * D); ua[i] = vp[lane]; ub[i] = vp[64 + lane]; }
#pragma unroll
        for (int i = 0; i < 8; ++i) {
            const float wg = wgt[i];
            y[0] = fmaf(wg, bf_lo(ua[i].x), y[0]); y[1] = fmaf(wg, bf_hi(ua[i].x), y[1]); y[2] = fmaf(wg, bf_lo(ua[i].y), y[2]); y[3] = fmaf(wg, bf_hi(ua[i].y), y[3]);
            y[4] = fmaf(wg, bf_lo(ua[i].z), y[4]); y[5] = fmaf(wg, bf_hi(ua[i].z), y[5]); y[6] = fmaf(wg, bf_lo(ua[i].w), y[6]); y[7] = fmaf(wg, bf_hi(ua[i].w), y[7]);
            y[8] = fmaf(wg, bf_lo(ub[i].x), y[8]); y[9] = fmaf(wg, bf_hi(ub[i].x), y[9]); y[10] = fmaf(wg, bf_lo(ub[i].y), y[10]); y[11] = fmaf(wg, bf_hi(ub[i].y), y[11]);
            y[12] = fmaf(wg, bf_lo(ub[i].z), y[12]); y[13] = fmaf(wg, bf_hi(ub[i].z), y[13]); y[14] = fmaf(wg, bf_lo(ub[i].w), y[14]); y[15] = fmaf(wg, bf_hi(ub[i].w), y[15]);
        }
    }
    const f32x4* hr = (const f32x4*)(H2 + (size_t)t * D);
    const f32x4 h0 = hr[2 * lane], h1 = hr[2 * lane + 1], h2 = hr[128 + 2 * lane], h3 = hr[128 + 2 * lane + 1];
    f32x4 z0 = (f32x4){y[0], y[1], y[2], y[3]} + h0, z1 = (f32x4){y[4], y[5], y[6], y[7]} + h1, z2 = (f32x4){y[8], y[9], y[10], y[11]} + h2, z3 = (f32x4){y[12], y[13], y[14], y[15]} + h3;
    float s = (z0.x * z0.x + z0.y * z0.y) + (z0.z * z0.z + z0.w * z0.w) + (z1.x * z1.x + z1.y * z1.y) + (z1.z * z1.z + z1.w * z1.w) + (z2.x * z2.x + z2.y * z2.y) + (z2.z * z2.z + z2.w * z2.w) + (z3.x * z3.x + z3.y * z3.y) + (z3.z * z3.z + z3.w * z3.w);
    const float r = rsqrtf(wave_sum(s) * (1.f / D) + EPS);
    const f32x4* gf = (const f32x4*)fg;
    f32x4* op = (f32x4*)(out + (size_t)t * D);
    op[2 * lane] = z0 * r * gf[2 * lane]; op[2 * lane + 1] = z1 * r * gf[2 * lane + 1]; op[128 + 2 * lane] = z2 * r * gf[128 + 2 * lane]; op[128 + 2 * lane + 1] = z3 * r * gf[128 + 2 * lane + 1];
}

__global__ void __launch_bounds__(NT, 2) mega(Args a) {
    extern __shared__ __attribute__((aligned(16))) unsigned char lds_raw[];
    LAS unsigned char* lds = (LAS unsigned char*)lds_raw;
    cg::grid_group grid = cg::this_grid();
    const int tid = threadIdx.x, lane = tid & 63, wave = __builtin_amdgcn_readfirstlane(tid >> 6), G = gridDim.x;
    unsigned char* ws = a.ws;
    const int lo = a.ph_lo, hi = a.ph_hi;
    bf16_t* WIN = (bf16_t*)(ws + WS_WIN); bf16_t* WOUT = (bf16_t*)(ws + WS_WOUT); bf16_t* WEFF = (bf16_t*)(ws + WS_WEFF);
    bf16_t* Ub = (bf16_t*)(ws + WS_U); bf16_t* Vb = (bf16_t*)(ws + WS_V); bf16_t* XN = (bf16_t*)(ws + WS_XN);
    bf16_t* GLU = (bf16_t*)(ws + WS_GLU); bf16_t* HG = (bf16_t*)(ws + WS_HG); bf16_t* Y = (bf16_t*)(ws + WS_Y);
    float* HS = (float*)(ws + WS_HS); float* HLD = (float*)(ws + WS_HLD);
    int* EIDX = (int*)(ws + WS_EIDX); float* GATE = (float*)(ws + WS_GATE);
    const int gw = blockIdx.x * NWAVES + wave, NGW = G * NWAVES;
#ifndef PH_MASK
#define PH_MASK 0xff
#endif
#define IN(k) (((PH_MASK >> (k)) & 1) && lo <= (k) && (k) < hi)
#define SEAM(k) do { if (IN(k) && IN((k) + 1)) grid.sync(); } while (0)
    if (IN(0)) { p0_prologue(a, lds, tid, lane, wave, G); }
    SEAM(0);
    if (IN(1)) {
        pg8::Gemm g{XN, WIN, M, DIN, D}; pg8::StaticOrder S; S.init(M, DIN, G, (int)blockIdx.x);
        pg8::EpiProj E{GLU, HG};
        pg8::gemm_phase<pg8::EpiProj, pg8::StaticOrder, true, true>(lds, g, S, E);
    }
    SEAM(1);
    if (IN(2)) {
        for (int u = blockIdx.x; u < BATCH * NH * SEGS; u += G) hgrn_unit<false>(lds, u, HG, a.in[7], a.in[8], HS, HLD, Y, tid, lane, wave);
        for (int wu = gw; wu < 2048; wu += NGW) conv_wave_unit(GLU, a.in[3], a.in[4], a.in[5], a.in[6], Y, wu, lane);
    }
    SEAM(2);
    if (IN(3)) {
        for (int u = blockIdx.x; u < BATCH * NH * SEGS; u += G) hgrn_unit<true>(lds, u, HG, a.in[7], a.in[8], HS, HLD, Y, tid, lane, wave);
    }
    SEAM(3);
    if (IN(4)) {
        pg8::Gemm g{Y, WOUT, M, D, D}; pg8::StaticOrder S; S.init(M, D, G, (int)blockIdx.x);
        pg8::EpiResF32 E{a.out, a.in[0], D};
        pg8::gemm_phase<pg8::EpiResF32, pg8::StaticOrder, true, true>(lds, g, S, E);
    }
    SEAM(4);
    if (IN(5)) {
        for (int r = gw; r < M; r += NGW) row_to_bf16(a.out + (size_t)r * D, XN + (size_t)r * D, nullptr, true, lane);
    }
    SEAM(5);
    if (IN(6)) {
        pg8::Gemm g{XN, WEFF, M, NQ, D}; pg8::StaticOrder S; S.init(M, NQ, G, (int)blockIdx.x);
        pg8::EpiTopK E{EIDX, GATE};
        for (int i = 0;; ++i) { pg8::OneUnit O; if (!S.next(i, O.u)) break; pg8::gemm_phase<pg8::EpiTopK, pg8::OneUnit, false, true>(lds, g, O, E); }
    }
    SEAM(6);
    if (IN(7)) {
        for (int t = gw; t < M; t += NGW) peer_token(t, XN, EIDX, GATE, Ub, Vb, a.out, a.in[15], a.out, lane);
    }
#undef IN
#undef SEAM
}
}

#ifndef STAGE
#define STAGE 5
#endif
#if STAGE < 5
namespace nv {
constexpr int D = 1024, BATCH = 8, SEQ = 4096, M = BATCH * SEQ;
constexpr int DCONV = 512, CW = 31, DH = 512, NH = 4, HD = 128, DIN = 3072;
constexpr int NKEY = 128;
constexpr float EPS = 1e-6f;
typedef unsigned short bf16_t;
__device__ __forceinline__ float bf1(bf16_t u) { return __builtin_bit_cast(float, (unsigned)u << 16); }
__device__ __forceinline__ float wsum(float v) {
#pragma unroll
    for (int o = 1; o < 64; o <<= 1) v += __shfl_xor(v, o);
    return v;
}
__device__ __forceinline__ float sigmoidf_(float x) { return 1.f / (1.f + __expf(-x)); }
__device__ __forceinline__ float siluf_(float x) { return x * sigmoidf_(x); }
__global__ void __launch_bounds__(256) k_cvt(const bf16_t* __restrict__ s, float* __restrict__ d, size_t n) { const size_t i = (size_t)blockIdx.x * 256 + threadIdx.x; if (i < n) d[i] = bf1(s[i]); }
__global__ void __launch_bounds__(256) k_rmsnorm(const float* __restrict__ x, const float* __restrict__ g, float* __restrict__ out, int rows) {
    const int lane = threadIdx.x & 63, w = threadIdx.x >> 6;
    const int row = blockIdx.x * 4 + w;
    if (row >= rows) return;
    const float4* xr = (const float4*)(x + (size_t)row * D);
    float4 v[4]; float s = 0.f;
#pragma unroll
    for (int j = 0; j < 4; ++j) { v[j] = xr[lane + 64 * j]; s += v[j].x * v[j].x + v[j].y * v[j].y + v[j].z * v[j].z + v[j].w * v[j].w; }
    s = wsum(s);
    const float r = rsqrtf(s * (1.f / D) + EPS);
    float4* o = (float4*)(out + (size_t)row * D);
    const float4* g4 = (const float4*)g;
#pragma unroll
    for (int j = 0; j < 4; ++j) { const float4 gg = g4[lane + 64 * j]; float4 t; t.x = v[j].x * r * gg.x; t.y = v[j].y * r * gg.y; t.z = v[j].z * r * gg.z; t.w = v[j].w * r * gg.w; o[lane + 64 * j] = t; }
}
template <bool RES>
__global__ void __launch_bounds__(256) k_gemm(const float* __restrict__ A, const float* __restrict__ B, float* __restrict__ C, const float* __restrict__ R, int Mm, int N, int K) {
    __shared__ float As[16][68];
    __shared__ float Bs[16][64];
    const int tid = threadIdx.x, tx = tid & 15, ty = tid >> 4;
    const int m0 = blockIdx.y * 64, n0 = blockIdx.x * 64;
    float acc[4][4];
#pragma unroll
    for (int i = 0; i < 4; ++i)
#pragma unroll
        for (int j = 0; j < 4; ++j) acc[i][j] = 0.f;
    for (int k0 = 0; k0 < K; k0 += 16) {
#pragma unroll
        for (int i = 0; i < 4; ++i) { const int idx = tid + i * 256, r = idx >> 4, kk = idx & 15; As[kk][r] = A[(size_t)(m0 + r) * K + k0 + kk]; }
#pragma unroll
        for (int i = 0; i < 4; ++i) { const int idx = tid + i * 256, kk = idx >> 6, c = idx & 63; Bs[kk][c] = B[(size_t)(k0 + kk) * N + n0 + c]; }
        __syncthreads();
#pragma unroll
        for (int kk = 0; kk < 16; ++kk) {
            float a[4], b[4];
#pragma unroll
            for (int i = 0; i < 4; ++i) a[i] = As[kk][ty * 4 + i];
#pragma unroll
            for (int j = 0; j < 4; ++j) b[j] = Bs[kk][tx * 4 + j];
#pragma unroll
            for (int i = 0; i < 4; ++i)
#pragma unroll
                for (int j = 0; j < 4; ++j) acc[i][j] = fmaf(a[i], b[j], acc[i][j]);
        }
        __syncthreads();
    }
#pragma unroll
    for (int i = 0; i < 4; ++i) {
        const size_t off = (size_t)(m0 + ty * 4 + i) * N + n0 + tx * 4;
        float4 o; o.x = acc[i][0]; o.y = acc[i][1]; o.z = acc[i][2]; o.w = acc[i][3];
        if (RES) { const float4 r = *(const float4*)(R + off); o.x += r.x; o.y += r.y; o.z += r.z; o.w += r.w; }
        *(float4*)(C + off) = o;
    }
}
__global__ void __launch_bounds__(512) k_conv_glu(const bf16_t* __restrict__ GLU, const float* __restrict__ cw, const float* __restrict__ cb, const float* __restrict__ ng, const float* __restrict__ nb, float* __restrict__ Y) {
    const int t = blockIdx.x, s = t % SEQ, c = threadIdx.x;
    float acc = cb[c];
    for (int j = 0; j < CW; ++j) { const int ss = s - (CW - 1) + j; if (ss >= 0) acc = fmaf(cw[j * DCONV + c], bf1(GLU[(size_t)(t - (CW - 1) + j) * DCONV + c]), acc); }
    const float mu = wsum(acc) * (1.f / 64.f), d = acc - mu, var = wsum(d * d) * (1.f / 64.f);
    Y[(size_t)t * D + c] = siluf_(d * rsqrtf(var + EPS) * ng[c] + nb[c]);
}
__global__ void __launch_bounds__(128) k_hgrn_hg(const bf16_t* __restrict__ HG, const float* __restrict__ lbl, const float* __restrict__ hng, float* __restrict__ Y) {
    __shared__ float fs[HD], ks[HD], qs[HD], red[2];
    const int b = blockIdx.x / NH, h = blockIdx.x % NH, v = threadIdx.x, col = h * HD + v;
    const float lb = 1.f / (1.f + __expf(lbl[DH + col] - lbl[col])), gn = hng[col];
    float S[HD];
#pragma unroll
    for (int k = 0; k < HD; ++k) S[k] = 0.f;
    for (int s = 0; s < SEQ; ++s) {
        const bf16_t* pr = HG + (size_t)(b * SEQ + s) * 2048;
        const float qv = bf1(pr[col]), z = bf1(pr[DH + col]), iv = bf1(pr[2 * DH + col]), gv = bf1(pr[3 * DH + col]);
        const float sg = sigmoidf_(z);
        fs[v] = lb + (1.f - lb) * sg; ks[v] = (1.f - lb) * (1.f - sg); qs[v] = qv;
        __syncthreads();
        float o = 0.f;
#pragma unroll
        for (int k = 0; k < HD; ++k) { S[k] = fmaf(fs[k], S[k], ks[k] * iv); o = fmaf(S[k], qs[k], o); }
        const float sq = wsum(o * o);
        if ((v & 63) == 0) red[v >> 6] = sq;
        __syncthreads();
        const float ms = (red[0] + red[1]) * (1.f / HD);
        Y[(size_t)(b * SEQ + s) * D + DCONV + col] = o * rsqrtf(ms + EPS) * gn * gv;
        __syncthreads();
    }
}
__global__ void __launch_bounds__(256) k_scores(const float* __restrict__ Q, const float* __restrict__ sk, float* __restrict__ SC) {
    __shared__ float qs[2048];
    const int t = blockIdx.x;
    for (int i = threadIdx.x; i < 2048; i += 256) qs[i] = Q[(size_t)t * 2048 + i];
    __syncthreads();
    for (int o = threadIdx.x; o < 2048; o += 256) {
        const int hp = o >> 7; const float* kr = sk + (size_t)o * 128; const float* qq = qs + hp * 128;
        float a = 0.f;
        for (int j = 0; j < 128; ++j) a = fmaf(qq[j], kr[j], a);
        SC[(size_t)t * 2048 + o] = a;
    }
}
__device__ __forceinline__ void wave_argmax(float& v, int& i) {
#pragma unroll
    for (int o = 1; o < 64; o <<= 1) { const float ov = __shfl_xor(v, o); const int oi = __shfl_xor(i, o); if (ov > v || (ov == v && oi < i)) { v = ov; i = oi; } }
}
__global__ void __launch_bounds__(64) k_topk(const float* __restrict__ SC, int* __restrict__ EIDX, float* __restrict__ GATE) {
    __shared__ float s1[16], s2[16]; __shared__ int i1[16], i2[16];
    const int t = blockIdx.x >> 3, h = blockIdx.x & 7, lane = threadIdx.x;
    const float* sc = SC + (size_t)t * 2048 + h * 256;
    for (int p = 0; p < 2; ++p) {
        float a0 = sc[p * 128 + lane], a1 = sc[p * 128 + 64 + lane];
        for (int r = 0; r < 16; ++r) {
            float v; int i;
            if (a0 >= a1) { v = a0; i = lane; } else { v = a1; i = lane + 64; }
            wave_argmax(v, i);
            if (lane == 0) { if (p == 0) { s1[r] = v; i1[r] = i; } else { s2[r] = v; i2[r] = i; } }
            if (i == lane) a0 = -INFINITY;
            if (i == lane + 64) a1 = -INFINITY;
        }
    }
    __syncthreads();
    float c[4];
#pragma unroll
    for (int e = 0; e < 4; ++e) { const int ci = lane * 4 + e; c[e] = s1[ci >> 4] + s2[ci & 15]; }
    float tmax = 0.f, myts = 0.f; int mye = 0;
    for (int r = 0; r < 16; ++r) {
        float v = c[0]; int i = lane * 4;
#pragma unroll
        for (int e = 1; e < 4; ++e) if (c[e] > v) { v = c[e]; i = lane * 4 + e; }
        wave_argmax(v, i);
#pragma unroll
        for (int e = 0; e < 4; ++e) if (i == lane * 4 + e) c[e] = -INFINITY;
        if (r == 0) tmax = v;
        if (lane == r) { myts = v; mye = i1[i >> 4] * NKEY + i2[i & 15]; }
    }
    const float ex = (lane < 16) ? __expf(myts - tmax) : 0.f;
    const float den = wsum(ex);
    if (lane < 16) { EIDX[(size_t)t * 128 + h * 16 + lane] = mye; GATE[(size_t)t * 128 + h * 16 + lane] = ex / den; }
}
__global__ void __launch_bounds__(256) k_peer(const float* __restrict__ XN2, const int* __restrict__ EIDX, const float* __restrict__ GATE, const float* __restrict__ U, const float* __restrict__ V,
                                              const float* H2, const float* __restrict__ fg, float* out) {
    const int lane = threadIdx.x & 63, w = threadIdx.x >> 6, t = blockIdx.x * 4 + w;
    const float4* xr = (const float4*)(XN2 + (size_t)t * D);
    float4 x[4], y[4];
#pragma unroll
    for (int j = 0; j < 4; ++j) { x[j] = xr[lane + 64 * j]; y[j] = make_float4(0.f, 0.f, 0.f, 0.f); }
    for (int e = 0; e < 128; ++e) {
        const int ei = EIDX[(size_t)t * 128 + e]; const float g = GATE[(size_t)t * 128 + e];
        const float4* ur = (const float4*)(U + (size_t)ei * D);
        float d = 0.f;
#pragma unroll
        for (int j = 0; j < 4; ++j) { const float4 u = ur[lane + 64 * j]; d += u.x * x[j].x + u.y * x[j].y + u.z * x[j].z + u.w * x[j].w; }
        d = wsum(d);
        const float wgt = g * 0.5f * d * (1.f + erff(d * 0.70710678118654752f));
        const float4* vr = (const float4*)(V + (size_t)ei * D);
#pragma unroll
        for (int j = 0; j < 4; ++j) { const float4 vv = vr[lane + 64 * j]; y[j].x = fmaf(wgt, vv.x, y[j].x); y[j].y = fmaf(wgt, vv.y, y[j].y); y[j].z = fmaf(wgt, vv.z, y[j].z); y[j].w = fmaf(wgt, vv.w, y[j].w); }
    }
    const float4* hr = (const float4*)(H2 + (size_t)t * D);
    float s = 0.f;
#pragma unroll
    for (int j = 0; j < 4; ++j) { const float4 hh = hr[lane + 64 * j]; y[j].x += hh.x; y[j].y += hh.y; y[j].z += hh.z; y[j].w += hh.w; s += y[j].x * y[j].x + y[j].y * y[j].y + y[j].z * y[j].z + y[j].w * y[j].w; }
    s = wsum(s);
    const float r = rsqrtf(s * (1.f / D) + EPS);
    float4* o = (float4*)(out + (size_t)t * D);
    const float4* g4 = (const float4*)fg;
#pragma unroll
    for (int j = 0; j < 4; ++j) { const float4 gg = g4[lane + 64 * j]; float4 q; q.x = y[j].x * r * gg.x; q.y = y[j].y * r * gg.y; q.z = y[j].z * r * gg.z; q.w = y[j].w * r * gg.w; o[lane + 64 * j] = q; }
}
}
#endif

extern "C" void kernel_launch(void* const* d_in, const int* in_sizes, int n_in, void* d_out, int out_size, void* d_ws, size_t ws_size, hipStream_t stream) {
    static int grid = 0;
    if (grid == 0) {
        if (n_in != 16 || out_size != mk::M * mk::D || ws_size < 512ull * mk::MiB) { fprintf(stderr, "kernel_launch: unexpected shapes (n_in %d out %d ws %zu)\n", n_in, out_size, ws_size); grid = -1; return; }
        int dev = 0, cus = 0, per_cu = 0;
        (void)hipGetDevice(&dev);
        (void)hipDeviceGetAttribute(&cus, hipDeviceAttributeMultiprocessorCount, dev);
        if (hipFuncSetAttribute((const void*)mk::mega, hipFuncAttributeMaxDynamicSharedMemorySize, mk::LDS_BYTES) != hipSuccess) { fprintf(stderr, "kernel_launch: hipFuncSetAttribute failed\n"); grid = -1; return; }
        if (hipOccupancyMaxActiveBlocksPerMultiprocessor(&per_cu, (const void*)mk::mega, mk::NT, mk::LDS_BYTES) != hipSuccess || per_cu < 1) { fprintf(stderr, "kernel_launch: occupancy query says %d\n", per_cu); per_cu = 1; }
        (void)hipGetLastError();
        grid = cus;
        fprintf(stderr, "kernel_launch: cus %d per_cu %d grid %d\n", cus, per_cu, grid);
    }
    if (grid < 0) return;
    mk::Args a{};
    for (int i = 0; i < 16; ++i) a.in[i] = (const float*)d_in[i];
    a.out = (float*)d_out; a.ws = (unsigned char*)d_ws;
    const int his[6] = {0, 2, 4, 6, 7, 8};
    a.ph_lo = 0; a.ph_hi = his[STAGE];
    void* args[] = {&a};
    hipError_t e = hipLaunchCooperativeKernel((const void*)mk::mega, dim3(grid), dim3(mk::NT), args, mk::LDS_BYTES, stream);
    if (e != hipSuccess) fprintf(stderr, "cooperative launch failed: %s (grid %d)\n", hipGetErrorString(e), grid);
#if STAGE < 5
    using namespace nv;
    char* ws = (char*)d_ws; const size_t MiB = 1u << 20;
    const float* x = (const float*)d_in[0];
    float* out = (float*)d_out;
    float* XN2f = (float*)(ws);
    float* Qh = (float*)(ws + 128 * MiB); float* SCh = (float*)(ws + 256 * MiB);
    int* EIDX = (int*)(ws + 384 * MiB); float* GATE = (float*)(ws + 400 * MiB);
#if STAGE == 1
    float* Yf = (float*)(ws + 320 * MiB);
    k_conv_glu<<<M, 512, 0, stream>>>((const bf16_t*)(ws + mk::WS_GLU), (const float*)d_in[3], (const float*)d_in[4], (const float*)d_in[5], (const float*)d_in[6], Yf);
    k_hgrn_hg<<<BATCH * NH, 128, 0, stream>>>((const bf16_t*)(ws + mk::WS_HG), (const float*)d_in[7], (const float*)d_in[8], Yf);
#endif
#if STAGE == 2
    float* Yf = (float*)(ws + 128 * MiB);
    k_cvt<<<(unsigned)((size_t)M * D / 256), 256, 0, stream>>>((const bf16_t*)(ws + mk::WS_Y), Yf, (size_t)M * D);
#endif
#if STAGE <= 2
    k_gemm<true><<<dim3(D / 64, M / 64), 256, 0, stream>>>(Yf, (const float*)d_in[9], out, x, M, D, D);
#endif
#if STAGE <= 3
    k_rmsnorm<<<M / 4, 256, 0, stream>>>(out, (const float*)d_in[10], XN2f, M);
    for (int hf = 0; hf < 2; ++hf) {
        const int Mh = M / 2;
        k_gemm<false><<<dim3(2048 / 64, Mh / 64), 256, 0, stream>>>(XN2f + (size_t)hf * Mh * D, (const float*)d_in[11], Qh, nullptr, Mh, 2048, D);
        k_scores<<<Mh, 256, 0, stream>>>(Qh, (const float*)d_in[12], SCh);
        k_topk<<<Mh * 8, 64, 0, stream>>>(SCh, EIDX + (size_t)hf * Mh * 128, GATE + (size_t)hf * Mh * 128);
    }
    k_peer<<<M / 4, 256, 0, stream>>>(XN2f, EIDX, GATE, (const float*)d_in[13], (const float*)d_in[14], out, (const float*)d_in[15], out);
#endif
#if STAGE == 4
    float* XN2g = (float*)(ws + 160 * MiB);
    k_rmsnorm<<<M / 4, 256, 0, stream>>>(out, (const float*)d_in[10], XN2g, M);
    k_peer<<<M / 4, 256, 0, stream>>>(XN2g, (const int*)(ws + mk::WS_EIDX), (const float*)(ws + mk::WS_GATE), (const float*)d_in[13], (const float*)d_in[14], out, (const float*)d_in[15], out);
#endif
#endif
}
```

```cpp
#include <hip/hip_runtime.h>
#include <hip/hip_cooperative_groups.h>
#include <cstdio>
#include <cstdint>
#include <cmath>
namespace cg = cooperative_groups;
namespace pg8 {
#define PG8_LAS __attribute__((address_space(3)))
typedef unsigned short bf16_t;
typedef short bf16x8 __attribute__((ext_vector_type(8)));
typedef float f32x4 __attribute__((ext_vector_type(4)));
typedef unsigned u32x4 __attribute__((ext_vector_type(4)));
constexpr int BM = 256, BK = 64, HALF = 128, HTB = HALF * BK * 2  , STAGE_BYTES = 8 * HTB, NXCD = 8, WGM = 8;

__host__ __device__ __forceinline__ int lds_byte(int r, int c) { const int st = (r >> 4) * 2 + (c >> 5), rr = r & 15, cc = c & 31, ob = rr * 64 + cc * 2; return st * 1024 + (ob ^ (((ob >> 9) & 1) << 5)); }
__host__ __device__ __forceinline__ void stage_rc(int b, int& R, int& C) { const int st = b / 1024, sb = b % 1024, swz = sb ^ (((sb >> 9) & 1) << 5); R = (st >> 1) * 16 + swz / 64; C = (st & 1) * 32 + (swz % 64) / 2; }
__host__ __device__ __forceinline__ int perm32(int rho) { const int n = rho >> 4, i = rho & 15; return 8 * (i >> 2) + 4 * n + (i & 3); }

struct Unit { int pm, pn; };
struct Gemm { const bf16_t* A; const bf16_t* Bt; int M, N, K; };

struct StaticOrder {
    int nM, nN, nwg, G, c;
    __host__ __device__ void init(int M, int N, int G_, int c_) { nM = M / BM; nN = N / BM; nwg = nM * nN; G = G_; c = c_; }
    __host__ __device__ bool next(int i, Unit& u) const {
        const long L = (long)i * G + c; if (L >= nwg) return false;
        int wgid = (int)L; { const int q = nwg / NXCD, r = nwg % NXCD, xcd = wgid % NXCD, off = wgid / NXCD; wgid = (xcd < r ? xcd * (q + 1) : r * (q + 1) + (xcd - r) * q) + off; }
        const int nig = WGM * nN, gid = wgid / nig, fm = gid * WGM, gsz = (nM - fm) < WGM ? (nM - fm) : WGM;
        u.pm = fm + ((wgid % nig) % gsz); u.pn = (wgid % nig) / gsz; return true;
    }
    __device__ __forceinline__ void a_ready(const Unit&) const {}
    __device__ __forceinline__ void done(const Unit&) const {}
};

__device__ __forceinline__ unsigned cvt_pk_bf16(float lo, float hi) { unsigned r; asm volatile("v_cvt_pk_bf16_f32 %0, %1, %2" : "=v"(r) : "v"(lo), "v"(hi)); return r; }
__device__ __forceinline__ int lane_id_v() { int l; asm volatile("v_mbcnt_lo_u32_b32 %0, -1, 0\n\tv_mbcnt_hi_u32_b32 %0, -1, %0" : "=v"(l)); return l; }
__device__ __forceinline__ float fsigmoid(float x) { return __builtin_amdgcn_rcpf(1.f + __builtin_amdgcn_exp2f(-1.4426950408889634f * x)); }

struct EpiProj {
    static constexpr bool PERM = true, AFTER_DRAIN = false;
    bf16_t* GLU; bf16_t* HG;
    __device__ __forceinline__ void operator()(const f32x4 (&acc)[2][2][4][2], const Unit& u, int wr, int wc, int fr, int fq) const {
        const int row0 = u.pm * BM + wr * 64 + fr;
        if (u.pn < 4) {
            const int col = u.pn * 128 + wc * 32 + 8 * fq;
#pragma unroll
            for (int ai = 0; ai < 2; ++ai)
#pragma unroll
                for (int m = 0; m < 4; ++m) {
                    const f32x4 a0 = acc[ai][0][m][0], a1 = acc[ai][0][m][1], g0 = acc[ai][1][m][0], g1 = acc[ai][1][m][1];
                    u32x4 w;
                    w.x = cvt_pk_bf16(a0[0] * fsigmoid(g0[0]), a0[1] * fsigmoid(g0[1])); w.y = cvt_pk_bf16(a0[2] * fsigmoid(g0[2]), a0[3] * fsigmoid(g0[3]));
                    w.z = cvt_pk_bf16(a1[0] * fsigmoid(g1[0]), a1[1] * fsigmoid(g1[1])); w.w = cvt_pk_bf16(a1[2] * fsigmoid(g1[2]), a1[3] * fsigmoid(g1[3]));
                    *(u32x4*)(GLU + (size_t)(row0 + ai * HALF + m * 16) * 512 + col) = w;
                }
        } else {
            const int t = u.pn - 4;
            const bool act = (t < 2) || (t >= 6);
            const int col = t * 256 + wc * 32 + 8 * fq;
#pragma unroll
            for (int ai = 0; ai < 2; ++ai)
#pragma unroll
                for (int m = 0; m < 4; ++m) {
                    bf16_t* rowp = HG + (size_t)(row0 + ai * HALF + m * 16) * 2048 + col;
#pragma unroll
                    for (int bj = 0; bj < 2; ++bj) {
                        f32x4 v0 = acc[ai][bj][m][0], v1 = acc[ai][bj][m][1];
                        if (act) {
#pragma unroll
                            for (int i = 0; i < 4; ++i) { v0[i] = v0[i] * fsigmoid(v0[i]); v1[i] = v1[i] * fsigmoid(v1[i]); }
                        }
                        u32x4 w; w.x = cvt_pk_bf16(v0[0], v0[1]); w.y = cvt_pk_bf16(v0[2], v0[3]); w.z = cvt_pk_bf16(v1[0], v1[1]); w.w = cvt_pk_bf16(v1[2], v1[3]);
                        *(u32x4*)(rowp + bj * HALF) = w;
                    }
                }
        }
    }
};

struct EpiResF32 {
    static constexpr bool PERM = false, AFTER_DRAIN = false;
    float* C; const float* R; int ldc;
    __device__ __forceinline__ void operator()(const f32x4 (&acc)[2][2][4][2], const Unit& u, int wr, int wc, int fr, int fq) const {
        const int row0 = u.pm * BM + wr * 64 + fr, col0 = u.pn * BM + wc * 32 + 4 * fq;
#pragma unroll
        for (int ai = 0; ai < 2; ++ai)
#pragma unroll
            for (int m = 0; m < 4; ++m) { const size_t off = (size_t)(row0 + ai * HALF + m * 16) * ldc + col0;
#pragma unroll
                for (int bj = 0; bj < 2; ++bj)
#pragma unroll
                    for (int n = 0; n < 2; ++n) { const f32x4 r = *(const f32x4*)(R + off + bj * HALF + n * 16); *(f32x4*)(C + off + bj * HALF + n * 16) = acc[ai][bj][m][n] + r; } }
    }
};

__device__ __forceinline__ unsigned f2key(float f) { const unsigned u = __builtin_bit_cast(unsigned, f); return (u & 0x80000000u) ? ~u : (u | 0x80000000u); }
__device__ __forceinline__ float key2f(unsigned k) { const unsigned u = (k & 0x80000000u) ? (k & 0x7fffffffu) : ~k; return __builtin_bit_cast(float, u); }
__device__ __forceinline__ unsigned umax_(unsigned a, unsigned b) { return a > b ? a : b; }
__device__ __forceinline__ unsigned umin_(unsigned a, unsigned b) { return a < b ? a : b; }
__device__ __forceinline__ void sort16_desc(unsigned (&v)[16]) {
#pragma unroll
    for (int k = 2; k <= 16; k <<= 1)
#pragma unroll
        for (int j = k >> 1; j > 0; j >>= 1)
#pragma unroll
            for (int i = 0; i < 16; ++i) { const int l = i ^ j; if (l > i) { const unsigned hi = umax_(v[i], v[l]), lo = umin_(v[i], v[l]); if ((i & k) == 0) { v[i] = hi; v[l] = lo; } else { v[i] = lo; v[l] = hi; } } }
}
__device__ __forceinline__ void bmerge16_desc(unsigned (&v)[16]) {
#pragma unroll
    for (int j = 8; j > 0; j >>= 1)
#pragma unroll
        for (int i = 0; i < 16; ++i) { const int l = i ^ j; if (l > i) { const unsigned hi = umax_(v[i], v[l]), lo = umin_(v[i], v[l]); v[i] = hi; v[l] = lo; } }
}
struct EpiTopK {
    static constexpr bool PERM = false, AFTER_DRAIN = true;
    int* EIDX; float* GATE;
    __device__ __forceinline__ void fused(f32x4 (&acc)[2][2][4][2], const Unit& u, int wr, int wc, int fr, int fq, PG8_LAS unsigned char* lds, int wid, int lane) const {
        PG8_LAS unsigned* T = (PG8_LAS unsigned*)lds;
        PG8_LAS unsigned* LB = (PG8_LAS unsigned*)(lds + 131072);
        const int h = u.pn;
#pragma unroll
        for (int ai = 0; ai < 2; ++ai) {
            const int rl = wr * 64 + fr;
#pragma unroll
            for (int bj = 0; bj < 2; ++bj)
#pragma unroll
                for (int m = 0; m < 4; ++m)
#pragma unroll
                    for (int n = 0; n < 2; ++n)
#pragma unroll
                        for (int i = 0; i < 4; ++i) {
                            const int c = bj * 128 + wc * 32 + n * 16 + fq * 4 + i;
                            const float v = acc[ai][bj][m][n][i];
                            T[c * 128 + rl + m * 16] = (f2key(v) & ~127u) | (unsigned)(127 - (c & 127));
                        }
            asm volatile("s_waitcnt lgkmcnt(0)" ::: "memory"); __builtin_amdgcn_s_barrier(); asm volatile("" ::: "memory");
            {
                const int p = wid >> 2, q = (wid >> 1) & 1, r = (wid & 1) * 64 + lane, base = p * 128 + q * 64;
                unsigned run[16], grp[16];
#pragma unroll
                for (int j = 0; j < 16; ++j) run[j] = T[(base + j) * 128 + r];
                sort16_desc(run);
#pragma unroll
                for (int gI = 1; gI < 4; ++gI) {
#pragma unroll
                    for (int j = 0; j < 16; ++j) grp[j] = T[(base + 16 * gI + j) * 128 + r];
                    sort16_desc(grp);
#pragma unroll
                    for (int j = 0; j < 16; ++j) run[j] = umax_(run[j], grp[15 - j]);
                    bmerge16_desc(run);
                }
#pragma unroll
                for (int j = 0; j < 16; ++j) LB[((p * 2 + q) * 16 + j) * 128 + r] = run[j];
            }
            asm volatile("s_waitcnt lgkmcnt(0)" ::: "memory"); __builtin_amdgcn_s_barrier(); asm volatile("" ::: "memory");
            if (wid < 4) {
                const int p = wid >> 1, r = (wid & 1) * 64 + lane;
                unsigned a[16];
#pragma unroll
                for (int j = 0; j < 16; ++j) a[j] = umax_(LB[((p * 2) * 16 + j) * 128 + r], LB[((p * 2 + 1) * 16 + (15 - j)) * 128 + r]);
                bmerge16_desc(a);
#pragma unroll
                for (int j = 0; j < 16; ++j) LB[((p * 2) * 16 + j) * 128 + r] = a[j];
            }
            asm volatile("s_waitcnt lgkmcnt(0)" ::: "memory"); __builtin_amdgcn_s_barrier(); asm volatile("" ::: "memory");
            if (wid < 2) {
                const int r = wid * 64 + lane;
                float v1[16], v2[16];
#pragma unroll
                for (int j = 0; j < 16; ++j) { v1[j] = key2f(LB[j * 128 + r] & ~127u); v2[j] = key2f(LB[(32 + j) * 128 + r] & ~127u); }
                unsigned lst[16];
#pragma unroll
                for (int j = 0; j < 16; ++j) lst[j] = (f2key(v1[0] + v2[j]) & ~255u) | (unsigned)(255 - j);
#pragma unroll
                for (int i = 1; i < 16; ++i)
#pragma unroll
                    for (int j = 0; j < 16; ++j) if ((i + 1) * (j + 1) <= 16) {
                        unsigned x = (f2key(v1[i] + v2[j]) & ~255u) | (unsigned)(255 - (i * 16 + j));
#pragma unroll
                        for (int t = 0; t < 16; ++t) if (t >= (i + 1) * (j + 1) - 1) { const unsigned hi = umax_(lst[t], x); x = umin_(lst[t], x); lst[t] = hi; }
                    }
                float e[16]; float sum = 0.f; const float mx = key2f(lst[0] & ~255u);
                int ex[16];
#pragma unroll
                for (int t = 0; t < 16; ++t) {
                    e[t] = __expf(key2f(lst[t] & ~255u) - mx); sum += e[t];
                    const int ci = 255 - (int)(lst[t] & 255u), a = ci >> 4, b = ci & 15;
                    const int i1 = 127 - (int)(LB[a * 128 + r] & 127u), i2 = 127 - (int)(LB[(32 + b) * 128 + r] & 127u);
                    ex[t] = i1 * 128 + i2;
                }
                const float inv = 1.f / sum;
                const size_t o = (size_t)(u.pm * BM + ai * 128 + r) * 128 + h * 16;
#pragma unroll
                for (int t4 = 0; t4 < 4; ++t4) {
                    *(f32x4*)(GATE + o + 4 * t4) = (f32x4){e[4 * t4] * inv, e[4 * t4 + 1] * inv, e[4 * t4 + 2] * inv, e[4 * t4 + 3] * inv};
                    *(u32x4*)(EIDX + o + 4 * t4) = (u32x4){(unsigned)ex[4 * t4], (unsigned)ex[4 * t4 + 1], (unsigned)ex[4 * t4 + 2], (unsigned)ex[4 * t4 + 3]};
                }
            }
            asm volatile("s_waitcnt lgkmcnt(0)" ::: "memory"); __builtin_amdgcn_s_barrier(); asm volatile("" ::: "memory");
        }
    }
};
struct OneUnit {
    Unit u;
    __device__ __forceinline__ bool next(int i, Unit& o) const { if (i) return false; o = u; return true; }
    __device__ __forceinline__ void a_ready(const Unit&) const {}
    __device__ __forceinline__ void done(const Unit&) const {}
};

template <class Epi, class Sched, bool ALIGN_EPI = false, bool SP2 = false>
__device__ __forceinline__ void gemm_phase(PG8_LAS unsigned char* lds, const Gemm g, const Sched& S, const Epi& E, const int wid) {
    const int lane = lane_id_v(), tid = wid * 64 + lane, wr = wid >> 2, wc = wid & 3, fr = lane & 15, fq = lane >> 4;
    const int K = g.K, nt = K / BK;
    unsigned voffA[2], voffB[2];
#pragma unroll
    for (int i = 0; i < 2; ++i) { int R, C; stage_rc(tid * 16 + i * 8192, R, C); const int Rb = Epi::PERM ? ((R & ~31) + perm32(R & 31)) : R;
        voffA[i] = (unsigned)(R * K + C) * 2u; voffB[i] = (unsigned)(Rb * K + C) * 2u; }
    const size_t kstep = (size_t)(BK * 2);
    const size_t hstep = (size_t)HALF * K * 2;
    const size_t tstep = 2 * hstep;
    const unsigned ldsw = (unsigned)wid * 1024u;
    const int aoff = lds_byte(wr * 64 + fr, fq * 8), boff = lds_byte(wc * 32 + fr, fq * 8);
#define PG8_SA(b, h) (((b) * 2 + (h)) * HTB)
#define PG8_SB(b, h) ((4 + (b) * 2 + (h)) * HTB)
#define PG8_STAGE(bufoff, gbase, voff) do { _Pragma("unroll") for (int _i = 0; _i < 2; ++_i) \
        __builtin_amdgcn_global_load_lds((const unsigned*)((const char*)(gbase) + (voff)[_i]), (PG8_LAS unsigned*)(lds + (bufoff) + ldsw + _i * 8192), 16, 0, 0); } while (0)
#define PG8_LDA(dst, b, h) do { _Pragma("unroll") for (int m = 0; m < 4; ++m) _Pragma("unroll") for (int k = 0; k < 2; ++k) dst[m][k] = *(const PG8_LAS bf16x8*)(lds + PG8_SA(b, h) + aoff + m * 2048 + k * 1024); } while (0)
#define PG8_LDB(dst, b, h) do { _Pragma("unroll") for (int n = 0; n < 2; ++n) _Pragma("unroll") for (int k = 0; k < 2; ++k) dst[n][k] = *(const PG8_LAS bf16x8*)(lds + PG8_SB(b, h) + boff + n * 2048 + k * 1024); } while (0)
#define PG8_MMA(ai, bj, At, Bt) do { __builtin_amdgcn_s_setprio(1); _Pragma("unroll") for (int m = 0; m < 4; ++m) _Pragma("unroll") for (int n = 0; n < 2; ++n) _Pragma("unroll") for (int k = 0; k < 2; ++k) \
        acc[ai][bj][m][n] = __builtin_amdgcn_mfma_f32_16x16x32_bf16(Bt[n][k], At[m][k], acc[ai][bj][m][n], 0, 0, 0); __builtin_amdgcn_s_setprio(0); } while (0)
#define PG8_WAIT_V(n) asm volatile("s_waitcnt vmcnt(" #n ")" ::: "memory")
#define PG8_WAIT_L(n) asm volatile("s_waitcnt lgkmcnt(" #n ")" ::: "memory")
#define PG8_BAR __builtin_amdgcn_s_barrier()
#define PG8_SCHED __builtin_amdgcn_sched_barrier(0)
    Unit cur, nxt; int ui = 0;
    if (!S.next(0, cur)) return;
    f32x4 acc[2][2][4][2];
#pragma unroll
    for (int a = 0; a < 2; ++a)
#pragma unroll
        for (int b = 0; b < 2; ++b)
#pragma unroll
            for (int m = 0; m < 4; ++m)
#pragma unroll
                for (int n = 0; n < 2; ++n) acc[a][b][m][n] = (f32x4){0.f, 0.f, 0.f, 0.f};
    bf16x8 At[4][2], B0[2][2], B1[2][2];
    const char* cA = (const char*)g.A + (size_t)cur.pm * tstep; const char* cB = (const char*)g.Bt + (size_t)cur.pn * tstep;
    S.a_ready(cur);
    if constexpr (SP2) {
        PG8_STAGE(PG8_SB(0, 0), cB, voffB); PG8_STAGE(PG8_SB(0, 1), cB + hstep, voffB); PG8_STAGE(PG8_SA(0, 0), cA, voffA); PG8_STAGE(PG8_SA(0, 1), cA + hstep, voffA);
        if (wr == 1) PG8_BAR;
        PG8_WAIT_V(2); PG8_BAR;
        PG8_STAGE(PG8_SB(1, 0), cB + kstep, voffB); PG8_STAGE(PG8_SA(1, 0), cA + kstep, voffA); PG8_STAGE(PG8_SB(1, 1), cB + hstep + kstep, voffB);
        PG8_WAIT_V(6); PG8_BAR;
    } else {
        PG8_STAGE(PG8_SB(0, 0), cB, voffB); PG8_STAGE(PG8_SA(0, 0), cA, voffA); PG8_STAGE(PG8_SB(0, 1), cB + hstep, voffB); PG8_STAGE(PG8_SA(0, 1), cA + hstep, voffA);
        if (wr == 1) PG8_BAR;
        PG8_WAIT_V(4); PG8_BAR;
        PG8_STAGE(PG8_SB(1, 0), cB + kstep, voffB); PG8_STAGE(PG8_SA(1, 0), cA + kstep, voffA); PG8_STAGE(PG8_SB(1, 1), cB + hstep + kstep, voffB);
        PG8_WAIT_V(6); PG8_BAR;
    }
    for (;;) {
        const bool has_next = S.next(ui + 1, nxt);
        const char* nA = has_next ? (const char*)g.A + (size_t)nxt.pm * tstep : cA; const char* nB = has_next ? (const char*)g.Bt + (size_t)nxt.pn * tstep : cB;
        for (int t = 0; t < nt; t += 2) {
            const bool last = (t == nt - 2);
            const char* a1 = cA + (size_t)(t + 1) * kstep;
            const char* a2 = last ? nA : cA + (size_t)(t + 2) * kstep; const char* b2 = last ? nB : cB + (size_t)(t + 2) * kstep;
            const char* a3 = a2 + kstep; const char* b3 = b2 + kstep;
            if (last && has_next) S.a_ready(nxt);
            if constexpr (SP2) {
            PG8_LDB(B0, 0, 0); PG8_LDB(B1, 0, 1); PG8_SCHED; PG8_LDA(At, 0, 0); PG8_STAGE(PG8_SA(1, 1), a1 + hstep, voffA);
            PG8_WAIT_V(8); PG8_WAIT_L(0); PG8_BAR; PG8_MMA(0, 0, At, B0); PG8_MMA(0, 1, At, B1); PG8_BAR; PG8_SCHED;
            PG8_LDA(At, 0, 1); PG8_STAGE(PG8_SB(0, 0), b2, voffB); PG8_STAGE(PG8_SB(0, 1), b2 + hstep, voffB); PG8_STAGE(PG8_SA(0, 0), a2, voffA);
            PG8_WAIT_V(8); PG8_WAIT_L(0); PG8_BAR; PG8_MMA(1, 0, At, B0); PG8_MMA(1, 1, At, B1); PG8_BAR; PG8_SCHED;
            PG8_LDB(B0, 1, 0); PG8_LDB(B1, 1, 1); PG8_SCHED; PG8_LDA(At, 1, 0); PG8_STAGE(PG8_SA(0, 1), a2 + hstep, voffA);
            PG8_WAIT_V(8); PG8_WAIT_L(0); PG8_BAR; PG8_MMA(0, 0, At, B0); PG8_MMA(0, 1, At, B1); PG8_BAR; PG8_SCHED;
            PG8_LDA(At, 1, 1); PG8_STAGE(PG8_SB(1, 0), b3, voffB); PG8_STAGE(PG8_SB(1, 1), b3 + hstep, voffB); PG8_STAGE(PG8_SA(1, 0), a3, voffA);
            PG8_WAIT_V(8); PG8_WAIT_L(0); PG8_BAR; PG8_MMA(1, 0, At, B0); PG8_MMA(1, 1, At, B1); PG8_BAR; PG8_SCHED;
            } else {
            PG8_LDB(B0, 0, 0); PG8_SCHED; PG8_LDA(At, 0, 0); PG8_STAGE(PG8_SA(1, 1), a1 + hstep, voffA);
            PG8_WAIT_L(8); PG8_BAR; PG8_WAIT_L(0); PG8_MMA(0, 0, At, B0); PG8_BAR; PG8_SCHED;
            PG8_LDB(B1, 0, 1); PG8_STAGE(PG8_SB(0, 0), b2, voffB);
            PG8_BAR; PG8_WAIT_L(0); PG8_MMA(0, 1, At, B1); PG8_BAR;
            PG8_LDA(At, 0, 1); PG8_STAGE(PG8_SA(0, 0), a2, voffA);
            PG8_BAR; PG8_WAIT_L(0); PG8_MMA(1, 0, At, B0); PG8_BAR; PG8_SCHED;
            PG8_STAGE(PG8_SB(0, 1), b2 + hstep, voffB);
            PG8_WAIT_V(6); PG8_BAR; PG8_MMA(1, 1, At, B1); PG8_BAR;
            PG8_LDB(B0, 1, 0); PG8_SCHED; PG8_LDA(At, 1, 0); PG8_STAGE(PG8_SA(0, 1), a2 + hstep, voffA);
            PG8_WAIT_L(8); PG8_BAR; PG8_WAIT_L(0); PG8_MMA(0, 0, At, B0); PG8_BAR; PG8_SCHED;
            PG8_LDB(B1, 1, 1); PG8_STAGE(PG8_SB(1, 0), b3, voffB);
            PG8_BAR; PG8_WAIT_L(0); PG8_MMA(0, 1, At, B1); PG8_BAR;
            PG8_LDA(At, 1, 1); PG8_STAGE(PG8_SA(1, 0), a3, voffA);
            PG8_BAR; PG8_WAIT_L(0); PG8_MMA(1, 0, At, B0); PG8_BAR; PG8_SCHED;
            PG8_STAGE(PG8_SB(1, 1), b3 + hstep, voffB);
            PG8_WAIT_V(6); PG8_BAR; PG8_MMA(1, 1, At, B1); PG8_BAR;
            }
        }
        if constexpr (ALIGN_EPI) { if (wr == 0) PG8_BAR; }
        if constexpr (!Epi::AFTER_DRAIN) { E(acc, cur, wr, wc, fr, fq); S.done(cur); }
        if (!has_next) break;
#pragma unroll
        for (int a = 0; a < 2; ++a)
#pragma unroll
            for (int b = 0; b < 2; ++b)
#pragma unroll
                for (int m = 0; m < 4; ++m)
#pragma unroll
                    for (int n = 0; n < 2; ++n) acc[a][b][m][n] = (f32x4){0.f, 0.f, 0.f, 0.f};
        cur = nxt; cA = nA; cB = nB; ++ui;
        if constexpr (ALIGN_EPI) { if (wr == 1) PG8_BAR; }
    }
    PG8_WAIT_V(0);
    if constexpr (!ALIGN_EPI) { if (wr == 0) PG8_BAR; }
    PG8_BAR;
    if constexpr (Epi::AFTER_DRAIN) { E.fused(acc, cur, wr, wc, fr, fq, lds, wid, lane); S.done(cur); }
#undef PG8_SA
#undef PG8_SB
#undef PG8_STAGE
#undef PG8_LDA
#undef PG8_LDB
#undef PG8_MMA
#undef PG8_WAIT_V
#undef PG8_WAIT_L
#undef PG8_BAR
#undef PG8_SCHED
}
}

namespace mk {
using pg8::bf16_t; using pg8::bf16x8; using pg8::f32x4; using pg8::u32x4; using pg8::cvt_pk_bf16; using pg8::fsigmoid;
#define LAS __attribute__((address_space(3)))
typedef unsigned u32x2 __attribute__((ext_vector_type(2)));
typedef float f32x2 __attribute__((ext_vector_type(2)));
typedef short bf16x4 __attribute__((ext_vector_type(4)));
constexpr int NWAVES = 8, NT = 512;
constexpr int D = 1024, BATCH = 8, SEQ = 4096, M = BATCH * SEQ, DCONV = 512, CW = 31, DH = 512, NH = 4, HD = 128, DIN = 3072, NQ = 2048, NEXP = 16384;
constexpr int SEGS = 8, SEGLEN = SEQ / SEGS, NCH = SEGLEN / 64;
constexpr float EPS = 1e-6f;
constexpr size_t MiB = 1u << 20;
constexpr size_t WS_WIN = 2 * MiB, WS_WOUT = 8 * MiB, WS_WEFF = 10 * MiB, WS_HS = 14 * MiB, WS_HLD = 30 * MiB, WS_U = 32 * MiB, WS_V = 64 * MiB, WS_XN = 96 * MiB,
                 WS_GLU = 160 * MiB, WS_HG = 192 * MiB, WS_Y = 320 * MiB, WS_EIDX = 416 * MiB, WS_GATE = 432 * MiB, WS_END = 448 * MiB;
constexpr int LDS_BYTES = 163840;

#define LDS_WAIT() asm volatile("s_waitcnt lgkmcnt(0)" ::: "memory")
#define BLOCK_BAR() do { asm volatile("s_waitcnt lgkmcnt(0)" ::: "memory"); __builtin_amdgcn_s_barrier(); asm volatile("" ::: "memory"); } while (0)
__device__ __forceinline__ float wave_sum(float v) {
#pragma unroll
    for (int o = 1; o < 64; o <<= 1) v += __shfl_xor(v, o);
    return v;
}
__device__ __forceinline__ float bf_lo(unsigned u) { return __builtin_bit_cast(float, u << 16); }
__device__ __forceinline__ float bf_hi(unsigned u) { return __builtin_bit_cast(float, u & 0xffff0000u); }
__device__ __forceinline__ float bf1(bf16_t u) { return __builtin_bit_cast(float, (unsigned)u << 16); }
__device__ __forceinline__ float fsilu(float x) { return x * fsigmoid(x); }

struct Args { const float* in[16]; float* out; unsigned char* ws; int ph_lo, ph_hi; };

__device__ __forceinline__ void p0_transpose_item(const float* __restrict__ W, int K, int N, bf16_t* __restrict__ WT, int out_row0, const float* __restrict__ gk, LAS float* scr, int k0, int n0, int lane) {
#pragma unroll 8
    for (int i = 0; i < 32; ++i) { const int kk = 2 * i + (lane >> 5); const float s = gk ? gk[k0 + kk] : 1.f; scr[kk * 33 + (lane & 31)] = W[(size_t)(k0 + kk) * N + n0 + (lane & 31)] * s; }
    LDS_WAIT();
    const int c = lane & 7;
#pragma unroll
    for (int j = 0; j < 4; ++j) { const int n = (lane >> 3) + 8 * j; const LAS float* s = scr + (8 * c) * 33 + n;
        u32x4 o; o.x = cvt_pk_bf16(s[0 * 33], s[1 * 33]); o.y = cvt_pk_bf16(s[2 * 33], s[3 * 33]); o.z = cvt_pk_bf16(s[4 * 33], s[5 * 33]); o.w = cvt_pk_bf16(s[6 * 33], s[7 * 33]);
        *(u32x4*)(WT + (size_t)(out_row0 + n) * K + k0 + 8 * c) = o; }
    LDS_WAIT();
}
__device__ __forceinline__ void row_to_bf16(const float* __restrict__ src, bf16_t* __restrict__ dst, const float* __restrict__ gv, bool norm, int lane) {
    const f32x4* xr = (const f32x4*)src + lane;
    f32x4 v[4]; float s = 0.f;
#pragma unroll
    for (int j = 0; j < 4; ++j) { v[j] = xr[64 * j]; s += (v[j].x * v[j].x + v[j].y * v[j].y) + (v[j].z * v[j].z + v[j].w * v[j].w); }
    float r = 1.f;
    if (norm) r = rsqrtf(wave_sum(s) * (1.f / D) + EPS);
    u32x2* o8 = (u32x2*)dst + lane;
#pragma unroll
    for (int j = 0; j < 4; ++j) {
        f32x4 t = v[j] * r;
        if (gv) t = t * ((const f32x4*)gv)[lane + 64 * j];
        u32x2 w; w.x = cvt_pk_bf16(t.x, t.y); w.y = cvt_pk_bf16(t.z, t.w); o8[64 * j] = w;
    }
}
__device__ __forceinline__ void row_to_fp8(const float* __restrict__ src, unsigned char* __restrict__ dst, const float* __restrict__ gv, float sc, int lane) {
    const f32x4* xr = (const f32x4*)src + lane;
    unsigned* o4 = (unsigned*)dst + lane;
#pragma unroll
    for (int j = 0; j < 4; ++j) {
        f32x4 t = xr[64 * j] * sc;
        if (gv) t = t * ((const f32x4*)gv)[lane + 64 * j];
        int w = __builtin_amdgcn_cvt_pk_fp8_f32(t.x, t.y, 0, false); w = __builtin_amdgcn_cvt_pk_fp8_f32(t.z, t.w, w, true);
        o4[64 * j] = (unsigned)w;
    }
}
__device__ __forceinline__ void weff_unit(LAS unsigned char* lds, const float* __restrict__ wq, const float* __restrict__ sk, const float* __restrict__ g2, bf16_t* __restrict__ WE, int unit, int tid) {
    LAS float* SK = (LAS float*)lds;
    LAS float* WQ = (LAS float*)(lds + 128 * 129 * 4);
    const int hp = unit >> 5, d0 = (unit & 31) * 32;
#pragma unroll 4
    for (int i = 0; i < 32; ++i) { const int idx = tid + i * NT; SK[(idx >> 7) * 129 + (idx & 127)] = sk[(size_t)hp * 16384 + idx]; }
#pragma unroll
    for (int i = 0; i < 8; ++i) { const int idx = tid + i * NT; WQ[idx] = wq[(size_t)(d0 + (idx >> 7)) * NQ + hp * 128 + (idx & 127)]; }
    __syncthreads();
    const int n = tid & 127, dq = tid >> 7;
    float acc[8];
#pragma unroll
    for (int e = 0; e < 8; ++e) acc[e] = 0.f;
    for (int j4 = 0; j4 < 32; ++j4) {
        float s[4];
#pragma unroll
        for (int q = 0; q < 4; ++q) s[q] = SK[n * 129 + 4 * j4 + q];
#pragma unroll
        for (int e = 0; e < 8; ++e) { const f32x4 w = *(const LAS f32x4*)(WQ + (dq * 8 + e) * 128 + 4 * j4); acc[e] = fmaf(s[0], w.x, acc[e]); acc[e] = fmaf(s[1], w.y, acc[e]); acc[e] = fmaf(s[2], w.z, acc[e]); acc[e] = fmaf(s[3], w.w, acc[e]); }
    }
    const float* gp = g2 + d0 + dq * 8;
    u32x4 o; o.x = cvt_pk_bf16(acc[0] * gp[0], acc[1] * gp[1]); o.y = cvt_pk_bf16(acc[2] * gp[2], acc[3] * gp[3]); o.z = cvt_pk_bf16(acc[4] * gp[4], acc[5] * gp[5]); o.w = cvt_pk_bf16(acc[6] * gp[6], acc[7] * gp[7]);
    *(u32x4*)(WE + (size_t)(hp * 128 + n) * D + d0 + dq * 8) = o;
    __syncthreads();
}
__device__ __forceinline__ void p0_prologue(const Args& a, LAS unsigned char* lds, int tid, int lane, int wave, int G) {
    unsigned char* ws = a.ws;
    for (int u = blockIdx.x; u < 512; u += G) weff_unit(lds, a.in[11], a.in[12], a.in[10], (bf16_t*)(ws + WS_WEFF), u, tid);
    LAS float* scr = (LAS float*)(lds + wave * 16384);
    const int gw = blockIdx.x * NWAVES + wave, NGW = G * NWAVES;
    constexpr int I_IN = (D / 64) * (DIN / 32), I_OUT = (D / 64) * (D / 32);
    for (int it = gw; it < I_IN + I_OUT; it += NGW) {
        if (it < I_IN) {
            const int kb = it / (DIN / 32), nb = it % (DIN / 32), n0 = nb * 32;
            int r0;
            if (n0 < 512) r0 = 256 * (n0 >> 7) + (n0 & 127); else if (n0 < 1024) r0 = 256 * ((n0 - 512) >> 7) + 128 + ((n0 - 512) & 127); else r0 = n0;
            p0_transpose_item(a.in[2], D, DIN, (bf16_t*)(ws + WS_WIN), r0, a.in[1], scr, kb * 64, n0, lane);
        } else {
            const int r = it - I_IN, kb = r / (D / 32), nb = r % (D / 32);
            p0_transpose_item(a.in[9], D, D, (bf16_t*)(ws + WS_WOUT), nb * 32, nullptr, scr, kb * 64, nb * 32, lane);
        }
    }
    for (int r = gw; r < NEXP; r += NGW) row_to_fp8(a.in[13] + (size_t)r * D, ws + WS_U + (size_t)r * D, a.in[10], 64.f, lane);
    for (int r = gw; r < NEXP; r += NGW) row_to_fp8(a.in[14] + (size_t)r * D, ws + WS_V + (size_t)r * D, nullptr, 8.f, lane);
    for (int r = gw; r < M; r += NGW) row_to_bf16(a.in[0] + (size_t)r * D, (bf16_t*)(ws + WS_XN) + (size_t)r * D, nullptr, true, lane);
}

__device__ __forceinline__ void conv_wave_unit(const bf16_t* __restrict__ GLU, const float* __restrict__ cw, const float* __restrict__ cb, const float* __restrict__ ng, const float* __restrict__ nb,
                                               bf16_t* __restrict__ Y, int wu, int lane) {
    const int grp = wu & 7, tb = wu >> 3, b = tb >> 5, s0 = (tb & 31) * 128, c = grp * 64 + lane;
    float w[CW];
#pragma unroll
    for (int j = 0; j < CW; ++j) w[j] = cw[j * DCONV + c];
    const float bias = cb[c], gam = ng[c], bet = nb[c];
    const size_t rowb = (size_t)b * SEQ;
    float win[38];
#pragma unroll
    for (int i = 0; i < 30; ++i) { const int s = s0 - 30 + i; win[i] = (s >= 0) ? bf1(GLU[(rowb + s) * DCONV + c]) : 0.f; }
#pragma unroll 1
    for (int it = 0; it < 16; ++it) {
        const int s = s0 + it * 8;
#pragma unroll
        for (int i = 0; i < 8; ++i) win[30 + i] = bf1(GLU[(rowb + s + i) * DCONV + c]);
#pragma unroll
        for (int i = 0; i < 8; ++i) {
            float acc = bias;
#pragma unroll
            for (int j = 0; j < CW; ++j) acc = fmaf(w[j], win[i + j], acc);
            const float mu = wave_sum(acc) * (1.f / 64.f), d = acc - mu, var = wave_sum(d * d) * (1.f / 64.f);
            const float hn = d * rsqrtf(var + EPS) * gam + bet;
            Y[(rowb + s + i) * D + c] = (bf16_t)(cvt_pk_bf16(fsilu(hn), 0.f) & 0xffffu);
        }
#pragma unroll
        for (int i = 0; i < 30; ++i) win[i] = win[i + 8];
    }
}

constexpr int HQ_OFF = 0, HK_OFF = 17408, HKH_OFF = 34816, HV_OFF = 53248, HP_OFF = 71680, HDC_OFF = 80896, HTOT_OFF = 81408, HO_OFF = 85504;
template <bool P3>
__device__ __forceinline__ void hgrn_unit(LAS unsigned char* lds, int unit, const bf16_t* __restrict__ HG, const float* __restrict__ lbl, const float* __restrict__ hng, float* __restrict__ HS, float* __restrict__ HLD,
                                          bf16_t* __restrict__ Y, int tid, int lane, int w) {
    const int seg = unit & (SEGS - 1), bh = unit >> 3, h = bh & 3, b = bh >> 2;
    const int g = lane >> 4, fr = lane & 15, kp = lane;
    const int c0 = h * HD + 2 * kp;
    const float lb0 = __builtin_amdgcn_rcpf(1.f + __expf(lbl[DH + c0] - lbl[c0])), lb1 = __builtin_amdgcn_rcpf(1.f + __expf(lbl[DH + c0 + 1] - lbl[c0 + 1]));
    f32x4 S[8];
#pragma unroll
    for (int i = 0; i < 8; ++i) S[i] = (f32x4){0.f, 0.f, 0.f, 0.f};
    if (P3) {
        for (int i = 0; i < seg; ++i) {
            const float* sp = HS + (size_t)(bh * SEGS + i) * 16384 + w * 2048 + lane;
            const float* ld = HLD + (size_t)(bh * SEGS + i) * 128 + 4 * g;
#pragma unroll
            for (int t = 0; t < 8; ++t) { const f32x4 dd = *(const f32x4*)(ld + 16 * t);
#pragma unroll
                for (int r = 0; r < 4; ++r) S[t][r] = fmaf(__expf(dd[r]), S[t][r], sp[(t * 4 + r) * 64]); }
        }
    }
    float ldsum0 = 0.f, ldsum1 = 0.f;
    const size_t row_base = (size_t)b * SEQ + (size_t)seg * SEGLEN;
    const unsigned* HGw = (const unsigned*)HG;
    unsigned zq[8], qq[8], vq[8];
#define HG_LOAD(c) do { _Pragma("unroll") for (int i = 0; i < 8; ++i) { const size_t ro = (row_base + (c) * 64 + 8 * w + i) * 1024 + (h * 64 + kp); \
        zq[i] = HGw[ro + 256]; vq[i] = HGw[ro + 512]; if (P3) qq[i] = HGw[ro]; } } while (0)
    HG_LOAD(0);
    float gn[16];
    const int nt_t = tid >> 3, nt_v = (tid & 7) * 16;
    if (P3) {
#pragma unroll
        for (int e = 0; e < 16; ++e) gn[e] = hng[h * HD + nt_v + e];
    }
#pragma unroll 1
    for (int c = 0; c < NCH; ++c) {
        float cs0[8], cs1[8], kk0[8], kk1[8];
        float cum0 = 0.f, cum1 = 0.f;
#pragma unroll
        for (int i = 0; i < 8; ++i) {
            const float sg0 = fsigmoid(bf_lo(zq[i])), sg1 = fsigmoid(bf_hi(zq[i]));
            cum0 += __logf(lb0 + (1.f - lb0) * sg0); cum1 += __logf(lb1 + (1.f - lb1) * sg1);
            cs0[i] = cum0; cs1[i] = cum1; kk0[i] = (1.f - lb0) * (1.f - sg0); kk1[i] = (1.f - lb1) * (1.f - sg1);
        }
        LAS float* tot = (LAS float*)(lds + HTOT_OFF);
        *(LAS f32x2*)(tot + w * 128 + 2 * kp) = (f32x2){cum0, cum1};
        BLOCK_BAR();
        float off0 = 0.f, off1 = 0.f, all0 = 0.f, all1 = 0.f;
#pragma unroll
        for (int ww = 0; ww < 8; ++ww) { const f32x2 tt = *(const LAS f32x2*)(tot + ww * 128 + 2 * kp); if (ww < w) { off0 += tt.x; off1 += tt.y; } all0 += tt.x; all1 += tt.y; }
        ldsum0 += all0; ldsum1 += all1;
        unsigned kh0[4], kh1[4], vt0[4], vt1[4];
#pragma unroll
        for (int i = 0; i < 8; i += 2) {
            float a0[2], a1[2];
#pragma unroll
            for (int e = 0; e < 2; ++e) {
                const float B0 = off0 + cs0[i + e], B1 = off1 + cs1[i + e];
                if (P3) {
                    const float q0 = bf_lo(qq[i + e]) * __expf(B0), q1 = bf_hi(qq[i + e]) * __expf(B1);
                    const float k0 = kk0[i + e] * __expf(-B0), k1 = kk1[i + e] * __expf(-B1);
                    *(LAS unsigned*)(lds + HQ_OFF + (8 * w + i + e) * 272 + 4 * kp) = cvt_pk_bf16(q0, q1);
                    *(LAS unsigned*)(lds + HK_OFF + (8 * w + i + e) * 272 + 4 * kp) = cvt_pk_bf16(k0, k1);
                }
                a0[e] = kk0[i + e] * __expf(all0 - B0); a1[e] = kk1[i + e] * __expf(all1 - B1);
            }
            kh0[i >> 1] = cvt_pk_bf16(a0[0], a0[1]); kh1[i >> 1] = cvt_pk_bf16(a1[0], a1[1]);
            vt0[i >> 1] = (vq[i] & 0xffffu) | (vq[i + 1] << 16); vt1[i >> 1] = (vq[i] >> 16) | (vq[i + 1] & 0xffff0000u);
        }
        *(LAS u32x4*)(lds + HKH_OFF + (2 * kp) * 144 + 16 * w) = (u32x4){kh0[0], kh0[1], kh0[2], kh0[3]};
        *(LAS u32x4*)(lds + HKH_OFF + (2 * kp + 1) * 144 + 16 * w) = (u32x4){kh1[0], kh1[1], kh1[2], kh1[3]};
        *(LAS u32x4*)(lds + HV_OFF + (2 * kp) * 144 + 16 * w) = (u32x4){vt0[0], vt0[1], vt0[2], vt0[3]};
        *(LAS u32x4*)(lds + HV_OFF + (2 * kp + 1) * 144 + 16 * w) = (u32x4){vt1[0], vt1[1], vt1[2], vt1[3]};
        if (w == 0) *(LAS f32x2*)(lds + HDC_OFF + 8 * kp) = (f32x2){__expf(all0), __expf(all1)};
        BLOCK_BAR();
        if (c + 1 < NCH) HG_LOAD(c + 1);
        bf16x8 vfrag[2];
#pragma unroll
        for (int ks = 0; ks < 2; ++ks) vfrag[ks] = *(const LAS bf16x8*)(lds + HV_OFF + (16 * w + fr) * 144 + 64 * ks + 16 * g);
        if (P3) {
            u32x4 gq[2];
            { const u32x4* gp = (const u32x4*)(HG + (row_base + c * 64 + nt_t) * 2048 + 1536 + h * HD + nt_v); gq[0] = gp[0]; gq[1] = gp[1]; }
            {
                const int mt = w >> 1;
#pragma unroll
                for (int nti = 0; nti < 2; ++nti) {
                    const int nt = 2 * (w & 1) + nti;
                    f32x4 p = (f32x4){0.f, 0.f, 0.f, 0.f};
                    if (nt <= mt) {
#pragma unroll
                        for (int ks = 0; ks < 4; ++ks) {
                            const bf16x8 af = *(const LAS bf16x8*)(lds + HQ_OFF + (16 * mt + fr) * 272 + 64 * ks + 16 * g);
                            const bf16x8 bf = *(const LAS bf16x8*)(lds + HK_OFF + (16 * nt + fr) * 272 + 64 * ks + 16 * g);
                            p = __builtin_amdgcn_mfma_f32_16x16x32_bf16(af, bf, p, 0, 0, 0);
                        }
                    }
#pragma unroll
                    for (int r = 0; r < 4; ++r) {
                        const int t = 16 * mt + 4 * g + r, s = 16 * nt + fr;
                        const float pv = (s <= t) ? p[r] : 0.f;
                        *(LAS bf16_t*)(lds + HP_OFF + t * 144 + 2 * s) = (bf16_t)(cvt_pk_bf16(pv, 0.f) & 0xffffu);
                    }
                }
            }
            BLOCK_BAR();
            f32x4 o[4];
#pragma unroll
            for (int mt = 0; mt < 4; ++mt) o[mt] = (f32x4){0.f, 0.f, 0.f, 0.f};
#pragma unroll
            for (int ks = 0; ks < 4; ++ks) {
                u32x4 sb; sb.x = cvt_pk_bf16(S[2 * ks][0], S[2 * ks][1]); sb.y = cvt_pk_bf16(S[2 * ks][2], S[2 * ks][3]); sb.z = cvt_pk_bf16(S[2 * ks + 1][0], S[2 * ks + 1][1]); sb.w = cvt_pk_bf16(S[2 * ks + 1][2], S[2 * ks + 1][3]);
                const bf16x8 bfrag = __builtin_bit_cast(bf16x8, sb);
#pragma unroll
                for (int mt = 0; mt < 4; ++mt) {
                    const u32x2 alo = *(const LAS u32x2*)(lds + HQ_OFF + (16 * mt + fr) * 272 + 64 * ks + 8 * g);
                    const u32x2 ahi = *(const LAS u32x2*)(lds + HQ_OFF + (16 * mt + fr) * 272 + 64 * ks + 32 + 8 * g);
                    const bf16x8 af = __builtin_bit_cast(bf16x8, (u32x4){alo.x, alo.y, ahi.x, ahi.y});
                    o[mt] = __builtin_amdgcn_mfma_f32_16x16x32_bf16(af, bfrag, o[mt], 0, 0, 0);
                }
            }
#pragma unroll
            for (int ks = 0; ks < 2; ++ks)
#pragma unroll
                for (int mt = 0; mt < 4; ++mt) {
                    const bf16x8 af = *(const LAS bf16x8*)(lds + HP_OFF + (16 * mt + fr) * 144 + 64 * ks + 16 * g);
                    o[mt] = __builtin_amdgcn_mfma_f32_16x16x32_bf16(af, vfrag[ks], o[mt], 0, 0, 0);
                }
#pragma unroll
            for (int mt = 0; mt < 4; ++mt)
#pragma unroll
                for (int r = 0; r < 4; ++r) *(LAS float*)(lds + HO_OFF + ((16 * mt + 4 * g + r) * 132 + 16 * w + fr) * 4) = o[mt][r];
#pragma unroll
            for (int i = 0; i < 8; ++i) {
                const f32x4 dd = *(const LAS f32x4*)(lds + HDC_OFF + (16 * i + 4 * g) * 4);
                S[i] = S[i] * dd;
#pragma unroll
                for (int ks = 0; ks < 2; ++ks) { const bf16x8 af = *(const LAS bf16x8*)(lds + HKH_OFF + (16 * i + fr) * 144 + 64 * ks + 16 * g); S[i] = __builtin_amdgcn_mfma_f32_16x16x32_bf16(af, vfrag[ks], S[i], 0, 0, 0); }
            }
            BLOCK_BAR();
            {
                f32x4 ov[4]; float ss = 0.f;
#pragma unroll
                for (int q = 0; q < 4; ++q) { ov[q] = *(const LAS f32x4*)(lds + HO_OFF + (nt_t * 132 + nt_v + 4 * q) * 4); ss += (ov[q].x * ov[q].x + ov[q].y * ov[q].y) + (ov[q].z * ov[q].z + ov[q].w * ov[q].w); }
                ss += __shfl_xor(ss, 1); ss += __shfl_xor(ss, 2); ss += __shfl_xor(ss, 4);
                const float rs = rsqrtf(ss * (1.f / HD) + EPS);
                u32x4 ow[2];
#pragma unroll
                for (int q = 0; q < 4; ++q) {
                    const unsigned g01 = (q & 1) ? gq[q >> 1].z : gq[q >> 1].x, g23 = (q & 1) ? gq[q >> 1].w : gq[q >> 1].y;
                    const float y0 = ov[q].x * rs * gn[4 * q] * bf_lo(g01), y1 = ov[q].y * rs * gn[4 * q + 1] * bf_hi(g01), y2 = ov[q].z * rs * gn[4 * q + 2] * bf_lo(g23), y3 = ov[q].w * rs * gn[4 * q + 3] * bf_hi(g23);
                    if (q & 1) { ow[q >> 1].z = cvt_pk_bf16(y0, y1); ow[q >> 1].w = cvt_pk_bf16(y2, y3); } else { ow[q >> 1].x = cvt_pk_bf16(y0, y1); ow[q >> 1].y = cvt_pk_bf16(y2, y3); }
                }
                u32x4* yp = (u32x4*)(Y + (row_base + c * 64 + nt_t) * D + DCONV + h * HD + nt_v); yp[0] = ow[0]; yp[1] = ow[1];
            }
        } else {
#pragma unroll
            for (int i = 0; i < 8; ++i) {
                const f32x4 dd = *(const LAS f32x4*)(lds + HDC_OFF + (16 * i + 4 * g) * 4);
                S[i] = S[i] * dd;
#pragma unroll
                for (int ks = 0; ks < 2; ++ks) { const bf16x8 af = *(const LAS bf16x8*)(lds + HKH_OFF + (16 * i + fr) * 144 + 64 * ks + 16 * g); S[i] = __builtin_amdgcn_mfma_f32_16x16x32_bf16(af, vfrag[ks], S[i], 0, 0, 0); }
            }
        }
    }
#undef HG_LOAD
    if (!P3) {
        float* sp = HS + (size_t)unit * 16384 + w * 2048 + lane;
#pragma unroll
        for (int t = 0; t < 8; ++t)
#pragma unroll
            for (int r = 0; r < 4; ++r) sp[(t * 4 + r) * 64] = S[t][r];
        if (w == 0) *(f32x2*)(HLD + (size_t)unit * 128 + 2 * kp) = (f32x2){ldsum0, ldsum1};
    }
    BLOCK_BAR();
}

constexpr float U_SCALE = 64.f, V_SCALE = 8.f;
__device__ __forceinline__ float wave_sum_dpp(float v) {
    v += __builtin_bit_cast(float, __builtin_amdgcn_update_dpp(0, __builtin_bit_cast(int, v), 0x111, 0xf, 0xf, false));
    v += __builtin_bit_cast(float, __builtin_amdgcn_update_dpp(0, __builtin_bit_cast(int, v), 0x112, 0xf, 0xf, false));
    v += __builtin_bit_cast(float, __builtin_amdgcn_update_dpp(0, __builtin_bit_cast(int, v), 0x114, 0xf, 0xf, false));
    v += __builtin_bit_cast(float, __builtin_amdgcn_update_dpp(0, __builtin_bit_cast(int, v), 0x118, 0xf, 0xf, false));
    v += __builtin_bit_cast(float, __builtin_amdgcn_update_dpp(0, __builtin_bit_cast(int, v), 0x142, 0xa, 0xf, false));
    v += __builtin_bit_cast(float, __builtin_amdgcn_update_dpp(0, __builtin_bit_cast(int, v), 0x143, 0xc, 0xf, false));
    return __builtin_bit_cast(float, __builtin_amdgcn_readlane(__builtin_bit_cast(int, v), 63));
}
__device__ __forceinline__ float gelu_as(float v) {
    const float av = fabsf(v), t = __builtin_amdgcn_rcpf(fmaf(av, 0.2316418882f, 1.0f));
    float q = fmaf(t, 0.5307027145f, -0.7265760135f); q = fmaf(q, t, 0.7107068705f); q = fmaf(q, t, -0.142248368f); q = fmaf(q, t, 0.127414796f); q = q * t;
    const float e = __builtin_amdgcn_exp2f(v * v * -0.72134752044f), m = v * (q * e);
    return v < 0.f ? m : v - m;
}
__device__ __forceinline__ float dot16_fp8(const u32x4 w, const f32x2 (&x2)[8]) {
    f32x2 acc = __builtin_amdgcn_cvt_pk_f32_fp8(w.x, false) * x2[0];
    acc = __builtin_elementwise_fma(__builtin_amdgcn_cvt_pk_f32_fp8(w.x, true), x2[1], acc);
    acc = __builtin_elementwise_fma(__builtin_amdgcn_cvt_pk_f32_fp8(w.y, false), x2[2], acc);
    acc = __builtin_elementwise_fma(__builtin_amdgcn_cvt_pk_f32_fp8(w.y, true), x2[3], acc);
    acc = __builtin_elementwise_fma(__builtin_amdgcn_cvt_pk_f32_fp8(w.z, false), x2[4], acc);
    acc = __builtin_elementwise_fma(__builtin_amdgcn_cvt_pk_f32_fp8(w.z, true), x2[5], acc);
    acc = __builtin_elementwise_fma(__builtin_amdgcn_cvt_pk_f32_fp8(w.w, false), x2[6], acc);
    acc = __builtin_elementwise_fma(__builtin_amdgcn_cvt_pk_f32_fp8(w.w, true), x2[7], acc);
    return acc.x + acc.y;
}
__device__ __forceinline__ void axpy16_fp8(const u32x4 w, const float s, f32x2 (&y2)[8]) {
    const f32x2 s2 = (f32x2){s, s};
    y2[0] = __builtin_elementwise_fma(__builtin_amdgcn_cvt_pk_f32_fp8(w.x, false), s2, y2[0]);
    y2[1] = __builtin_elementwise_fma(__builtin_amdgcn_cvt_pk_f32_fp8(w.x, true), s2, y2[1]);
    y2[2] = __builtin_elementwise_fma(__builtin_amdgcn_cvt_pk_f32_fp8(w.y, false), s2, y2[2]);
    y2[3] = __builtin_elementwise_fma(__builtin_amdgcn_cvt_pk_f32_fp8(w.y, true), s2, y2[3]);
    y2[4] = __builtin_elementwise_fma(__builtin_amdgcn_cvt_pk_f32_fp8(w.z, false), s2, y2[4]);
    y2[5] = __builtin_elementwise_fma(__builtin_amdgcn_cvt_pk_f32_fp8(w.z, true), s2, y2[5]);
    y2[6] = __builtin_elementwise_fma(__builtin_amdgcn_cvt_pk_f32_fp8(w.w, false), s2, y2[6]);
    y2[7] = __builtin_elementwise_fma(__builtin_amdgcn_cvt_pk_f32_fp8(w.w, true), s2, y2[7]);
}
#define P7_LOAD1(dst, evh, tab, slot) do { const int e_ = __builtin_amdgcn_readlane((evh), (slot)); dst = __builtin_amdgcn_raw_buffer_load_b128((tab), voff, e_ << 10, 0); } while (0)
#define P7_ISSUE(BANK, evh, tab, q) do { _Pragma("unroll") for (int r = 0; r < 16; ++r) P7_LOAD1(BANK[r], evh, tab, (q) * 16 + r); } while (0)
#define P7_CONS_U(BANK, q, evn, tabn, qn) do { _Pragma("unroll") for (int r = 0; r < 16; ++r) { const float tot_ = wave_sum_dpp(dot16_fp8(BANK[r], x2)); dvec = (lane == (q) * 16 + r) ? tot_ : dvec; \
        __builtin_amdgcn_sched_barrier(0); P7_LOAD1(BANK[r], evn, tabn, (qn) * 16 + r); __builtin_amdgcn_sched_barrier(0); } } while (0)
#define P7_CONS_V(BANK, q, evn, tabn, qn) do { _Pragma("unroll") for (int r = 0; r < 16; ++r) { const float w_ = __builtin_bit_cast(float, __builtin_amdgcn_readlane(__builtin_bit_cast(int, wvec), (q) * 16 + r)); axpy16_fp8(BANK[r], w_, y2); \
        __builtin_amdgcn_sched_barrier(0); P7_LOAD1(BANK[r], evn, tabn, (qn) * 16 + r); __builtin_amdgcn_sched_barrier(0); } } while (0)
__device__ __forceinline__ void peer_phase(const bf16_t* __restrict__ XN2, const int* __restrict__ EIDX, const float* __restrict__ GATE, const unsigned char* __restrict__ U8p, const unsigned char* __restrict__ V8p,
                                           const float* H2, const float* __restrict__ fg, float* out, int gw, int NGW, int lane) {
    if (gw >= M) return;
    const __amdgpu_buffer_rsrc_t RU = __builtin_amdgcn_make_buffer_rsrc((void*)U8p, 0, NEXP * 1024, 0x00020000);
    const __amdgpu_buffer_rsrc_t RV = __builtin_amdgcn_make_buffer_rsrc((void*)V8p, 0, NEXP * 1024, 0x00020000);
    const int voff = lane * 16;
    u32x4 A[16], B[16];
    int t = gw;
    int ev0 = EIDX[(size_t)t * 128 + lane], ev1 = EIDX[(size_t)t * 128 + 64 + lane];
    float gv0 = GATE[(size_t)t * 128 + lane], gv1 = GATE[(size_t)t * 128 + 64 + lane];
    u32x4 xa = *((const u32x4*)(XN2 + (size_t)t * D) + 2 * lane), xb = *((const u32x4*)(XN2 + (size_t)t * D) + 2 * lane + 1);
    P7_ISSUE(A, ev0, RU, 0);
    P7_ISSUE(B, ev0, RU, 1);
#pragma unroll 1
    for (;;) {
        const int tn = t + NGW; const bool has_next = tn < M; const int tl = has_next ? tn : t;
        const int nev0 = EIDX[(size_t)tl * 128 + lane], nev1 = EIDX[(size_t)tl * 128 + 64 + lane];
        const float ngv0 = GATE[(size_t)tl * 128 + lane], ngv1 = GATE[(size_t)tl * 128 + 64 + lane];
        const u32x4 nxa = *((const u32x4*)(XN2 + (size_t)tl * D) + 2 * lane), nxb = *((const u32x4*)(XN2 + (size_t)tl * D) + 2 * lane + 1);
        f32x2 x2[8], y2[8];
        x2[0] = (f32x2){bf_lo(xa.x), bf_hi(xa.x)}; x2[1] = (f32x2){bf_lo(xa.y), bf_hi(xa.y)}; x2[2] = (f32x2){bf_lo(xa.z), bf_hi(xa.z)}; x2[3] = (f32x2){bf_lo(xa.w), bf_hi(xa.w)};
        x2[4] = (f32x2){bf_lo(xb.x), bf_hi(xb.x)}; x2[5] = (f32x2){bf_lo(xb.y), bf_hi(xb.y)}; x2[6] = (f32x2){bf_lo(xb.z), bf_hi(xb.z)}; x2[7] = (f32x2){bf_lo(xb.w), bf_hi(xb.w)};
#pragma unroll
        for (int j = 0; j < 8; ++j) y2[j] = (f32x2){0.f, 0.f};
        float dvec = 0.f, wvec = 0.f;
#pragma unroll 1
        for (int half = 0; half < 2; ++half) {
            const int evh = half ? ev1 : ev0;
            const float gvh = half ? gv1 : gv0;
            const int evx = half ? nev0 : ev1;
#pragma unroll 1
            for (int sp = 0; sp < 2; ++sp) {
                const __amdgpu_buffer_rsrc_t tabn = sp ? RV : RU; const int qn = sp ? 0 : 2;
                P7_CONS_U(A, 2 * sp, evh, tabn, qn);
                P7_CONS_U(B, 2 * sp + 1, evh, tabn, qn + 1);
            }
            wvec = gvh * gelu_as(dvec * (1.f / U_SCALE)) * (1.f / V_SCALE);
#pragma unroll 1
            for (int sp = 0; sp < 2; ++sp) {
                const __amdgpu_buffer_rsrc_t tabn = sp ? RU : RV; const int qn = sp ? 0 : 2; const int evn = sp ? evx : evh;
                P7_CONS_V(A, 2 * sp, evn, tabn, qn);
                P7_CONS_V(B, 2 * sp + 1, evn, tabn, qn + 1);
            }
        }
        {
            const f32x4* hr = (const f32x4*)(H2 + (size_t)t * D) + 4 * lane;
            const f32x4 h0 = hr[0], h1 = hr[1], h2 = hr[2], h3 = hr[3];
            f32x4 z0 = (f32x4){y2[0].x, y2[0].y, y2[1].x, y2[1].y} + h0, z1 = (f32x4){y2[2].x, y2[2].y, y2[3].x, y2[3].y} + h1, z2 = (f32x4){y2[4].x, y2[4].y, y2[5].x, y2[5].y} + h2, z3 = (f32x4){y2[6].x, y2[6].y, y2[7].x, y2[7].y} + h3;
            const float s = (z0.x * z0.x + z0.y * z0.y) + (z0.z * z0.z + z0.w * z0.w) + (z1.x * z1.x + z1.y * z1.y) + (z1.z * z1.z + z1.w * z1.w) + (z2.x * z2.x + z2.y * z2.y) + (z2.z * z2.z + z2.w * z2.w) + (z3.x * z3.x + z3.y * z3.y) + (z3.z * z3.z + z3.w * z3.w);
            const float rr = rsqrtf(wave_sum_dpp(s) * (1.f / D) + EPS);
            const f32x4* gf = (const f32x4*)fg + 4 * lane;
            f32x4* op = (f32x4*)(out + (size_t)t * D) + 4 * lane;
            op[0] = z0 * rr * gf[0]; op[1] = z1 * rr * gf[1]; op[2] = z2 * rr * gf[2]; op[3] = z3 * rr * gf[3];
        }
        if (!has_next) break;
        t = tn; ev0 = nev0; ev1 = nev1; gv0 = ngv0; gv1 = ngv1; xa = nxa; xb = nxb;
    }
}
#undef P7_ISSUE
#undef P7_LOAD1
#undef P7_CONS_U
#undef P7_CONS_V

__global__ void __launch_bounds__(NT, 2) mega(Args a) {
    extern __shared__ __attribute__((aligned(16))) unsigned char lds_raw[];
    LAS unsigned char* lds = (LAS unsigned char*)lds_raw;
    cg::grid_group grid = cg::this_grid();
    const int wave = __builtin_amdgcn_readfirstlane(threadIdx.x >> 6), G = gridDim.x;
#define PH_IDS() const int lane = pg8::lane_id_v(), tid = wave * 64 + lane; (void)tid; (void)lane
    unsigned char* ws = a.ws;
    const int lo = a.ph_lo, hi = a.ph_hi;
    bf16_t* WIN = (bf16_t*)(ws + WS_WIN); bf16_t* WOUT = (bf16_t*)(ws + WS_WOUT); bf16_t* WEFF = (bf16_t*)(ws + WS_WEFF);
    bf16_t* XN = (bf16_t*)(ws + WS_XN);
    bf16_t* GLU = (bf16_t*)(ws + WS_GLU); bf16_t* HG = (bf16_t*)(ws + WS_HG); bf16_t* Y = (bf16_t*)(ws + WS_Y);
    float* HS = (float*)(ws + WS_HS); float* HLD = (float*)(ws + WS_HLD);
    int* EIDX = (int*)(ws + WS_EIDX); float* GATE = (float*)(ws + WS_GATE);
    const int gw = blockIdx.x * NWAVES + wave, NGW = G * NWAVES;
#ifndef PH_MASK
#define PH_MASK 0xff
#endif
#define IN(k) (((PH_MASK >> (k)) & 1) && lo <= (k) && (k) < hi)
#define SEAM(k) do { if (IN(k) && IN((k) + 1)) grid.sync(); } while (0)
    if (IN(0)) { PH_IDS(); p0_prologue(a, lds, tid, lane, wave, G); }
    SEAM(0);
    if (IN(1)) {
        pg8::Gemm g{XN, WIN, M, DIN, D}; pg8::StaticOrder S; S.init(M, DIN, G, (int)blockIdx.x);
        pg8::EpiProj E{GLU, HG};
        pg8::gemm_phase<pg8::EpiProj, pg8::StaticOrder, true, true>(lds, g, S, E, wave);
    }
    SEAM(1);
    if (IN(2)) { PH_IDS();
        for (int u = blockIdx.x; u < BATCH * NH * SEGS; u += G) hgrn_unit<false>(lds, u, HG, a.in[7], a.in[8], HS, HLD, Y, tid, lane, wave);
        for (int wu = gw; wu < 2048; wu += NGW) conv_wave_unit(GLU, a.in[3], a.in[4], a.in[5], a.in[6], Y, wu, lane);
    }
    SEAM(2);
    if (IN(3)) { PH_IDS();
        for (int u = blockIdx.x; u < BATCH * NH * SEGS; u += G) hgrn_unit<true>(lds, u, HG, a.in[7], a.in[8], HS, HLD, Y, tid, lane, wave);
    }
    SEAM(3);
    if (IN(4)) {
        pg8::Gemm g{Y, WOUT, M, D, D}; pg8::StaticOrder S; S.init(M, D, G, (int)blockIdx.x);
        pg8::EpiResF32 E{a.out, a.in[0], D};
        pg8::gemm_phase<pg8::EpiResF32, pg8::StaticOrder, true, true>(lds, g, S, E, wave);
    }
    SEAM(4);
    if (IN(5)) { PH_IDS();
        for (int r = gw; r < M; r += NGW) row_to_bf16(a.out + (size_t)r * D, XN + (size_t)r * D, nullptr, true, lane);
    }
    SEAM(5);
    if (IN(6)) {
        pg8::Gemm g{XN, WEFF, M, NQ, D}; pg8::StaticOrder S; S.init(M, NQ, G, (int)blockIdx.x);
        pg8::EpiTopK E{EIDX, GATE};
        for (int i = 0;; ++i) { pg8::OneUnit O; if (!S.next(i, O.u)) break; pg8::gemm_phase<pg8::EpiTopK, pg8::OneUnit, false, true>(lds, g, O, E, wave); }
    }
    SEAM(6);
    if (IN(7)) { PH_IDS();
        peer_phase(XN, EIDX, GATE, ws + WS_U, ws + WS_V, a.out, a.in[15], a.out, gw, NGW, lane);
    }
#undef IN
#undef SEAM
}
}

#ifndef STAGE
#define STAGE 5
#endif
#if STAGE < 5
namespace nv {
constexpr int D = 1024, BATCH = 8, SEQ = 4096, M = BATCH * SEQ;
constexpr int DCONV = 512, CW = 31, DH = 512, NH = 4, HD = 128, DIN = 3072;
constexpr int NKEY = 128;
constexpr float EPS = 1e-6f;
typedef unsigned short bf16_t;
__device__ __forceinline__ float bf1(bf16_t u) { return __builtin_bit_cast(float, (unsigned)u << 16); }
__device__ __forceinline__ float wsum(float v) {
#pragma unroll
    for (int o = 1; o < 64; o <<= 1) v += __shfl_xor(v, o);
    return v;
}
__device__ __forceinline__ float sigmoidf_(float x) { return 1.f / (1.f + __expf(-x)); }
__device__ __forceinline__ float siluf_(float x) { return x * sigmoidf_(x); }
__global__ void __launch_bounds__(256) k_cvt(const bf16_t* __restrict__ s, float* __restrict__ d, size_t n) { const size_t i = (size_t)blockIdx.x * 256 + threadIdx.x; if (i < n) d[i] = bf1(s[i]); }
__global__ void __launch_bounds__(256) k_rmsnorm(const float* __restrict__ x, const float* __restrict__ g, float* __restrict__ out, int rows) {
    const int lane = threadIdx.x & 63, w = threadIdx.x >> 6;
    const int row = blockIdx.x * 4 + w;
    if (row >= rows) return;
    const float4* xr = (const float4*)(x + (size_t)row * D);
    float4 v[4]; float s = 0.f;
#pragma unroll
    for (int j = 0; j < 4; ++j) { v[j] = xr[lane + 64 * j]; s += v[j].x * v[j].x + v[j].y * v[j].y + v[j].z * v[j].z + v[j].w * v[j].w; }
    s = wsum(s);
    const float r = rsqrtf(s * (1.f / D) + EPS);
    float4* o = (float4*)(out + (size_t)row * D);
    const float4* g4 = (const float4*)g;
#pragma unroll
    for (int j = 0; j < 4; ++j) { const float4 gg = g4[lane + 64 * j]; float4 t; t.x = v[j].x * r * gg.x; t.y = v[j].y * r * gg.y; t.z = v[j].z * r * gg.z; t.w = v[j].w * r * gg.w; o[lane + 64 * j] = t; }
}
template <bool RES>
__global__ void __launch_bounds__(256) k_gemm(const float* __restrict__ A, const float* __restrict__ B, float* __restrict__ C, const float* __restrict__ R, int Mm, int N, int K) {
    __shared__ float As[16][68];
    __shared__ float Bs[16][64];
    const int tid = threadIdx.x, tx = tid & 15, ty = tid >> 4;
    const int m0 = blockIdx.y * 64, n0 = blockIdx.x * 64;
    float acc[4][4];
#pragma unroll
    for (int i = 0; i < 4; ++i)
#pragma unroll
        for (int j = 0; j < 4; ++j) acc[i][j] = 0.f;
    for (int k0 = 0; k0 < K; k0 += 16) {
#pragma unroll
        for (int i = 0; i < 4; ++i) { const int idx = tid + i * 256, r = idx >> 4, kk = idx & 15; As[kk][r] = A[(size_t)(m0 + r) * K + k0 + kk]; }
#pragma unroll
        for (int i = 0; i < 4; ++i) { const int idx = tid + i * 256, kk = idx >> 6, c = idx & 63; Bs[kk][c] = B[(size_t)(k0 + kk) * N + n0 + c]; }
        __syncthreads();
#pragma unroll
        for (int kk = 0; kk < 16; ++kk) {
            float a[4], b[4];
#pragma unroll
            for (int i = 0; i < 4; ++i) a[i] = As[kk][ty * 4 + i];
#pragma unroll
            for (int j = 0; j < 4; ++j) b[j] = Bs[kk][tx * 4 + j];
#pragma unroll
            for (int i = 0; i < 4; ++i)
#pragma unroll
                for (int j = 0; j < 4; ++j) acc[i][j] = fmaf(a[i], b[j], acc[i][j]);
        }
        __syncthreads();
    }
#pragma unroll
    for (int i = 0; i < 4; ++i) {
        const size_t off = (size_t)(m0 + ty * 4 + i) * N + n0 + tx * 4;
        float4 o; o.x = acc[i][0]; o.y = acc[i][1]; o.z = acc[i][2]; o.w = acc[i][3];
        if (RES) { const float4 r = *(const float4*)(R + off); o.x += r.x; o.y += r.y; o.z += r.z; o.w += r.w; }
        *(float4*)(C + off) = o;
    }
}
__global__ void __launch_bounds__(512) k_conv_glu(const bf16_t* __restrict__ GLU, const float* __restrict__ cw, const float* __restrict__ cb, const float* __restrict__ ng, const float* __restrict__ nb, float* __restrict__ Y) {
    const int t = blockIdx.x, s = t % SEQ, c = threadIdx.x;
    float acc = cb[c];
    for (int j = 0; j < CW; ++j) { const int ss = s - (CW - 1) + j; if (ss >= 0) acc = fmaf(cw[j * DCONV + c], bf1(GLU[(size_t)(t - (CW - 1) + j) * DCONV + c]), acc); }
    const float mu = wsum(acc) * (1.f / 64.f), d = acc - mu, var = wsum(d * d) * (1.f / 64.f);
    Y[(size_t)t * D + c] = siluf_(d * rsqrtf(var + EPS) * ng[c] + nb[c]);
}
__global__ void __launch_bounds__(128) k_hgrn_hg(const bf16_t* __restrict__ HG, const float* __restrict__ lbl, const float* __restrict__ hng, float* __restrict__ Y) {
    __shared__ float fs[HD], ks[HD], qs[HD], red[2];
    const int b = blockIdx.x / NH, h = blockIdx.x % NH, v = threadIdx.x, col = h * HD + v;
    const float lb = 1.f / (1.f + __expf(lbl[DH + col] - lbl[col])), gn = hng[col];
    float S[HD];
#pragma unroll
    for (int k = 0; k < HD; ++k) S[k] = 0.f;
    for (int s = 0; s < SEQ; ++s) {
        const bf16_t* pr = HG + (size_t)(b * SEQ + s) * 2048;
        const float qv = bf1(pr[col]), z = bf1(pr[DH + col]), iv = bf1(pr[2 * DH + col]), gv = bf1(pr[3 * DH + col]);
        const float sg = sigmoidf_(z);
        fs[v] = lb + (1.f - lb) * sg; ks[v] = (1.f - lb) * (1.f - sg); qs[v] = qv;
        __syncthreads();
        float o = 0.f;
#pragma unroll
        for (int k = 0; k < HD; ++k) { S[k] = fmaf(fs[k], S[k], ks[k] * iv); o = fmaf(S[k], qs[k], o); }
        const float sq = wsum(o * o);
        if ((v & 63) == 0) red[v >> 6] = sq;
        __syncthreads();
        const float ms = (red[0] + red[1]) * (1.f / HD);
        Y[(size_t)(b * SEQ + s) * D + DCONV + col] = o * rsqrtf(ms + EPS) * gn * gv;
        __syncthreads();
    }
}
__global__ void __launch_bounds__(256) k_scores(const float* __restrict__ Q, const float* __restrict__ sk, float* __restrict__ SC) {
    __shared__ float qs[2048];
    const int t = blockIdx.x;
    for (int i = threadIdx.x; i < 2048; i += 256) qs[i] = Q[(size_t)t * 2048 + i];
    __syncthreads();
    for (int o = threadIdx.x; o < 2048; o += 256) {
        const int hp = o >> 7; const float* kr = sk + (size_t)o * 128; const float* qq = qs + hp * 128;
        float a = 0.f;
        for (int j = 0; j < 128; ++j) a = fmaf(qq[j], kr[j], a);
        SC[(size_t)t * 2048 + o] = a;
    }
}
__device__ __forceinline__ void wave_argmax(float& v, int& i) {
#pragma unroll
    for (int o = 1; o < 64; o <<= 1) { const float ov = __shfl_xor(v, o); const int oi = __shfl_xor(i, o); if (ov > v || (ov == v && oi < i)) { v = ov; i = oi; } }
}
__global__ void __launch_bounds__(64) k_topk(const float* __restrict__ SC, int* __restrict__ EIDX, float* __restrict__ GATE) {
    __shared__ float s1[16], s2[16]; __shared__ int i1[16], i2[16];
    const int t = blockIdx.x >> 3, h = blockIdx.x & 7, lane = threadIdx.x;
    const float* sc = SC + (size_t)t * 2048 + h * 256;
    for (int p = 0; p < 2; ++p) {
        float a0 = sc[p * 128 + lane], a1 = sc[p * 128 + 64 + lane];
        for (int r = 0; r < 16; ++r) {
            float v; int i;
            if (a0 >= a1) { v = a0; i = lane; } else { v = a1; i = lane + 64; }
            wave_argmax(v, i);
            if (lane == 0) { if (p == 0) { s1[r] = v; i1[r] = i; } else { s2[r] = v; i2[r] = i; } }
            if (i == lane) a0 = -INFINITY;
            if (i == lane + 64) a1 = -INFINITY;
        }
    }
    __syncthreads();
    float c[4];
#pragma unroll
    for (int e = 0; e < 4; ++e) { const int ci = lane * 4 + e; c[e] = s1[ci >> 4] + s2[ci & 15]; }
    float tmax = 0.f, myts = 0.f; int mye = 0;
    for (int r = 0; r < 16; ++r) {
        float v = c[0]; int i = lane * 4;
#pragma unroll
        for (int e = 1; e < 4; ++e) if (c[e] > v) { v = c[e]; i = lane * 4 + e; }
        wave_argmax(v, i);
#pragma unroll
        for (int e = 0; e < 4; ++e) if (i == lane * 4 + e) c[e] = -INFINITY;
        if (r == 0) tmax = v;
        if (lane == r) { myts = v; mye = i1[i >> 4] * NKEY + i2[i & 15]; }
    }
    const float ex = (lane < 16) ? __expf(myts - tmax) : 0.f;
    const float den = wsum(ex);
    if (lane < 16) { EIDX[(size_t)t * 128 + h * 16 + lane] = mye; GATE[(size_t)t * 128 + h * 16 + lane] = ex / den; }
}
__global__ void __launch_bounds__(256) k_peer(const float* __restrict__ XN2, const int* __restrict__ EIDX, const float* __restrict__ GATE, const float* __restrict__ U, const float* __restrict__ V,
                                              const float* H2, const float* __restrict__ fg, float* out) {
    const int lane = threadIdx.x & 63, w = threadIdx.x >> 6, t = blockIdx.x * 4 + w;
    const float4* xr = (const float4*)(XN2 + (size_t)t * D);
    float4 x[4], y[4];
#pragma unroll
    for (int j = 0; j < 4; ++j) { x[j] = xr[lane + 64 * j]; y[j] = make_float4(0.f, 0.f, 0.f, 0.f); }
    for (int e = 0; e < 128; ++e) {
        const int ei = EIDX[(size_t)t * 128 + e]; const float g = GATE[(size_t)t * 128 + e];
        const float4* ur = (const float4*)(U + (size_t)ei * D);
        float d = 0.f;
#pragma unroll
        for (int j = 0; j < 4; ++j) { const float4 u = ur[lane + 64 * j]; d += u.x * x[j].x + u.y * x[j].y + u.z * x[j].z + u.w * x[j].w; }
        d = wsum(d);
        const float wgt = g * 0.5f * d * (1.f + erff(d * 0.70710678118654752f));
        const float4* vr = (const float4*)(V + (size_t)ei * D);
#pragma unroll
        for (int j = 0; j < 4; ++j) { const float4 vv = vr[lane + 64 * j]; y[j].x = fmaf(wgt, vv.x, y[j].x); y[j].y = fmaf(wgt, vv.y, y[j].y); y[j].z = fmaf(wgt, vv.z, y[j].z); y[j].w = fmaf(wgt, vv.w, y[j].w); }
    }
    const float4* hr = (const float4*)(H2 + (size_t)t * D);
    float s = 0.f;
#pragma unroll
    for (int j = 0; j < 4; ++j) { const float4 hh = hr[lane + 64 * j]; y[j].x += hh.x; y[j].y += hh.y; y[j].z += hh.z; y[j].w += hh.w; s += y[j].x * y[j].x + y[j].y * y[j].y + y[j].z * y[j].z + y[j].w * y[j].w; }
    s = wsum(s);
    const float r = rsqrtf(s * (1.f / D) + EPS);
    float4* o = (float4*)(out + (size_t)t * D);
    const float4* g4 = (const float4*)fg;
#pragma unroll
    for (int j = 0; j < 4; ++j) { const float4 gg = g4[lane + 64 * j]; float4 q; q.x = y[j].x * r * gg.x; q.y = y[j].y * r * gg.y; q.z = y[j].z * r * gg.z; q.w = y[j].w * r * gg.w; o[lane + 64 * j] = q; }
}
}
#endif

extern "C" void kernel_launch(void* const* d_in, const int* in_sizes, int n_in, void* d_out, int out_size, void* d_ws, size_t ws_size, hipStream_t stream) {
    static int grid = 0;
    if (grid == 0) {
        if (n_in != 16 || out_size != mk::M * mk::D || ws_size < 512ull * mk::MiB) { fprintf(stderr, "kernel_launch: unexpected shapes (n_in %d out %d ws %zu)\n", n_in, out_size, ws_size); grid = -1; return; }
        int dev = 0, cus = 0, per_cu = 0;
        (void)hipGetDevice(&dev);
        (void)hipDeviceGetAttribute(&cus, hipDeviceAttributeMultiprocessorCount, dev);
        if (hipFuncSetAttribute((const void*)mk::mega, hipFuncAttributeMaxDynamicSharedMemorySize, mk::LDS_BYTES) != hipSuccess) { fprintf(stderr, "kernel_launch: hipFuncSetAttribute failed\n"); grid = -1; return; }
        if (hipOccupancyMaxActiveBlocksPerMultiprocessor(&per_cu, (const void*)mk::mega, mk::NT, mk::LDS_BYTES) != hipSuccess || per_cu < 1) { fprintf(stderr, "kernel_launch: occupancy query says %d\n", per_cu); per_cu = 1; }
        (void)hipGetLastError();
        grid = cus;
        fprintf(stderr, "kernel_launch: cus %d per_cu %d grid %d\n", cus, per_cu, grid);
    }
    if (grid < 0) return;
    mk::Args a{};
    for (int i = 0; i < 16; ++i) a.in[i] = (const float*)d_in[i];
    a.out = (float*)d_out; a.ws = (unsigned char*)d_ws;
    const int his[6] = {0, 2, 4, 6, 7, 8};
    a.ph_lo = 0; a.ph_hi = his[STAGE];
    void* args[] = {&a};
#ifdef PROBE_PHASE
    const int plo[3] = {0, PROBE_PHASE, 7}, phi[3] = {7, PROBE_PHASE + 1, 8};
    for (int li = 0; li < 3; ++li) { if (li == 1 && PROBE_PHASE < 0) continue; a.ph_lo = plo[li]; a.ph_hi = phi[li];
        hipError_t e = hipLaunchCooperativeKernel((const void*)mk::mega, dim3(grid), dim3(mk::NT), args, mk::LDS_BYTES, stream);
        if (e != hipSuccess) fprintf(stderr, "cooperative launch failed: %s (grid %d)\n", hipGetErrorString(e), grid); }
#else
    hipError_t e = hipLaunchCooperativeKernel((const void*)mk::mega, dim3(grid), dim3(mk::NT), args, mk::LDS_BYTES, stream);
    if (e != hipSuccess) fprintf(stderr, "cooperative launch failed: %s (grid %d)\n", hipGetErrorString(e), grid);
#endif
#if STAGE < 5
    using namespace nv;
    char* ws = (char*)d_ws; const size_t MiB = 1u << 20;
    const float* x = (const float*)d_in[0];
    float* out = (float*)d_out;
    float* XN2f = (float*)(ws);
    float* Qh = (float*)(ws + 128 * MiB); float* SCh = (float*)(ws + 256 * MiB);
    int* EIDX = (int*)(ws + 384 * MiB); float* GATE = (float*)(ws + 400 * MiB);
#if STAGE == 1
    float* Yf = (float*)(ws + 320 * MiB);
    k_conv_glu<<<M, 512, 0, stream>>>((const bf16_t*)(ws + mk::WS_GLU), (const float*)d_in[3], (const float*)d_in[4], (const float*)d_in[5], (const float*)d_in[6], Yf);
    k_hgrn_hg<<<BATCH * NH, 128, 0, stream>>>((const bf16_t*)(ws + mk::WS_HG), (const float*)d_in[7], (const float*)d_in[8], Yf);
#endif
#if STAGE == 2
    float* Yf = (float*)(ws + 128 * MiB);
    k_cvt<<<(unsigned)((size_t)M * D / 256), 256, 0, stream>>>((const bf16_t*)(ws + mk::WS_Y), Yf, (size_t)M * D);
#endif
#if STAGE <= 2
    k_gemm<true><<<dim3(D / 64, M / 64), 256, 0, stream>>>(Yf, (const float*)d_in[9], out, x, M, D, D);
#endif
#if STAGE <= 3
    k_rmsnorm<<<M / 4, 256, 0, stream>>>(out, (const float*)d_in[10], XN2f, M);
    for (int hf = 0; hf < 2; ++hf) {
        const int Mh = M / 2;
        k_gemm<false><<<dim3(2048 / 64, Mh / 64), 256, 0, stream>>>(XN2f + (size_t)hf * Mh * D, (const float*)d_in[11], Qh, nullptr, Mh, 2048, D);
        k_scores<<<Mh, 256, 0, stream>>>(Qh, (const float*)d_in[12], SCh);
        k_topk<<<Mh * 8, 64, 0, stream>>>(SCh, EIDX + (size_t)hf * Mh * 128, GATE + (size_t)hf * Mh * 128);
    }
    k_peer<<<M / 4, 256, 0, stream>>>(XN2f, EIDX, GATE, (const float*)d_in[13], (const float*)d_in[14], out, (const float*)d_in[15], out);
#endif
#if STAGE == 4
    float* XN2g = (float*)(ws + 160 * MiB);
    k_rmsnorm<<<M / 4, 256, 0, stream>>>(out, (const float*)d_in[10], XN2g, M);
    k_peer<<<M / 4, 256, 0, stream>>>(XN2g, (const int*)(ws + mk::WS_EIDX), (const float*)(ws + mk::WS_GATE), (const float*)d_in[13], (const float*)d_in[14], out, (const float*)d_in[15], out);
#endif
#endif
}
```

```cpp
#include <hip/hip_runtime.h>
#include <hip/hip_cooperative_groups.h>
#include <cstdio>
#include <cstdint>
#include <cmath>
#include <type_traits>
namespace cg = cooperative_groups;
namespace pg8 {
#define PG8_LAS __attribute__((address_space(3)))
typedef unsigned short bf16_t;
typedef short bf16x8 __attribute__((ext_vector_type(8)));
typedef float f32x4 __attribute__((ext_vector_type(4)));
typedef unsigned u32x4 __attribute__((ext_vector_type(4)));
constexpr int BM = 256, BK = 64, HALF = 128, HTB = HALF * BK * 2  , STAGE_BYTES = 8 * HTB, NXCD = 8, WGM = 8;

__host__ __device__ __forceinline__ int lds_byte(int r, int c) { const int st = (r >> 4) * 2 + (c >> 5), rr = r & 15, cc = c & 31, ob = rr * 64 + cc * 2; return st * 1024 + (ob ^ (((ob >> 9) & 1) << 5)); }
__host__ __device__ __forceinline__ void stage_rc(int b, int& R, int& C) { const int st = b / 1024, sb = b % 1024, swz = sb ^ (((sb >> 9) & 1) << 5); R = (st >> 1) * 16 + swz / 64; C = (st & 1) * 32 + (swz % 64) / 2; }
__host__ __device__ __forceinline__ int perm32(int rho) { const int n = rho >> 4, i = rho & 15; return 8 * (i >> 2) + 4 * n + (i & 3); }

struct Unit { int pm, pn; };
struct Gemm { const bf16_t* A; const bf16_t* Bt; int M, N, K; };

struct StaticOrder {
    int nM, nN, nwg, G, c;
    __host__ __device__ void init(int M, int N, int G_, int c_) { nM = M / BM; nN = N / BM; nwg = nM * nN; G = G_; c = c_; }
    __host__ __device__ bool next(int i, Unit& u) const {
        const long L = (long)i * G + c; if (L >= nwg) return false;
        int wgid = (int)L; { const int q = nwg / NXCD, r = nwg % NXCD, xcd = wgid % NXCD, off = wgid / NXCD; wgid = (xcd < r ? xcd * (q + 1) : r * (q + 1) + (xcd - r) * q) + off; }
        const int nig = WGM * nN, gid = wgid / nig, fm = gid * WGM, gsz = (nM - fm) < WGM ? (nM - fm) : WGM;
        u.pm = fm + ((wgid % nig) % gsz); u.pn = (wgid % nig) / gsz; return true;
    }
    __device__ __forceinline__ void a_ready(const Unit&) const {}
    __device__ __forceinline__ void done(const Unit&) const {}
};

__device__ __forceinline__ unsigned cvt_pk_bf16(float lo, float hi) { unsigned r; asm volatile("v_cvt_pk_bf16_f32 %0, %1, %2" : "=v"(r) : "v"(lo), "v"(hi)); return r; }
__device__ __forceinline__ int lane_id_v() { int l; asm volatile("v_mbcnt_lo_u32_b32 %0, -1, 0\n\tv_mbcnt_hi_u32_b32 %0, -1, %0" : "=v"(l)); return l; }
__device__ __forceinline__ float fsigmoid(float x) { return __builtin_amdgcn_rcpf(1.f + __builtin_amdgcn_exp2f(-1.4426950408889634f * x)); }

struct EpiProj {
    static constexpr bool PERM = true, AFTER_DRAIN = false;
    bf16_t* GLU; bf16_t* HG;
    __device__ __forceinline__ void operator()(const f32x4 (&acc)[2][2][4][2], const Unit& u, int wr, int wc, int fr, int fq) const {
        const int row0 = u.pm * BM + wr * 64 + fr;
        if (u.pn < 4) {
            const int col = u.pn * 128 + wc * 32 + 8 * fq;
#pragma unroll
            for (int ai = 0; ai < 2; ++ai)
#pragma unroll
                for (int m = 0; m < 4; ++m) {
                    const f32x4 a0 = acc[ai][0][m][0], a1 = acc[ai][0][m][1], g0 = acc[ai][1][m][0], g1 = acc[ai][1][m][1];
                    u32x4 w;
                    w.x = cvt_pk_bf16(a0[0] * fsigmoid(g0[0]), a0[1] * fsigmoid(g0[1])); w.y = cvt_pk_bf16(a0[2] * fsigmoid(g0[2]), a0[3] * fsigmoid(g0[3]));
                    w.z = cvt_pk_bf16(a1[0] * fsigmoid(g1[0]), a1[1] * fsigmoid(g1[1])); w.w = cvt_pk_bf16(a1[2] * fsigmoid(g1[2]), a1[3] * fsigmoid(g1[3]));
                    *(u32x4*)(GLU + (size_t)(row0 + ai * HALF + m * 16) * 512 + col) = w;
                }
        } else {
            const int t = u.pn - 4;
            const bool act = (t < 2) || (t >= 6);
            const int col = t * 256 + wc * 32 + 8 * fq;
#pragma unroll
            for (int ai = 0; ai < 2; ++ai)
#pragma unroll
                for (int m = 0; m < 4; ++m) {
                    bf16_t* rowp = HG + (size_t)(row0 + ai * HALF + m * 16) * 2048 + col;
#pragma unroll
                    for (int bj = 0; bj < 2; ++bj) {
                        f32x4 v0 = acc[ai][bj][m][0], v1 = acc[ai][bj][m][1];
                        if (act) {
#pragma unroll
                            for (int i = 0; i < 4; ++i) { v0[i] = v0[i] * fsigmoid(v0[i]); v1[i] = v1[i] * fsigmoid(v1[i]); }
                        }
                        u32x4 w; w.x = cvt_pk_bf16(v0[0], v0[1]); w.y = cvt_pk_bf16(v0[2], v0[3]); w.z = cvt_pk_bf16(v1[0], v1[1]); w.w = cvt_pk_bf16(v1[2], v1[3]);
                        *(u32x4*)(rowp + bj * HALF) = w;
                    }
                }
        }
    }
};

struct EpiResF32 {
    static constexpr bool PERM = false, AFTER_DRAIN = false;
    float* C; const float* R; int ldc;
    __device__ __forceinline__ void operator()(const f32x4 (&acc)[2][2][4][2], const Unit& u, int wr, int wc, int fr, int fq) const {
        const int row0 = u.pm * BM + wr * 64 + fr, col0 = u.pn * BM + wc * 32 + 4 * fq;
#pragma unroll
        for (int ai = 0; ai < 2; ++ai)
#pragma unroll
            for (int m = 0; m < 4; ++m) { const size_t off = (size_t)(row0 + ai * HALF + m * 16) * ldc + col0;
#pragma unroll
                for (int bj = 0; bj < 2; ++bj)
#pragma unroll
                    for (int n = 0; n < 2; ++n) { const f32x4 r = *(const f32x4*)(R + off + bj * HALF + n * 16); *(f32x4*)(C + off + bj * HALF + n * 16) = acc[ai][bj][m][n] + r; } }
    }
};

__device__ __forceinline__ unsigned f2key(float f) { const unsigned u = __builtin_bit_cast(unsigned, f); return (u & 0x80000000u) ? ~u : (u | 0x80000000u); }
__device__ __forceinline__ float key2f(unsigned k) { const unsigned u = (k & 0x80000000u) ? (k & 0x7fffffffu) : ~k; return __builtin_bit_cast(float, u); }
__device__ __forceinline__ unsigned umax_(unsigned a, unsigned b) { return a > b ? a : b; }
__device__ __forceinline__ unsigned umin_(unsigned a, unsigned b) { return a < b ? a : b; }
__device__ __forceinline__ void sort16_desc(unsigned (&v)[16]) {
#pragma unroll
    for (int k = 2; k <= 16; k <<= 1)
#pragma unroll
        for (int j = k >> 1; j > 0; j >>= 1)
#pragma unroll
            for (int i = 0; i < 16; ++i) { const int l = i ^ j; if (l > i) { const unsigned hi = umax_(v[i], v[l]), lo = umin_(v[i], v[l]); if ((i & k) == 0) { v[i] = hi; v[l] = lo; } else { v[i] = lo; v[l] = hi; } } }
}
__device__ __forceinline__ void bmerge16_desc(unsigned (&v)[16]) {
#pragma unroll
    for (int j = 8; j > 0; j >>= 1)
#pragma unroll
        for (int i = 0; i < 16; ++i) { const int l = i ^ j; if (l > i) { const unsigned hi = umax_(v[i], v[l]), lo = umin_(v[i], v[l]); v[i] = hi; v[l] = lo; } }
}
struct EpiTopK {
    static constexpr bool PERM = false, AFTER_DRAIN = true;
    int* EIDX; float* GATE;
    __device__ __forceinline__ void fused(f32x4 (&acc)[2][2][4][2], const Unit& u, int wr, int wc, int fr, int fq, PG8_LAS unsigned char* lds, int wid, int lane) const {
        PG8_LAS unsigned* T = (PG8_LAS unsigned*)lds;
        PG8_LAS unsigned* LB = (PG8_LAS unsigned*)(lds + 131072);
        const int h = u.pn;
#pragma unroll
        for (int ai = 0; ai < 2; ++ai) {
            const int rl = wr * 64 + fr;
#pragma unroll
            for (int bj = 0; bj < 2; ++bj)
#pragma unroll
                for (int m = 0; m < 4; ++m)
#pragma unroll
                    for (int n = 0; n < 2; ++n)
#pragma unroll
                        for (int i = 0; i < 4; ++i) {
                            const int c = bj * 128 + wc * 32 + n * 16 + fq * 4 + i;
                            const float v = acc[ai][bj][m][n][i];
                            T[c * 128 + rl + m * 16] = (f2key(v) & ~127u) | (unsigned)(127 - (c & 127));
                        }
            asm volatile("s_waitcnt lgkmcnt(0)" ::: "memory"); __builtin_amdgcn_s_barrier(); asm volatile("" ::: "memory");
            {
                const int p = wid >> 2, q = (wid >> 1) & 1, r = (wid & 1) * 64 + lane, base = p * 128 + q * 64;
                unsigned run[16], grp[16];
#pragma unroll
                for (int j = 0; j < 16; ++j) run[j] = T[(base + j) * 128 + r];
                sort16_desc(run);
#pragma unroll
                for (int gI = 1; gI < 4; ++gI) {
#pragma unroll
                    for (int j = 0; j < 16; ++j) grp[j] = T[(base + 16 * gI + j) * 128 + r];
                    sort16_desc(grp);
#pragma unroll
                    for (int j = 0; j < 16; ++j) run[j] = umax_(run[j], grp[15 - j]);
                    bmerge16_desc(run);
                }
#pragma unroll
                for (int j = 0; j < 16; ++j) LB[((p * 2 + q) * 16 + j) * 128 + r] = run[j];
            }
            asm volatile("s_waitcnt lgkmcnt(0)" ::: "memory"); __builtin_amdgcn_s_barrier(); asm volatile("" ::: "memory");
            if (wid < 4) {
                const int p = wid >> 1, r = (wid & 1) * 64 + lane;
                unsigned a[16];
#pragma unroll
                for (int j = 0; j < 16; ++j) a[j] = umax_(LB[((p * 2) * 16 + j) * 128 + r], LB[((p * 2 + 1) * 16 + (15 - j)) * 128 + r]);
                bmerge16_desc(a);
#pragma unroll
                for (int j = 0; j < 16; ++j) LB[((p * 2) * 16 + j) * 128 + r] = a[j];
            }
            asm volatile("s_waitcnt lgkmcnt(0)" ::: "memory"); __builtin_amdgcn_s_barrier(); asm volatile("" ::: "memory");
            if (wid < 2) {
                const int r = wid * 64 + lane;
                float v1[16], v2[16];
#pragma unroll
                for (int j = 0; j < 16; ++j) { v1[j] = key2f(LB[j * 128 + r] & ~127u); v2[j] = key2f(LB[(32 + j) * 128 + r] & ~127u); }
                unsigned lst[16];
#pragma unroll
                for (int j = 0; j < 16; ++j) lst[j] = (f2key(v1[0] + v2[j]) & ~255u) | (unsigned)(255 - j);
#pragma unroll
                for (int i = 1; i < 16; ++i)
#pragma unroll
                    for (int j = 0; j < 16; ++j) if ((i + 1) * (j + 1) <= 16) {
                        unsigned x = (f2key(v1[i] + v2[j]) & ~255u) | (unsigned)(255 - (i * 16 + j));
#pragma unroll
                        for (int t = 0; t < 16; ++t) if (t >= (i + 1) * (j + 1) - 1) { const unsigned hi = umax_(lst[t], x); x = umin_(lst[t], x); lst[t] = hi; }
                    }
                float e[16]; float sum = 0.f; const float mx = key2f(lst[0] & ~255u);
                int ex[16];
#pragma unroll
                for (int t = 0; t < 16; ++t) {
                    e[t] = __expf(key2f(lst[t] & ~255u) - mx); sum += e[t];
                    const int ci = 255 - (int)(lst[t] & 255u), a = ci >> 4, b = ci & 15;
                    const int i1 = 127 - (int)(LB[a * 128 + r] & 127u), i2 = 127 - (int)(LB[(32 + b) * 128 + r] & 127u);
                    ex[t] = i1 * 128 + i2;
                }
                const float inv = 1.f / sum;
                const size_t o = (size_t)(u.pm * BM + ai * 128 + r) * 128 + h * 16;
#pragma unroll
                for (int t4 = 0; t4 < 4; ++t4) {
                    *(f32x4*)(GATE + o + 4 * t4) = (f32x4){e[4 * t4] * inv, e[4 * t4 + 1] * inv, e[4 * t4 + 2] * inv, e[4 * t4 + 3] * inv};
                    *(u32x4*)(EIDX + o + 4 * t4) = (u32x4){(unsigned)ex[4 * t4], (unsigned)ex[4 * t4 + 1], (unsigned)ex[4 * t4 + 2], (unsigned)ex[4 * t4 + 3]};
                }
            }
            asm volatile("s_waitcnt lgkmcnt(0)" ::: "memory"); __builtin_amdgcn_s_barrier(); asm volatile("" ::: "memory");
        }
    }
};
struct OneUnit {
    Unit u;
    __device__ __forceinline__ bool next(int i, Unit& o) const { if (i) return false; o = u; return true; }
    __device__ __forceinline__ void a_ready(const Unit&) const {}
    __device__ __forceinline__ void done(const Unit&) const {}
};

template <class Epi, class Sched, bool ALIGN_EPI = false, bool SP2 = false>
__device__ __forceinline__ void gemm_phase(PG8_LAS unsigned char* lds, const Gemm g, const Sched& S, const Epi& E, const int wid) {
    const int lane = lane_id_v(), tid = wid * 64 + lane, wr = wid >> 2, wc = wid & 3, fr = lane & 15, fq = lane >> 4;
    const int K = g.K, nt = K / BK;
    unsigned voffA[2], voffB[2];
#pragma unroll
    for (int i = 0; i < 2; ++i) { int R, C; stage_rc(tid * 16 + i * 8192, R, C); const int Rb = Epi::PERM ? ((R & ~31) + perm32(R & 31)) : R;
        voffA[i] = (unsigned)(R * K + C) * 2u; voffB[i] = (unsigned)(Rb * K + C) * 2u; }
    const size_t kstep = (size_t)(BK * 2);
    const size_t hstep = (size_t)HALF * K * 2;
    const size_t tstep = 2 * hstep;
    const unsigned ldsw = (unsigned)wid * 1024u;
    const int aoff = lds_byte(wr * 64 + fr, fq * 8), boff = lds_byte(wc * 32 + fr, fq * 8);
#define PG8_SA(b, h) (((b) * 2 + (h)) * HTB)
#define PG8_SB(b, h) ((4 + (b) * 2 + (h)) * HTB)
#define PG8_STAGE(bufoff, gbase, voff) do { _Pragma("unroll") for (int _i = 0; _i < 2; ++_i) \
        __builtin_amdgcn_global_load_lds((const unsigned*)((const char*)(gbase) + (voff)[_i]), (PG8_LAS unsigned*)(lds + (bufoff) + ldsw + _i * 8192), 16, 0, 0); } while (0)
#define PG8_LDA(dst, b, h) do { _Pragma("unroll") for (int m = 0; m < 4; ++m) _Pragma("unroll") for (int k = 0; k < 2; ++k) dst[m][k] = *(const PG8_LAS bf16x8*)(lds + PG8_SA(b, h) + aoff + m * 2048 + k * 1024); } while (0)
#define PG8_LDB(dst, b, h) do { _Pragma("unroll") for (int n = 0; n < 2; ++n) _Pragma("unroll") for (int k = 0; k < 2; ++k) dst[n][k] = *(const PG8_LAS bf16x8*)(lds + PG8_SB(b, h) + boff + n * 2048 + k * 1024); } while (0)
#define PG8_MMA(ai, bj, At, Bt) do { __builtin_amdgcn_s_setprio(1); _Pragma("unroll") for (int m = 0; m < 4; ++m) _Pragma("unroll") for (int n = 0; n < 2; ++n) _Pragma("unroll") for (int k = 0; k < 2; ++k) \
        acc[ai][bj][m][n] = __builtin_amdgcn_mfma_f32_16x16x32_bf16(Bt[n][k], At[m][k], acc[ai][bj][m][n], 0, 0, 0); __builtin_amdgcn_s_setprio(0); } while (0)
#define PG8_WAIT_V(n) asm volatile("s_waitcnt vmcnt(" #n ")" ::: "memory")
#define PG8_WAIT_L(n) asm volatile("s_waitcnt lgkmcnt(" #n ")" ::: "memory")
#define PG8_BAR __builtin_amdgcn_s_barrier()
#define PG8_SCHED __builtin_amdgcn_sched_barrier(0)
    Unit cur, nxt; int ui = 0;
    if (!S.next(0, cur)) return;
    f32x4 acc[2][2][4][2];
#pragma unroll
    for (int a = 0; a < 2; ++a)
#pragma unroll
        for (int b = 0; b < 2; ++b)
#pragma unroll
            for (int m = 0; m < 4; ++m)
#pragma unroll
                for (int n = 0; n < 2; ++n) acc[a][b][m][n] = (f32x4){0.f, 0.f, 0.f, 0.f};
    bf16x8 At[4][2], B0[2][2], B1[2][2];
    const char* cA = (const char*)g.A + (size_t)cur.pm * tstep; const char* cB = (const char*)g.Bt + (size_t)cur.pn * tstep;
    S.a_ready(cur);
    if constexpr (SP2) {
        PG8_STAGE(PG8_SB(0, 0), cB, voffB); PG8_STAGE(PG8_SB(0, 1), cB + hstep, voffB); PG8_STAGE(PG8_SA(0, 0), cA, voffA); PG8_STAGE(PG8_SA(0, 1), cA + hstep, voffA);
        if (wr == 1) PG8_BAR;
        PG8_WAIT_V(2); PG8_BAR;
        PG8_STAGE(PG8_SB(1, 0), cB + kstep, voffB); PG8_STAGE(PG8_SA(1, 0), cA + kstep, voffA); PG8_STAGE(PG8_SB(1, 1), cB + hstep + kstep, voffB);
        PG8_WAIT_V(6); PG8_BAR;
    } else {
        PG8_STAGE(PG8_SB(0, 0), cB, voffB); PG8_STAGE(PG8_SA(0, 0), cA, voffA); PG8_STAGE(PG8_SB(0, 1), cB + hstep, voffB); PG8_STAGE(PG8_SA(0, 1), cA + hstep, voffA);
        if (wr == 1) PG8_BAR;
        PG8_WAIT_V(4); PG8_BAR;
        PG8_STAGE(PG8_SB(1, 0), cB + kstep, voffB); PG8_STAGE(PG8_SA(1, 0), cA + kstep, voffA); PG8_STAGE(PG8_SB(1, 1), cB + hstep + kstep, voffB);
        PG8_WAIT_V(6); PG8_BAR;
    }
    for (;;) {
        const bool has_next = S.next(ui + 1, nxt);
        const char* nA = has_next ? (const char*)g.A + (size_t)nxt.pm * tstep : cA; const char* nB = has_next ? (const char*)g.Bt + (size_t)nxt.pn * tstep : cB;
        for (int t = 0; t < nt; t += 2) {
            const bool last = (t == nt - 2);
            const char* a1 = cA + (size_t)(t + 1) * kstep;
            const char* a2 = last ? nA : cA + (size_t)(t + 2) * kstep; const char* b2 = last ? nB : cB + (size_t)(t + 2) * kstep;
            const char* a3 = a2 + kstep; const char* b3 = b2 + kstep;
            if (last && has_next) S.a_ready(nxt);
            if constexpr (SP2) {
            PG8_LDB(B0, 0, 0); PG8_LDB(B1, 0, 1); PG8_SCHED; PG8_LDA(At, 0, 0); PG8_STAGE(PG8_SA(1, 1), a1 + hstep, voffA);
            PG8_WAIT_V(8); PG8_WAIT_L(0); PG8_BAR; PG8_MMA(0, 0, At, B0); PG8_MMA(0, 1, At, B1); PG8_BAR; PG8_SCHED;
            PG8_LDA(At, 0, 1); PG8_STAGE(PG8_SB(0, 0), b2, voffB); PG8_STAGE(PG8_SB(0, 1), b2 + hstep, voffB); PG8_STAGE(PG8_SA(0, 0), a2, voffA);
            PG8_WAIT_V(8); PG8_WAIT_L(0); PG8_BAR; PG8_MMA(1, 0, At, B0); PG8_MMA(1, 1, At, B1); PG8_BAR; PG8_SCHED;
            PG8_LDB(B0, 1, 0); PG8_LDB(B1, 1, 1); PG8_SCHED; PG8_LDA(At, 1, 0); PG8_STAGE(PG8_SA(0, 1), a2 + hstep, voffA);
            PG8_WAIT_V(8); PG8_WAIT_L(0); PG8_BAR; PG8_MMA(0, 0, At, B0); PG8_MMA(0, 1, At, B1); PG8_BAR; PG8_SCHED;
            PG8_LDA(At, 1, 1); PG8_STAGE(PG8_SB(1, 0), b3, voffB); PG8_STAGE(PG8_SB(1, 1), b3 + hstep, voffB); PG8_STAGE(PG8_SA(1, 0), a3, voffA);
            PG8_WAIT_V(8); PG8_WAIT_L(0); PG8_BAR; PG8_MMA(1, 0, At, B0); PG8_MMA(1, 1, At, B1); PG8_BAR; PG8_SCHED;
            } else {
            PG8_LDB(B0, 0, 0); PG8_SCHED; PG8_LDA(At, 0, 0); PG8_STAGE(PG8_SA(1, 1), a1 + hstep, voffA);
            PG8_WAIT_L(8); PG8_BAR; PG8_WAIT_L(0); PG8_MMA(0, 0, At, B0); PG8_BAR; PG8_SCHED;
            PG8_LDB(B1, 0, 1); PG8_STAGE(PG8_SB(0, 0), b2, voffB);
            PG8_BAR; PG8_WAIT_L(0); PG8_MMA(0, 1, At, B1); PG8_BAR;
            PG8_LDA(At, 0, 1); PG8_STAGE(PG8_SA(0, 0), a2, voffA);
            PG8_BAR; PG8_WAIT_L(0); PG8_MMA(1, 0, At, B0); PG8_BAR; PG8_SCHED;
            PG8_STAGE(PG8_SB(0, 1), b2 + hstep, voffB);
            PG8_WAIT_V(6); PG8_BAR; PG8_MMA(1, 1, At, B1); PG8_BAR;
            PG8_LDB(B0, 1, 0); PG8_SCHED; PG8_LDA(At, 1, 0); PG8_STAGE(PG8_SA(0, 1), a2 + hstep, voffA);
            PG8_WAIT_L(8); PG8_BAR; PG8_WAIT_L(0); PG8_MMA(0, 0, At, B0); PG8_BAR; PG8_SCHED;
            PG8_LDB(B1, 1, 1); PG8_STAGE(PG8_SB(1, 0), b3, voffB);
            PG8_BAR; PG8_WAIT_L(0); PG8_MMA(0, 1, At, B1); PG8_BAR;
            PG8_LDA(At, 1, 1); PG8_STAGE(PG8_SA(1, 0), a3, voffA);
            PG8_BAR; PG8_WAIT_L(0); PG8_MMA(1, 0, At, B0); PG8_BAR; PG8_SCHED;
            PG8_STAGE(PG8_SB(1, 1), b3 + hstep, voffB);
            PG8_WAIT_V(6); PG8_BAR; PG8_MMA(1, 1, At, B1); PG8_BAR;
            }
        }
        if constexpr (ALIGN_EPI) { if (wr == 0) PG8_BAR; }
        if constexpr (!Epi::AFTER_DRAIN) { E(acc, cur, wr, wc, fr, fq); S.done(cur); }
        if (!has_next) break;
#pragma unroll
        for (int a = 0; a < 2; ++a)
#pragma unroll
            for (int b = 0; b < 2; ++b)
#pragma unroll
                for (int m = 0; m < 4; ++m)
#pragma unroll
                    for (int n = 0; n < 2; ++n) acc[a][b][m][n] = (f32x4){0.f, 0.f, 0.f, 0.f};
        cur = nxt; cA = nA; cB = nB; ++ui;
        if constexpr (ALIGN_EPI) { if (wr == 1) PG8_BAR; }
    }
    PG8_WAIT_V(0);
    if constexpr (!ALIGN_EPI) { if (wr == 0) PG8_BAR; }
    PG8_BAR;
    if constexpr (Epi::AFTER_DRAIN) { E.fused(acc, cur, wr, wc, fr, fq, lds, wid, lane); S.done(cur); }
#undef PG8_SA
#undef PG8_SB
#undef PG8_STAGE
#undef PG8_LDA
#undef PG8_LDB
#undef PG8_MMA
#undef PG8_WAIT_V
#undef PG8_WAIT_L
#undef PG8_BAR
#undef PG8_SCHED
}
}

namespace mk {
using pg8::bf16_t; using pg8::bf16x8; using pg8::f32x4; using pg8::u32x4; using pg8::cvt_pk_bf16; using pg8::fsigmoid;
#define LAS __attribute__((address_space(3)))
typedef unsigned u32x2 __attribute__((ext_vector_type(2)));
typedef float f32x2 __attribute__((ext_vector_type(2)));
typedef short bf16x4 __attribute__((ext_vector_type(4)));
constexpr int NWAVES = 8, NT = 512;
constexpr int D = 1024, BATCH = 8, SEQ = 4096, M = BATCH * SEQ, DCONV = 512, CW = 31, DH = 512, NH = 4, HD = 128, DIN = 3072, NQ = 2048, NEXP = 16384;
constexpr int SEGS = 8, SEGLEN = SEQ / SEGS, NCH = SEGLEN / 64;
constexpr float EPS = 1e-6f;
constexpr size_t MiB = 1u << 20;
constexpr size_t WS_WIN = 2 * MiB, WS_WOUT = 8 * MiB, WS_WEFF = 10 * MiB, WS_HS = 14 * MiB, WS_HLD = 30 * MiB, WS_USC = 31 * MiB, WS_VSC = 31 * MiB + 65536, WS_U = 32 * MiB, WS_V = 64 * MiB, WS_XN = 96 * MiB,
                 WS_GLU = 160 * MiB, WS_HG = 192 * MiB, WS_Y = 320 * MiB, WS_EIDX = 416 * MiB, WS_GATE = 432 * MiB, WS_END = 448 * MiB;
constexpr int LDS_BYTES = 163840;
#ifndef PEER_V4_DEF
#define PEER_V4_DEF true
#endif
constexpr bool PEER_V4 = PEER_V4_DEF;

#define LDS_WAIT() asm volatile("s_waitcnt lgkmcnt(0)" ::: "memory")
#define BLOCK_BAR() do { asm volatile("s_waitcnt lgkmcnt(0)" ::: "memory"); __builtin_amdgcn_s_barrier(); asm volatile("" ::: "memory"); } while (0)
__device__ __forceinline__ float wave_sum(float v) {
#pragma unroll
    for (int o = 1; o < 64; o <<= 1) v += __shfl_xor(v, o);
    return v;
}
__device__ __forceinline__ float wave_sum_dpp(float v) {
    v += __builtin_bit_cast(float, __builtin_amdgcn_update_dpp(0, __builtin_bit_cast(int, v), 0x111, 0xf, 0xf, false));
    v += __builtin_bit_cast(float, __builtin_amdgcn_update_dpp(0, __builtin_bit_cast(int, v), 0x112, 0xf, 0xf, false));
    v += __builtin_bit_cast(float, __builtin_amdgcn_update_dpp(0, __builtin_bit_cast(int, v), 0x114, 0xf, 0xf, false));
    v += __builtin_bit_cast(float, __builtin_amdgcn_update_dpp(0, __builtin_bit_cast(int, v), 0x118, 0xf, 0xf, false));
    v += __builtin_bit_cast(float, __builtin_amdgcn_update_dpp(0, __builtin_bit_cast(int, v), 0x142, 0xa, 0xf, false));
    v += __builtin_bit_cast(float, __builtin_amdgcn_update_dpp(0, __builtin_bit_cast(int, v), 0x143, 0xc, 0xf, false));
    return __builtin_bit_cast(float, __builtin_amdgcn_readlane(__builtin_bit_cast(int, v), 63));
}
__device__ __forceinline__ float bf_lo(unsigned u) { return __builtin_bit_cast(float, u << 16); }
__device__ __forceinline__ float bf_hi(unsigned u) { return __builtin_bit_cast(float, u & 0xffff0000u); }
__device__ __forceinline__ float bf1(bf16_t u) { return __builtin_bit_cast(float, (unsigned)u << 16); }
__device__ __forceinline__ float fsilu(float x) { return x * fsigmoid(x); }

struct Args { const float* in[16]; float* out; unsigned char* ws; int ph_lo, ph_hi; };

__device__ __forceinline__ void p0_transpose_item(const float* __restrict__ W, int K, int N, bf16_t* __restrict__ WT, int out_row0, const float* __restrict__ gk, LAS float* scr, int k0, int n0, int lane) {
#pragma unroll 8
    for (int i = 0; i < 32; ++i) { const int kk = 2 * i + (lane >> 5); const float s = gk ? gk[k0 + kk] : 1.f; scr[kk * 33 + (lane & 31)] = W[(size_t)(k0 + kk) * N + n0 + (lane & 31)] * s; }
    LDS_WAIT();
    const int c = lane & 7;
#pragma unroll
    for (int j = 0; j < 4; ++j) { const int n = (lane >> 3) + 8 * j; const LAS float* s = scr + (8 * c) * 33 + n;
        u32x4 o; o.x = cvt_pk_bf16(s[0 * 33], s[1 * 33]); o.y = cvt_pk_bf16(s[2 * 33], s[3 * 33]); o.z = cvt_pk_bf16(s[4 * 33], s[5 * 33]); o.w = cvt_pk_bf16(s[6 * 33], s[7 * 33]);
        *(u32x4*)(WT + (size_t)(out_row0 + n) * K + k0 + 8 * c) = o; }
    LDS_WAIT();
}
__device__ __forceinline__ void row_to_bf16(const float* __restrict__ src, bf16_t* __restrict__ dst, const float* __restrict__ gv, bool norm, int lane) {
    const f32x4* xr = (const f32x4*)src + lane;
    f32x4 v[4]; float s = 0.f;
#pragma unroll
    for (int j = 0; j < 4; ++j) { v[j] = xr[64 * j]; s += (v[j].x * v[j].x + v[j].y * v[j].y) + (v[j].z * v[j].z + v[j].w * v[j].w); }
    float r = 1.f;
    if (norm) r = rsqrtf(wave_sum(s) * (1.f / D) + EPS);
    u32x2* o8 = (u32x2*)dst + lane;
#pragma unroll
    for (int j = 0; j < 4; ++j) {
        f32x4 t = v[j] * r;
        if (gv) t = t * ((const f32x4*)gv)[lane + 64 * j];
        u32x2 w; w.x = cvt_pk_bf16(t.x, t.y); w.y = cvt_pk_bf16(t.z, t.w); o8[64 * j] = w;
    }
}
__device__ __forceinline__ void row_to_fp8(const float* __restrict__ src, unsigned char* __restrict__ dst, const float* __restrict__ gv, float sc, int lane) {
    const f32x4* xr = (const f32x4*)src + lane;
    unsigned* o4 = (unsigned*)dst + lane;
#pragma unroll
    for (int j = 0; j < 4; ++j) {
        f32x4 t = xr[64 * j] * sc;
        if (gv) t = t * ((const f32x4*)gv)[lane + 64 * j];
        int w = __builtin_amdgcn_cvt_pk_fp8_f32(t.x, t.y, 0, false); w = __builtin_amdgcn_cvt_pk_fp8_f32(t.z, t.w, w, true);
        o4[64 * j] = (unsigned)w;
    }
}
template <int MODE>
__device__ __forceinline__ void rows_convert(const float* __restrict__ src, unsigned char* __restrict__ dst, const float* __restrict__ gv, float sc, int nrows, int gw, int NGW, int lane) {
    if (nrows % (4 * NGW) != 0) {
        for (int r = gw; r < nrows; r += NGW) { if (MODE == 0) row_to_bf16(src + (size_t)r * D, (bf16_t*)dst + (size_t)r * D, nullptr, true, lane); else row_to_fp8(src + (size_t)r * D, dst + (size_t)r * D, MODE == 1 ? gv : nullptr, sc, lane); }
        return;
    }
    f32x4 gq[4];
    if (MODE == 1) {
#pragma unroll
        for (int j = 0; j < 4; ++j) gq[j] = ((const f32x4*)gv)[lane + 64 * j] * sc;
    }
    for (int r = gw; r < nrows; r += 4 * NGW) {
        f32x4 v[4][4];
#pragma unroll
        for (int k = 0; k < 4; ++k)
#pragma unroll
            for (int j = 0; j < 4; ++j) v[k][j] = ((const f32x4*)(src + (size_t)(r + k * NGW) * D))[lane + 64 * j];
#pragma unroll
        for (int k = 0; k < 4; ++k) {
            if (MODE == 0) {
                float s = 0.f;
#pragma unroll
                for (int j = 0; j < 4; ++j) s += (v[k][j].x * v[k][j].x + v[k][j].y * v[k][j].y) + (v[k][j].z * v[k][j].z + v[k][j].w * v[k][j].w);
                const float rr = rsqrtf(wave_sum(s) * (1.f / D) + EPS);
                u32x2* o8 = (u32x2*)((bf16_t*)dst + (size_t)(r + k * NGW) * D) + lane;
#pragma unroll
                for (int j = 0; j < 4; ++j) { const f32x4 t = v[k][j] * rr; u32x2 w; w.x = cvt_pk_bf16(t.x, t.y); w.y = cvt_pk_bf16(t.z, t.w); o8[64 * j] = w; }
            } else {
                unsigned* o4 = (unsigned*)(dst + (size_t)(r + k * NGW) * D) + lane;
#pragma unroll
                for (int j = 0; j < 4; ++j) { const f32x4 t = (MODE == 1) ? v[k][j] * gq[j] : v[k][j] * sc;
                    int w = __builtin_amdgcn_cvt_pk_fp8_f32(t.x, t.y, 0, false); w = __builtin_amdgcn_cvt_pk_fp8_f32(t.z, t.w, w, true); o4[64 * j] = (unsigned)w; }
            }
        }
    }
}
template <bool FP4>
__device__ __forceinline__ void rows_quant(const float* __restrict__ src, unsigned char* __restrict__ dst, float* __restrict__ scales, const float* __restrict__ gv, int nrows, int gw, int NGW, int lane) {
    f32x4 gq[4];
#pragma unroll
    for (int j = 0; j < 4; ++j) gq[j] = gv ? ((const f32x4*)gv)[lane + 64 * j] : (f32x4){1.f, 1.f, 1.f, 1.f};
    for (int r0 = gw; r0 < nrows; r0 += 2 * NGW) {
        f32x4 v[2][4];
#pragma unroll
        for (int k = 0; k < 2; ++k) { const int r = (r0 + k * NGW < nrows) ? r0 + k * NGW : r0;
#pragma unroll
            for (int j = 0; j < 4; ++j) v[k][j] = ((const f32x4*)(src + (size_t)r * D))[lane + 64 * j] * gq[j]; }
#pragma unroll
        for (int k = 0; k < 2; ++k) {
            const int r = r0 + k * NGW; if (r >= nrows) break;
            float am = 0.f;
#pragma unroll
            for (int j = 0; j < 4; ++j) am = fmaxf(am, fmaxf(fmaxf(fabsf(v[k][j].x), fabsf(v[k][j].y)), fmaxf(fabsf(v[k][j].z), fabsf(v[k][j].w))));
#pragma unroll
            for (int o = 1; o < 64; o <<= 1) am = fmaxf(am, __shfl_xor(am, o));
            const float fmx = FP4 ? 6.f : 240.f;
            const float sc = am > 0.f ? am * (1.f / fmx) : 1.f, inv = am > 0.f ? fmx / am : 1.f;
            if (lane == 0) scales[r] = sc;
            if constexpr (FP4) {
                unsigned w0 = 0u, w1 = 0u;
                { const f32x4 t0 = v[k][0] * inv, t1 = v[k][1] * inv, t2 = v[k][2] * inv, t3 = v[k][3] * inv;
                  w0 = __builtin_amdgcn_cvt_scalef32_pk_fp4_f32(w0, t0.x, t0.y, 1.0f, 0); w0 = __builtin_amdgcn_cvt_scalef32_pk_fp4_f32(w0, t0.z, t0.w, 1.0f, 1);
                  w0 = __builtin_amdgcn_cvt_scalef32_pk_fp4_f32(w0, t1.x, t1.y, 1.0f, 2); w0 = __builtin_amdgcn_cvt_scalef32_pk_fp4_f32(w0, t1.z, t1.w, 1.0f, 3);
                  w1 = __builtin_amdgcn_cvt_scalef32_pk_fp4_f32(w1, t2.x, t2.y, 1.0f, 0); w1 = __builtin_amdgcn_cvt_scalef32_pk_fp4_f32(w1, t2.z, t2.w, 1.0f, 1);
                  w1 = __builtin_amdgcn_cvt_scalef32_pk_fp4_f32(w1, t3.x, t3.y, 1.0f, 2); w1 = __builtin_amdgcn_cvt_scalef32_pk_fp4_f32(w1, t3.z, t3.w, 1.0f, 3); }
                ((u32x2*)(dst + (size_t)r * 512))[lane] = (u32x2){w0, w1};
            } else {
                u32x4 w;
#pragma unroll
                for (int j = 0; j < 4; ++j) { const f32x4 t = v[k][j] * inv; int q = __builtin_amdgcn_cvt_pk_fp8_f32(t.x, t.y, 0, false); q = __builtin_amdgcn_cvt_pk_fp8_f32(t.z, t.w, q, true); w[j] = (unsigned)q; }
                ((u32x4*)(dst + (size_t)r * 1024))[lane] = w;
            }
        }
    }
}
__device__ __forceinline__ void weff_unit(LAS unsigned char* lds, const float* __restrict__ wq, const float* __restrict__ sk, const float* __restrict__ g2, bf16_t* __restrict__ WE, int unit, int tid) {
    LAS float* SK = (LAS float*)lds;
    LAS float* WQ = (LAS float*)(lds + 128 * 129 * 4);
    const int hp = unit >> 5, d0 = (unit & 31) * 32;
#pragma unroll 4
    for (int i = 0; i < 32; ++i) { const int idx = tid + i * NT; SK[(idx >> 7) * 129 + (idx & 127)] = sk[(size_t)hp * 16384 + idx]; }
#pragma unroll
    for (int i = 0; i < 8; ++i) { const int idx = tid + i * NT; WQ[idx] = wq[(size_t)(d0 + (idx >> 7)) * NQ + hp * 128 + (idx & 127)]; }
    __syncthreads();
    const int n = tid & 127, dq = tid >> 7;
    float acc[8];
#pragma unroll
    for (int e = 0; e < 8; ++e) acc[e] = 0.f;
    for (int j4 = 0; j4 < 32; ++j4) {
        float s[4];
#pragma unroll
        for (int q = 0; q < 4; ++q) s[q] = SK[n * 129 + 4 * j4 + q];
#pragma unroll
        for (int e = 0; e < 8; ++e) { const f32x4 w = *(const LAS f32x4*)(WQ + (dq * 8 + e) * 128 + 4 * j4); acc[e] = fmaf(s[0], w.x, acc[e]); acc[e] = fmaf(s[1], w.y, acc[e]); acc[e] = fmaf(s[2], w.z, acc[e]); acc[e] = fmaf(s[3], w.w, acc[e]); }
    }
    const float* gp = g2 + d0 + dq * 8;
    u32x4 o; o.x = cvt_pk_bf16(acc[0] * gp[0], acc[1] * gp[1]); o.y = cvt_pk_bf16(acc[2] * gp[2], acc[3] * gp[3]); o.z = cvt_pk_bf16(acc[4] * gp[4], acc[5] * gp[5]); o.w = cvt_pk_bf16(acc[6] * gp[6], acc[7] * gp[7]);
    *(u32x4*)(WE + (size_t)(hp * 128 + n) * D + d0 + dq * 8) = o;
    __syncthreads();
}
__device__ __forceinline__ void p0_prologue(const Args& a, LAS unsigned char* lds, int tid, int lane, int wave, int G) {
    unsigned char* ws = a.ws;
    for (int u = blockIdx.x; u < 512; u += G) weff_unit(lds, a.in[11], a.in[12], a.in[10], (bf16_t*)(ws + WS_WEFF), u, tid);
    LAS float* scr = (LAS float*)(lds + wave * 16384);
    const int gw = blockIdx.x * NWAVES + wave, NGW = G * NWAVES;
    constexpr int I_IN = (D / 64) * (DIN / 32), I_OUT = (D / 64) * (D / 32);
    for (int it = gw; it < I_IN + I_OUT; it += NGW) {
        if (it < I_IN) {
            const int kb = it / (DIN / 32), nb = it % (DIN / 32), n0 = nb * 32;
            int r0;
            if (n0 < 512) r0 = 256 * (n0 >> 7) + (n0 & 127); else if (n0 < 1024) r0 = 256 * ((n0 - 512) >> 7) + 128 + ((n0 - 512) & 127); else r0 = n0;
            p0_transpose_item(a.in[2], D, DIN, (bf16_t*)(ws + WS_WIN), r0, a.in[1], scr, kb * 64, n0, lane);
        } else {
            const int r = it - I_IN, kb = r / (D / 32), nb = r % (D / 32);
            p0_transpose_item(a.in[9], D, D, (bf16_t*)(ws + WS_WOUT), nb * 32, nullptr, scr, kb * 64, nb * 32, lane);
        }
    }
    rows_quant<true>(a.in[13], ws + WS_U, (float*)(ws + WS_USC), a.in[10], NEXP, gw, NGW, lane);
    rows_quant<PEER_V4>(a.in[14], ws + WS_V, (float*)(ws + WS_VSC), nullptr, NEXP, gw, NGW, lane);
    rows_convert<0>(a.in[0], ws + WS_XN, nullptr, 1.f, M, gw, NGW, lane);
}

__device__ __forceinline__ void conv_wave_unit(const bf16_t* __restrict__ GLU, const float* __restrict__ cw, const float* __restrict__ cb, const float* __restrict__ ng, const float* __restrict__ nb,
                                               bf16_t* __restrict__ Y, int wu, int lane) {
    const int grp = wu & 7, tb = wu >> 3, b = tb >> 5, s0 = (tb & 31) * 128, c = grp * 64 + lane;
    float w[CW];
#pragma unroll
    for (int j = 0; j < CW; ++j) w[j] = cw[j * DCONV + c];
    const float bias = cb[c], gam = ng[c], bet = nb[c];
    const size_t rowb = (size_t)b * SEQ;
    float win[38];
#pragma unroll
    for (int i = 0; i < 30; ++i) { const int s = s0 - 30 + i; win[i] = (s >= 0) ? bf1(GLU[(rowb + s) * DCONV + c]) : 0.f; }
    bf16_t nx[8];
#pragma unroll
    for (int i = 0; i < 8; ++i) nx[i] = GLU[(rowb + s0 + i) * DCONV + c];
#pragma unroll 1
    for (int it = 0; it < 16; ++it) {
        const int s = s0 + it * 8;
#pragma unroll
        for (int i = 0; i < 8; ++i) win[30 + i] = bf1(nx[i]);
        const int sn = (it < 15) ? s + 8 : s;
#pragma unroll
        for (int i = 0; i < 8; ++i) nx[i] = GLU[(rowb + sn + i) * DCONV + c];
        float acc[8];
#pragma unroll
        for (int i = 0; i < 8; ++i) {
            float t = bias;
#pragma unroll
            for (int j = 0; j < CW; ++j) t = fmaf(w[j], win[i + j], t);
            acc[i] = t;
        }
#pragma unroll
        for (int i = 0; i < 8; ++i) {
            const float mu = wave_sum_dpp(acc[i]) * (1.f / 64.f), m2 = wave_sum_dpp(acc[i] * acc[i]) * (1.f / 64.f);
            const float var = fmaxf(m2 - mu * mu, 0.f);
            const float hn = (acc[i] - mu) * rsqrtf(var + EPS) * gam + bet;
            Y[(rowb + s + i) * D + c] = (bf16_t)(cvt_pk_bf16(fsilu(hn), 0.f) & 0xffffu);
        }
#pragma unroll
        for (int i = 0; i < 30; ++i) win[i] = win[i + 8];
    }
}

constexpr int HQ_OFF = 0, HK_OFF = 17408, HKH_OFF = 34816, HV_OFF = 53248, HP_OFF = 71680, HDC_OFF = 80896, HTOT_OFF = 81408, HO_OFF = 85504;
template <bool P3>
__device__ __forceinline__ void hgrn_unit(LAS unsigned char* lds, int unit, const bf16_t* __restrict__ HG, const float* __restrict__ lbl, const float* __restrict__ hng, float* __restrict__ HS, float* __restrict__ HLD,
                                          bf16_t* __restrict__ Y, int tid, int lane, int w) {
    const int seg = unit & (SEGS - 1), bh = unit >> 3, h = bh & 3, b = bh >> 2;
    const int g = lane >> 4, fr = lane & 15, kp = lane;
    const int c0 = h * HD + 2 * kp;
    const float lb0 = __builtin_amdgcn_rcpf(1.f + __expf(lbl[DH + c0] - lbl[c0])), lb1 = __builtin_amdgcn_rcpf(1.f + __expf(lbl[DH + c0 + 1] - lbl[c0 + 1]));
    f32x4 S[8];
#pragma unroll
    for (int i = 0; i < 8; ++i) S[i] = (f32x4){0.f, 0.f, 0.f, 0.f};
    if (P3) {
        for (int i = 0; i < seg; ++i) {
            const float* sp = HS + (size_t)(bh * SEGS + i) * 16384 + w * 2048 + lane;
            const float* ld = HLD + (size_t)(bh * SEGS + i) * 128 + 4 * g;
#pragma unroll
            for (int t = 0; t < 8; ++t) { const f32x4 dd = *(const f32x4*)(ld + 16 * t);
#pragma unroll
                for (int r = 0; r < 4; ++r) S[t][r] = fmaf(__expf(dd[r]), S[t][r], sp[(t * 4 + r) * 64]); }
        }
    }
    float ldsum0 = 0.f, ldsum1 = 0.f;
    const size_t row_base = (size_t)b * SEQ + (size_t)seg * SEGLEN;
    const unsigned* HGw = (const unsigned*)HG;
    unsigned zq[8], qq[8], vq[8];
#define HG_LOAD(c) do { _Pragma("unroll") for (int i = 0; i < 8; ++i) { const size_t ro = (row_base + (c) * 64 + 8 * w + i) * 1024 + (h * 64 + kp); \
        zq[i] = HGw[ro + 256]; vq[i] = HGw[ro + 512]; if (P3) qq[i] = HGw[ro]; } } while (0)
    HG_LOAD(0);
    float gn[16];
    const int nt_t = tid >> 3, nt_v = (tid & 7) * 16;
    if (P3) {
#pragma unroll
        for (int e = 0; e < 16; ++e) gn[e] = hng[h * HD + nt_v + e];
    }
#pragma unroll 1
    for (int c = 0; c < NCH; ++c) {
        float cs0[8], cs1[8], kk0[8], kk1[8];
        float cum0 = 0.f, cum1 = 0.f;
#pragma unroll
        for (int i = 0; i < 8; ++i) {
            const float sg0 = fsigmoid(bf_lo(zq[i])), sg1 = fsigmoid(bf_hi(zq[i]));
            cum0 += __logf(lb0 + (1.f - lb0) * sg0); cum1 += __logf(lb1 + (1.f - lb1) * sg1);
            cs0[i] = cum0; cs1[i] = cum1; kk0[i] = (1.f - lb0) * (1.f - sg0); kk1[i] = (1.f - lb1) * (1.f - sg1);
        }
        LAS float* tot = (LAS float*)(lds + HTOT_OFF);
        *(LAS f32x2*)(tot + w * 128 + 2 * kp) = (f32x2){cum0, cum1};
        BLOCK_BAR();
        float off0 = 0.f, off1 = 0.f, all0 = 0.f, all1 = 0.f;
#pragma unroll
        for (int ww = 0; ww < 8; ++ww) { const f32x2 tt = *(const LAS f32x2*)(tot + ww * 128 + 2 * kp); if (ww < w) { off0 += tt.x; off1 += tt.y; } all0 += tt.x; all1 += tt.y; }
        ldsum0 += all0; ldsum1 += all1;
        unsigned kh0[4], kh1[4], vt0[4], vt1[4];
#pragma unroll
        for (int i = 0; i < 8; i += 2) {
            float a0[2], a1[2];
#pragma unroll
            for (int e = 0; e < 2; ++e) {
                const float B0 = off0 + cs0[i + e], B1 = off1 + cs1[i + e];
                if (P3) {
                    const float q0 = bf_lo(qq[i + e]) * __expf(B0), q1 = bf_hi(qq[i + e]) * __expf(B1);
                    const float k0 = kk0[i + e] * __expf(-B0), k1 = kk1[i + e] * __expf(-B1);
                    *(LAS unsigned*)(lds + HQ_OFF + (8 * w + i + e) * 272 + 4 * kp) = cvt_pk_bf16(q0, q1);
                    *(LAS unsigned*)(lds + HK_OFF + (8 * w + i + e) * 272 + 4 * kp) = cvt_pk_bf16(k0, k1);
                }
                a0[e] = kk0[i + e] * __expf(all0 - B0); a1[e] = kk1[i + e] * __expf(all1 - B1);
            }
            kh0[i >> 1] = cvt_pk_bf16(a0[0], a0[1]); kh1[i >> 1] = cvt_pk_bf16(a1[0], a1[1]);
            vt0[i >> 1] = (vq[i] & 0xffffu) | (vq[i + 1] << 16); vt1[i >> 1] = (vq[i] >> 16) | (vq[i + 1] & 0xffff0000u);
        }
        *(LAS u32x4*)(lds + HKH_OFF + (2 * kp) * 144 + 16 * w) = (u32x4){kh0[0], kh0[1], kh0[2], kh0[3]};
        *(LAS u32x4*)(lds + HKH_OFF + (2 * kp + 1) * 144 + 16 * w) = (u32x4){kh1[0], kh1[1], kh1[2], kh1[3]};
        *(LAS u32x4*)(lds + HV_OFF + (2 * kp) * 144 + 16 * w) = (u32x4){vt0[0], vt0[1], vt0[2], vt0[3]};
        *(LAS u32x4*)(lds + HV_OFF + (2 * kp + 1) * 144 + 16 * w) = (u32x4){vt1[0], vt1[1], vt1[2], vt1[3]};
        if (w == 0) *(LAS f32x2*)(lds + HDC_OFF + 8 * kp) = (f32x2){__expf(all0), __expf(all1)};
        BLOCK_BAR();
        if (c + 1 < NCH) HG_LOAD(c + 1);
        bf16x8 vfrag[2];
#pragma unroll
        for (int ks = 0; ks < 2; ++ks) vfrag[ks] = *(const LAS bf16x8*)(lds + HV_OFF + (16 * w + fr) * 144 + 64 * ks + 16 * g);
        if (P3) {
            u32x4 gq[2];
            { const u32x4* gp = (const u32x4*)(HG + (row_base + c * 64 + nt_t) * 2048 + 1536 + h * HD + nt_v); gq[0] = gp[0]; gq[1] = gp[1]; }
            {
                const int mt = w >> 1;
#pragma unroll
                for (int nti = 0; nti < 2; ++nti) {
                    const int nt = 2 * (w & 1) + nti;
                    f32x4 p = (f32x4){0.f, 0.f, 0.f, 0.f};
                    if (nt <= mt) {
#pragma unroll
                        for (int ks = 0; ks < 4; ++ks) {
                            const bf16x8 af = *(const LAS bf16x8*)(lds + HQ_OFF + (16 * mt + fr) * 272 + 64 * ks + 16 * g);
                            const bf16x8 bf = *(const LAS bf16x8*)(lds + HK_OFF + (16 * nt + fr) * 272 + 64 * ks + 16 * g);
                            p = __builtin_amdgcn_mfma_f32_16x16x32_bf16(af, bf, p, 0, 0, 0);
                        }
                    }
#pragma unroll
                    for (int r = 0; r < 4; ++r) {
                        const int t = 16 * mt + 4 * g + r, s = 16 * nt + fr;
                        const float pv = (s <= t) ? p[r] : 0.f;
                        *(LAS bf16_t*)(lds + HP_OFF + t * 144 + 2 * s) = (bf16_t)(cvt_pk_bf16(pv, 0.f) & 0xffffu);
                    }
                }
            }
            BLOCK_BAR();
            f32x4 o[4];
#pragma unroll
            for (int mt = 0; mt < 4; ++mt) o[mt] = (f32x4){0.f, 0.f, 0.f, 0.f};
#pragma unroll
            for (int ks = 0; ks < 4; ++ks) {
                u32x4 sb; sb.x = cvt_pk_bf16(S[2 * ks][0], S[2 * ks][1]); sb.y = cvt_pk_bf16(S[2 * ks][2], S[2 * ks][3]); sb.z = cvt_pk_bf16(S[2 * ks + 1][0], S[2 * ks + 1][1]); sb.w = cvt_pk_bf16(S[2 * ks + 1][2], S[2 * ks + 1][3]);
                const bf16x8 bfrag = __builtin_bit_cast(bf16x8, sb);
#pragma unroll
                for (int mt = 0; mt < 4; ++mt) {
                    const u32x2 alo = *(const LAS u32x2*)(lds + HQ_OFF + (16 * mt + fr) * 272 + 64 * ks + 8 * g);
                    const u32x2 ahi = *(const LAS u32x2*)(lds + HQ_OFF + (16 * mt + fr) * 272 + 64 * ks + 32 + 8 * g);
                    const bf16x8 af = __builtin_bit_cast(bf16x8, (u32x4){alo.x, alo.y, ahi.x, ahi.y});
                    o[mt] = __builtin_amdgcn_mfma_f32_16x16x32_bf16(af, bfrag, o[mt], 0, 0, 0);
                }
            }
#pragma unroll
            for (int ks = 0; ks < 2; ++ks)
#pragma unroll
                for (int mt = 0; mt < 4; ++mt) {
                    const bf16x8 af = *(const LAS bf16x8*)(lds + HP_OFF + (16 * mt + fr) * 144 + 64 * ks + 16 * g);
                    o[mt] = __builtin_amdgcn_mfma_f32_16x16x32_bf16(af, vfrag[ks], o[mt], 0, 0, 0);
                }
#pragma unroll
            for (int mt = 0; mt < 4; ++mt)
#pragma unroll
                for (int r = 0; r < 4; ++r) *(LAS float*)(lds + HO_OFF + ((16 * mt + 4 * g + r) * 132 + 16 * w + fr) * 4) = o[mt][r];
#pragma unroll
            for (int i = 0; i < 8; ++i) {
                const f32x4 dd = *(const LAS f32x4*)(lds + HDC_OFF + (16 * i + 4 * g) * 4);
                S[i] = S[i] * dd;
#pragma unroll
                for (int ks = 0; ks < 2; ++ks) { const bf16x8 af = *(const LAS bf16x8*)(lds + HKH_OFF + (16 * i + fr) * 144 + 64 * ks + 16 * g); S[i] = __builtin_amdgcn_mfma_f32_16x16x32_bf16(af, vfrag[ks], S[i], 0, 0, 0); }
            }
            BLOCK_BAR();
            {
                f32x4 ov[4]; float ss = 0.f;
#pragma unroll
                for (int q = 0; q < 4; ++q) { ov[q] = *(const LAS f32x4*)(lds + HO_OFF + (nt_t * 132 + nt_v + 4 * q) * 4); ss += (ov[q].x * ov[q].x + ov[q].y * ov[q].y) + (ov[q].z * ov[q].z + ov[q].w * ov[q].w); }
                ss += __shfl_xor(ss, 1); ss += __shfl_xor(ss, 2); ss += __shfl_xor(ss, 4);
                const float rs = rsqrtf(ss * (1.f / HD) + EPS);
                u32x4 ow[2];
#pragma unroll
                for (int q = 0; q < 4; ++q) {
                    const unsigned g01 = (q & 1) ? gq[q >> 1].z : gq[q >> 1].x, g23 = (q & 1) ? gq[q >> 1].w : gq[q >> 1].y;
                    const float y0 = ov[q].x * rs * gn[4 * q] * bf_lo(g01), y1 = ov[q].y * rs * gn[4 * q + 1] * bf_hi(g01), y2 = ov[q].z * rs * gn[4 * q + 2] * bf_lo(g23), y3 = ov[q].w * rs * gn[4 * q + 3] * bf_hi(g23);
                    if (q & 1) { ow[q >> 1].z = cvt_pk_bf16(y0, y1); ow[q >> 1].w = cvt_pk_bf16(y2, y3); } else { ow[q >> 1].x = cvt_pk_bf16(y0, y1); ow[q >> 1].y = cvt_pk_bf16(y2, y3); }
                }
                u32x4* yp = (u32x4*)(Y + (row_base + c * 64 + nt_t) * D + DCONV + h * HD + nt_v); yp[0] = ow[0]; yp[1] = ow[1];
            }
        } else {
#pragma unroll
            for (int i = 0; i < 8; ++i) {
                const f32x4 dd = *(const LAS f32x4*)(lds + HDC_OFF + (16 * i + 4 * g) * 4);
                S[i] = S[i] * dd;
#pragma unroll
                for (int ks = 0; ks < 2; ++ks) { const bf16x8 af = *(const LAS bf16x8*)(lds + HKH_OFF + (16 * i + fr) * 144 + 64 * ks + 16 * g); S[i] = __builtin_amdgcn_mfma_f32_16x16x32_bf16(af, vfrag[ks], S[i], 0, 0, 0); }
            }
        }
    }
#undef HG_LOAD
    if (!P3) {
        float* sp = HS + (size_t)unit * 16384 + w * 2048 + lane;
#pragma unroll
        for (int t = 0; t < 8; ++t)
#pragma unroll
            for (int r = 0; r < 4; ++r) sp[(t * 4 + r) * 64] = S[t][r];
        if (w == 0) *(f32x2*)(HLD + (size_t)unit * 128 + 2 * kp) = (f32x2){ldsum0, ldsum1};
    }
    BLOCK_BAR();
}

__device__ __forceinline__ float gelu_as(float v) {
    const float av = fabsf(v), t = __builtin_amdgcn_rcpf(fmaf(av, 0.2316418882f, 1.0f));
    float q = fmaf(t, 0.5307027145f, -0.7265760135f); q = fmaf(q, t, 0.7107068705f); q = fmaf(q, t, -0.142248368f); q = fmaf(q, t, 0.127414796f); q = q * t;
    const float e = __builtin_amdgcn_exp2f(v * v * -0.72134752044f), m = v * (q * e);
    return v < 0.f ? m : v - m;
}
__device__ __forceinline__ float dot16_fp4(const unsigned w0, const unsigned w1, const f32x2 (&x2)[8]) {
    f32x2 acc = __builtin_amdgcn_cvt_scalef32_pk_f32_fp4(w0, 1.0f, 0) * x2[0];
    acc = __builtin_elementwise_fma(__builtin_amdgcn_cvt_scalef32_pk_f32_fp4(w0, 1.0f, 1), x2[1], acc);
    acc = __builtin_elementwise_fma(__builtin_amdgcn_cvt_scalef32_pk_f32_fp4(w0, 1.0f, 2), x2[2], acc);
    acc = __builtin_elementwise_fma(__builtin_amdgcn_cvt_scalef32_pk_f32_fp4(w0, 1.0f, 3), x2[3], acc);
    acc = __builtin_elementwise_fma(__builtin_amdgcn_cvt_scalef32_pk_f32_fp4(w1, 1.0f, 0), x2[4], acc);
    acc = __builtin_elementwise_fma(__builtin_amdgcn_cvt_scalef32_pk_f32_fp4(w1, 1.0f, 1), x2[5], acc);
    acc = __builtin_elementwise_fma(__builtin_amdgcn_cvt_scalef32_pk_f32_fp4(w1, 1.0f, 2), x2[6], acc);
    acc = __builtin_elementwise_fma(__builtin_amdgcn_cvt_scalef32_pk_f32_fp4(w1, 1.0f, 3), x2[7], acc);
    return acc.x + acc.y;
}
__device__ __forceinline__ void axpy16_fp4(const unsigned w0, const unsigned w1, const float s, f32x2 (&y2)[8]) {
    const f32x2 s2 = (f32x2){s, s};
    y2[0] = __builtin_elementwise_fma(__builtin_amdgcn_cvt_scalef32_pk_f32_fp4(w0, 1.0f, 0), s2, y2[0]);
    y2[1] = __builtin_elementwise_fma(__builtin_amdgcn_cvt_scalef32_pk_f32_fp4(w0, 1.0f, 1), s2, y2[1]);
    y2[2] = __builtin_elementwise_fma(__builtin_amdgcn_cvt_scalef32_pk_f32_fp4(w0, 1.0f, 2), s2, y2[2]);
    y2[3] = __builtin_elementwise_fma(__builtin_amdgcn_cvt_scalef32_pk_f32_fp4(w0, 1.0f, 3), s2, y2[3]);
    y2[4] = __builtin_elementwise_fma(__builtin_amdgcn_cvt_scalef32_pk_f32_fp4(w1, 1.0f, 0), s2, y2[4]);
    y2[5] = __builtin_elementwise_fma(__builtin_amdgcn_cvt_scalef32_pk_f32_fp4(w1, 1.0f, 1), s2, y2[5]);
    y2[6] = __builtin_elementwise_fma(__builtin_amdgcn_cvt_scalef32_pk_f32_fp4(w1, 1.0f, 2), s2, y2[6]);
    y2[7] = __builtin_elementwise_fma(__builtin_amdgcn_cvt_scalef32_pk_f32_fp4(w1, 1.0f, 3), s2, y2[7]);
}
__device__ __forceinline__ void axpy16_fp8(const u32x4 w, const float s, f32x2 (&y2)[8]) {
    const f32x2 s2 = (f32x2){s, s};
    y2[0] = __builtin_elementwise_fma(__builtin_amdgcn_cvt_pk_f32_fp8(w.x, false), s2, y2[0]);
    y2[1] = __builtin_elementwise_fma(__builtin_amdgcn_cvt_pk_f32_fp8(w.x, true), s2, y2[1]);
    y2[2] = __builtin_elementwise_fma(__builtin_amdgcn_cvt_pk_f32_fp8(w.y, false), s2, y2[2]);
    y2[3] = __builtin_elementwise_fma(__builtin_amdgcn_cvt_pk_f32_fp8(w.y, true), s2, y2[3]);
    y2[4] = __builtin_elementwise_fma(__builtin_amdgcn_cvt_pk_f32_fp8(w.z, false), s2, y2[4]);
    y2[5] = __builtin_elementwise_fma(__builtin_amdgcn_cvt_pk_f32_fp8(w.z, true), s2, y2[5]);
    y2[6] = __builtin_elementwise_fma(__builtin_amdgcn_cvt_pk_f32_fp8(w.w, false), s2, y2[6]);
    y2[7] = __builtin_elementwise_fma(__builtin_amdgcn_cvt_pk_f32_fp8(w.w, true), s2, y2[7]);
}
#define P7_LOADU(dst, evh, slot) do { const int e_ = __builtin_amdgcn_readlane((evh), (slot)); const u32x2 t_ = __builtin_amdgcn_raw_buffer_load_b64(RU, lane * 8, e_ << 9, 0); dst.x = t_.x; dst.y = t_.y; } while (0)
#define P7_LOADV(dst, evh, slot) do { const int e_ = __builtin_amdgcn_readlane((evh), (slot)); if constexpr (V4) { const u32x2 t_ = __builtin_amdgcn_raw_buffer_load_b64(RV, lane * 8, e_ << 9, 0); dst.x = t_.x; dst.y = t_.y; } \
        else { const u32x4 t_ = __builtin_amdgcn_raw_buffer_load_b128(RV, lane * 16, e_ << 10, 0); dst.x = t_.x; dst.y = t_.y; dst.z = t_.z; dst.w = t_.w; } } while (0)
#define P7_DOT(BANK, q, r) do { const float tot_ = wave_sum_dpp(dot16_fp4(BANK[r].x, BANK[r].y, x2)); dvec = (lane == (q) * 16 + r) ? tot_ : dvec; } while (0)
#define P7_AXPY(BANK, q, r) do { const float w_ = __builtin_bit_cast(float, __builtin_amdgcn_readlane(__builtin_bit_cast(int, wvec), (q) * 16 + r)); \
        if constexpr (V4) axpy16_fp4(BANK[r].x, BANK[r].y, w_, y2); else axpy16_fp8((u32x4){BANK[r].x, BANK[r].y, BANK[r].z, BANK[r].w}, w_, y2); } while (0)
struct P7Row4 { unsigned x, y; };
struct P7Row8 { unsigned x, y, z, w; };
template <bool V4>
__device__ __forceinline__ void peer_phase(const bf16_t* __restrict__ XN2, const int* __restrict__ EIDX, const float* __restrict__ GATE, const unsigned char* __restrict__ Up, const unsigned char* __restrict__ Vp,
                                           const float* __restrict__ USC, const float* __restrict__ VSC, const float* H2, const float* __restrict__ fg, float* out, int gw, int NGW, int lane) {
    if (gw >= M) return;
    const __amdgpu_buffer_rsrc_t RU = __builtin_amdgcn_make_buffer_rsrc((void*)Up, 0, NEXP * 512, 0x00020000);
    const __amdgpu_buffer_rsrc_t RV = __builtin_amdgcn_make_buffer_rsrc((void*)Vp, 0, NEXP * (V4 ? 512 : 1024), 0x00020000);
    typedef typename std::conditional<V4, P7Row4, P7Row8>::type Row;
    Row A[16], B[16];
    int t = gw;
    int ev0 = EIDX[(size_t)t * 128 + lane], ev1 = EIDX[(size_t)t * 128 + 64 + lane];
    float gv0 = GATE[(size_t)t * 128 + lane], gv1 = GATE[(size_t)t * 128 + 64 + lane];
    u32x2 xq[4];
#pragma unroll
    for (int j = 0; j < 4; ++j) xq[j] = ((const u32x2*)(XN2 + (size_t)t * D))[lane + 64 * j];
#pragma unroll
    for (int r = 0; r < 16; ++r) P7_LOADU(A[r], ev0, r);
#pragma unroll
    for (int r = 0; r < 16; ++r) P7_LOADU(B[r], ev0, 16 + r);
#pragma unroll 1
    for (;;) {
        const int tn = t + NGW; const bool has_next = tn < M; const int tl = has_next ? tn : t;
        const int nev0 = EIDX[(size_t)tl * 128 + lane], nev1 = EIDX[(size_t)tl * 128 + 64 + lane];
        const float ngv0 = GATE[(size_t)tl * 128 + lane], ngv1 = GATE[(size_t)tl * 128 + 64 + lane];
        u32x2 nxq[4];
#pragma unroll
        for (int j = 0; j < 4; ++j) nxq[j] = ((const u32x2*)(XN2 + (size_t)tl * D))[lane + 64 * j];
        const float us0 = USC[ev0], us1 = USC[ev1], vs0 = VSC[ev0], vs1 = VSC[ev1];
        f32x2 x2[8], y2[8];
#pragma unroll
        for (int j = 0; j < 4; ++j) { x2[2 * j] = (f32x2){bf_lo(xq[j].x), bf_hi(xq[j].x)}; x2[2 * j + 1] = (f32x2){bf_lo(xq[j].y), bf_hi(xq[j].y)}; }
#pragma unroll
        for (int j = 0; j < 8; ++j) y2[j] = (f32x2){0.f, 0.f};
        float dvec = 0.f, wvec = 0.f;
#pragma unroll 1
        for (int half = 0; half < 2; ++half) {
            const int evh = half ? ev1 : ev0;
            const int evx = half ? nev0 : ev1;
#define P7_STEP(OP, BANK, q, LD, evv, slot0) do { _Pragma("unroll") for (int r = 0; r < 16; ++r) { OP(BANK, q, r); __builtin_amdgcn_sched_barrier(0); LD(BANK[r], evv, (slot0) + r); __builtin_amdgcn_sched_barrier(0); } } while (0)
            P7_STEP(P7_DOT, A, 0, P7_LOADU, evh, 32);
            P7_STEP(P7_DOT, B, 1, P7_LOADU, evh, 48);
            P7_STEP(P7_DOT, A, 2, P7_LOADV, evh, 0);
            P7_STEP(P7_DOT, B, 3, P7_LOADV, evh, 16);
            wvec = (half ? gv1 : gv0) * (half ? vs1 : vs0) * gelu_as(dvec * (half ? us1 : us0));
            P7_STEP(P7_AXPY, A, 0, P7_LOADV, evh, 32);
            P7_STEP(P7_AXPY, B, 1, P7_LOADV, evh, 48);
            P7_STEP(P7_AXPY, A, 2, P7_LOADU, evx, 0);
            P7_STEP(P7_AXPY, B, 3, P7_LOADU, evx, 16);
#undef P7_STEP
        }
        {
            const f32x4* hr = (const f32x4*)(H2 + (size_t)t * D) + lane;
            f32x4 z[4]; float sq = 0.f;
#pragma unroll
            for (int j = 0; j < 4; ++j) { z[j] = hr[64 * j] + (f32x4){y2[2 * j].x, y2[2 * j].y, y2[2 * j + 1].x, y2[2 * j + 1].y}; sq += (z[j].x * z[j].x + z[j].y * z[j].y) + (z[j].z * z[j].z + z[j].w * z[j].w); }
            const float rr = rsqrtf(wave_sum_dpp(sq) * (1.f / D) + EPS);
            const f32x4* gf = (const f32x4*)fg + lane;
            f32x4* op = (f32x4*)(out + (size_t)t * D) + lane;
#pragma unroll
            for (int j = 0; j < 4; ++j) op[64 * j] = z[j] * rr * gf[64 * j];
        }
        if (!has_next) break;
        t = tn; ev0 = nev0; ev1 = nev1; gv0 = ngv0; gv1 = ngv1;
#pragma unroll
        for (int j = 0; j < 4; ++j) xq[j] = nxq[j];
    }
}
#undef P7_LOADU
#undef P7_LOADV
#undef P7_DOT
#undef P7_AXPY

#define XB_TMO      128
#define XB_XCNT(j)  (256  + 64 * (j))
#define XB_XSUB(j)  (1280 + 64 * (j))
#define XB_XGEN(j)  (2304 + 64 * (j))
#define XB_TOP      3328
#define XB_TOPGEN   3392
#define XCD_BAR_WORDS 3456
#define XB_SPIN_CAP (1u << 18)

__device__ __forceinline__ unsigned xb_ld(unsigned* p)              { return __hip_atomic_load(p, __ATOMIC_RELAXED, __HIP_MEMORY_SCOPE_AGENT); }
__device__ __forceinline__ unsigned xb_add(unsigned* p, unsigned v) { return __hip_atomic_fetch_add(p, v, __ATOMIC_RELAXED, __HIP_MEMORY_SCOPE_AGENT); }
__device__ __forceinline__ unsigned xb_xcc_id() { return (unsigned)__builtin_amdgcn_s_getreg((3 << 11) | 20) & 0xFu; }
#define XB_SPIN(cond, bar) do { unsigned _sp = 0; while (cond) { __builtin_amdgcn_s_sleep(1); \
    if ((++_sp & 255u) == 0u) { if (xb_ld(&(bar)[XB_TMO])) break; if (_sp > XB_SPIN_CAP) { atomicAdd(&(bar)[XB_TMO], 1u); break; } } } } while (0)


struct XcdBar { unsigned* bar; unsigned x, nloc, nx; };
__device__ __forceinline__ void xcd_bar_post(unsigned* bar, unsigned x) { (void)xb_add(&bar[XB_XCNT(x)], 1u); }
__device__ __forceinline__ void xcd_bar_census(XcdBar& b) {
    unsigned cnt = 0u, mine = 0u;
#pragma unroll
    for (unsigned j = 0; j < 16; ++j) { const unsigned c = xb_ld(&b.bar[XB_XCNT(j)]); cnt += (c > 0u) ? 1u : 0u; mine = (j == b.x) ? c : mine; }
    b.nloc = mine > 0u ? mine : 1u; b.nx = cnt > 0u ? cnt : 1u;
}
__device__ __forceinline__ void xcd_barrier(const XcdBar& b, bool leader_thread) {
    asm volatile("s_waitcnt vmcnt(0)" ::: "memory");
    __syncthreads();
    if (leader_thread) {
        unsigned* bar = b.bar;
        __builtin_amdgcn_s_waitcnt(0);
        const unsigned nloc = b.nloc, nx = b.nx;
        const unsigned old = xb_add(&bar[XB_XSUB(b.x)], 1u);
        const unsigned gen = old / nloc;
        if (old + 1u == (gen + 1u) * nloc) {
            __builtin_amdgcn_fence(__ATOMIC_RELEASE, "agent");
            asm volatile("s_waitcnt vmcnt(0)" ::: "memory");
            const unsigned og = xb_add(&bar[XB_TOP], 1u);
            const unsigned tg = og / nx;
            if (og + 1u == (tg + 1u) * nx) xb_add(&bar[XB_TOPGEN], 1u);
            else XB_SPIN(xb_ld(&bar[XB_TOPGEN]) == tg, bar);
            __builtin_amdgcn_fence(__ATOMIC_ACQUIRE, "agent");
            xb_add(&bar[XB_XGEN(b.x)], 1u);
            asm volatile("s_waitcnt vmcnt(0)" ::: "memory");
        } else {
            XB_SPIN(xb_ld(&bar[XB_XGEN(b.x)]) == gen, bar);
            __builtin_amdgcn_fence(__ATOMIC_ACQUIRE, "agent");
            asm volatile("s_waitcnt vmcnt(0)" ::: "memory");
        }
    }
    __syncthreads();
}

__global__ void __launch_bounds__(NT, 2) mega(Args a) {
    extern __shared__ __attribute__((aligned(16))) unsigned char lds_raw[];
    LAS unsigned char* lds = (LAS unsigned char*)lds_raw;
    cg::grid_group grid = cg::this_grid();
    const int wave = __builtin_amdgcn_readfirstlane(threadIdx.x >> 6), G = gridDim.x;
#define PH_IDS() const int lane = pg8::lane_id_v(), tid = wave * 64 + lane; (void)tid; (void)lane
    unsigned char* ws = a.ws;
    const int lo = a.ph_lo, hi = a.ph_hi;
    bf16_t* WIN = (bf16_t*)(ws + WS_WIN); bf16_t* WOUT = (bf16_t*)(ws + WS_WOUT); bf16_t* WEFF = (bf16_t*)(ws + WS_WEFF);
    bf16_t* XN = (bf16_t*)(ws + WS_XN);
    bf16_t* GLU = (bf16_t*)(ws + WS_GLU); bf16_t* HG = (bf16_t*)(ws + WS_HG); bf16_t* Y = (bf16_t*)(ws + WS_Y);
    float* HS = (float*)(ws + WS_HS); float* HLD = (float*)(ws + WS_HLD);
    int* EIDX = (int*)(ws + WS_EIDX); float* GATE = (float*)(ws + WS_GATE);
    const int gw = blockIdx.x * NWAVES + wave, NGW = G * NWAVES;
#ifndef PH_MASK
#define PH_MASK 0xff
#endif
#define IN(k) (((PH_MASK >> (k)) & 1) && lo <= (k) && (k) < hi)
    XcdBar xb; xb.bar = (unsigned*)ws; xb.x = xb_xcc_id(); xb.nloc = 1u; xb.nx = 1u;
    const bool xb_leader = (wave == 0) && (pg8::lane_id_v() == 0);
    if (lo == 0 && xb_leader) xcd_bar_post(xb.bar, xb.x);
#define SEAM(k) do { if (IN(k) && IN((k) + 1)) { if ((k) == 0) { grid.sync(); if (xb_leader) xcd_bar_census(xb); } else xcd_barrier(xb, xb_leader); } } while (0)
    if (IN(0)) { PH_IDS(); p0_prologue(a, lds, tid, lane, wave, G); }
    SEAM(0);
    if (IN(1)) {
        pg8::Gemm g{XN, WIN, M, DIN, D}; pg8::StaticOrder S; S.init(M, DIN, G, (int)blockIdx.x);
        pg8::EpiProj E{GLU, HG};
        pg8::gemm_phase<pg8::EpiProj, pg8::StaticOrder, true, true>(lds, g, S, E, wave);
    }
    SEAM(1);
    if (IN(2)) { PH_IDS();
        for (int u = blockIdx.x; u < BATCH * NH * SEGS; u += G) hgrn_unit<false>(lds, u, HG, a.in[7], a.in[8], HS, HLD, Y, tid, lane, wave);
        for (int wu = gw; wu < 2048; wu += NGW) conv_wave_unit(GLU, a.in[3], a.in[4], a.in[5], a.in[6], Y, wu, lane);
    }
    SEAM(2);
    if (IN(3)) { PH_IDS();
        for (int u = blockIdx.x; u < BATCH * NH * SEGS; u += G) hgrn_unit<true>(lds, u, HG, a.in[7], a.in[8], HS, HLD, Y, tid, lane, wave);
    }
    SEAM(3);
    if (IN(4)) {
        pg8::Gemm g{Y, WOUT, M, D, D}; pg8::StaticOrder S; S.init(M, D, G, (int)blockIdx.x);
        pg8::EpiResF32 E{a.out, a.in[0], D};
        pg8::gemm_phase<pg8::EpiResF32, pg8::StaticOrder, true, true>(lds, g, S, E, wave);
    }
    SEAM(4);
    if (IN(5)) { PH_IDS();
        rows_convert<0>(a.out, ws + WS_XN, nullptr, 1.f, M, gw, NGW, lane);
    }
    SEAM(5);
    if (IN(6)) {
        pg8::Gemm g{XN, WEFF, M, NQ, D}; pg8::StaticOrder S; S.init(M, NQ, G, (int)blockIdx.x);
        pg8::EpiTopK E{EIDX, GATE};
        for (int i = 0;; ++i) { pg8::OneUnit O; if (!S.next(i, O.u)) break; pg8::gemm_phase<pg8::EpiTopK, pg8::OneUnit, false, true>(lds, g, O, E, wave); }
    }
    SEAM(6);
    if (IN(7)) { PH_IDS();
        peer_phase<PEER_V4>(XN, EIDX, GATE, ws + WS_U, ws + WS_V, (const float*)(ws + WS_USC), (const float*)(ws + WS_VSC), a.out, a.in[15], a.out, gw, NGW, lane);
    }
#undef IN
#undef SEAM
}
}

#ifndef STAGE
#define STAGE 5
#endif
#if STAGE < 5
namespace nv {
constexpr int D = 1024, BATCH = 8, SEQ = 4096, M = BATCH * SEQ;
constexpr int DCONV = 512, CW = 31, DH = 512, NH = 4, HD = 128, DIN = 3072;
constexpr int NKEY = 128;
constexpr float EPS = 1e-6f;
typedef unsigned short bf16_t;
__device__ __forceinline__ float bf1(bf16_t u) { return __builtin_bit_cast(float, (unsigned)u << 16); }
__device__ __forceinline__ float wsum(float v) {
#pragma unroll
    for (int o = 1; o < 64; o <<= 1) v += __shfl_xor(v, o);
    return v;
}
__device__ __forceinline__ float sigmoidf_(float x) { return 1.f / (1.f + __expf(-x)); }
__device__ __forceinline__ float siluf_(float x) { return x * sigmoidf_(x); }
__global__ void __launch_bounds__(256) k_cvt(const bf16_t* __restrict__ s, float* __restrict__ d, size_t n) { const size_t i = (size_t)blockIdx.x * 256 + threadIdx.x; if (i < n) d[i] = bf1(s[i]); }
__global__ void __launch_bounds__(256) k_rmsnorm(const float* __restrict__ x, const float* __restrict__ g, float* __restrict__ out, int rows) {
    const int lane = threadIdx.x & 63, w = threadIdx.x >> 6;
    const int row = blockIdx.x * 4 + w;
    if (row >= rows) return;
    const float4* xr = (const float4*)(x + (size_t)row * D);
    float4 v[4]; float s = 0.f;
#pragma unroll
    for (int j = 0; j < 4; ++j) { v[j] = xr[lane + 64 * j]; s += v[j].x * v[j].x + v[j].y * v[j].y + v[j].z * v[j].z + v[j].w * v[j].w; }
    s = wsum(s);
    const float r = rsqrtf(s * (1.f / D) + EPS);
    float4* o = (float4*)(out + (size_t)row * D);
    const float4* g4 = (const float4*)g;
#pragma unroll
    for (int j = 0; j < 4; ++j) { const float4 gg = g4[lane + 64 * j]; float4 t; t.x = v[j].x * r * gg.x; t.y = v[j].y * r * gg.y; t.z = v[j].z * r * gg.z; t.w = v[j].w * r * gg.w; o[lane + 64 * j] = t; }
}
template <bool RES>
__global__ void __launch_bounds__(256) k_gemm(const float* __restrict__ A, const float* __restrict__ B, float* __restrict__ C, const float* __restrict__ R, int Mm, int N, int K) {
    __shared__ float As[16][68];
    __shared__ float Bs[16][64];
    const int tid = threadIdx.x, tx = tid & 15, ty = tid >> 4;
    const int m0 = blockIdx.y * 64, n0 = blockIdx.x * 64;
    float acc[4][4];
#pragma unroll
    for (int i = 0; i < 4; ++i)
#pragma unroll
        for (int j = 0; j < 4; ++j) acc[i][j] = 0.f;
    for (int k0 = 0; k0 < K; k0 += 16) {
#pragma unroll
        for (int i = 0; i < 4; ++i) { const int idx = tid + i * 256, r = idx >> 4, kk = idx & 15; As[kk][r] = A[(size_t)(m0 + r) * K + k0 + kk]; }
#pragma unroll
        for (int i = 0; i < 4; ++i) { const int idx = tid + i * 256, kk = idx >> 6, c = idx & 63; Bs[kk][c] = B[(size_t)(k0 + kk) * N + n0 + c]; }
        __syncthreads();
#pragma unroll
        for (int kk = 0; kk < 16; ++kk) {
            float a[4], b[4];
#pragma unroll
            for (int i = 0; i < 4; ++i) a[i] = As[kk][ty * 4 + i];
#pragma unroll
            for (int j = 0; j < 4; ++j) b[j] = Bs[kk][tx * 4 + j];
#pragma unroll
            for (int i = 0; i < 4; ++i)
#pragma unroll
                for (int j = 0; j < 4; ++j) acc[i][j] = fmaf(a[i], b[j], acc[i][j]);
        }
        __syncthreads();
    }
#pragma unroll
    for (int i = 0; i < 4; ++i) {
        const size_t off = (size_t)(m0 + ty * 4 + i) * N + n0 + tx * 4;
        float4 o; o.x = acc[i][0]; o.y = acc[i][1]; o.z = acc[i][2]; o.w = acc[i][3];
        if (RES) { const float4 r = *(const float4*)(R + off); o.x += r.x; o.y += r.y; o.z += r.z; o.w += r.w; }
        *(float4*)(C + off) = o;
    }
}
__global__ void __launch_bounds__(512) k_conv_glu(const bf16_t* __restrict__ GLU, const float* __restrict__ cw, const float* __restrict__ cb, const float* __restrict__ ng, const float* __restrict__ nb, float* __restrict__ Y) {
    const int t = blockIdx.x, s = t % SEQ, c = threadIdx.x;
    float acc = cb[c];
    for (int j = 0; j < CW; ++j) { const int ss = s - (CW - 1) + j; if (ss >= 0) acc = fmaf(cw[j * DCONV + c], bf1(GLU[(size_t)(t - (CW - 1) + j) * DCONV + c]), acc); }
    const float mu = wsum(acc) * (1.f / 64.f), d = acc - mu, var = wsum(d * d) * (1.f / 64.f);
    Y[(size_t)t * D + c] = siluf_(d * rsqrtf(var + EPS) * ng[c] + nb[c]);
}
__global__ void __launch_bounds__(128) k_hgrn_hg(const bf16_t* __restrict__ HG, const float* __restrict__ lbl, const float* __restrict__ hng, float* __restrict__ Y) {
    __shared__ float fs[HD], ks[HD], qs[HD], red[2];
    const int b = blockIdx.x / NH, h = blockIdx.x % NH, v = threadIdx.x, col = h * HD + v;
    const float lb = 1.f / (1.f + __expf(lbl[DH + col] - lbl[col])), gn = hng[col];
    float S[HD];
#pragma unroll
    for (int k = 0; k < HD; ++k) S[k] = 0.f;
    for (int s = 0; s < SEQ; ++s) {
        const bf16_t* pr = HG + (size_t)(b * SEQ + s) * 2048;
        const float qv = bf1(pr[col]), z = bf1(pr[DH + col]), iv = bf1(pr[2 * DH + col]), gv = bf1(pr[3 * DH + col]);
        const float sg = sigmoidf_(z);
        fs[v] = lb + (1.f - lb) * sg; ks[v] = (1.f - lb) * (1.f - sg); qs[v] = qv;
        __syncthreads();
        float o = 0.f;
#pragma unroll
        for (int k = 0; k < HD; ++k) { S[k] = fmaf(fs[k], S[k], ks[k] * iv); o = fmaf(S[k], qs[k], o); }
        const float sq = wsum(o * o);
        if ((v & 63) == 0) red[v >> 6] = sq;
        __syncthreads();
        const float ms = (red[0] + red[1]) * (1.f / HD);
        Y[(size_t)(b * SEQ + s) * D + DCONV + col] = o * rsqrtf(ms + EPS) * gn * gv;
        __syncthreads();
    }
}
__global__ void __launch_bounds__(256) k_scores(const float* __restrict__ Q, const float* __restrict__ sk, float* __restrict__ SC) {
    __shared__ float qs[2048];
    const int t = blockIdx.x;
    for (int i = threadIdx.x; i < 2048; i += 256) qs[i] = Q[(size_t)t * 2048 + i];
    __syncthreads();
    for (int o = threadIdx.x; o < 2048; o += 256) {
        const int hp = o >> 7; const float* kr = sk + (size_t)o * 128; const float* qq = qs + hp * 128;
        float a = 0.f;
        for (int j = 0; j < 128; ++j) a = fmaf(qq[j], kr[j], a);
        SC[(size_t)t * 2048 + o] = a;
    }
}
__device__ __forceinline__ void wave_argmax(float& v, int& i) {
#pragma unroll
    for (int o = 1; o < 64; o <<= 1) { const float ov = __shfl_xor(v, o); const int oi = __shfl_xor(i, o); if (ov > v || (ov == v && oi < i)) { v = ov; i = oi; } }
}
__global__ void __launch_bounds__(64) k_topk(const float* __restrict__ SC, int* __restrict__ EIDX, float* __restrict__ GATE) {
    __shared__ float s1[16], s2[16]; __shared__ int i1[16], i2[16];
    const int t = blockIdx.x >> 3, h = blockIdx.x & 7, lane = threadIdx.x;
    const float* sc = SC + (size_t)t * 2048 + h * 256;
    for (int p = 0; p < 2; ++p) {
        float a0 = sc[p * 128 + lane], a1 = sc[p * 128 + 64 + lane];
        for (int r = 0; r < 16; ++r) {
            float v; int i;
            if (a0 >= a1) { v = a0; i = lane; } else { v = a1; i = lane + 64; }
            wave_argmax(v, i);
            if (lane == 0) { if (p == 0) { s1[r] = v; i1[r] = i; } else { s2[r] = v; i2[r] = i; } }
            if (i == lane) a0 = -INFINITY;
            if (i == lane + 64) a1 = -INFINITY;
        }
    }
    __syncthreads();
    float c[4];
#pragma unroll
    for (int e = 0; e < 4; ++e) { const int ci = lane * 4 + e; c[e] = s1[ci >> 4] + s2[ci & 15]; }
    float tmax = 0.f, myts = 0.f; int mye = 0;
    for (int r = 0; r < 16; ++r) {
        float v = c[0]; int i = lane * 4;
#pragma unroll
        for (int e = 1; e < 4; ++e) if (c[e] > v) { v = c[e]; i = lane * 4 + e; }
        wave_argmax(v, i);
#pragma unroll
        for (int e = 0; e < 4; ++e) if (i == lane * 4 + e) c[e] = -INFINITY;
        if (r == 0) tmax = v;
        if (lane == r) { myts = v; mye = i1[i >> 4] * NKEY + i2[i & 15]; }
    }
    const float ex = (lane < 16) ? __expf(myts - tmax) : 0.f;
    const float den = wsum(ex);
    if (lane < 16) { EIDX[(size_t)t * 128 + h * 16 + lane] = mye; GATE[(size_t)t * 128 + h * 16 + lane] = ex / den; }
}
__global__ void __launch_bounds__(256) k_peer(const float* __restrict__ XN2, const int* __restrict__ EIDX, const float* __restrict__ GATE, const float* __restrict__ U, const float* __restrict__ V,
                                              const float* H2, const float* __restrict__ fg, float* out) {
    const int lane = threadIdx.x & 63, w = threadIdx.x >> 6, t = blockIdx.x * 4 + w;
    const float4* xr = (const float4*)(XN2 + (size_t)t * D);
    float4 x[4], y[4];
#pragma unroll
    for (int j = 0; j < 4; ++j) { x[j] = xr[lane + 64 * j]; y[j] = make_float4(0.f, 0.f, 0.f, 0.f); }
    for (int e = 0; e < 128; ++e) {
        const int ei = EIDX[(size_t)t * 128 + e]; const float g = GATE[(size_t)t * 128 + e];
        const float4* ur = (const float4*)(U + (size_t)ei * D);
        float d = 0.f;
#pragma unroll
        for (int j = 0; j < 4; ++j) { const float4 u = ur[lane + 64 * j]; d += u.x * x[j].x + u.y * x[j].y + u.z * x[j].z + u.w * x[j].w; }
        d = wsum(d);
        const float wgt = g * 0.5f * d * (1.f + erff(d * 0.70710678118654752f));
        const float4* vr = (const float4*)(V + (size_t)ei * D);
#pragma unroll
        for (int j = 0; j < 4; ++j) { const float4 vv = vr[lane + 64 * j]; y[j].x = fmaf(wgt, vv.x, y[j].x); y[j].y = fmaf(wgt, vv.y, y[j].y); y[j].z = fmaf(wgt, vv.z, y[j].z); y[j].w = fmaf(wgt, vv.w, y[j].w); }
    }
    const float4* hr = (const float4*)(H2 + (size_t)t * D);
    float s = 0.f;
#pragma unroll
    for (int j = 0; j < 4; ++j) { const float4 hh = hr[lane + 64 * j]; y[j].x += hh.x; y[j].y += hh.y; y[j].z += hh.z; y[j].w += hh.w; s += y[j].x * y[j].x + y[j].y * y[j].y + y[j].z * y[j].z + y[j].w * y[j].w; }
    s = wsum(s);
    const float r = rsqrtf(s * (1.f / D) + EPS);
    float4* o = (float4*)(out + (size_t)t * D);
    const float4* g4 = (const float4*)fg;
#pragma unroll
    for (int j = 0; j < 4; ++j) { const float4 gg = g4[lane + 64 * j]; float4 q; q.x = y[j].x * r * gg.x; q.y = y[j].y * r * gg.y; q.z = y[j].z * r * gg.z; q.w = y[j].w * r * gg.w; o[lane + 64 * j] = q; }
}
}
#endif

extern "C" void kernel_launch(void* const* d_in, const int* in_sizes, int n_in, void* d_out, int out_size, void* d_ws, size_t ws_size, hipStream_t stream) {
    static int grid = 0;
    if (grid == 0) {
        if (n_in != 16 || out_size != mk::M * mk::D || ws_size < 512ull * mk::MiB) { fprintf(stderr, "kernel_launch: unexpected shapes (n_in %d out %d ws %zu)\n", n_in, out_size, ws_size); grid = -1; return; }
        int dev = 0, cus = 0, per_cu = 0;
        (void)hipGetDevice(&dev);
        (void)hipDeviceGetAttribute(&cus, hipDeviceAttributeMultiprocessorCount, dev);
        if (hipFuncSetAttribute((const void*)mk::mega, hipFuncAttributeMaxDynamicSharedMemorySize, mk::LDS_BYTES) != hipSuccess) { fprintf(stderr, "kernel_launch: hipFuncSetAttribute failed\n"); grid = -1; return; }
        if (hipOccupancyMaxActiveBlocksPerMultiprocessor(&per_cu, (const void*)mk::mega, mk::NT, mk::LDS_BYTES) != hipSuccess || per_cu < 1) { fprintf(stderr, "kernel_launch: occupancy query says %d\n", per_cu); per_cu = 1; }
        (void)hipGetLastError();
        grid = cus;
        fprintf(stderr, "kernel_launch: cus %d per_cu %d grid %d\n", cus, per_cu, grid);
    }
    if (grid < 0) return;
    if (hipMemsetAsync(d_ws, 0, 16384, stream) != hipSuccess) { fprintf(stderr, "kernel_launch: memset failed\n"); return; }
    mk::Args a{};
    for (int i = 0; i < 16; ++i) a.in[i] = (const float*)d_in[i];
    a.out = (float*)d_out; a.ws = (unsigned char*)d_ws;
    const int his[6] = {0, 2, 4, 6, 7, 8};
    a.ph_lo = 0; a.ph_hi = his[STAGE];
    void* args[] = {&a};
#ifdef PROBE_PHASE
    const int plo[3] = {0, PROBE_PHASE == 0 ? 0 : PROBE_PHASE, 7}, phi[3] = {PROBE_PHASE == 0 ? 1 : 7, PROBE_PHASE == 0 ? 8 : PROBE_PHASE + 1, 8};
    for (int li = 0; li < 3; ++li) { if ((li == 1 && PROBE_PHASE < 0) || (li == 2 && PROBE_PHASE == 0)) continue; a.ph_lo = plo[li]; a.ph_hi = phi[li];
        if (li) (void)hipMemsetAsync(d_ws, 0, 16384, stream);
        hipError_t e = hipLaunchCooperativeKernel((const void*)mk::mega, dim3(grid), dim3(mk::NT), args, mk::LDS_BYTES, stream);
        if (e != hipSuccess) fprintf(stderr, "cooperative launch failed: %s (grid %d)\n", hipGetErrorString(e), grid); }
#else
    hipError_t e = hipLaunchCooperativeKernel((const void*)mk::mega, dim3(grid), dim3(mk::NT), args, mk::LDS_BYTES, stream);
    if (e != hipSuccess) fprintf(stderr, "cooperative launch failed: %s (grid %d)\n", hipGetErrorString(e), grid);
#endif
#if STAGE < 5
    using namespace nv;
    char* ws = (char*)d_ws; const size_t MiB = 1u << 20;
    const float* x = (const float*)d_in[0];
    float* out = (float*)d_out;
    float* XN2f = (float*)(ws);
    float* Qh = (float*)(ws + 128 * MiB); float* SCh = (float*)(ws + 256 * MiB);
    int* EIDX = (int*)(ws + 384 * MiB); float* GATE = (float*)(ws + 400 * MiB);
#if STAGE == 1
    float* Yf = (float*)(ws + 320 * MiB);
    k_conv_glu<<<M, 512, 0, stream>>>((const bf16_t*)(ws + mk::WS_GLU), (const float*)d_in[3], (const float*)d_in[4], (const float*)d_in[5], (const float*)d_in[6], Yf);
    k_hgrn_hg<<<BATCH * NH, 128, 0, stream>>>((const bf16_t*)(ws + mk::WS_HG), (const float*)d_in[7], (const float*)d_in[8], Yf);
#endif
#if STAGE == 2
    float* Yf = (float*)(ws + 128 * MiB);
    k_cvt<<<(unsigned)((size_t)M * D / 256), 256, 0, stream>>>((const bf16_t*)(ws + mk::WS_Y), Yf, (size_t)M * D);
#endif
#if STAGE <= 2
    k_gemm<true><<<dim3(D / 64, M / 64), 256, 0, stream>>>(Yf, (const float*)d_in[9], out, x, M, D, D);
#endif
#if STAGE <= 3
    k_rmsnorm<<<M / 4, 256, 0, stream>>>(out, (const float*)d_in[10], XN2f, M);
    for (int hf = 0; hf < 2; ++hf) {
        const int Mh = M / 2;
        k_gemm<false><<<dim3(2048 / 64, Mh / 64), 256, 0, stream>>>(XN2f + (size_t)hf * Mh * D, (const float*)d_in[11], Qh, nullptr, Mh, 2048, D);
        k_scores<<<Mh, 256, 0, stream>>>(Qh, (const float*)d_in[12], SCh);
        k_topk<<<Mh * 8, 64, 0, stream>>>(SCh, EIDX + (size_t)hf * Mh * 128, GATE + (size_t)hf * Mh * 128);
    }
    k_peer<<<M / 4, 256, 0, stream>>>(XN2f, EIDX, GATE, (const float*)d_in[13], (const float*)d_in[14], out, (const float*)d_in[15], out);
#endif
#if STAGE == 4
    float* XN2g = (float*)(ws + 160 * MiB);
    k_rmsnorm<<<M / 4, 256, 0, stream>>>(out, (const float*)d_in[10], XN2g, M);
    k_peer<<<M / 4, 256, 0, stream>>>(XN2g, (const int*)(ws + mk::WS_EIDX), (const float*)(ws + mk::WS_GATE), (const float*)d_in[13], (const float*)d_in[14], out, (const float*)d_in[15], out);
#endif
#endif
}
```

```cpp
#include <hip/hip_runtime.h>
#include <hip/hip_cooperative_groups.h>
#include <cstdio>
#include <cstdint>
#include <cmath>
#include <type_traits>
namespace cg = cooperative_groups;
namespace pg8 {
#define PG8_LAS __attribute__((address_space(3)))
typedef unsigned short bf16_t;
typedef short bf16x8 __attribute__((ext_vector_type(8)));
typedef float f32x4 __attribute__((ext_vector_type(4)));
typedef unsigned u32x4 __attribute__((ext_vector_type(4)));
constexpr int BM = 256, BK = 64, HALF = 128, HTB = HALF * BK * 2  , STAGE_BYTES = 8 * HTB, NXCD = 8, WGM = 8;

__host__ __device__ __forceinline__ int lds_byte(int r, int c) { const int st = (r >> 4) * 2 + (c >> 5), rr = r & 15, cc = c & 31, ob = rr * 64 + cc * 2; return st * 1024 + (ob ^ (((ob >> 9) & 1) << 5)); }
__host__ __device__ __forceinline__ void stage_rc(int b, int& R, int& C) { const int st = b / 1024, sb = b % 1024, swz = sb ^ (((sb >> 9) & 1) << 5); R = (st >> 1) * 16 + swz / 64; C = (st & 1) * 32 + (swz % 64) / 2; }
__host__ __device__ __forceinline__ int perm32(int rho) { const int n = rho >> 4, i = rho & 15; return 8 * (i >> 2) + 4 * n + (i & 3); }

struct Unit { int pm, pn; };
struct Gemm { const bf16_t* A; const bf16_t* Bt; int M, N, K; };

struct StaticOrder {
    int nM, nN, nwg, G, c;
    __host__ __device__ void init(int M, int N, int G_, int c_) { nM = M / BM; nN = N / BM; nwg = nM * nN; G = G_; c = c_; }
    __host__ __device__ bool next(int i, Unit& u) const {
        const long L = (long)i * G + c; if (L >= nwg) return false;
        int wgid = (int)L; { const int q = nwg / NXCD, r = nwg % NXCD, xcd = wgid % NXCD, off = wgid / NXCD; wgid = (xcd < r ? xcd * (q + 1) : r * (q + 1) + (xcd - r) * q) + off; }
        const int nig = WGM * nN, gid = wgid / nig, fm = gid * WGM, gsz = (nM - fm) < WGM ? (nM - fm) : WGM;
        u.pm = fm + ((wgid % nig) % gsz); u.pn = (wgid % nig) / gsz; return true;
    }
    __device__ __forceinline__ void a_ready(const Unit&) const {}
    __device__ __forceinline__ void done(const Unit&) const {}
};

__device__ __forceinline__ unsigned cvt_pk_bf16(float lo, float hi) { unsigned r; asm volatile("v_cvt_pk_bf16_f32 %0, %1, %2" : "=v"(r) : "v"(lo), "v"(hi)); return r; }
__device__ __forceinline__ int lane_id_v() { int l; asm volatile("v_mbcnt_lo_u32_b32 %0, -1, 0\n\tv_mbcnt_hi_u32_b32 %0, -1, %0" : "=v"(l)); return l; }
__device__ __forceinline__ float fsigmoid(float x) { return __builtin_amdgcn_rcpf(1.f + __builtin_amdgcn_exp2f(-1.4426950408889634f * x)); }

struct EpiProj {
    static constexpr bool PERM = true, AFTER_DRAIN = false;
    bf16_t* GLU; bf16_t* HG;
    static constexpr size_t MROWS = 32768;
    __device__ __forceinline__ void operator()(const f32x4 (&acc)[2][2][4][2], const Unit& u, int wr, int wc, int fr, int fq) const {
        const int row0 = u.pm * BM + wr * 64 + fr;
        if (u.pn < 4) {
            const int col = u.pn * 128 + wc * 32 + 8 * fq;
#pragma unroll
            for (int ai = 0; ai < 2; ++ai)
#pragma unroll
                for (int m = 0; m < 4; ++m) {
                    const f32x4 a0 = acc[ai][0][m][0], a1 = acc[ai][0][m][1], g0 = acc[ai][1][m][0], g1 = acc[ai][1][m][1];
                    u32x4 w;
                    w.x = cvt_pk_bf16(a0[0] * fsigmoid(g0[0]), a0[1] * fsigmoid(g0[1])); w.y = cvt_pk_bf16(a0[2] * fsigmoid(g0[2]), a0[3] * fsigmoid(g0[3]));
                    w.z = cvt_pk_bf16(a1[0] * fsigmoid(g1[0]), a1[1] * fsigmoid(g1[1])); w.w = cvt_pk_bf16(a1[2] * fsigmoid(g1[2]), a1[3] * fsigmoid(g1[3]));
                    *(u32x4*)(GLU + ((size_t)(col >> 6) * MROWS + (row0 + ai * HALF + m * 16)) * 64 + (col & 63)) = w;
                }
        } else {
            const int t = u.pn - 4;
            const bool act = (t < 2) || (t >= 6);
            const int col = t * 256 + wc * 32 + 8 * fq;
#pragma unroll
            for (int ai = 0; ai < 2; ++ai)
#pragma unroll
                for (int m = 0; m < 4; ++m) {
                    const int hcol = (t & 1) * 256 + wc * 32 + 8 * fq;
                    bf16_t* rowp = HG + ((size_t)((t >> 1) * 4 + (hcol >> 7)) * MROWS + (row0 + ai * HALF + m * 16)) * 128 + (hcol & 127);
#pragma unroll
                    for (int bj = 0; bj < 2; ++bj) {
                        f32x4 v0 = acc[ai][bj][m][0], v1 = acc[ai][bj][m][1];
                        if (act) {
#pragma unroll
                            for (int i = 0; i < 4; ++i) { v0[i] = v0[i] * fsigmoid(v0[i]); v1[i] = v1[i] * fsigmoid(v1[i]); }
                        }
                        u32x4 w; w.x = cvt_pk_bf16(v0[0], v0[1]); w.y = cvt_pk_bf16(v0[2], v0[3]); w.z = cvt_pk_bf16(v1[0], v1[1]); w.w = cvt_pk_bf16(v1[2], v1[3]);
                        *(u32x4*)(rowp + (size_t)bj * MROWS * 128) = w;
                    }
                }
        }
    }
};

struct EpiResBf16 {
    static constexpr bool PERM = true, AFTER_DRAIN = false;
    bf16_t* O; const float* R; float* SSQ;
    __device__ __forceinline__ void operator()(const f32x4 (&acc)[2][2][4][2], const Unit& u, int wr, int wc, int fr, int fq) const {
        const int row0 = u.pm * BM + wr * 64 + fr, col0 = u.pn * BM + wc * 32 + 8 * fq;
#pragma unroll
        for (int ai = 0; ai < 2; ++ai)
#pragma unroll
            for (int m = 0; m < 4; ++m) {
                const int row = row0 + ai * HALF + m * 16; const size_t off = (size_t)row * 1024 + col0;
                float ss = 0.f;
#pragma unroll
                for (int bj = 0; bj < 2; ++bj) {
                    const f32x4 v0 = acc[ai][bj][m][0] + *(const f32x4*)(R + off + bj * HALF), v1 = acc[ai][bj][m][1] + *(const f32x4*)(R + off + bj * HALF + 4);
                    ss += (v0[0] * v0[0] + v0[1] * v0[1]) + (v0[2] * v0[2] + v0[3] * v0[3]) + (v1[0] * v1[0] + v1[1] * v1[1]) + (v1[2] * v1[2] + v1[3] * v1[3]);
                    u32x4 w; w.x = cvt_pk_bf16(v0[0], v0[1]); w.y = cvt_pk_bf16(v0[2], v0[3]); w.z = cvt_pk_bf16(v1[0], v1[1]); w.w = cvt_pk_bf16(v1[2], v1[3]);
                    *(u32x4*)(O + off + bj * HALF) = w;
                }
                ss += __shfl_xor(ss, 16); ss += __shfl_xor(ss, 32);
                if (fq == 0) SSQ[(size_t)row * 16 + u.pn * 4 + wc] = ss;
            }
    }
};

__device__ __forceinline__ unsigned f2key(float f) { const unsigned u = __builtin_bit_cast(unsigned, f); return (u & 0x80000000u) ? ~u : (u | 0x80000000u); }
__device__ __forceinline__ float key2f(unsigned k) { const unsigned u = (k & 0x80000000u) ? (k & 0x7fffffffu) : ~k; return __builtin_bit_cast(float, u); }
__device__ __forceinline__ unsigned umax_(unsigned a, unsigned b) { return a > b ? a : b; }
__device__ __forceinline__ unsigned umin_(unsigned a, unsigned b) { return a < b ? a : b; }
__device__ __forceinline__ void sort16_desc(unsigned (&v)[16]) {
#pragma unroll
    for (int k = 2; k <= 16; k <<= 1)
#pragma unroll
        for (int j = k >> 1; j > 0; j >>= 1)
#pragma unroll
            for (int i = 0; i < 16; ++i) { const int l = i ^ j; if (l > i) { const unsigned hi = umax_(v[i], v[l]), lo = umin_(v[i], v[l]); if ((i & k) == 0) { v[i] = hi; v[l] = lo; } else { v[i] = lo; v[l] = hi; } } }
}
__device__ __forceinline__ void bmerge16_desc(unsigned (&v)[16]) {
#pragma unroll
    for (int j = 8; j > 0; j >>= 1)
#pragma unroll
        for (int i = 0; i < 16; ++i) { const int l = i ^ j; if (l > i) { const unsigned hi = umax_(v[i], v[l]), lo = umin_(v[i], v[l]); v[i] = hi; v[l] = lo; } }
}
struct EpiTopK {
    static constexpr bool PERM = false, AFTER_DRAIN = true;
    int* EIDX; float* GATE; const float* SSQ;
    __device__ __forceinline__ void fused(f32x4 (&acc)[2][2][4][2], const Unit& u, int wr, int wc, int fr, int fq, PG8_LAS unsigned char* lds, int wid, int lane) const {
        PG8_LAS unsigned* T = (PG8_LAS unsigned*)lds;
        PG8_LAS unsigned* LB = (PG8_LAS unsigned*)(lds + 131072);
        const int h = u.pn;
#pragma unroll
        for (int ai = 0; ai < 2; ++ai) {
            const int rl = wr * 64 + fr;
#pragma unroll
            for (int bj = 0; bj < 2; ++bj)
#pragma unroll
                for (int m = 0; m < 4; ++m)
#pragma unroll
                    for (int n = 0; n < 2; ++n)
#pragma unroll
                        for (int i = 0; i < 4; ++i) {
                            const int c = bj * 128 + wc * 32 + n * 16 + fq * 4 + i;
                            const float v = acc[ai][bj][m][n][i];
                            T[c * 128 + rl + m * 16] = (f2key(v) & ~127u) | (unsigned)(127 - (c & 127));
                        }
            asm volatile("s_waitcnt lgkmcnt(0)" ::: "memory"); __builtin_amdgcn_s_barrier(); asm volatile("" ::: "memory");
            {
                const int p = wid >> 2, q = (wid >> 1) & 1, r = (wid & 1) * 64 + lane, base = p * 128 + q * 64;
                unsigned run[16], grp[16];
#pragma unroll
                for (int j = 0; j < 16; ++j) run[j] = T[(base + j) * 128 + r];
                sort16_desc(run);
#pragma unroll
                for (int gI = 1; gI < 4; ++gI) {
#pragma unroll
                    for (int j = 0; j < 16; ++j) grp[j] = T[(base + 16 * gI + j) * 128 + r];
                    sort16_desc(grp);
#pragma unroll
                    for (int j = 0; j < 16; ++j) run[j] = umax_(run[j], grp[15 - j]);
                    bmerge16_desc(run);
                }
#pragma unroll
                for (int j = 0; j < 16; ++j) LB[((p * 2 + q) * 16 + j) * 128 + r] = run[j];
            }
            asm volatile("s_waitcnt lgkmcnt(0)" ::: "memory"); __builtin_amdgcn_s_barrier(); asm volatile("" ::: "memory");
            if (wid < 4) {
                const int p = wid >> 1, r = (wid & 1) * 64 + lane;
                unsigned a[16];
#pragma unroll
                for (int j = 0; j < 16; ++j) a[j] = umax_(LB[((p * 2) * 16 + j) * 128 + r], LB[((p * 2 + 1) * 16 + (15 - j)) * 128 + r]);
                bmerge16_desc(a);
#pragma unroll
                for (int j = 0; j < 16; ++j) LB[((p * 2) * 16 + j) * 128 + r] = a[j];
            }
            asm volatile("s_waitcnt lgkmcnt(0)" ::: "memory"); __builtin_amdgcn_s_barrier(); asm volatile("" ::: "memory");
            if (wid < 2) {
                const int r = wid * 64 + lane;
                float v1[16], v2[16];
#pragma unroll
                for (int j = 0; j < 16; ++j) { v1[j] = key2f(LB[j * 128 + r] & ~127u); v2[j] = key2f(LB[(32 + j) * 128 + r] & ~127u); }
                unsigned lst[16];
#pragma unroll
                for (int j = 0; j < 16; ++j) lst[j] = (f2key(v1[0] + v2[j]) & ~255u) | (unsigned)(255 - j);
#pragma unroll
                for (int i = 1; i < 16; ++i)
#pragma unroll
                    for (int j = 0; j < 16; ++j) if ((i + 1) * (j + 1) <= 16) {
                        unsigned x = (f2key(v1[i] + v2[j]) & ~255u) | (unsigned)(255 - (i * 16 + j));
#pragma unroll
                        for (int t = 0; t < 16; ++t) if (t >= (i + 1) * (j + 1) - 1) { const unsigned hi = umax_(lst[t], x); x = umin_(lst[t], x); lst[t] = hi; }
                    }
                float rstd;
                { const f32x4* sq = (const f32x4*)(SSQ + (size_t)(u.pm * BM + ai * 128 + r) * 16); const f32x4 q0 = sq[0], q1 = sq[1], q2 = sq[2], q3 = sq[3];
                  const float tot = ((q0[0] + q0[1]) + (q0[2] + q0[3])) + ((q1[0] + q1[1]) + (q1[2] + q1[3])) + ((q2[0] + q2[1]) + (q2[2] + q2[3])) + ((q3[0] + q3[1]) + (q3[2] + q3[3]));
                  rstd = rsqrtf(tot * (1.f / 1024.f) + 1e-6f); }
                float e[16]; float sum = 0.f; const float mx = key2f(lst[0] & ~255u);
                int ex[16];
#pragma unroll
                for (int t = 0; t < 16; ++t) {
                    e[t] = __expf((key2f(lst[t] & ~255u) - mx) * rstd); sum += e[t];
                    const int ci = 255 - (int)(lst[t] & 255u), a = ci >> 4, b = ci & 15;
                    const int i1 = 127 - (int)(LB[a * 128 + r] & 127u), i2 = 127 - (int)(LB[(32 + b) * 128 + r] & 127u);
                    ex[t] = i1 * 128 + i2;
                }
                const float inv = 1.f / sum;
                const size_t o = (size_t)(u.pm * BM + ai * 128 + r) * 128 + h * 16;
#pragma unroll
                for (int t4 = 0; t4 < 4; ++t4) {
                    *(f32x4*)(GATE + o + 4 * t4) = (f32x4){e[4 * t4] * inv, e[4 * t4 + 1] * inv, e[4 * t4 + 2] * inv, e[4 * t4 + 3] * inv};
                    *(u32x4*)(EIDX + o + 4 * t4) = (u32x4){(unsigned)ex[4 * t4], (unsigned)ex[4 * t4 + 1], (unsigned)ex[4 * t4 + 2], (unsigned)ex[4 * t4 + 3]};
                }
            }
            asm volatile("s_waitcnt lgkmcnt(0)" ::: "memory"); __builtin_amdgcn_s_barrier(); asm volatile("" ::: "memory");
        }
    }
};
struct OneUnit {
    Unit u;
    __device__ __forceinline__ bool next(int i, Unit& o) const { if (i) return false; o = u; return true; }
    __device__ __forceinline__ void a_ready(const Unit&) const {}
    __device__ __forceinline__ void done(const Unit&) const {}
};

template <class Epi, class Sched, bool ALIGN_EPI = false, bool SP2 = false>
__device__ __forceinline__ void gemm_phase(PG8_LAS unsigned char* lds, const Gemm g, const Sched& S, const Epi& E, const int wid) {
    const int lane = lane_id_v(), tid = wid * 64 + lane, wr = wid >> 2, wc = wid & 3, fr = lane & 15, fq = lane >> 4;
    const int K = g.K, nt = K / BK;
    unsigned voffA[2], voffB[2];
#pragma unroll
    for (int i = 0; i < 2; ++i) { int R, C; stage_rc(tid * 16 + i * 8192, R, C); const int Rb = Epi::PERM ? ((R & ~31) + perm32(R & 31)) : R;
        voffA[i] = (unsigned)(R * K + C) * 2u; voffB[i] = (unsigned)(Rb * K + C) * 2u; }
    const size_t kstep = (size_t)(BK * 2);
    const size_t hstep = (size_t)HALF * K * 2;
    const size_t tstep = 2 * hstep;
    const unsigned ldsw = (unsigned)wid * 1024u;
    const int aoff = lds_byte(wr * 64 + fr, fq * 8), boff = lds_byte(wc * 32 + fr, fq * 8);
#define PG8_SA(b, h) (((b) * 2 + (h)) * HTB)
#define PG8_SB(b, h) ((4 + (b) * 2 + (h)) * HTB)
#define PG8_STAGE(bufoff, gbase, voff) do { _Pragma("unroll") for (int _i = 0; _i < 2; ++_i) \
        __builtin_amdgcn_global_load_lds((const unsigned*)((const char*)(gbase) + (voff)[_i]), (PG8_LAS unsigned*)(lds + (bufoff) + ldsw + _i * 8192), 16, 0, 0); } while (0)
#define PG8_LDA(dst, b, h) do { _Pragma("unroll") for (int m = 0; m < 4; ++m) _Pragma("unroll") for (int k = 0; k < 2; ++k) dst[m][k] = *(const PG8_LAS bf16x8*)(lds + PG8_SA(b, h) + aoff + m * 2048 + k * 1024); } while (0)
#define PG8_LDB(dst, b, h) do { _Pragma("unroll") for (int n = 0; n < 2; ++n) _Pragma("unroll") for (int k = 0; k < 2; ++k) dst[n][k] = *(const PG8_LAS bf16x8*)(lds + PG8_SB(b, h) + boff + n * 2048 + k * 1024); } while (0)
#define PG8_MMA(ai, bj, At, Bt) do { __builtin_amdgcn_s_setprio(1); _Pragma("unroll") for (int m = 0; m < 4; ++m) _Pragma("unroll") for (int n = 0; n < 2; ++n) _Pragma("unroll") for (int k = 0; k < 2; ++k) \
        acc[ai][bj][m][n] = __builtin_amdgcn_mfma_f32_16x16x32_bf16(Bt[n][k], At[m][k], acc[ai][bj][m][n], 0, 0, 0); __builtin_amdgcn_s_setprio(0); } while (0)
#define PG8_WAIT_V(n) asm volatile("s_waitcnt vmcnt(" #n ")" ::: "memory")
#define PG8_WAIT_L(n) asm volatile("s_waitcnt lgkmcnt(" #n ")" ::: "memory")
#define PG8_BAR __builtin_amdgcn_s_barrier()
#define PG8_SCHED __builtin_amdgcn_sched_barrier(0)
    Unit cur, nxt; int ui = 0;
    if (!S.next(0, cur)) return;
    f32x4 acc[2][2][4][2];
#pragma unroll
    for (int a = 0; a < 2; ++a)
#pragma unroll
        for (int b = 0; b < 2; ++b)
#pragma unroll
            for (int m = 0; m < 4; ++m)
#pragma unroll
                for (int n = 0; n < 2; ++n) acc[a][b][m][n] = (f32x4){0.f, 0.f, 0.f, 0.f};
    bf16x8 At[4][2], B0[2][2], B1[2][2];
    const char* cA = (const char*)g.A + (size_t)cur.pm * tstep; const char* cB = (const char*)g.Bt + (size_t)cur.pn * tstep;
    S.a_ready(cur);
    if constexpr (SP2) {
        PG8_STAGE(PG8_SB(0, 0), cB, voffB); PG8_STAGE(PG8_SB(0, 1), cB + hstep, voffB); PG8_STAGE(PG8_SA(0, 0), cA, voffA); PG8_STAGE(PG8_SA(0, 1), cA + hstep, voffA);
        if (wr == 1) PG8_BAR;
        PG8_WAIT_V(2); PG8_BAR;
        PG8_STAGE(PG8_SB(1, 0), cB + kstep, voffB); PG8_STAGE(PG8_SA(1, 0), cA + kstep, voffA); PG8_STAGE(PG8_SB(1, 1), cB + hstep + kstep, voffB);
        PG8_WAIT_V(6); PG8_BAR;
    } else {
        PG8_STAGE(PG8_SB(0, 0), cB, voffB); PG8_STAGE(PG8_SA(0, 0), cA, voffA); PG8_STAGE(PG8_SB(0, 1), cB + hstep, voffB); PG8_STAGE(PG8_SA(0, 1), cA + hstep, voffA);
        if (wr == 1) PG8_BAR;
        PG8_WAIT_V(4); PG8_BAR;
        PG8_STAGE(PG8_SB(1, 0), cB + kstep, voffB); PG8_STAGE(PG8_SA(1, 0), cA + kstep, voffA); PG8_STAGE(PG8_SB(1, 1), cB + hstep + kstep, voffB);
        PG8_WAIT_V(6); PG8_BAR;
    }
    for (;;) {
        const bool has_next = S.next(ui + 1, nxt);
        const char* nA = has_next ? (const char*)g.A + (size_t)nxt.pm * tstep : cA; const char* nB = has_next ? (const char*)g.Bt + (size_t)nxt.pn * tstep : cB;
        for (int t = 0; t < nt; t += 2) {
            const bool last = (t == nt - 2);
            const char* a1 = cA + (size_t)(t + 1) * kstep;
            const char* a2 = last ? nA : cA + (size_t)(t + 2) * kstep; const char* b2 = last ? nB : cB + (size_t)(t + 2) * kstep;
            const char* a3 = a2 + kstep; const char* b3 = b2 + kstep;
            if (last && has_next) S.a_ready(nxt);
            if constexpr (SP2) {
            PG8_LDB(B0, 0, 0); PG8_LDB(B1, 0, 1); PG8_SCHED; PG8_LDA(At, 0, 0); PG8_STAGE(PG8_SA(1, 1), a1 + hstep, voffA);
            PG8_WAIT_V(8); PG8_WAIT_L(0); PG8_BAR; PG8_MMA(0, 0, At, B0); PG8_MMA(0, 1, At, B1); PG8_BAR; PG8_SCHED;
            PG8_LDA(At, 0, 1); PG8_STAGE(PG8_SB(0, 0), b2, voffB); PG8_STAGE(PG8_SB(0, 1), b2 + hstep, voffB); PG8_STAGE(PG8_SA(0, 0), a2, voffA);
            PG8_WAIT_V(8); PG8_WAIT_L(0); PG8_BAR; PG8_MMA(1, 0, At, B0); PG8_MMA(1, 1, At, B1); PG8_BAR; PG8_SCHED;
            PG8_LDB(B0, 1, 0); PG8_LDB(B1, 1, 1); PG8_SCHED; PG8_LDA(At, 1, 0); PG8_STAGE(PG8_SA(0, 1), a2 + hstep, voffA);
            PG8_WAIT_V(8); PG8_WAIT_L(0); PG8_BAR; PG8_MMA(0, 0, At, B0); PG8_MMA(0, 1, At, B1); PG8_BAR; PG8_SCHED;
            PG8_LDA(At, 1, 1); PG8_STAGE(PG8_SB(1, 0), b3, voffB); PG8_STAGE(PG8_SB(1, 1), b3 + hstep, voffB); PG8_STAGE(PG8_SA(1, 0), a3, voffA);
            PG8_WAIT_V(8); PG8_WAIT_L(0); PG8_BAR; PG8_MMA(1, 0, At, B0); PG8_MMA(1, 1, At, B1); PG8_BAR; PG8_SCHED;
            } else {
            PG8_LDB(B0, 0, 0); PG8_SCHED; PG8_LDA(At, 0, 0); PG8_STAGE(PG8_SA(1, 1), a1 + hstep, voffA);
            PG8_WAIT_L(8); PG8_BAR; PG8_WAIT_L(0); PG8_MMA(0, 0, At, B0); PG8_BAR; PG8_SCHED;
            PG8_LDB(B1, 0, 1); PG8_STAGE(PG8_SB(0, 0), b2, voffB);
            PG8_BAR; PG8_WAIT_L(0); PG8_MMA(0, 1, At, B1); PG8_BAR;
            PG8_LDA(At, 0, 1); PG8_STAGE(PG8_SA(0, 0), a2, voffA);
            PG8_BAR; PG8_WAIT_L(0); PG8_MMA(1, 0, At, B0); PG8_BAR; PG8_SCHED;
            PG8_STAGE(PG8_SB(0, 1), b2 + hstep, voffB);
            PG8_WAIT_V(6); PG8_BAR; PG8_MMA(1, 1, At, B1); PG8_BAR;
            PG8_LDB(B0, 1, 0); PG8_SCHED; PG8_LDA(At, 1, 0); PG8_STAGE(PG8_SA(0, 1), a2 + hstep, voffA);
            PG8_WAIT_L(8); PG8_BAR; PG8_WAIT_L(0); PG8_MMA(0, 0, At, B0); PG8_BAR; PG8_SCHED;
            PG8_LDB(B1, 1, 1); PG8_STAGE(PG8_SB(1, 0), b3, voffB);
            PG8_BAR; PG8_WAIT_L(0); PG8_MMA(0, 1, At, B1); PG8_BAR;
            PG8_LDA(At, 1, 1); PG8_STAGE(PG8_SA(1, 0), a3, voffA);
            PG8_BAR; PG8_WAIT_L(0); PG8_MMA(1, 0, At, B0); PG8_BAR; PG8_SCHED;
            PG8_STAGE(PG8_SB(1, 1), b3 + hstep, voffB);
            PG8_WAIT_V(6); PG8_BAR; PG8_MMA(1, 1, At, B1); PG8_BAR;
            }
        }
        if constexpr (ALIGN_EPI) { if (wr == 0) PG8_BAR; }
        if constexpr (!Epi::AFTER_DRAIN) { E(acc, cur, wr, wc, fr, fq); S.done(cur); }
        if (!has_next) break;
#pragma unroll
        for (int a = 0; a < 2; ++a)
#pragma unroll
            for (int b = 0; b < 2; ++b)
#pragma unroll
                for (int m = 0; m < 4; ++m)
#pragma unroll
                    for (int n = 0; n < 2; ++n) acc[a][b][m][n] = (f32x4){0.f, 0.f, 0.f, 0.f};
        cur = nxt; cA = nA; cB = nB; ++ui;
        if constexpr (ALIGN_EPI) { if (wr == 1) PG8_BAR; }
    }
    PG8_WAIT_V(0);
    if constexpr (!ALIGN_EPI) { if (wr == 0) PG8_BAR; }
    PG8_BAR;
    if constexpr (Epi::AFTER_DRAIN) { E.fused(acc, cur, wr, wc, fr, fq, lds, wid, lane); S.done(cur); }
#undef PG8_SA
#undef PG8_SB
#undef PG8_STAGE
#undef PG8_LDA
#undef PG8_LDB
#undef PG8_MMA
#undef PG8_WAIT_V
#undef PG8_WAIT_L
#undef PG8_BAR
#undef PG8_SCHED
}
}

namespace mk {
using pg8::bf16_t; using pg8::bf16x8; using pg8::f32x4; using pg8::u32x4; using pg8::cvt_pk_bf16; using pg8::fsigmoid;
#define LAS __attribute__((address_space(3)))
typedef unsigned u32x2 __attribute__((ext_vector_type(2)));
typedef float f32x2 __attribute__((ext_vector_type(2)));
typedef short bf16x4 __attribute__((ext_vector_type(4)));
constexpr int NWAVES = 8, NT = 512;
constexpr int D = 1024, BATCH = 8, SEQ = 4096, M = BATCH * SEQ, DCONV = 512, CW = 31, DH = 512, NH = 4, HD = 128, DIN = 3072, NQ = 2048, NEXP = 16384;
constexpr int SEGS = 8, SEGLEN = SEQ / SEGS, NCH = SEGLEN / 64;
constexpr float EPS = 1e-6f;
constexpr size_t MiB = 1u << 20;
constexpr size_t WS_WIN = 2 * MiB, WS_WOUT = 8 * MiB, WS_WEFF = 10 * MiB, WS_HS = 14 * MiB, WS_HLD = 30 * MiB, WS_USC = 31 * MiB, WS_VSC = 31 * MiB + 65536, WS_SSQ = 48 * MiB, WS_U = 32 * MiB, WS_V = 64 * MiB, WS_XN = 96 * MiB,
                 WS_GLU = 160 * MiB, WS_HG = 192 * MiB, WS_Y = 320 * MiB, WS_EIDX = 416 * MiB, WS_GATE = 432 * MiB, WS_END = 448 * MiB;
constexpr int LDS_BYTES = 163840;
#ifndef PEER_V4_DEF
#define PEER_V4_DEF true
#endif
constexpr bool PEER_V4 = PEER_V4_DEF;
#ifndef U_NIBSWAP_DEF
#define U_NIBSWAP_DEF false
#endif
constexpr bool U_NIBSWAP = U_NIBSWAP_DEF;

#define LDS_WAIT() asm volatile("s_waitcnt lgkmcnt(0)" ::: "memory")
#define BLOCK_BAR() do { asm volatile("s_waitcnt lgkmcnt(0)" ::: "memory"); __builtin_amdgcn_s_barrier(); asm volatile("" ::: "memory"); } while (0)
__device__ __forceinline__ float wave_sum(float v) {
#pragma unroll
    for (int o = 1; o < 64; o <<= 1) v += __shfl_xor(v, o);
    return v;
}
__device__ __forceinline__ float wave_sum_dpp(float v) {
    v += __builtin_bit_cast(float, __builtin_amdgcn_update_dpp(0, __builtin_bit_cast(int, v), 0x111, 0xf, 0xf, false));
    v += __builtin_bit_cast(float, __builtin_amdgcn_update_dpp(0, __builtin_bit_cast(int, v), 0x112, 0xf, 0xf, false));
    v += __builtin_bit_cast(float, __builtin_amdgcn_update_dpp(0, __builtin_bit_cast(int, v), 0x114, 0xf, 0xf, false));
    v += __builtin_bit_cast(float, __builtin_amdgcn_update_dpp(0, __builtin_bit_cast(int, v), 0x118, 0xf, 0xf, false));
    v += __builtin_bit_cast(float, __builtin_amdgcn_update_dpp(0, __builtin_bit_cast(int, v), 0x142, 0xa, 0xf, false));
    v += __builtin_bit_cast(float, __builtin_amdgcn_update_dpp(0, __builtin_bit_cast(int, v), 0x143, 0xc, 0xf, false));
    return __builtin_bit_cast(float, __builtin_amdgcn_readlane(__builtin_bit_cast(int, v), 63));
}
__device__ __forceinline__ float wave_max_dpp(float v) {
    v = fmaxf(v, __builtin_bit_cast(float, __builtin_amdgcn_update_dpp(0, __builtin_bit_cast(int, v), 0x111, 0xf, 0xf, false)));
    v = fmaxf(v, __builtin_bit_cast(float, __builtin_amdgcn_update_dpp(0, __builtin_bit_cast(int, v), 0x112, 0xf, 0xf, false)));
    v = fmaxf(v, __builtin_bit_cast(float, __builtin_amdgcn_update_dpp(0, __builtin_bit_cast(int, v), 0x114, 0xf, 0xf, false)));
    v = fmaxf(v, __builtin_bit_cast(float, __builtin_amdgcn_update_dpp(0, __builtin_bit_cast(int, v), 0x118, 0xf, 0xf, false)));
    v = fmaxf(v, __builtin_bit_cast(float, __builtin_amdgcn_update_dpp(0, __builtin_bit_cast(int, v), 0x142, 0xa, 0xf, false)));
    v = fmaxf(v, __builtin_bit_cast(float, __builtin_amdgcn_update_dpp(0, __builtin_bit_cast(int, v), 0x143, 0xc, 0xf, false)));
    return __builtin_bit_cast(float, __builtin_amdgcn_readlane(__builtin_bit_cast(int, v), 63));
}
__device__ __forceinline__ float bf_lo(unsigned u) { return __builtin_bit_cast(float, u << 16); }
__device__ __forceinline__ float bf_hi(unsigned u) { return __builtin_bit_cast(float, u & 0xffff0000u); }
__device__ __forceinline__ float bf1(bf16_t u) { return __builtin_bit_cast(float, (unsigned)u << 16); }
__device__ __forceinline__ float fsilu(float x) { return x * fsigmoid(x); }

struct Args { const float* in[16]; float* out; unsigned char* ws; int ph_lo, ph_hi; };

__device__ __forceinline__ void p0_transpose_item(const float* __restrict__ W, int K, int N, bf16_t* __restrict__ WT, int out_row0, const float* __restrict__ gk, LAS float* scr, int k0, int n0, int lane) {
#pragma unroll 8
    for (int i = 0; i < 32; ++i) { const int kk = 2 * i + (lane >> 5); const float s = gk ? gk[k0 + kk] : 1.f; scr[kk * 33 + (lane & 31)] = W[(size_t)(k0 + kk) * N + n0 + (lane & 31)] * s; }
    LDS_WAIT();
    const int c = lane & 7;
#pragma unroll
    for (int j = 0; j < 4; ++j) { const int n = (lane >> 3) + 8 * j; const LAS float* s = scr + (8 * c) * 33 + n;
        u32x4 o; o.x = cvt_pk_bf16(s[0 * 33], s[1 * 33]); o.y = cvt_pk_bf16(s[2 * 33], s[3 * 33]); o.z = cvt_pk_bf16(s[4 * 33], s[5 * 33]); o.w = cvt_pk_bf16(s[6 * 33], s[7 * 33]);
        *(u32x4*)(WT + (size_t)(out_row0 + n) * K + k0 + 8 * c) = o; }
    LDS_WAIT();
}
__device__ __forceinline__ void row_to_bf16(const float* __restrict__ src, bf16_t* __restrict__ dst, const float* __restrict__ gv, bool norm, int lane) {
    const f32x4* xr = (const f32x4*)src + lane;
    f32x4 v[4]; float s = 0.f;
#pragma unroll
    for (int j = 0; j < 4; ++j) { v[j] = xr[64 * j]; s += (v[j].x * v[j].x + v[j].y * v[j].y) + (v[j].z * v[j].z + v[j].w * v[j].w); }
    float r = 1.f;
    if (norm) r = rsqrtf(wave_sum(s) * (1.f / D) + EPS);
    u32x2* o8 = (u32x2*)dst + lane;
#pragma unroll
    for (int j = 0; j < 4; ++j) {
        f32x4 t = v[j] * r;
        if (gv) t = t * ((const f32x4*)gv)[lane + 64 * j];
        u32x2 w; w.x = cvt_pk_bf16(t.x, t.y); w.y = cvt_pk_bf16(t.z, t.w); o8[64 * j] = w;
    }
}
__device__ __forceinline__ void row_to_fp8(const float* __restrict__ src, unsigned char* __restrict__ dst, const float* __restrict__ gv, float sc, int lane) {
    const f32x4* xr = (const f32x4*)src + lane;
    unsigned* o4 = (unsigned*)dst + lane;
#pragma unroll
    for (int j = 0; j < 4; ++j) {
        f32x4 t = xr[64 * j] * sc;
        if (gv) t = t * ((const f32x4*)gv)[lane + 64 * j];
        int w = __builtin_amdgcn_cvt_pk_fp8_f32(t.x, t.y, 0, false); w = __builtin_amdgcn_cvt_pk_fp8_f32(t.z, t.w, w, true);
        o4[64 * j] = (unsigned)w;
    }
}
template <int MODE>
__device__ __forceinline__ void rows_convert(const float* __restrict__ src, unsigned char* __restrict__ dst, const float* __restrict__ gv, float sc, int nrows, int gw, int NGW, int lane) {
    if (nrows % (4 * NGW) != 0) {
        for (int r = gw; r < nrows; r += NGW) { if (MODE == 0) row_to_bf16(src + (size_t)r * D, (bf16_t*)dst + (size_t)r * D, nullptr, true, lane); else row_to_fp8(src + (size_t)r * D, dst + (size_t)r * D, MODE == 1 ? gv : nullptr, sc, lane); }
        return;
    }
    f32x4 gq[4];
    if (MODE == 1) {
#pragma unroll
        for (int j = 0; j < 4; ++j) gq[j] = ((const f32x4*)gv)[lane + 64 * j] * sc;
    }
    for (int r = gw; r < nrows; r += 4 * NGW) {
        f32x4 v[4][4];
#pragma unroll
        for (int k = 0; k < 4; ++k)
#pragma unroll
            for (int j = 0; j < 4; ++j) v[k][j] = ((const f32x4*)(src + (size_t)(r + k * NGW) * D))[lane + 64 * j];
#pragma unroll
        for (int k = 0; k < 4; ++k) {
            if (MODE == 0) {
                float s = 0.f;
#pragma unroll
                for (int j = 0; j < 4; ++j) s += (v[k][j].x * v[k][j].x + v[k][j].y * v[k][j].y) + (v[k][j].z * v[k][j].z + v[k][j].w * v[k][j].w);
                const float rr = rsqrtf(wave_sum(s) * (1.f / D) + EPS);
                u32x2* o8 = (u32x2*)((bf16_t*)dst + (size_t)(r + k * NGW) * D) + lane;
#pragma unroll
                for (int j = 0; j < 4; ++j) { const f32x4 t = v[k][j] * rr; u32x2 w; w.x = cvt_pk_bf16(t.x, t.y); w.y = cvt_pk_bf16(t.z, t.w); o8[64 * j] = w; }
            } else {
                unsigned* o4 = (unsigned*)(dst + (size_t)(r + k * NGW) * D) + lane;
#pragma unroll
                for (int j = 0; j < 4; ++j) { const f32x4 t = (MODE == 1) ? v[k][j] * gq[j] : v[k][j] * sc;
                    int w = __builtin_amdgcn_cvt_pk_fp8_f32(t.x, t.y, 0, false); w = __builtin_amdgcn_cvt_pk_fp8_f32(t.z, t.w, w, true); o4[64 * j] = (unsigned)w; }
            }
        }
    }
}
template <bool FP4, bool NATURAL = false, bool NIBSWAP = false>
__device__ __forceinline__ void rows_quant(const float* __restrict__ src, unsigned char* __restrict__ dst, float* __restrict__ scales, const float* __restrict__ gv, int nrows, int gw, int NGW, int lane) {
    f32x4 gq[4];
#pragma unroll
    for (int j = 0; j < 4; ++j) gq[j] = gv ? ((const f32x4*)gv)[NATURAL ? 4 * lane + j : lane + 64 * j] : (f32x4){1.f, 1.f, 1.f, 1.f};
    for (int r0 = gw; r0 < nrows; r0 += 4 * NGW) {
        f32x4 v[4][4];
#pragma unroll
        for (int k = 0; k < 4; ++k) { const int r = (r0 + k * NGW < nrows) ? r0 + k * NGW : r0;
#pragma unroll
            for (int j = 0; j < 4; ++j) v[k][j] = ((const f32x4*)(src + (size_t)r * D))[NATURAL ? 4 * lane + j : lane + 64 * j] * gq[j]; }
#pragma unroll
        for (int k = 0; k < 4; ++k) {
            const int r = r0 + k * NGW; if (r >= nrows) break;
            float am = 0.f;
#pragma unroll
            for (int j = 0; j < 4; ++j) am = fmaxf(am, fmaxf(fmaxf(fabsf(v[k][j].x), fabsf(v[k][j].y)), fmaxf(fabsf(v[k][j].z), fabsf(v[k][j].w))));
            am = wave_max_dpp(am);
            const float fmx = FP4 ? 6.f : 240.f;
            const float sc = am > 0.f ? am * (1.f / fmx) : 1.f, inv = am > 0.f ? fmx / am : 1.f;
            if (lane == 0) scales[r] = sc;
            if constexpr (FP4) {
                unsigned w0 = 0u, w1 = 0u;
                { const f32x4 t0 = v[k][0] * inv, t1 = v[k][1] * inv, t2 = v[k][2] * inv, t3 = v[k][3] * inv;
#define Q4(wd, a_, b_, sel) wd = NIBSWAP ? __builtin_amdgcn_cvt_scalef32_pk_fp4_f32(wd, b_, a_, 1.0f, sel) : __builtin_amdgcn_cvt_scalef32_pk_fp4_f32(wd, a_, b_, 1.0f, sel)
                  Q4(w0, t0.x, t0.y, 0); Q4(w0, t0.z, t0.w, 1); Q4(w0, t1.x, t1.y, 2); Q4(w0, t1.z, t1.w, 3);
                  Q4(w1, t2.x, t2.y, 0); Q4(w1, t2.z, t2.w, 1); Q4(w1, t3.x, t3.y, 2); Q4(w1, t3.z, t3.w, 3);
#undef Q4
                }
                ((u32x2*)(dst + (size_t)r * 512))[NATURAL ? lane : 2 * (lane & 31) + (lane >> 5)] = (u32x2){w0, w1};
            } else {
                u32x4 w;
#pragma unroll
                for (int j = 0; j < 4; ++j) { const f32x4 t = v[k][j] * inv; int q = __builtin_amdgcn_cvt_pk_fp8_f32(t.x, t.y, 0, false); q = __builtin_amdgcn_cvt_pk_fp8_f32(t.z, t.w, q, true); w[j] = (unsigned)q; }
                ((u32x4*)(dst + (size_t)r * 1024))[lane] = w;
            }
        }
    }
}
__device__ __forceinline__ void weff_unit(LAS unsigned char* lds, const float* __restrict__ wq, const float* __restrict__ sk, const float* __restrict__ g2, bf16_t* __restrict__ WE, int unit, int tid) {
    LAS float* SK = (LAS float*)lds;
    LAS float* WQ = (LAS float*)(lds + 128 * 129 * 4);
    const int hp = unit >> 5, d0 = (unit & 31) * 32;
#pragma unroll 4
    for (int i = 0; i < 32; ++i) { const int idx = tid + i * NT; SK[(idx >> 7) * 129 + (idx & 127)] = sk[(size_t)hp * 16384 + idx]; }
#pragma unroll
    for (int i = 0; i < 8; ++i) { const int idx = tid + i * NT; WQ[idx] = wq[(size_t)(d0 + (idx >> 7)) * NQ + hp * 128 + (idx & 127)]; }
    __syncthreads();
    const int n = tid & 127, dq = tid >> 7;
    float acc[8];
#pragma unroll
    for (int e = 0; e < 8; ++e) acc[e] = 0.f;
    for (int j4 = 0; j4 < 32; ++j4) {
        float s[4];
#pragma unroll
        for (int q = 0; q < 4; ++q) s[q] = SK[n * 129 + 4 * j4 + q];
#pragma unroll
        for (int e = 0; e < 8; ++e) { const f32x4 w = *(const LAS f32x4*)(WQ + (dq * 8 + e) * 128 + 4 * j4); acc[e] = fmaf(s[0], w.x, acc[e]); acc[e] = fmaf(s[1], w.y, acc[e]); acc[e] = fmaf(s[2], w.z, acc[e]); acc[e] = fmaf(s[3], w.w, acc[e]); }
    }
    const float* gp = g2 + d0 + dq * 8;
    u32x4 o; o.x = cvt_pk_bf16(acc[0] * gp[0], acc[1] * gp[1]); o.y = cvt_pk_bf16(acc[2] * gp[2], acc[3] * gp[3]); o.z = cvt_pk_bf16(acc[4] * gp[4], acc[5] * gp[5]); o.w = cvt_pk_bf16(acc[6] * gp[6], acc[7] * gp[7]);
    *(u32x4*)(WE + (size_t)(hp * 128 + n) * D + d0 + dq * 8) = o;
    __syncthreads();
}
__device__ __forceinline__ void p0_prologue(const Args& a, LAS unsigned char* lds, int tid, int lane, int wave, int G) {
    unsigned char* ws = a.ws;
    for (int u = blockIdx.x; u < 512; u += G) weff_unit(lds, a.in[11], a.in[12], a.in[10], (bf16_t*)(ws + WS_WEFF), u, tid);
    LAS float* scr = (LAS float*)(lds + wave * 16384);
    const int gw = blockIdx.x * NWAVES + wave, NGW = G * NWAVES;
    constexpr int I_IN = (D / 64) * (DIN / 32), I_OUT = (D / 64) * (D / 32);
    for (int it = gw; it < I_IN + I_OUT; it += NGW) {
        if (it < I_IN) {
            const int kb = it / (DIN / 32), nb = it % (DIN / 32), n0 = nb * 32;
            int r0;
            if (n0 < 512) r0 = 256 * (n0 >> 7) + (n0 & 127); else if (n0 < 1024) r0 = 256 * ((n0 - 512) >> 7) + 128 + ((n0 - 512) & 127); else r0 = n0;
            p0_transpose_item(a.in[2], D, DIN, (bf16_t*)(ws + WS_WIN), r0, a.in[1], scr, kb * 64, n0, lane);
        } else {
            const int r = it - I_IN, kb = r / (D / 32), nb = r % (D / 32);
            p0_transpose_item(a.in[9], D, D, (bf16_t*)(ws + WS_WOUT), nb * 32, nullptr, scr, kb * 64, nb * 32, lane);
        }
    }
    rows_quant<true, true, U_NIBSWAP>(a.in[13], ws + WS_U, (float*)(ws + WS_USC), a.in[10], NEXP, gw, NGW, lane);
    rows_quant<PEER_V4>(a.in[14], ws + WS_V, (float*)(ws + WS_VSC), nullptr, NEXP, gw, NGW, lane);
    rows_convert<0>(a.in[0], ws + WS_XN, nullptr, 1.f, M, gw, NGW, lane);
}

__device__ __forceinline__ void conv_wave_unit(const bf16_t* __restrict__ GLU, const float* __restrict__ cw, const float* __restrict__ cb, const float* __restrict__ ng, const float* __restrict__ nb,
                                               bf16_t* __restrict__ Y, int wu, int lane) {
    const int grp = wu & 7, tb = wu >> 3, b = tb >> 5, s0 = (tb & 31) * 128, c = grp * 64 + lane;
    float w[CW];
#pragma unroll
    for (int j = 0; j < CW; ++j) w[j] = cw[j * DCONV + c];
    const float bias = cb[c], gam = ng[c], bet = nb[c];
    const size_t rowb = (size_t)b * SEQ;
    const bf16_t* GLUp = GLU + (size_t)grp * M * 64 + lane;
    float win[38];
#pragma unroll
    for (int i = 0; i < 30; ++i) { const int s = s0 - 30 + i; win[i] = (s >= 0) ? bf1(GLUp[(rowb + s) * 64]) : 0.f; }
    bf16_t nx[8];
#pragma unroll
    for (int i = 0; i < 8; ++i) nx[i] = GLUp[(rowb + s0 + i) * 64];
#pragma unroll 1
    for (int it = 0; it < 16; ++it) {
        const int s = s0 + it * 8;
#pragma unroll
        for (int i = 0; i < 8; ++i) win[30 + i] = bf1(nx[i]);
        const int sn = (it < 15) ? s + 8 : s;
#pragma unroll
        for (int i = 0; i < 8; ++i) nx[i] = GLUp[(rowb + sn + i) * 64];
        float acc[8];
#pragma unroll
        for (int i = 0; i < 8; ++i) {
            float t = bias;
#pragma unroll
            for (int j = 0; j < CW; ++j) t = fmaf(w[j], win[i + j], t);
            acc[i] = t;
        }
#pragma unroll
        for (int i = 0; i < 8; ++i) {
            const float mu = wave_sum_dpp(acc[i]) * (1.f / 64.f), m2 = wave_sum_dpp(acc[i] * acc[i]) * (1.f / 64.f);
            const float var = fmaxf(m2 - mu * mu, 0.f);
            const float hn = (acc[i] - mu) * rsqrtf(var + EPS) * gam + bet;
            Y[(rowb + s + i) * D + c] = (bf16_t)(cvt_pk_bf16(fsilu(hn), 0.f) & 0xffffu);
        }
#pragma unroll
        for (int i = 0; i < 30; ++i) win[i] = win[i + 8];
    }
}

constexpr int HQ_OFF = 0, HK_OFF = 17408, HKH_OFF = 34816, HV_OFF = 53248, HP_OFF = 71680, HDC_OFF = 80896, HTOT_OFF = 81408, HO_OFF = 85504;
template <bool P3, int DG = 0>
__device__ __forceinline__ void hgrn_unit(LAS unsigned char* lds, int unit, const bf16_t* __restrict__ HG, const float* __restrict__ lbl, const float* __restrict__ hng, float* __restrict__ HS, float* __restrict__ HLD,
                                          bf16_t* __restrict__ Y, int tid, int lane, int w) {
    const int seg = unit & (SEGS - 1), bh = unit >> 3, h = bh & 3, b = bh >> 2;
    const int g = lane >> 4, fr = lane & 15, kp = lane;
    const int c0 = h * HD + 2 * kp;
    const float lb0 = __builtin_amdgcn_rcpf(1.f + __expf(lbl[DH + c0] - lbl[c0])), lb1 = __builtin_amdgcn_rcpf(1.f + __expf(lbl[DH + c0 + 1] - lbl[c0 + 1]));
    f32x4 S[8];
#pragma unroll
    for (int i = 0; i < 8; ++i) S[i] = (f32x4){0.f, 0.f, 0.f, 0.f};
    if (P3 && !(DG & 1)) {
        for (int i = 0; i < seg; ++i) {
            const float* sp = HS + (size_t)(bh * SEGS + i) * 16384 + w * 2048 + lane;
            const float* ld = HLD + (size_t)(bh * SEGS + i) * 128 + 4 * g;
#pragma unroll
            for (int t = 0; t < 8; ++t) { const f32x4 dd = *(const f32x4*)(ld + 16 * t);
#pragma unroll
                for (int r = 0; r < 4; ++r) S[t][r] = fmaf(__expf(dd[r]), S[t][r], sp[(t * 4 + r) * 64]); }
        }
    }
    float ldsum0 = 0.f, ldsum1 = 0.f;
    const size_t row_base = (size_t)b * SEQ + (size_t)seg * SEGLEN;
    const unsigned* HGw = (const unsigned*)HG;
    constexpr size_t PLANE_DW = (size_t)M * 64;
    unsigned zq[8], qq[8], vq[8];
#define HG_LOAD(c) do { if (DG & 2) { _Pragma("unroll") for (int i = 0; i < 8; ++i) { zq[i] = 0x3c003c00u + (unsigned)((c) + i + w); vq[i] = 0x3e003d00u + (unsigned)i; qq[i] = 0x3d003e00u + (unsigned)(c); } break; } _Pragma("unroll") for (int i = 0; i < 8; ++i) { const size_t ro = (row_base + (c) * 64 + 8 * w + i) * 64 + kp; \
        zq[i] = HGw[(size_t)(4 + h) * PLANE_DW + ro]; vq[i] = HGw[(size_t)(8 + h) * PLANE_DW + ro]; if (P3) qq[i] = HGw[(size_t)h * PLANE_DW + ro]; } } while (0)
    HG_LOAD(0);
    float gn[16];
    const int nt_t = tid >> 3, nt_v = (tid & 7) * 16;
    if (P3) {
#pragma unroll
        for (int e = 0; e < 16; ++e) gn[e] = hng[h * HD + nt_v + e];
    }
#pragma unroll 1
    for (int c = 0; c < NCH; ++c) {
        float cs0[8], cs1[8], kk0[8], kk1[8];
        float cum0 = 0.f, cum1 = 0.f;
        if (DG & 16) {
#pragma unroll
            for (int i = 0; i < 8; ++i) { cs0[i] = cs1[i] = -0.1f * i; kk0[i] = kk1[i] = 0.5f; }
        } else
#pragma unroll
        for (int i = 0; i < 8; ++i) {
            const float sg0 = fsigmoid(bf_lo(zq[i])), sg1 = fsigmoid(bf_hi(zq[i]));
            cum0 += __logf(lb0 + (1.f - lb0) * sg0); cum1 += __logf(lb1 + (1.f - lb1) * sg1);
            cs0[i] = cum0; cs1[i] = cum1; kk0[i] = (1.f - lb0) * (1.f - sg0); kk1[i] = (1.f - lb1) * (1.f - sg1);
        }
        LAS float* tot = (LAS float*)(lds + HTOT_OFF);
        *(LAS f32x2*)(tot + w * 128 + 2 * kp) = (f32x2){cum0, cum1};
        BLOCK_BAR();
        float off0 = 0.f, off1 = 0.f, all0 = 0.f, all1 = 0.f;
#pragma unroll
        for (int ww = 0; ww < 8; ++ww) { const f32x2 tt = *(const LAS f32x2*)(tot + ww * 128 + 2 * kp); if (ww < w) { off0 += tt.x; off1 += tt.y; } all0 += tt.x; all1 += tt.y; }
        ldsum0 += all0; ldsum1 += all1;
        unsigned kh0[4], kh1[4], vt0[4], vt1[4];
        if (DG & 16) {
#pragma unroll
            for (int i = 0; i < 4; ++i) { kh0[i] = kh1[i] = 0x3c003c00u; vt0[i] = vq[2 * i]; vt1[i] = vq[2 * i + 1]; }
        } else
#pragma unroll
        for (int i = 0; i < 8; i += 2) {
            float a0[2], a1[2];
#pragma unroll
            for (int e = 0; e < 2; ++e) {
                const float B0 = off0 + cs0[i + e], B1 = off1 + cs1[i + e];
                if (P3) {
                    const float q0 = bf_lo(qq[i + e]) * __expf(B0), q1 = bf_hi(qq[i + e]) * __expf(B1);
                    const float k0 = kk0[i + e] * __expf(-B0), k1 = kk1[i + e] * __expf(-B1);
                    *(LAS unsigned*)(lds + HQ_OFF + (8 * w + i + e) * 272 + 4 * kp) = cvt_pk_bf16(q0, q1);
                    *(LAS unsigned*)(lds + HK_OFF + (8 * w + i + e) * 272 + 4 * kp) = cvt_pk_bf16(k0, k1);
                }
                a0[e] = kk0[i + e] * __expf(all0 - B0); a1[e] = kk1[i + e] * __expf(all1 - B1);
            }
            kh0[i >> 1] = cvt_pk_bf16(a0[0], a0[1]); kh1[i >> 1] = cvt_pk_bf16(a1[0], a1[1]);
            vt0[i >> 1] = (vq[i] & 0xffffu) | (vq[i + 1] << 16); vt1[i >> 1] = (vq[i] >> 16) | (vq[i + 1] & 0xffff0000u);
        }
        *(LAS u32x4*)(lds + HKH_OFF + (2 * kp) * 144 + 16 * w) = (u32x4){kh0[0], kh0[1], kh0[2], kh0[3]};
        *(LAS u32x4*)(lds + HKH_OFF + (2 * kp + 1) * 144 + 16 * w) = (u32x4){kh1[0], kh1[1], kh1[2], kh1[3]};
        *(LAS u32x4*)(lds + HV_OFF + (2 * kp) * 144 + 16 * w) = (u32x4){vt0[0], vt0[1], vt0[2], vt0[3]};
        *(LAS u32x4*)(lds + HV_OFF + (2 * kp + 1) * 144 + 16 * w) = (u32x4){vt1[0], vt1[1], vt1[2], vt1[3]};
        if (w == 0) *(LAS f32x2*)(lds + HDC_OFF + 8 * kp) = (f32x2){__expf(all0), __expf(all1)};
        BLOCK_BAR();
        if (c + 1 < NCH) HG_LOAD(c + 1);
        bf16x8 vfrag[2];
#pragma unroll
        for (int ks = 0; ks < 2; ++ks) vfrag[ks] = *(const LAS bf16x8*)(lds + HV_OFF + (16 * w + fr) * 144 + 64 * ks + 16 * g);
        if (P3) {
            u32x4 gq[2];
            if (DG & 2) { gq[0] = (u32x4){0x3c003c00u, 0x3c003c00u, 0x3c003c00u, 0x3c003c00u}; gq[1] = gq[0]; } else
            { const u32x4* gp = (const u32x4*)(HG + (size_t)(12 + h) * M * 128 + (row_base + c * 64 + nt_t) * 128 + nt_v); gq[0] = gp[0]; gq[1] = gp[1]; }
            {
                const int mt = w >> 1;
#pragma unroll
                for (int nti = 0; nti < 2; ++nti) {
                    const int nt = 2 * (w & 1) + nti;
                    f32x4 p = (f32x4){0.f, 0.f, 0.f, 0.f};
                    if (nt <= mt && !(DG & 4)) {
#pragma unroll
                        for (int ks = 0; ks < 4; ++ks) {
                            const bf16x8 af = *(const LAS bf16x8*)(lds + HQ_OFF + (16 * mt + fr) * 272 + 64 * ks + 16 * g);
                            const bf16x8 bf = *(const LAS bf16x8*)(lds + HK_OFF + (16 * nt + fr) * 272 + 64 * ks + 16 * g);
                            p = __builtin_amdgcn_mfma_f32_16x16x32_bf16(af, bf, p, 0, 0, 0);
                        }
                    }
#pragma unroll
                    for (int r = 0; r < 4; ++r) {
                        const int t = 16 * mt + 4 * g + r, s = 16 * nt + fr;
                        const float pv = (s <= t) ? p[r] : 0.f;
                        *(LAS bf16_t*)(lds + HP_OFF + t * 144 + 2 * s) = (bf16_t)(cvt_pk_bf16(pv, 0.f) & 0xffffu);
                    }
                }
            }
            BLOCK_BAR();
            f32x4 o[4];
#pragma unroll
            for (int mt = 0; mt < 4; ++mt) o[mt] = (f32x4){0.f, 0.f, 0.f, 0.f};
            if (!(DG & 4))
#pragma unroll
            for (int ks = 0; ks < 4; ++ks) {
                u32x4 sb; sb.x = cvt_pk_bf16(S[2 * ks][0], S[2 * ks][1]); sb.y = cvt_pk_bf16(S[2 * ks][2], S[2 * ks][3]); sb.z = cvt_pk_bf16(S[2 * ks + 1][0], S[2 * ks + 1][1]); sb.w = cvt_pk_bf16(S[2 * ks + 1][2], S[2 * ks + 1][3]);
                const bf16x8 bfrag = __builtin_bit_cast(bf16x8, sb);
#pragma unroll
                for (int mt = 0; mt < 4; ++mt) {
                    const u32x2 alo = *(const LAS u32x2*)(lds + HQ_OFF + (16 * mt + fr) * 272 + 64 * ks + 8 * g);
                    const u32x2 ahi = *(const LAS u32x2*)(lds + HQ_OFF + (16 * mt + fr) * 272 + 64 * ks + 32 + 8 * g);
                    const bf16x8 af = __builtin_bit_cast(bf16x8, (u32x4){alo.x, alo.y, ahi.x, ahi.y});
                    o[mt] = __builtin_amdgcn_mfma_f32_16x16x32_bf16(af, bfrag, o[mt], 0, 0, 0);
                }
            }
            if (!(DG & 4))
#pragma unroll
            for (int ks = 0; ks < 2; ++ks)
#pragma unroll
                for (int mt = 0; mt < 4; ++mt) {
                    const bf16x8 af = *(const LAS bf16x8*)(lds + HP_OFF + (16 * mt + fr) * 144 + 64 * ks + 16 * g);
                    o[mt] = __builtin_amdgcn_mfma_f32_16x16x32_bf16(af, vfrag[ks], o[mt], 0, 0, 0);
                }
#pragma unroll
            for (int mt = 0; mt < 4; ++mt)
#pragma unroll
                for (int r = 0; r < 4; ++r) *(LAS float*)(lds + HO_OFF + ((16 * mt + 4 * g + r) * 132 + 16 * w + fr) * 4) = o[mt][r];
            if (!(DG & 4))
#pragma unroll
            for (int i = 0; i < 8; ++i) {
                const f32x4 dd = *(const LAS f32x4*)(lds + HDC_OFF + (16 * i + 4 * g) * 4);
                S[i] = S[i] * dd;
#pragma unroll
                for (int ks = 0; ks < 2; ++ks) { const bf16x8 af = *(const LAS bf16x8*)(lds + HKH_OFF + (16 * i + fr) * 144 + 64 * ks + 16 * g); S[i] = __builtin_amdgcn_mfma_f32_16x16x32_bf16(af, vfrag[ks], S[i], 0, 0, 0); }
            }
            BLOCK_BAR();
            if (!(DG & 8)) {
                f32x4 ov[4]; float ss = 0.f;
#pragma unroll
                for (int q = 0; q < 4; ++q) { ov[q] = *(const LAS f32x4*)(lds + HO_OFF + (nt_t * 132 + nt_v + 4 * q) * 4); ss += (ov[q].x * ov[q].x + ov[q].y * ov[q].y) + (ov[q].z * ov[q].z + ov[q].w * ov[q].w); }
                ss += __shfl_xor(ss, 1); ss += __shfl_xor(ss, 2); ss += __shfl_xor(ss, 4);
                const float rs = rsqrtf(ss * (1.f / HD) + EPS);
                u32x4 ow[2];
#pragma unroll
                for (int q = 0; q < 4; ++q) {
                    const unsigned g01 = (q & 1) ? gq[q >> 1].z : gq[q >> 1].x, g23 = (q & 1) ? gq[q >> 1].w : gq[q >> 1].y;
                    const float y0 = ov[q].x * rs * gn[4 * q] * bf_lo(g01), y1 = ov[q].y * rs * gn[4 * q + 1] * bf_hi(g01), y2 = ov[q].z * rs * gn[4 * q + 2] * bf_lo(g23), y3 = ov[q].w * rs * gn[4 * q + 3] * bf_hi(g23);
                    if (q & 1) { ow[q >> 1].z = cvt_pk_bf16(y0, y1); ow[q >> 1].w = cvt_pk_bf16(y2, y3); } else { ow[q >> 1].x = cvt_pk_bf16(y0, y1); ow[q >> 1].y = cvt_pk_bf16(y2, y3); }
                }
                u32x4* yp = (u32x4*)(Y + (row_base + c * 64 + nt_t) * D + DCONV + h * HD + nt_v); yp[0] = ow[0]; yp[1] = ow[1];
            }
        } else {
            if (!(DG & 4))
#pragma unroll
            for (int i = 0; i < 8; ++i) {
                const f32x4 dd = *(const LAS f32x4*)(lds + HDC_OFF + (16 * i + 4 * g) * 4);
                S[i] = S[i] * dd;
#pragma unroll
                for (int ks = 0; ks < 2; ++ks) { const bf16x8 af = *(const LAS bf16x8*)(lds + HKH_OFF + (16 * i + fr) * 144 + 64 * ks + 16 * g); S[i] = __builtin_amdgcn_mfma_f32_16x16x32_bf16(af, vfrag[ks], S[i], 0, 0, 0); }
            }
        }
    }
#undef HG_LOAD
    if (!P3 && !(DG & 8)) {
        float* sp = HS + (size_t)unit * 16384 + w * 2048 + lane;
#pragma unroll
        for (int t = 0; t < 8; ++t)
#pragma unroll
            for (int r = 0; r < 4; ++r) sp[(t * 4 + r) * 64] = S[t][r];
        if (w == 0) *(f32x2*)(HLD + (size_t)unit * 128 + 2 * kp) = (f32x2){ldsum0, ldsum1};
    }
    BLOCK_BAR();
}

__device__ __forceinline__ float gelu_as(float v) {
    const float av = fabsf(v), t = __builtin_amdgcn_rcpf(fmaf(av, 0.2316418882f, 1.0f));
    float q = fmaf(t, 0.5307027145f, -0.7265760135f); q = fmaf(q, t, 0.7107068705f); q = fmaf(q, t, -0.142248368f); q = fmaf(q, t, 0.127414796f); q = q * t;
    const float e = __builtin_amdgcn_exp2f(v * v * -0.72134752044f), m = v * (q * e);
    return v < 0.f ? m : v - m;
}
__device__ __forceinline__ float dot16_fp4(const unsigned w0, const unsigned w1, const f32x2 (&x2)[8]) {
    f32x2 acc = __builtin_amdgcn_cvt_scalef32_pk_f32_fp4(w0, 1.0f, 0) * x2[0];
    acc = __builtin_elementwise_fma(__builtin_amdgcn_cvt_scalef32_pk_f32_fp4(w0, 1.0f, 1), x2[1], acc);
    acc = __builtin_elementwise_fma(__builtin_amdgcn_cvt_scalef32_pk_f32_fp4(w0, 1.0f, 2), x2[2], acc);
    acc = __builtin_elementwise_fma(__builtin_amdgcn_cvt_scalef32_pk_f32_fp4(w0, 1.0f, 3), x2[3], acc);
    acc = __builtin_elementwise_fma(__builtin_amdgcn_cvt_scalef32_pk_f32_fp4(w1, 1.0f, 0), x2[4], acc);
    acc = __builtin_elementwise_fma(__builtin_amdgcn_cvt_scalef32_pk_f32_fp4(w1, 1.0f, 1), x2[5], acc);
    acc = __builtin_elementwise_fma(__builtin_amdgcn_cvt_scalef32_pk_f32_fp4(w1, 1.0f, 2), x2[6], acc);
    acc = __builtin_elementwise_fma(__builtin_amdgcn_cvt_scalef32_pk_f32_fp4(w1, 1.0f, 3), x2[7], acc);
    return acc.x + acc.y;
}
__device__ __forceinline__ void axpy16_fp4(const unsigned w0, const unsigned w1, const float s, f32x2 (&y2)[8]) {
    const f32x2 s2 = (f32x2){s, s};
    y2[0] = __builtin_elementwise_fma(__builtin_amdgcn_cvt_scalef32_pk_f32_fp4(w0, 1.0f, 0), s2, y2[0]);
    y2[1] = __builtin_elementwise_fma(__builtin_amdgcn_cvt_scalef32_pk_f32_fp4(w0, 1.0f, 1), s2, y2[1]);
    y2[2] = __builtin_elementwise_fma(__builtin_amdgcn_cvt_scalef32_pk_f32_fp4(w0, 1.0f, 2), s2, y2[2]);
    y2[3] = __builtin_elementwise_fma(__builtin_amdgcn_cvt_scalef32_pk_f32_fp4(w0, 1.0f, 3), s2, y2[3]);
    y2[4] = __builtin_elementwise_fma(__builtin_amdgcn_cvt_scalef32_pk_f32_fp4(w1, 1.0f, 0), s2, y2[4]);
    y2[5] = __builtin_elementwise_fma(__builtin_amdgcn_cvt_scalef32_pk_f32_fp4(w1, 1.0f, 1), s2, y2[5]);
    y2[6] = __builtin_elementwise_fma(__builtin_amdgcn_cvt_scalef32_pk_f32_fp4(w1, 1.0f, 2), s2, y2[6]);
    y2[7] = __builtin_elementwise_fma(__builtin_amdgcn_cvt_scalef32_pk_f32_fp4(w1, 1.0f, 3), s2, y2[7]);
}
__device__ __forceinline__ void axpy16_fp8(const u32x4 w, const float s, f32x2 (&y2)[8]) {
    const f32x2 s2 = (f32x2){s, s};
    y2[0] = __builtin_elementwise_fma(__builtin_amdgcn_cvt_pk_f32_fp8(w.x, false), s2, y2[0]);
    y2[1] = __builtin_elementwise_fma(__builtin_amdgcn_cvt_pk_f32_fp8(w.x, true), s2, y2[1]);
    y2[2] = __builtin_elementwise_fma(__builtin_amdgcn_cvt_pk_f32_fp8(w.y, false), s2, y2[2]);
    y2[3] = __builtin_elementwise_fma(__builtin_amdgcn_cvt_pk_f32_fp8(w.y, true), s2, y2[3]);
    y2[4] = __builtin_elementwise_fma(__builtin_amdgcn_cvt_pk_f32_fp8(w.z, false), s2, y2[4]);
    y2[5] = __builtin_elementwise_fma(__builtin_amdgcn_cvt_pk_f32_fp8(w.z, true), s2, y2[5]);
    y2[6] = __builtin_elementwise_fma(__builtin_amdgcn_cvt_pk_f32_fp8(w.w, false), s2, y2[6]);
    y2[7] = __builtin_elementwise_fma(__builtin_amdgcn_cvt_pk_f32_fp8(w.w, true), s2, y2[7]);
}
__device__ __forceinline__ f32x2 cvt4(unsigned w, int) { return (f32x2){0.f, 0.f}; }
#define C4(w, k) __builtin_amdgcn_cvt_scalef32_pk_f32_fp4((w), 1.0f, (k))
__device__ __forceinline__ float dot32_fp4(const u32x4 w, const f32x2 (&x2)[16]) {
    f32x2 a0 = C4(w.x, 0) * x2[0], a1 = C4(w.y, 0) * x2[4];
    a0 = __builtin_elementwise_fma(C4(w.x, 1), x2[1], a0); a1 = __builtin_elementwise_fma(C4(w.y, 1), x2[5], a1);
    a0 = __builtin_elementwise_fma(C4(w.x, 2), x2[2], a0); a1 = __builtin_elementwise_fma(C4(w.y, 2), x2[6], a1);
    a0 = __builtin_elementwise_fma(C4(w.x, 3), x2[3], a0); a1 = __builtin_elementwise_fma(C4(w.y, 3), x2[7], a1);
    a0 = __builtin_elementwise_fma(C4(w.z, 0), x2[8], a0); a1 = __builtin_elementwise_fma(C4(w.w, 0), x2[12], a1);
    a0 = __builtin_elementwise_fma(C4(w.z, 1), x2[9], a0); a1 = __builtin_elementwise_fma(C4(w.w, 1), x2[13], a1);
    a0 = __builtin_elementwise_fma(C4(w.z, 2), x2[10], a0); a1 = __builtin_elementwise_fma(C4(w.w, 2), x2[14], a1);
    a0 = __builtin_elementwise_fma(C4(w.z, 3), x2[11], a0); a1 = __builtin_elementwise_fma(C4(w.w, 3), x2[15], a1);
    a0 = a0 + a1;
    return a0.x + a0.y;
}
typedef _Float16 h16x2 __attribute__((ext_vector_type(2)));
#define C4H(w, k) __builtin_bit_cast(h16x2, __builtin_amdgcn_cvt_scalef32_pk_f16_fp4((w), 1.0f, (k)))
__device__ __forceinline__ void axpy32_fp4(const u32x4 w, const float s, h16x2 (&y2)[16]) {
    const _Float16 sh = (_Float16)s; const h16x2 s2 = (h16x2){sh, sh};
    y2[0] = __builtin_elementwise_fma(C4H(w.x, 0), s2, y2[0]); y2[1] = __builtin_elementwise_fma(C4H(w.x, 1), s2, y2[1]); y2[2] = __builtin_elementwise_fma(C4H(w.x, 2), s2, y2[2]); y2[3] = __builtin_elementwise_fma(C4H(w.x, 3), s2, y2[3]);
    y2[4] = __builtin_elementwise_fma(C4H(w.y, 0), s2, y2[4]); y2[5] = __builtin_elementwise_fma(C4H(w.y, 1), s2, y2[5]); y2[6] = __builtin_elementwise_fma(C4H(w.y, 2), s2, y2[6]); y2[7] = __builtin_elementwise_fma(C4H(w.y, 3), s2, y2[7]);
    y2[8] = __builtin_elementwise_fma(C4H(w.z, 0), s2, y2[8]); y2[9] = __builtin_elementwise_fma(C4H(w.z, 1), s2, y2[9]); y2[10] = __builtin_elementwise_fma(C4H(w.z, 2), s2, y2[10]); y2[11] = __builtin_elementwise_fma(C4H(w.z, 3), s2, y2[11]);
    y2[12] = __builtin_elementwise_fma(C4H(w.w, 0), s2, y2[12]); y2[13] = __builtin_elementwise_fma(C4H(w.w, 1), s2, y2[13]); y2[14] = __builtin_elementwise_fma(C4H(w.w, 2), s2, y2[14]); y2[15] = __builtin_elementwise_fma(C4H(w.w, 3), s2, y2[15]);
}
#undef C4H
__device__ __forceinline__ float half_sum_dpp(float v) {
    v += __builtin_bit_cast(float, __builtin_amdgcn_update_dpp(0, __builtin_bit_cast(int, v), 0x111, 0xf, 0xf, false));
    v += __builtin_bit_cast(float, __builtin_amdgcn_update_dpp(0, __builtin_bit_cast(int, v), 0x112, 0xf, 0xf, false));
    v += __builtin_bit_cast(float, __builtin_amdgcn_update_dpp(0, __builtin_bit_cast(int, v), 0x114, 0xf, 0xf, false));
    v += __builtin_bit_cast(float, __builtin_amdgcn_update_dpp(0, __builtin_bit_cast(int, v), 0x118, 0xf, 0xf, false));
    v += __builtin_bit_cast(float, __builtin_amdgcn_update_dpp(0, __builtin_bit_cast(int, v), 0x142, 0xa, 0xf, false));
    return v;
}
typedef int i32x8 __attribute__((ext_vector_type(8)));
#define P7_EMASK ((DGP & 8) ? 15 : (DGP & 1) ? 1023 : 0x7fffffff)
#define P7_LOAD2(dst, evv, slot) do { const int ea_ = __builtin_amdgcn_readlane((evv), (slot)) & P7_EMASK, eb_ = __builtin_amdgcn_readlane((evv), (slot) + 1) & P7_EMASK; \
        dst = __builtin_amdgcn_raw_buffer_load_b128(RV, ((hi ? eb_ : ea_) << 9) + l16, 0, 0); } while (0)
#define P7_AXPY2(BANK, q, r) do { const float wa_ = __builtin_bit_cast(float, __builtin_amdgcn_readlane(__builtin_bit_cast(int, wvec), (q) * 16 + 2 * (r))), wb_ = __builtin_bit_cast(float, __builtin_amdgcn_readlane(__builtin_bit_cast(int, wvec), (q) * 16 + 2 * (r) + 1)); \
        axpy32_fp4(BANK[r], hi ? wb_ : wa_, y2); } while (0)
#define P7_UBASE(evv, g) ((((__shfl((evv), 16 * (g) + li)) & P7_EMASK) << 9) + 16 * lq)
#define P7_LOADU1(dst, ubase, s) do { dst = __builtin_amdgcn_raw_buffer_load_b128(RU, (ubase) + 64 * (s), 0, 0); } while (0)
#define P7_MFMA_STEP(abuf, xb, s, D1, D2) do { \
        const u32x4 b1_ = *(const LAS u32x4*)((xb) + 64 * (s) + 16 * lq), b2_ = *(const LAS u32x4*)((xb) + 512 + 64 * (s) + 16 * lq); \
        const i32x8 av_ = (i32x8){(int)abuf.x, (int)abuf.y, (int)abuf.z, (int)abuf.w, 0, 0, 0, 0}; \
        D1 = __builtin_amdgcn_mfma_scale_f32_16x16x128_f8f6f4(av_, (i32x8){(int)b1_.x, (int)b1_.y, (int)b1_.z, (int)b1_.w, 0, 0, 0, 0}, D1, 4, 4, 0, 0x7f7f7f7f, 0, 0x7f7f7f7f); \
        D2 = __builtin_amdgcn_mfma_scale_f32_16x16x128_f8f6f4(av_, (i32x8){(int)b2_.x, (int)b2_.y, (int)b2_.z, (int)b2_.w, 0, 0, 0, 0}, D2, 4, 4, 0, 0x7f7f7f7f, 0, 0x7f7f7f7f); } while (0)
#define P7_DV(g, dg, dv) do { const float tmp_ = (lane & 3) == 0 ? dg[0] : (lane & 3) == 1 ? dg[1] : (lane & 3) == 2 ? dg[2] : dg[3]; const float val_ = __shfl(tmp_, srcl); dv = (lq == (g)) ? val_ : dv; } while (0)
__device__ __forceinline__ void x_to_fp4x2(const u32x2 (&xq)[8], LAS unsigned char* xb, int l32, float& s1, float& s2) {
    float am = 0.f;
#pragma unroll
    for (int j = 0; j < 8; ++j) am = fmaxf(am, fmaxf(fmaxf(fabsf(bf_lo(xq[j].x)), fabsf(bf_hi(xq[j].x))), fmaxf(fabsf(bf_lo(xq[j].y)), fabsf(bf_hi(xq[j].y)))));
#pragma unroll
    for (int o = 1; o < 64; o <<= 1) am = fmaxf(am, __shfl_xor(am, o));
    s1 = am > 0.f ? am * (1.f / 6.f) : 1.f; const float i1 = am > 0.f ? 6.f / am : 1.f;
    float am2 = 0.f;
#pragma unroll
    for (int j = 0; j < 8; ++j) {
        const float x0 = bf_lo(xq[j].x), x1 = bf_hi(xq[j].x), x2_ = bf_lo(xq[j].y), x3 = bf_hi(xq[j].y);
        unsigned w = 0u;
        w = __builtin_amdgcn_cvt_scalef32_pk_fp4_f32(w, x0 * i1, x1 * i1, 1.0f, 0); w = __builtin_amdgcn_cvt_scalef32_pk_fp4_f32(w, x2_ * i1, x3 * i1, 1.0f, 1);
        *(LAS unsigned short*)(xb + 2 * (l32 + 32 * j)) = (unsigned short)w;
        const f32x2 d0 = __builtin_amdgcn_cvt_scalef32_pk_f32_fp4(w, 1.0f, 0), d1 = __builtin_amdgcn_cvt_scalef32_pk_f32_fp4(w, 1.0f, 1);
        am2 = fmaxf(am2, fmaxf(fmaxf(fabsf(x0 - s1 * d0.x), fabsf(x1 - s1 * d0.y)), fmaxf(fabsf(x2_ - s1 * d1.x), fabsf(x3 - s1 * d1.y))));
    }
#pragma unroll
    for (int o = 1; o < 64; o <<= 1) am2 = fmaxf(am2, __shfl_xor(am2, o));
    s2 = am2 > 0.f ? am2 * (1.f / 6.f) : 1.f; const float i2 = am2 > 0.f ? 6.f / am2 : 1.f;
    asm volatile("s_waitcnt lgkmcnt(0)" ::: "memory");
#pragma unroll
    for (int j = 0; j < 8; ++j) {
        const float x0 = bf_lo(xq[j].x), x1 = bf_hi(xq[j].x), x2_ = bf_lo(xq[j].y), x3 = bf_hi(xq[j].y);
        const unsigned w1 = *(const LAS unsigned short*)(xb + 2 * (l32 + 32 * j));
        const f32x2 d0 = __builtin_amdgcn_cvt_scalef32_pk_f32_fp4(w1, 1.0f, 0), d1 = __builtin_amdgcn_cvt_scalef32_pk_f32_fp4(w1, 1.0f, 1);
        unsigned w = 0u;
        w = __builtin_amdgcn_cvt_scalef32_pk_fp4_f32(w, (x0 - s1 * d0.x) * i2, (x1 - s1 * d0.y) * i2, 1.0f, 0); w = __builtin_amdgcn_cvt_scalef32_pk_fp4_f32(w, (x2_ - s1 * d1.x) * i2, (x3 - s1 * d1.y) * i2, 1.0f, 1);
        *(LAS unsigned short*)(xb + 512 + 2 * (l32 + 32 * j)) = (unsigned short)w;
    }
    asm volatile("s_waitcnt lgkmcnt(0)" ::: "memory");
}
template <bool V4, int DGP = 0>
__device__ __forceinline__ void peer_phase(LAS unsigned char* lds, int wave, const bf16_t* __restrict__ XN2, const int* __restrict__ EIDX, const float* __restrict__ GATE, const unsigned char* __restrict__ Up, const unsigned char* __restrict__ Vp,
                                           const float* __restrict__ USC, const float* __restrict__ VSC, const float* __restrict__ SSQ, const float* __restrict__ fg, float* __restrict__ out, int gw, int NGW, int lane) {
    static_assert(V4, "this build of the PEER phase streams fp4 value rows");
    if (gw >= M) return;
    LAS unsigned char* xbase = lds + wave * 2048;
    const __amdgpu_buffer_rsrc_t RU = __builtin_amdgcn_make_buffer_rsrc((void*)Up, 0, NEXP * 512, 0x00020000);
    const __amdgpu_buffer_rsrc_t RV = __builtin_amdgcn_make_buffer_rsrc((void*)Vp, 0, NEXP * 512, 0x00020000);
    const bool hi = lane >= 32; const int l32 = lane & 31, l16 = l32 * 16, li = lane & 15, lq = lane >> 4, srcl = 16 * (li >> 2) + li;
    u32x4 UA[8], UB[8], VA[4], VB[4];
    int t = gw, par = 0;
    u32x2 xq[8];
#pragma unroll
    for (int j = 0; j < 8; ++j) xq[j] = ((const u32x2*)(XN2 + (size_t)t * D))[l32 + 32 * j];
    int evc = EIDX[(size_t)t * 128 + lane], evn = EIDX[(size_t)t * 128 + 64 + lane];
    float gvn = GATE[(size_t)t * 128 + 64 + lane];
    float xs1, xs2;
    x_to_fp4x2(xq, xbase, l32, xs1, xs2);
    float rstd_t = rsqrtf(wave_sum_dpp(lane < 16 ? SSQ[(size_t)t * 16 + lane] : 0.f) * (1.f / D) + EPS);
    float wvec;
    {
        float dvec = 0.f;
#pragma unroll 1
        for (int g = 0; g < 4; ++g) {
            const int ub = P7_UBASE(evc, g);
#pragma unroll
            for (int s = 0; s < 8; ++s) P7_LOADU1(UA[s], ub, s);
            f32x4 D1 = (f32x4){0.f, 0.f, 0.f, 0.f}, D2 = D1;
#pragma unroll
            for (int s = 0; s < 8; ++s) P7_MFMA_STEP(UA[s], xbase, s, D1, D2);
            const f32x4 dd = D1 * xs1 + D2 * xs2;
            if (g == 0) P7_DV(0, dd, dvec); else if (g == 1) P7_DV(1, dd, dvec); else if (g == 2) P7_DV(2, dd, dvec); else P7_DV(3, dd, dvec);
        }
        wvec = GATE[(size_t)t * 128 + lane] * VSC[evc] * gelu_as(dvec * (USC[evc] * rstd_t));
    }
    {
#pragma unroll
        for (int r = 0; r < 4; ++r) P7_LOAD2(VA[r], evc, 2 * r);
#pragma unroll
        for (int r = 0; r < 4; ++r) P7_LOAD2(VB[r], evc, 8 + 2 * r);
        const int ub0 = P7_UBASE(evn, 0), ub1 = P7_UBASE(evn, 1);
#pragma unroll
        for (int s = 0; s < 8; ++s) P7_LOADU1(UA[s], ub0, s);
#pragma unroll
        for (int s = 0; s < 8; ++s) P7_LOADU1(UB[s], ub1, s);
    }
    h16x2 y2[16];
#pragma unroll
    for (int j = 0; j < 16; ++j) y2[j] = (h16x2){(_Float16)0.f, (_Float16)0.f};
    int h = 0;
    int tn = t + NGW; bool has_next = tn < M; int tl = has_next ? tn : t;
    int nev0 = EIDX[(size_t)tl * 128 + lane], nev1 = EIDX[(size_t)tl * 128 + 64 + lane];
    float ngv0 = GATE[(size_t)tl * 128 + lane], ngv1 = GATE[(size_t)tl * 128 + 64 + lane];
    u32x2 nxq[8];
#pragma unroll
    for (int j = 0; j < 8; ++j) nxq[j] = ((const u32x2*)(XN2 + (size_t)tl * D))[l32 + 32 * j];
    float nxs1 = 1.f, nxs2 = 1.f, nrstd = 1.f;
#pragma unroll 1
    for (;;) {
        if (h == 1) {
            x_to_fp4x2(nxq, xbase + (par ^ 1) * 1024, l32, nxs1, nxs2);
            nrstd = rsqrtf(wave_sum_dpp(lane < 16 ? SSQ[(size_t)tl * 16 + lane] : 0.f) * (1.f / D) + EPS);
        }
        const LAS unsigned char* xbn = xbase + (h ? (par ^ 1) : par) * 1024;
        const float s1n = h ? nxs1 : xs1, s2n = h ? nxs2 : xs2, rsn = h ? nrstd : rstd_t;
        const int evnn = h ? nev1 : nev0;
        const float uscn = USC[evn] * rsn, vscn = VSC[evn];
        float dvec = 0.f;
#define P7_PIPE(g, UBUF, UREFILL, evr, slotr) do { \
            f32x4 D1 = (f32x4){0.f, 0.f, 0.f, 0.f}, D2 = D1; \
            _Pragma("unroll") for (int r = 0; r < 8; ++r) { \
                P7_MFMA_STEP(UBUF[r], xbn, r, D1, D2); __builtin_amdgcn_sched_barrier(0); UREFILL; __builtin_amdgcn_sched_barrier(0); \
                if (r < 4) { P7_AXPY2X(VA[r], (g) * 16 + 2 * r); __builtin_amdgcn_sched_barrier(0); P7_LOAD2(VA[r], evr, (slotr) + 2 * r); } \
                else { P7_AXPY2X(VB[r - 4], (g) * 16 + 2 * r); __builtin_amdgcn_sched_barrier(0); P7_LOAD2(VB[r - 4], evr, (slotr) + 2 * r); } \
                __builtin_amdgcn_sched_barrier(0); } \
            const f32x4 dd = D1 * s1n + D2 * s2n; P7_DV(g, dd, dvec); } while (0)
#define P7_AXPY2X(ROW, slot) do { const float wa_ = __builtin_bit_cast(float, __builtin_amdgcn_readlane(__builtin_bit_cast(int, wvec), (slot))), wb_ = __builtin_bit_cast(float, __builtin_amdgcn_readlane(__builtin_bit_cast(int, wvec), (slot) + 1)); \
        axpy32_fp4(ROW, hi ? wb_ : wa_, y2); \
        asm volatile("" : "+v"(y2[0]), "+v"(y2[1]), "+v"(y2[2]), "+v"(y2[3]), "+v"(y2[4]), "+v"(y2[5]), "+v"(y2[6]), "+v"(y2[7]), "+v"(y2[8]), "+v"(y2[9]), "+v"(y2[10]), "+v"(y2[11]), "+v"(y2[12]), "+v"(y2[13]), "+v"(y2[14]), "+v"(y2[15])); } while (0)
        { const int ub = P7_UBASE(evn, 2);  P7_PIPE(0, UA, P7_LOADU1(UA[r], ub, r), evc, 16); }
        { const int ub = P7_UBASE(evn, 3);  P7_PIPE(1, UB, P7_LOADU1(UB[r], ub, r), evc, 32); }
        { const int ub = P7_UBASE(evnn, 0); P7_PIPE(2, UA, P7_LOADU1(UA[r], ub, r), evc, 48); }
        { const int ub = P7_UBASE(evnn, 1); P7_PIPE(3, UB, P7_LOADU1(UB[r], ub, r), evn, 0); }
#undef P7_AXPY2X
#undef P7_PIPE
        const float wnext = gvn * vscn * gelu_as(dvec * uscn);
        if (h == 1) {
            f32x4 z[4]; float sq = 0.f;
#pragma unroll
            for (int jj = 0; jj < 4; ++jj) {
                const u32x2 xe = xq[2 * jj], xo = xq[2 * jj + 1];
                const f32x4 ye = (f32x4){(float)y2[2 * jj].x, (float)y2[2 * jj].y, (float)y2[2 * jj + 1].x, (float)y2[2 * jj + 1].y}, yo = (f32x4){(float)y2[8 + 2 * jj].x, (float)y2[8 + 2 * jj].y, (float)y2[8 + 2 * jj + 1].x, (float)y2[8 + 2 * jj + 1].y};
                const f32x4 mine = hi ? yo : ye, give = hi ? ye : yo;
                f32x4 got; got.x = __shfl_xor(give.x, 32); got.y = __shfl_xor(give.y, 32); got.z = __shfl_xor(give.z, 32); got.w = __shfl_xor(give.w, 32);
                const u32x2 xm = hi ? xo : xe;
                z[jj] = mine + got + (f32x4){bf_lo(xm.x), bf_hi(xm.x), bf_lo(xm.y), bf_hi(xm.y)};
                sq += (z[jj].x * z[jj].x + z[jj].y * z[jj].y) + (z[jj].z * z[jj].z + z[jj].w * z[jj].w);
            }
            const float rr = rsqrtf(wave_sum_dpp(sq) * (1.f / D) + EPS);
            const int hb = hi ? 1 : 0;
#pragma unroll
            for (int jj = 0; jj < 4; ++jj) { const int G = l32 + 32 * (hb + 2 * jj); __builtin_nontemporal_store(z[jj] * rr * ((const f32x4*)fg)[G], (f32x4*)(out + (size_t)t * D) + G); }
            if (!has_next) break;
            t = tn; par ^= 1; xs1 = nxs1; xs2 = nxs2; rstd_t = nrstd;
#pragma unroll
            for (int j = 0; j < 8; ++j) xq[j] = nxq[j];
#pragma unroll
            for (int j = 0; j < 16; ++j) y2[j] = (h16x2){(_Float16)0.f, (_Float16)0.f};
            evc = evn; evn = nev1; gvn = ngv1;
            tn = t + NGW; has_next = tn < M; tl = has_next ? tn : t;
            nev0 = EIDX[(size_t)tl * 128 + lane]; nev1 = EIDX[(size_t)tl * 128 + 64 + lane]; ngv0 = GATE[(size_t)tl * 128 + lane]; ngv1 = GATE[(size_t)tl * 128 + 64 + lane];
#pragma unroll
            for (int j = 0; j < 8; ++j) nxq[j] = ((const u32x2*)(XN2 + (size_t)tl * D))[l32 + 32 * j];
            h = 0;
        } else {
            evc = evn; evn = nev0; gvn = ngv0; h = 1;
        }
        wvec = wnext;
    }
}
#undef P7_LOAD2
#undef P7_AXPY2
#undef P7_UBASE
#undef P7_LOADU1
#undef P7_MFMA_STEP
#undef P7_DV
#undef P7_EMASK
#undef C4

#define XB_TMO      128
#define XB_XCNT(j)  (256  + 64 * (j))
#define XB_XSUB(j)  (1280 + 64 * (j))
#define XB_XGEN(j)  (2304 + 64 * (j))
#define XB_TOP      3328
#define XB_TOPGEN   3392
#define XCD_BAR_WORDS 3456
#define XB_SPIN_CAP (1u << 18)

__device__ __forceinline__ unsigned xb_ld(unsigned* p)              { return __hip_atomic_load(p, __ATOMIC_RELAXED, __HIP_MEMORY_SCOPE_AGENT); }
__device__ __forceinline__ unsigned xb_add(unsigned* p, unsigned v) { return __hip_atomic_fetch_add(p, v, __ATOMIC_RELAXED, __HIP_MEMORY_SCOPE_AGENT); }
__device__ __forceinline__ unsigned xb_xcc_id() { return (unsigned)__builtin_amdgcn_s_getreg((3 << 11) | 20) & 0xFu; }
#define XB_SPIN(cond, bar) do { unsigned _sp = 0; while (cond) { __builtin_amdgcn_s_sleep(1); \
    if ((++_sp & 255u) == 0u) { if (xb_ld(&(bar)[XB_TMO])) break; if (_sp > XB_SPIN_CAP) { atomicAdd(&(bar)[XB_TMO], 1u); break; } } } } while (0)


struct XcdBar { unsigned* bar; unsigned x, nloc, nx; };
__device__ __forceinline__ void xcd_bar_post(unsigned* bar, unsigned x) { (void)xb_add(&bar[XB_XCNT(x)], 1u); }
__device__ __forceinline__ void xcd_bar_census(XcdBar& b) {
    unsigned cnt = 0u, mine = 0u;
#pragma unroll
    for (unsigned j = 0; j < 16; ++j) { const unsigned c = xb_ld(&b.bar[XB_XCNT(j)]); cnt += (c > 0u) ? 1u : 0u; mine = (j == b.x) ? c : mine; }
    b.nloc = mine > 0u ? mine : 1u; b.nx = cnt > 0u ? cnt : 1u;
}
__device__ __forceinline__ void xcd_barrier(const XcdBar& b, bool leader_thread) {
    asm volatile("s_waitcnt vmcnt(0)" ::: "memory");
    __syncthreads();
    if (leader_thread) {
        unsigned* bar = b.bar;
        __builtin_amdgcn_s_waitcnt(0);
        const unsigned nloc = b.nloc, nx = b.nx;
        const unsigned old = xb_add(&bar[XB_XSUB(b.x)], 1u);
        const unsigned gen = old / nloc;
        if (old + 1u == (gen + 1u) * nloc) {
            __builtin_amdgcn_fence(__ATOMIC_RELEASE, "agent");
            asm volatile("s_waitcnt vmcnt(0)" ::: "memory");
            const unsigned og = xb_add(&bar[XB_TOP], 1u);
            const unsigned tg = og / nx;
            if (og + 1u == (tg + 1u) * nx) xb_add(&bar[XB_TOPGEN], 1u);
            else XB_SPIN(xb_ld(&bar[XB_TOPGEN]) == tg, bar);
            __builtin_amdgcn_fence(__ATOMIC_ACQUIRE, "agent");
            xb_add(&bar[XB_XGEN(b.x)], 1u);
            asm volatile("s_waitcnt vmcnt(0)" ::: "memory");
        } else {
            XB_SPIN(xb_ld(&bar[XB_XGEN(b.x)]) == gen, bar);
            __builtin_amdgcn_fence(__ATOMIC_ACQUIRE, "agent");
            asm volatile("s_waitcnt vmcnt(0)" ::: "memory");
        }
    }
    __syncthreads();
}

#ifdef DIAG_BENCH
__global__ void __launch_bounds__(NT, 2) diag_bench(Args a) {
    const int lane = pg8::lane_id_v();
    unsigned w[16]; f32x2 acc[16]; int ia[16];
#pragma unroll
    for (int i = 0; i < 16; ++i) { w[i] = ((const unsigned*)a.in[0])[lane + 64 * i]; acc[i] = (f32x2){0.f, 0.f}; ia[i] = 0; }
    const f32x2 xx = (f32x2){1.0001f, 0.9999f};
#pragma unroll 1
    for (int it = 0; it < 4096; ++it) {
#pragma unroll
        for (int i = 0; i < 16; ++i) {
#if DIAG_BENCH == 1
            acc[i] += __builtin_amdgcn_cvt_scalef32_pk_f32_fp4(w[i], 1.0f, 0); w[i] += 0x11u;
#elif DIAG_BENCH == 2
            acc[i] = __builtin_elementwise_fma(acc[i], xx, xx);
#elif DIAG_BENCH == 3
            acc[i] += __builtin_amdgcn_cvt_pk_f32_fp8(w[i], false); w[i] += 0x11u;
#elif DIAG_BENCH == 4
            ia[i] = __builtin_amdgcn_sdot4(w[i], 0x01020304, ia[i], false); w[i] += 0x11u;
#elif DIAG_BENCH == 5
            acc[i].x += __builtin_amdgcn_cvt_f32_ubyte0(w[i]); acc[i].y += __builtin_amdgcn_cvt_f32_ubyte1(w[i]); w[i] += 0x11u;
#elif DIAG_BENCH == 6
            acc[i].x = fmaf(acc[i].x, 1.0001f, 0.5f); acc[i].y = fmaf(acc[i].y, 0.9999f, 0.5f);
#elif DIAG_BENCH == 7
            acc[i] += (f32x2){0.5f, 0.25f}; w[i] += 0x11u;
#endif
        }
    }
    float r = 0.f;
#pragma unroll
    for (int i = 0; i < 16; ++i) r += acc[i].x + acc[i].y + (float)ia[i] + (float)w[i];
    if (r == 123.456f) ((float*)(a.ws + 448 * MiB))[lane] = r;
}
#endif
#ifdef DIAG_FLAGS
__global__ void __launch_bounds__(NT, 2) diag_hgrn(Args a) {
    extern __shared__ __attribute__((aligned(16))) unsigned char lds_raw[];
    LAS unsigned char* lds = (LAS unsigned char*)lds_raw;
    const int wave = __builtin_amdgcn_readfirstlane(threadIdx.x >> 6), lane = pg8::lane_id_v(), tid = wave * 64 + lane;
    unsigned char* ws = a.ws;
    for (int u = blockIdx.x; u < BATCH * NH * SEGS; u += gridDim.x)
        hgrn_unit<DIAG_P3 != 0, DIAG_FLAGS>(lds, u, (const bf16_t*)(ws + WS_HG), a.in[7], a.in[8], DIAG_P3 ? (float*)(ws + WS_HS) : (float*)(ws + 480 * MiB), DIAG_P3 ? (float*)(ws + WS_HLD) : (float*)(ws + 500 * MiB), (bf16_t*)(ws + 448 * MiB), tid, lane, wave);
}
#endif
__global__ void __launch_bounds__(NT, 2) mega(Args a) {
    extern __shared__ __attribute__((aligned(16))) unsigned char lds_raw[];
    LAS unsigned char* lds = (LAS unsigned char*)lds_raw;
    cg::grid_group grid = cg::this_grid();
    const int wave = __builtin_amdgcn_readfirstlane(threadIdx.x >> 6), G = gridDim.x;
#define PH_IDS() const int lane = pg8::lane_id_v(), tid = wave * 64 + lane; (void)tid; (void)lane
    unsigned char* ws = a.ws;
    const int lo = a.ph_lo, hi = a.ph_hi;
    bf16_t* WIN = (bf16_t*)(ws + WS_WIN); bf16_t* WOUT = (bf16_t*)(ws + WS_WOUT); bf16_t* WEFF = (bf16_t*)(ws + WS_WEFF);
    bf16_t* XN = (bf16_t*)(ws + WS_XN);
    bf16_t* GLU = (bf16_t*)(ws + WS_GLU); bf16_t* HG = (bf16_t*)(ws + WS_HG); bf16_t* Y = (bf16_t*)(ws + WS_Y);
    float* HS = (float*)(ws + WS_HS); float* HLD = (float*)(ws + WS_HLD);
    int* EIDX = (int*)(ws + WS_EIDX); float* GATE = (float*)(ws + WS_GATE);
    const int gw = blockIdx.x * NWAVES + wave, NGW = G * NWAVES;
#ifndef PH_MASK
#define PH_MASK 0xff
#endif
#define IN(k) (((PH_MASK >> (k)) & 1) && lo <= (k) && (k) < hi)
    XcdBar xb; xb.bar = (unsigned*)ws; xb.x = xb_xcc_id(); xb.nloc = 1u; xb.nx = 1u;
    const bool xb_leader = (wave == 0) && (pg8::lane_id_v() == 0);
    if (lo == 0 && xb_leader) xcd_bar_post(xb.bar, xb.x);
#define SEAM(k) do { if (IN(k) && IN((k) + 1)) { if ((k) == 0) { grid.sync(); if (xb_leader) xcd_bar_census(xb); } else xcd_barrier(xb, xb_leader); } } while (0)
    if (IN(0)) { PH_IDS(); p0_prologue(a, lds, tid, lane, wave, G); }
    SEAM(0);
    if (IN(1)) {
        pg8::Gemm g{XN, WIN, M, DIN, D}; pg8::StaticOrder S; S.init(M, DIN, G, (int)blockIdx.x);
        pg8::EpiProj E{GLU, HG};
        pg8::gemm_phase<pg8::EpiProj, pg8::StaticOrder, true, true>(lds, g, S, E, wave);
    }
    SEAM(1);
    if (IN(2)) { PH_IDS();
        for (int u = blockIdx.x; u < BATCH * NH * SEGS; u += G) hgrn_unit<false>(lds, u, HG, a.in[7], a.in[8], HS, HLD, Y, tid, lane, wave);
        for (int wu = gw; wu < 2048; wu += NGW) conv_wave_unit(GLU, a.in[3], a.in[4], a.in[5], a.in[6], Y, wu, lane);
    }
    SEAM(2);
    if (IN(3)) { PH_IDS();
        for (int u = blockIdx.x; u < BATCH * NH * SEGS; u += G) hgrn_unit<true>(lds, u, HG, a.in[7], a.in[8], HS, HLD, Y, tid, lane, wave);
    }
    SEAM(3);
    if (IN(4)) {
        pg8::Gemm g{Y, WOUT, M, D, D}; pg8::StaticOrder S; S.init(M, D, G, (int)blockIdx.x);
        pg8::EpiResBf16 E{XN, a.in[0], (float*)(ws + WS_SSQ)};
        pg8::gemm_phase<pg8::EpiResBf16, pg8::StaticOrder, true, true>(lds, g, S, E, wave);
    }
    SEAM(4);
    if (IN(6)) {
        pg8::Gemm g{XN, WEFF, M, NQ, D}; pg8::StaticOrder S; S.init(M, NQ, G, (int)blockIdx.x);
        pg8::EpiTopK E{EIDX, GATE, (const float*)(ws + WS_SSQ)};
        for (int i = 0;; ++i) { pg8::OneUnit O; if (!S.next(i, O.u)) break; pg8::gemm_phase<pg8::EpiTopK, pg8::OneUnit, false, true>(lds, g, O, E, wave); }
    }
    SEAM(6);
    if (IN(7)) { PH_IDS();
        peer_phase<PEER_V4>(lds, wave, XN, EIDX, GATE, ws + WS_U, ws + WS_V, (const float*)(ws + WS_USC), (const float*)(ws + WS_VSC), (const float*)(ws + WS_SSQ), a.in[15], a.out, gw, NGW, lane);
    }
#undef IN
#undef SEAM
}
}

#ifndef STAGE
#define STAGE 5
#endif
#if STAGE < 5
namespace nv {
constexpr int D = 1024, BATCH = 8, SEQ = 4096, M = BATCH * SEQ;
constexpr int DCONV = 512, CW = 31, DH = 512, NH = 4, HD = 128, DIN = 3072;
constexpr int NKEY = 128;
constexpr float EPS = 1e-6f;
typedef unsigned short bf16_t;
__device__ __forceinline__ float bf1(bf16_t u) { return __builtin_bit_cast(float, (unsigned)u << 16); }
__device__ __forceinline__ float wsum(float v) {
#pragma unroll
    for (int o = 1; o < 64; o <<= 1) v += __shfl_xor(v, o);
    return v;
}
__device__ __forceinline__ float sigmoidf_(float x) { return 1.f / (1.f + __expf(-x)); }
__device__ __forceinline__ float siluf_(float x) { return x * sigmoidf_(x); }
__global__ void __launch_bounds__(256) k_cvt(const bf16_t* __restrict__ s, float* __restrict__ d, size_t n) { const size_t i = (size_t)blockIdx.x * 256 + threadIdx.x; if (i < n) d[i] = bf1(s[i]); }
__global__ void __launch_bounds__(256) k_rmsnorm(const float* __restrict__ x, const float* __restrict__ g, float* __restrict__ out, int rows) {
    const int lane = threadIdx.x & 63, w = threadIdx.x >> 6;
    const int row = blockIdx.x * 4 + w;
    if (row >= rows) return;
    const float4* xr = (const float4*)(x + (size_t)row * D);
    float4 v[4]; float s = 0.f;
#pragma unroll
    for (int j = 0; j < 4; ++j) { v[j] = xr[lane + 64 * j]; s += v[j].x * v[j].x + v[j].y * v[j].y + v[j].z * v[j].z + v[j].w * v[j].w; }
    s = wsum(s);
    const float r = rsqrtf(s * (1.f / D) + EPS);
    float4* o = (float4*)(out + (size_t)row * D);
    const float4* g4 = (const float4*)g;
#pragma unroll
    for (int j = 0; j < 4; ++j) { const float4 gg = g4[lane + 64 * j]; float4 t; t.x = v[j].x * r * gg.x; t.y = v[j].y * r * gg.y; t.z = v[j].z * r * gg.z; t.w = v[j].w * r * gg.w; o[lane + 64 * j] = t; }
}
template <bool RES>
__global__ void __launch_bounds__(256) k_gemm(const float* __restrict__ A, const float* __restrict__ B, float* __restrict__ C, const float* __restrict__ R, int Mm, int N, int K) {
    __shared__ float As[16][68];
    __shared__ float Bs[16][64];
    const int tid = threadIdx.x, tx = tid & 15, ty = tid >> 4;
    const int m0 = blockIdx.y * 64, n0 = blockIdx.x * 64;
    float acc[4][4];
#pragma unroll
    for (int i = 0; i < 4; ++i)
#pragma unroll
        for (int j = 0; j < 4; ++j) acc[i][j] = 0.f;
    for (int k0 = 0; k0 < K; k0 += 16) {
#pragma unroll
        for (int i = 0; i < 4; ++i) { const int idx = tid + i * 256, r = idx >> 4, kk = idx & 15; As[kk][r] = A[(size_t)(m0 + r) * K + k0 + kk]; }
#pragma unroll
        for (int i = 0; i < 4; ++i) { const int idx = tid + i * 256, kk = idx >> 6, c = idx & 63; Bs[kk][c] = B[(size_t)(k0 + kk) * N + n0 + c]; }
        __syncthreads();
#pragma unroll
        for (int kk = 0; kk < 16; ++kk) {
            float a[4], b[4];
#pragma unroll
            for (int i = 0; i < 4; ++i) a[i] = As[kk][ty * 4 + i];
#pragma unroll
            for (int j = 0; j < 4; ++j) b[j] = Bs[kk][tx * 4 + j];
#pragma unroll
            for (int i = 0; i < 4; ++i)
#pragma unroll
                for (int j = 0; j < 4; ++j) acc[i][j] = fmaf(a[i], b[j], acc[i][j]);
        }
        __syncthreads();
    }
#pragma unroll
    for (int i = 0; i < 4; ++i) {
        const size_t off = (size_t)(m0 + ty * 4 + i) * N + n0 + tx * 4;
        float4 o; o.x = acc[i][0]; o.y = acc[i][1]; o.z = acc[i][2]; o.w = acc[i][3];
        if (RES) { const float4 r = *(const float4*)(R + off); o.x += r.x; o.y += r.y; o.z += r.z; o.w += r.w; }
        *(float4*)(C + off) = o;
    }
}
__global__ void __launch_bounds__(512) k_conv_glu(const bf16_t* __restrict__ GLU, const float* __restrict__ cw, const float* __restrict__ cb, const float* __restrict__ ng, const float* __restrict__ nb, float* __restrict__ Y) {
    const int t = blockIdx.x, s = t % SEQ, c = threadIdx.x;
    float acc = cb[c];
    for (int j = 0; j < CW; ++j) { const int ss = s - (CW - 1) + j; if (ss >= 0) acc = fmaf(cw[j * DCONV + c], bf1(GLU[(size_t)(t - (CW - 1) + j) * DCONV + c]), acc); }
    const float mu = wsum(acc) * (1.f / 64.f), d = acc - mu, var = wsum(d * d) * (1.f / 64.f);
    Y[(size_t)t * D + c] = siluf_(d * rsqrtf(var + EPS) * ng[c] + nb[c]);
}
__global__ void __launch_bounds__(128) k_hgrn_hg(const bf16_t* __restrict__ HG, const float* __restrict__ lbl, const float* __restrict__ hng, float* __restrict__ Y) {
    __shared__ float fs[HD], ks[HD], qs[HD], red[2];
    const int b = blockIdx.x / NH, h = blockIdx.x % NH, v = threadIdx.x, col = h * HD + v;
    const float lb = 1.f / (1.f + __expf(lbl[DH + col] - lbl[col])), gn = hng[col];
    float S[HD];
#pragma unroll
    for (int k = 0; k < HD; ++k) S[k] = 0.f;
    for (int s = 0; s < SEQ; ++s) {
        const bf16_t* pr = HG + (size_t)(b * SEQ + s) * 2048;
        const float qv = bf1(pr[col]), z = bf1(pr[DH + col]), iv = bf1(pr[2 * DH + col]), gv = bf1(pr[3 * DH + col]);
        const float sg = sigmoidf_(z);
        fs[v] = lb + (1.f - lb) * sg; ks[v] = (1.f - lb) * (1.f - sg); qs[v] = qv;
        __syncthreads();
        float o = 0.f;
#pragma unroll
        for (int k = 0; k < HD; ++k) { S[k] = fmaf(fs[k], S[k], ks[k] * iv); o = fmaf(S[k], qs[k], o); }
        const float sq = wsum(o * o);
        if ((v & 63) == 0) red[v >> 6] = sq;
        __syncthreads();
        const float ms = (red[0] + red[1]) * (1.f / HD);
        Y[(size_t)(b * SEQ + s) * D + DCONV + col] = o * rsqrtf(ms + EPS) * gn * gv;
        __syncthreads();
    }
}
__global__ void __launch_bounds__(256) k_scores(const float* __restrict__ Q, const float* __restrict__ sk, float* __restrict__ SC) {
    __shared__ float qs[2048];
    const int t = blockIdx.x;
    for (int i = threadIdx.x; i < 2048; i += 256) qs[i] = Q[(size_t)t * 2048 + i];
    __syncthreads();
    for (int o = threadIdx.x; o < 2048; o += 256) {
        const int hp = o >> 7; const float* kr = sk + (size_t)o * 128; const float* qq = qs + hp * 128;
        float a = 0.f;
        for (int j = 0; j < 128; ++j) a = fmaf(qq[j], kr[j], a);
        SC[(size_t)t * 2048 + o] = a;
    }
}
__device__ __forceinline__ void wave_argmax(float& v, int& i) {
#pragma unroll
    for (int o = 1; o < 64; o <<= 1) { const float ov = __shfl_xor(v, o); const int oi = __shfl_xor(i, o); if (ov > v || (ov == v && oi < i)) { v = ov; i = oi; } }
}
__global__ void __launch_bounds__(64) k_topk(const float* __restrict__ SC, int* __restrict__ EIDX, float* __restrict__ GATE) {
    __shared__ float s1[16], s2[16]; __shared__ int i1[16], i2[16];
    const int t = blockIdx.x >> 3, h = blockIdx.x & 7, lane = threadIdx.x;
    const float* sc = SC + (size_t)t * 2048 + h * 256;
    for (int p = 0; p < 2; ++p) {
        float a0 = sc[p * 128 + lane], a1 = sc[p * 128 + 64 + lane];
        for (int r = 0; r < 16; ++r) {
            float v; int i;
            if (a0 >= a1) { v = a0; i = lane; } else { v = a1; i = lane + 64; }
            wave_argmax(v, i);
            if (lane == 0) { if (p == 0) { s1[r] = v; i1[r] = i; } else { s2[r] = v; i2[r] = i; } }
            if (i == lane) a0 = -INFINITY;
            if (i == lane + 64) a1 = -INFINITY;
        }
    }
    __syncthreads();
    float c[4];
#pragma unroll
    for (int e = 0; e < 4; ++e) { const int ci = lane * 4 + e; c[e] = s1[ci >> 4] + s2[ci & 15]; }
    float tmax = 0.f, myts = 0.f; int mye = 0;
    for (int r = 0; r < 16; ++r) {
        float v = c[0]; int i = lane * 4;
#pragma unroll
        for (int e = 1; e < 4; ++e) if (c[e] > v) { v = c[e]; i = lane * 4 + e; }
        wave_argmax(v, i);
#pragma unroll
        for (int e = 0; e < 4; ++e) if (i == lane * 4 + e) c[e] = -INFINITY;
        if (r == 0) tmax = v;
        if (lane == r) { myts = v; mye = i1[i >> 4] * NKEY + i2[i & 15]; }
    }
    const float ex = (lane < 16) ? __expf(myts - tmax) : 0.f;
    const float den = wsum(ex);
    if (lane < 16) { EIDX[(size_t)t * 128 + h * 16 + lane] = mye; GATE[(size_t)t * 128 + h * 16 + lane] = ex / den; }
}
__global__ void __launch_bounds__(256) k_peer(const float* __restrict__ XN2, const int* __restrict__ EIDX, const float* __restrict__ GATE, const float* __restrict__ U, const float* __restrict__ V,
                                              const float* H2, const float* __restrict__ fg, float* out) {
    const int lane = threadIdx.x & 63, w = threadIdx.x >> 6, t = blockIdx.x * 4 + w;
    const float4* xr = (const float4*)(XN2 + (size_t)t * D);
    float4 x[4], y[4];
#pragma unroll
    for (int j = 0; j < 4; ++j) { x[j] = xr[lane + 64 * j]; y[j] = make_float4(0.f, 0.f, 0.f, 0.f); }
    for (int e = 0; e < 128; ++e) {
        const int ei = EIDX[(size_t)t * 128 + e]; const float g = GATE[(size_t)t * 128 + e];
        const float4* ur = (const float4*)(U + (size_t)ei * D);
        float d = 0.f;
#pragma unroll
        for (int j = 0; j < 4; ++j) { const float4 u = ur[lane + 64 * j]; d += u.x * x[j].x + u.y * x[j].y + u.z * x[j].z + u.w * x[j].w; }
        d = wsum(d);
        const float wgt = g * 0.5f * d * (1.f + erff(d * 0.70710678118654752f));
        const float4* vr = (const float4*)(V + (size_t)ei * D);
#pragma unroll
        for (int j = 0; j < 4; ++j) { const float4 vv = vr[lane + 64 * j]; y[j].x = fmaf(wgt, vv.x, y[j].x); y[j].y = fmaf(wgt, vv.y, y[j].y); y[j].z = fmaf(wgt, vv.z, y[j].z); y[j].w = fmaf(wgt, vv.w, y[j].w); }
    }
    const float4* hr = (const float4*)(H2 + (size_t)t * D);
    float s = 0.f;
#pragma unroll
    for (int j = 0; j < 4; ++j) { const float4 hh = hr[lane + 64 * j]; y[j].x += hh.x; y[j].y += hh.y; y[j].z += hh.z; y[j].w += hh.w; s += y[j].x * y[j].x + y[j].y * y[j].y + y[j].z * y[j].z + y[j].w * y[j].w; }
    s = wsum(s);
    const float r = rsqrtf(s * (1.f / D) + EPS);
    float4* o = (float4*)(out + (size_t)t * D);
    const float4* g4 = (const float4*)fg;
#pragma unroll
    for (int j = 0; j < 4; ++j) { const float4 gg = g4[lane + 64 * j]; float4 q; q.x = y[j].x * r * gg.x; q.y = y[j].y * r * gg.y; q.z = y[j].z * r * gg.z; q.w = y[j].w * r * gg.w; o[lane + 64 * j] = q; }
}
}
#endif

extern "C" void kernel_launch(void* const* d_in, const int* in_sizes, int n_in, void* d_out, int out_size, void* d_ws, size_t ws_size, hipStream_t stream) {
    static int grid = 0;
    if (grid == 0) {
        if (n_in != 16 || out_size != mk::M * mk::D || ws_size < 512ull * mk::MiB) { fprintf(stderr, "kernel_launch: unexpected shapes (n_in %d out %d ws %zu)\n", n_in, out_size, ws_size); grid = -1; return; }
        int dev = 0, cus = 0, per_cu = 0;
        (void)hipGetDevice(&dev);
        (void)hipDeviceGetAttribute(&cus, hipDeviceAttributeMultiprocessorCount, dev);
        if (hipFuncSetAttribute((const void*)mk::mega, hipFuncAttributeMaxDynamicSharedMemorySize, mk::LDS_BYTES) != hipSuccess) { fprintf(stderr, "kernel_launch: hipFuncSetAttribute failed\n"); grid = -1; return; }
        if (hipOccupancyMaxActiveBlocksPerMultiprocessor(&per_cu, (const void*)mk::mega, mk::NT, mk::LDS_BYTES) != hipSuccess || per_cu < 1) { fprintf(stderr, "kernel_launch: occupancy query says %d\n", per_cu); per_cu = 1; }
        (void)hipGetLastError();
        grid = cus;
        fprintf(stderr, "kernel_launch: cus %d per_cu %d grid %d\n", cus, per_cu, grid);
    }
    if (grid < 0) return;
    if (hipMemsetAsync(d_ws, 0, 16384, stream) != hipSuccess) { fprintf(stderr, "kernel_launch: memset failed\n"); return; }
    mk::Args a{};
    for (int i = 0; i < 16; ++i) a.in[i] = (const float*)d_in[i];
    a.out = (float*)d_out; a.ws = (unsigned char*)d_ws;
    const int his[6] = {0, 2, 4, 5, 7, 8};
    a.ph_lo = 0; a.ph_hi = his[STAGE];
    void* args[] = {&a};
#ifdef DIAG_BENCH
    {
        hipError_t e = hipLaunchCooperativeKernel((const void*)mk::mega, dim3(grid), dim3(mk::NT), args, mk::LDS_BYTES, stream); (void)e;
        hipLaunchKernelGGL(mk::diag_bench, dim3(grid), dim3(mk::NT), 0, stream, a);
    }
#elif defined(DIAG_PEER)
    {
        a.ph_lo = 0; a.ph_hi = 7; (void)hipLaunchCooperativeKernel((const void*)mk::mega, dim3(grid), dim3(mk::NT), args, mk::LDS_BYTES, stream);
        hipLaunchKernelGGL(mk::diag_peer, dim3(grid), dim3(mk::NT), 16384, stream, a);
        (void)hipMemsetAsync(d_ws, 0, 16384, stream);
        a.ph_lo = 7; a.ph_hi = 8; (void)hipLaunchCooperativeKernel((const void*)mk::mega, dim3(grid), dim3(mk::NT), args, mk::LDS_BYTES, stream);
    }
#elif defined(DIAG_FLAGS)
    {
        static bool once = false; if (!once) { once = true; (void)hipFuncSetAttribute((const void*)mk::diag_hgrn, hipFuncAttributeMaxDynamicSharedMemorySize, mk::LDS_BYTES); }
        a.ph_lo = 0; a.ph_hi = 7; (void)hipLaunchCooperativeKernel((const void*)mk::mega, dim3(grid), dim3(mk::NT), args, mk::LDS_BYTES, stream);
        hipLaunchKernelGGL(mk::diag_hgrn, dim3(grid), dim3(mk::NT), mk::LDS_BYTES, stream, a);
        (void)hipMemsetAsync(d_ws, 0, 16384, stream);
        a.ph_lo = 7; a.ph_hi = 8; (void)hipLaunchCooperativeKernel((const void*)mk::mega, dim3(grid), dim3(mk::NT), args, mk::LDS_BYTES, stream);
    }
#elif defined(PROBE_PHASE)
    const int plo[3] = {0, PROBE_PHASE == 0 ? 0 : PROBE_PHASE, 7}, phi[3] = {PROBE_PHASE == 0 ? 1 : 7, PROBE_PHASE == 0 ? 8 : PROBE_PHASE + 1, 8};
    for (int li = 0; li < 3; ++li) { if ((li == 1 && PROBE_PHASE < 0) || (li == 2 && PROBE_PHASE == 0)) continue; a.ph_lo = plo[li]; a.ph_hi = phi[li];
        if (li) (void)hipMemsetAsync(d_ws, 0, 16384, stream);
        hipError_t e = hipLaunchCooperativeKernel((const void*)mk::mega, dim3(grid), dim3(mk::NT), args, mk::LDS_BYTES, stream);
        if (e != hipSuccess) fprintf(stderr, "cooperative launch failed: %s (grid %d)\n", hipGetErrorString(e), grid); }
#else
    hipError_t e = hipLaunchCooperativeKernel((const void*)mk::mega, dim3(grid), dim3(mk::NT), args, mk::LDS_BYTES, stream);
    if (e != hipSuccess) fprintf(stderr, "cooperative launch failed: %s (grid %d)\n", hipGetErrorString(e), grid);
#endif
#if STAGE < 5
    using namespace nv;
    char* ws = (char*)d_ws; const size_t MiB = 1u << 20;
    const float* x = (const float*)d_in[0];
    float* out = (float*)d_out;
    float* XN2f = (float*)(ws);
    float* Qh = (float*)(ws + 128 * MiB); float* SCh = (float*)(ws + 256 * MiB);
    int* EIDX = (int*)(ws + 384 * MiB); float* GATE = (float*)(ws + 400 * MiB);
#if STAGE == 1
    float* Yf = (float*)(ws + 320 * MiB);
    k_conv_glu<<<M, 512, 0, stream>>>((const bf16_t*)(ws + mk::WS_GLU), (const float*)d_in[3], (const float*)d_in[4], (const float*)d_in[5], (const float*)d_in[6], Yf);
    k_hgrn_hg<<<BATCH * NH, 128, 0, stream>>>((const bf16_t*)(ws + mk::WS_HG), (const float*)d_in[7], (const float*)d_in[8], Yf);
#endif
#if STAGE == 2
    float* Yf = (float*)(ws + 128 * MiB);
    k_cvt<<<(unsigned)((size_t)M * D / 256), 256, 0, stream>>>((const bf16_t*)(ws + mk::WS_Y), Yf, (size_t)M * D);
#endif
#if STAGE <= 2
    k_gemm<true><<<dim3(D / 64, M / 64), 256, 0, stream>>>(Yf, (const float*)d_in[9], out, x, M, D, D);
#endif
#if STAGE <= 3
    k_rmsnorm<<<M / 4, 256, 0, stream>>>(out, (const float*)d_in[10], XN2f, M);
    for (int hf = 0; hf < 2; ++hf) {
        const int Mh = M / 2;
        k_gemm<false><<<dim3(2048 / 64, Mh / 64), 256, 0, stream>>>(XN2f + (size_t)hf * Mh * D, (const float*)d_in[11], Qh, nullptr, Mh, 2048, D);
        k_scores<<<Mh, 256, 0, stream>>>(Qh, (const float*)d_in[12], SCh);
        k_topk<<<Mh * 8, 64, 0, stream>>>(SCh, EIDX + (size_t)hf * Mh * 128, GATE + (size_t)hf * Mh * 128);
    }
    k_peer<<<M / 4, 256, 0, stream>>>(XN2f, EIDX, GATE, (const float*)d_in[13], (const float*)d_in[14], out, (const float*)d_in[15], out);
#endif
#if STAGE == 4
    float* XN2g = (float*)(ws + 160 * MiB);
    k_rmsnorm<<<M / 4, 256, 0, stream>>>(out, (const float*)d_in[10], XN2g, M);
    k_peer<<<M / 4, 256, 0, stream>>>(XN2g, (const int*)(ws + mk::WS_EIDX), (const float*)(ws + mk::WS_GATE), (const float*)d_in[13], (const float*)d_in[14], out, (const float*)d_in[15], out);
#endif
#endif
}
```

```cpp
#include <hip/hip_runtime.h>
#include <hip/hip_cooperative_groups.h>
#include <cstdio>
#include <cstdint>
#include <cmath>
#include <type_traits>
namespace cg = cooperative_groups;
namespace pg8 {
#define PG8_LAS __attribute__((address_space(3)))
typedef unsigned short bf16_t;
typedef short bf16x8 __attribute__((ext_vector_type(8)));
typedef float f32x4 __attribute__((ext_vector_type(4)));
typedef unsigned u32x4 __attribute__((ext_vector_type(4)));
constexpr int BM = 256, BK = 64, HALF = 128, HTB = HALF * BK * 2  , STAGE_BYTES = 8 * HTB, NXCD = 8, WGM = 8;

__host__ __device__ __forceinline__ int lds_byte(int r, int c) { const int st = (r >> 4) * 2 + (c >> 5), rr = r & 15, cc = c & 31, ob = rr * 64 + cc * 2; return st * 1024 + (ob ^ (((ob >> 9) & 1) << 5)); }
__host__ __device__ __forceinline__ void stage_rc(int b, int& R, int& C) { const int st = b / 1024, sb = b % 1024, swz = sb ^ (((sb >> 9) & 1) << 5); R = (st >> 1) * 16 + swz / 64; C = (st & 1) * 32 + (swz % 64) / 2; }
__host__ __device__ __forceinline__ int perm32(int rho) { const int n = rho >> 4, i = rho & 15; return 8 * (i >> 2) + 4 * n + (i & 3); }

struct Unit { int pm, pn; };
struct Gemm { const bf16_t* A; const bf16_t* Bt; int M, N, K; };

struct StaticOrder {
    int nM, nN, nwg, G, c;
    __host__ __device__ void init(int M, int N, int G_, int c_) { nM = M / BM; nN = N / BM; nwg = nM * nN; G = G_; c = c_; }
    __host__ __device__ bool next(int i, Unit& u) const {
        const long L = (long)i * G + c; if (L >= nwg) return false;
        int wgid = (int)L; { const int q = nwg / NXCD, r = nwg % NXCD, xcd = wgid % NXCD, off = wgid / NXCD; wgid = (xcd < r ? xcd * (q + 1) : r * (q + 1) + (xcd - r) * q) + off; }
        const int nig = WGM * nN, gid = wgid / nig, fm = gid * WGM, gsz = (nM - fm) < WGM ? (nM - fm) : WGM;
        u.pm = fm + ((wgid % nig) % gsz); u.pn = (wgid % nig) / gsz; return true;
    }
    __device__ __forceinline__ void a_ready(const Unit&) const {}
    __device__ __forceinline__ void done(const Unit&) const {}
};

__device__ __forceinline__ unsigned cvt_pk_bf16(float lo, float hi) { unsigned r; asm volatile("v_cvt_pk_bf16_f32 %0, %1, %2" : "=v"(r) : "v"(lo), "v"(hi)); return r; }
__device__ __forceinline__ int lane_id_v() { int l; asm volatile("v_mbcnt_lo_u32_b32 %0, -1, 0\n\tv_mbcnt_hi_u32_b32 %0, -1, %0" : "=v"(l)); return l; }
__device__ __forceinline__ float fsigmoid(float x) { return __builtin_amdgcn_rcpf(1.f + __builtin_amdgcn_exp2f(-1.4426950408889634f * x)); }

struct EpiProj {
    static constexpr bool PERM = true, AFTER_DRAIN = false;
    bf16_t* GLU; bf16_t* HG;
    static constexpr size_t MROWS = 32768;
    __device__ __forceinline__ void operator()(const f32x4 (&acc)[2][2][4][2], const Unit& u, int wr, int wc, int fr, int fq) const {
        const int row0 = u.pm * BM + wr * 64 + fr;
        if (u.pn < 4) {
            const int col = u.pn * 128 + wc * 32 + 8 * fq;
#pragma unroll
            for (int ai = 0; ai < 2; ++ai)
#pragma unroll
                for (int m = 0; m < 4; ++m) {
                    const f32x4 a0 = acc[ai][0][m][0], a1 = acc[ai][0][m][1], g0 = acc[ai][1][m][0], g1 = acc[ai][1][m][1];
                    u32x4 w;
                    w.x = cvt_pk_bf16(a0[0] * fsigmoid(g0[0]), a0[1] * fsigmoid(g0[1])); w.y = cvt_pk_bf16(a0[2] * fsigmoid(g0[2]), a0[3] * fsigmoid(g0[3]));
                    w.z = cvt_pk_bf16(a1[0] * fsigmoid(g1[0]), a1[1] * fsigmoid(g1[1])); w.w = cvt_pk_bf16(a1[2] * fsigmoid(g1[2]), a1[3] * fsigmoid(g1[3]));
                    *(u32x4*)(GLU + ((size_t)(col >> 6) * MROWS + (row0 + ai * HALF + m * 16)) * 64 + (col & 63)) = w;
                }
        } else {
            const int t = u.pn - 4;
            const bool act = (t < 2) || (t >= 6);
            const int col = t * 256 + wc * 32 + 8 * fq;
#pragma unroll
            for (int ai = 0; ai < 2; ++ai)
#pragma unroll
                for (int m = 0; m < 4; ++m) {
                    const int hcol = (t & 1) * 256 + wc * 32 + 8 * fq;
                    bf16_t* rowp = HG + ((size_t)((t >> 1) * 4 + (hcol >> 7)) * MROWS + (row0 + ai * HALF + m * 16)) * 128 + (hcol & 127);
#pragma unroll
                    for (int bj = 0; bj < 2; ++bj) {
                        f32x4 v0 = acc[ai][bj][m][0], v1 = acc[ai][bj][m][1];
                        if (act) {
#pragma unroll
                            for (int i = 0; i < 4; ++i) { v0[i] = v0[i] * fsigmoid(v0[i]); v1[i] = v1[i] * fsigmoid(v1[i]); }
                        }
                        u32x4 w; w.x = cvt_pk_bf16(v0[0], v0[1]); w.y = cvt_pk_bf16(v0[2], v0[3]); w.z = cvt_pk_bf16(v1[0], v1[1]); w.w = cvt_pk_bf16(v1[2], v1[3]);
                        *(u32x4*)(rowp + (size_t)bj * MROWS * 128) = w;
                    }
                }
        }
    }
};

struct EpiResBf16 {
    static constexpr bool PERM = true, AFTER_DRAIN = false;
    bf16_t* O; const float* R; float* SSQ;
    __device__ __forceinline__ void operator()(const f32x4 (&acc)[2][2][4][2], const Unit& u, int wr, int wc, int fr, int fq) const {
        const int row0 = u.pm * BM + wr * 64 + fr, col0 = u.pn * BM + wc * 32 + 8 * fq;
#pragma unroll
        for (int ai = 0; ai < 2; ++ai) {
            f32x4 rv[4][2][2];
#pragma unroll
            for (int m = 0; m < 4; ++m) { const size_t off = (size_t)(row0 + ai * HALF + m * 16) * 1024 + col0;
#pragma unroll
                for (int bj = 0; bj < 2; ++bj) { rv[m][bj][0] = *(const f32x4*)(R + off + bj * HALF); rv[m][bj][1] = *(const f32x4*)(R + off + bj * HALF + 4); } }
#pragma unroll
            for (int m = 0; m < 4; ++m) {
                const int row = row0 + ai * HALF + m * 16; const size_t off = (size_t)row * 1024 + col0;
                float ss = 0.f;
#pragma unroll
                for (int bj = 0; bj < 2; ++bj) {
                    const f32x4 v0 = acc[ai][bj][m][0] + rv[m][bj][0], v1 = acc[ai][bj][m][1] + rv[m][bj][1];
                    ss += (v0[0] * v0[0] + v0[1] * v0[1]) + (v0[2] * v0[2] + v0[3] * v0[3]) + (v1[0] * v1[0] + v1[1] * v1[1]) + (v1[2] * v1[2] + v1[3] * v1[3]);
                    u32x4 w; w.x = cvt_pk_bf16(v0[0], v0[1]); w.y = cvt_pk_bf16(v0[2], v0[3]); w.z = cvt_pk_bf16(v1[0], v1[1]); w.w = cvt_pk_bf16(v1[2], v1[3]);
                    *(u32x4*)(O + off + bj * HALF) = w;
                }
                ss += __shfl_xor(ss, 16); ss += __shfl_xor(ss, 32);
                if (fq == 0) SSQ[(size_t)row * 16 + u.pn * 4 + wc] = ss;
            }
        }
    }
};

__device__ __forceinline__ unsigned f2key(float f) { const unsigned u = __builtin_bit_cast(unsigned, f); return (u & 0x80000000u) ? ~u : (u | 0x80000000u); }
__device__ __forceinline__ float key2f(unsigned k) { const unsigned u = (k & 0x80000000u) ? (k & 0x7fffffffu) : ~k; return __builtin_bit_cast(float, u); }
__device__ __forceinline__ unsigned umax_(unsigned a, unsigned b) { return a > b ? a : b; }
__device__ __forceinline__ unsigned umin_(unsigned a, unsigned b) { return a < b ? a : b; }
__device__ __forceinline__ void sort16_desc(unsigned (&v)[16]) {
#pragma unroll
    for (int k = 2; k <= 16; k <<= 1)
#pragma unroll
        for (int j = k >> 1; j > 0; j >>= 1)
#pragma unroll
            for (int i = 0; i < 16; ++i) { const int l = i ^ j; if (l > i) { const unsigned hi = umax_(v[i], v[l]), lo = umin_(v[i], v[l]); if ((i & k) == 0) { v[i] = hi; v[l] = lo; } else { v[i] = lo; v[l] = hi; } } }
}
__device__ __forceinline__ void bmerge16_desc(unsigned (&v)[16]) {
#pragma unroll
    for (int j = 8; j > 0; j >>= 1)
#pragma unroll
        for (int i = 0; i < 16; ++i) { const int l = i ^ j; if (l > i) { const unsigned hi = umax_(v[i], v[l]), lo = umin_(v[i], v[l]); v[i] = hi; v[l] = lo; } }
}
struct EpiTopK {
    static constexpr bool PERM = false, AFTER_DRAIN = true;
    int* EIDX; float* GATE; const float* SSQ;
    __device__ __forceinline__ void fused(f32x4 (&acc)[2][2][4][2], const Unit& u, int wr, int wc, int fr, int fq, PG8_LAS unsigned char* lds, int wid, int lane) const {
        PG8_LAS unsigned* T = (PG8_LAS unsigned*)lds;
        PG8_LAS unsigned* LB = (PG8_LAS unsigned*)(lds + 131072);
        const int h = u.pn;
#pragma unroll
        for (int ai = 0; ai < 2; ++ai) {
            const int rl = wr * 64 + fr;
#pragma unroll
            for (int bj = 0; bj < 2; ++bj)
#pragma unroll
                for (int m = 0; m < 4; ++m)
#pragma unroll
                    for (int n = 0; n < 2; ++n)
#pragma unroll
                        for (int i = 0; i < 4; ++i) {
                            const int c = bj * 128 + wc * 32 + n * 16 + fq * 4 + i;
                            const float v = acc[ai][bj][m][n][i];
                            T[c * 128 + rl + m * 16] = (f2key(v) & ~127u) | (unsigned)(127 - (c & 127));
                        }
            asm volatile("s_waitcnt lgkmcnt(0)" ::: "memory"); __builtin_amdgcn_s_barrier(); asm volatile("" ::: "memory");
            {
                const int p = wid >> 2, q = (wid >> 1) & 1, r = (wid & 1) * 64 + lane, base = p * 128 + q * 64;
                unsigned run[16], grp[16];
#pragma unroll
                for (int j = 0; j < 16; ++j) run[j] = T[(base + j) * 128 + r];
                sort16_desc(run);
#pragma unroll
                for (int gI = 1; gI < 4; ++gI) {
#pragma unroll
                    for (int j = 0; j < 16; ++j) grp[j] = T[(base + 16 * gI + j) * 128 + r];
                    sort16_desc(grp);
#pragma unroll
                    for (int j = 0; j < 16; ++j) run[j] = umax_(run[j], grp[15 - j]);
                    bmerge16_desc(run);
                }
#pragma unroll
                for (int j = 0; j < 16; ++j) LB[((p * 2 + q) * 16 + j) * 128 + r] = run[j];
            }
            asm volatile("s_waitcnt lgkmcnt(0)" ::: "memory"); __builtin_amdgcn_s_barrier(); asm volatile("" ::: "memory");
            if (wid < 4) {
                const int p = wid >> 1, r = (wid & 1) * 64 + lane;
                unsigned a[16];
#pragma unroll
                for (int j = 0; j < 16; ++j) a[j] = umax_(LB[((p * 2) * 16 + j) * 128 + r], LB[((p * 2 + 1) * 16 + (15 - j)) * 128 + r]);
                bmerge16_desc(a);
#pragma unroll
                for (int j = 0; j < 16; ++j) LB[((p * 2) * 16 + j) * 128 + r] = a[j];
            }
            asm volatile("s_waitcnt lgkmcnt(0)" ::: "memory"); __builtin_amdgcn_s_barrier(); asm volatile("" ::: "memory");
            if (wid < 2) {
                const int r = wid * 64 + lane;
                float v1[16], v2[16];
#pragma unroll
                for (int j = 0; j < 16; ++j) { v1[j] = key2f(LB[j * 128 + r] & ~127u); v2[j] = key2f(LB[(32 + j) * 128 + r] & ~127u); }
                unsigned lst[16];
#pragma unroll
                for (int j = 0; j < 16; ++j) lst[j] = (f2key(v1[0] + v2[j]) & ~255u) | (unsigned)(255 - j);
#pragma unroll
                for (int i = 1; i < 16; ++i)
#pragma unroll
                    for (int j = 0; j < 16; ++j) if ((i + 1) * (j + 1) <= 16) {
                        unsigned x = (f2key(v1[i] + v2[j]) & ~255u) | (unsigned)(255 - (i * 16 + j));
#pragma unroll
                        for (int t = 0; t < 16; ++t) if (t >= (i + 1) * (j + 1) - 1) { const unsigned hi = umax_(lst[t], x); x = umin_(lst[t], x); lst[t] = hi; }
                    }
                float rstd;
                { const f32x4* sq = (const f32x4*)(SSQ + (size_t)(u.pm * BM + ai * 128 + r) * 16); const f32x4 q0 = sq[0], q1 = sq[1], q2 = sq[2], q3 = sq[3];
                  const float tot = ((q0[0] + q0[1]) + (q0[2] + q0[3])) + ((q1[0] + q1[1]) + (q1[2] + q1[3])) + ((q2[0] + q2[1]) + (q2[2] + q2[3])) + ((q3[0] + q3[1]) + (q3[2] + q3[3]));
                  rstd = rsqrtf(tot * (1.f / 1024.f) + 1e-6f); }
                float e[16]; float sum = 0.f; const float mx = key2f(lst[0] & ~255u);
                int ex[16];
#pragma unroll
                for (int t = 0; t < 16; ++t) {
                    e[t] = __expf((key2f(lst[t] & ~255u) - mx) * rstd); sum += e[t];
                    const int ci = 255 - (int)(lst[t] & 255u), a = ci >> 4, b = ci & 15;
                    const int i1 = 127 - (int)(LB[a * 128 + r] & 127u), i2 = 127 - (int)(LB[(32 + b) * 128 + r] & 127u);
                    ex[t] = i1 * 128 + i2;
                }
                const float inv = 1.f / sum;
                const size_t o = (size_t)(u.pm * BM + ai * 128 + r) * 128 + h * 16;
#pragma unroll
                for (int t4 = 0; t4 < 4; ++t4) {
                    *(f32x4*)(GATE + o + 4 * t4) = (f32x4){e[4 * t4] * inv, e[4 * t4 + 1] * inv, e[4 * t4 + 2] * inv, e[4 * t4 + 3] * inv};
                    *(u32x4*)(EIDX + o + 4 * t4) = (u32x4){(unsigned)ex[4 * t4], (unsigned)ex[4 * t4 + 1], (unsigned)ex[4 * t4 + 2], (unsigned)ex[4 * t4 + 3]};
                }
            }
            asm volatile("s_waitcnt lgkmcnt(0)" ::: "memory"); __builtin_amdgcn_s_barrier(); asm volatile("" ::: "memory");
        }
    }
};
struct OneUnit {
    Unit u;
    __device__ __forceinline__ bool next(int i, Unit& o) const { if (i) return false; o = u; return true; }
    __device__ __forceinline__ void a_ready(const Unit&) const {}
    __device__ __forceinline__ void done(const Unit&) const {}
};

template <class Epi, class Sched, bool ALIGN_EPI = false, bool SP2 = false>
__device__ __forceinline__ void gemm_phase(PG8_LAS unsigned char* lds, const Gemm g, const Sched& S, const Epi& E, const int wid) {
    const int lane = lane_id_v(), tid = wid * 64 + lane, wr = wid >> 2, wc = wid & 3, fr = lane & 15, fq = lane >> 4;
    const int K = g.K, nt = K / BK;
    unsigned voffA[2], voffB[2];
#pragma unroll
    for (int i = 0; i < 2; ++i) { int R, C; stage_rc(tid * 16 + i * 8192, R, C); const int Rb = Epi::PERM ? ((R & ~31) + perm32(R & 31)) : R;
        voffA[i] = (unsigned)(R * K + C) * 2u; voffB[i] = (unsigned)(Rb * K + C) * 2u; }
    const size_t kstep = (size_t)(BK * 2);
    const size_t hstep = (size_t)HALF * K * 2;
    const size_t tstep = 2 * hstep;
    const unsigned ldsw = (unsigned)wid * 1024u;
    const int aoff = lds_byte(wr * 64 + fr, fq * 8), boff = lds_byte(wc * 32 + fr, fq * 8);
#define PG8_SA(b, h) (((b) * 2 + (h)) * HTB)
#define PG8_SB(b, h) ((4 + (b) * 2 + (h)) * HTB)
#define PG8_STAGE(bufoff, gbase, voff) do { _Pragma("unroll") for (int _i = 0; _i < 2; ++_i) \
        __builtin_amdgcn_global_load_lds((const unsigned*)((const char*)(gbase) + (voff)[_i]), (PG8_LAS unsigned*)(lds + (bufoff) + ldsw + _i * 8192), 16, 0, 0); } while (0)
#define PG8_LDA(dst, b, h) do { _Pragma("unroll") for (int m = 0; m < 4; ++m) _Pragma("unroll") for (int k = 0; k < 2; ++k) dst[m][k] = *(const PG8_LAS bf16x8*)(lds + PG8_SA(b, h) + aoff + m * 2048 + k * 1024); } while (0)
#define PG8_LDB(dst, b, h) do { _Pragma("unroll") for (int n = 0; n < 2; ++n) _Pragma("unroll") for (int k = 0; k < 2; ++k) dst[n][k] = *(const PG8_LAS bf16x8*)(lds + PG8_SB(b, h) + boff + n * 2048 + k * 1024); } while (0)
#define PG8_MMA(ai, bj, At, Bt) do { __builtin_amdgcn_s_setprio(1); _Pragma("unroll") for (int m = 0; m < 4; ++m) _Pragma("unroll") for (int n = 0; n < 2; ++n) _Pragma("unroll") for (int k = 0; k < 2; ++k) \
        acc[ai][bj][m][n] = __builtin_amdgcn_mfma_f32_16x16x32_bf16(Bt[n][k], At[m][k], acc[ai][bj][m][n], 0, 0, 0); __builtin_amdgcn_s_setprio(0); } while (0)
#define PG8_WAIT_V(n) asm volatile("s_waitcnt vmcnt(" #n ")" ::: "memory")
#define PG8_WAIT_L(n) asm volatile("s_waitcnt lgkmcnt(" #n ")" ::: "memory")
#define PG8_BAR __builtin_amdgcn_s_barrier()
#define PG8_SCHED __builtin_amdgcn_sched_barrier(0)
    Unit cur, nxt; int ui = 0;
    if (!S.next(0, cur)) return;
    f32x4 acc[2][2][4][2];
#pragma unroll
    for (int a = 0; a < 2; ++a)
#pragma unroll
        for (int b = 0; b < 2; ++b)
#pragma unroll
            for (int m = 0; m < 4; ++m)
#pragma unroll
                for (int n = 0; n < 2; ++n) acc[a][b][m][n] = (f32x4){0.f, 0.f, 0.f, 0.f};
    bf16x8 At[4][2], B0[2][2], B1[2][2];
    const char* cA = (const char*)g.A + (size_t)cur.pm * tstep; const char* cB = (const char*)g.Bt + (size_t)cur.pn * tstep;
    S.a_ready(cur);
    if constexpr (SP2) {
        PG8_STAGE(PG8_SB(0, 0), cB, voffB); PG8_STAGE(PG8_SB(0, 1), cB + hstep, voffB); PG8_STAGE(PG8_SA(0, 0), cA, voffA); PG8_STAGE(PG8_SA(0, 1), cA + hstep, voffA);
        if (wr == 1) PG8_BAR;
        PG8_WAIT_V(2); PG8_BAR;
        PG8_STAGE(PG8_SB(1, 0), cB + kstep, voffB); PG8_STAGE(PG8_SA(1, 0), cA + kstep, voffA); PG8_STAGE(PG8_SB(1, 1), cB + hstep + kstep, voffB);
        PG8_WAIT_V(6); PG8_BAR;
    } else {
        PG8_STAGE(PG8_SB(0, 0), cB, voffB); PG8_STAGE(PG8_SA(0, 0), cA, voffA); PG8_STAGE(PG8_SB(0, 1), cB + hstep, voffB); PG8_STAGE(PG8_SA(0, 1), cA + hstep, voffA);
        if (wr == 1) PG8_BAR;
        PG8_WAIT_V(4); PG8_BAR;
        PG8_STAGE(PG8_SB(1, 0), cB + kstep, voffB); PG8_STAGE(PG8_SA(1, 0), cA + kstep, voffA); PG8_STAGE(PG8_SB(1, 1), cB + hstep + kstep, voffB);
        PG8_WAIT_V(6); PG8_BAR;
    }
    for (;;) {
        const bool has_next = S.next(ui + 1, nxt);
        const char* nA = has_next ? (const char*)g.A + (size_t)nxt.pm * tstep : cA; const char* nB = has_next ? (const char*)g.Bt + (size_t)nxt.pn * tstep : cB;
        for (int t = 0; t < nt; t += 2) {
            const bool last = (t == nt - 2);
            const char* a1 = cA + (size_t)(t + 1) * kstep;
            const char* a2 = last ? nA : cA + (size_t)(t + 2) * kstep; const char* b2 = last ? nB : cB + (size_t)(t + 2) * kstep;
            const char* a3 = a2 + kstep; const char* b3 = b2 + kstep;
            if (last && has_next) S.a_ready(nxt);
            if constexpr (SP2) {
            PG8_LDB(B0, 0, 0); PG8_LDB(B1, 0, 1); PG8_SCHED; PG8_LDA(At, 0, 0); PG8_STAGE(PG8_SA(1, 1), a1 + hstep, voffA);
            PG8_WAIT_V(8); PG8_WAIT_L(0); PG8_BAR; PG8_MMA(0, 0, At, B0); PG8_MMA(0, 1, At, B1); PG8_BAR; PG8_SCHED;
            PG8_LDA(At, 0, 1); PG8_STAGE(PG8_SB(0, 0), b2, voffB); PG8_STAGE(PG8_SB(0, 1), b2 + hstep, voffB); PG8_STAGE(PG8_SA(0, 0), a2, voffA);
            PG8_WAIT_V(8); PG8_WAIT_L(0); PG8_BAR; PG8_MMA(1, 0, At, B0); PG8_MMA(1, 1, At, B1); PG8_BAR; PG8_SCHED;
            PG8_LDB(B0, 1, 0); PG8_LDB(B1, 1, 1); PG8_SCHED; PG8_LDA(At, 1, 0); PG8_STAGE(PG8_SA(0, 1), a2 + hstep, voffA);
            PG8_WAIT_V(8); PG8_WAIT_L(0); PG8_BAR; PG8_MMA(0, 0, At, B0); PG8_MMA(0, 1, At, B1); PG8_BAR; PG8_SCHED;
            PG8_LDA(At, 1, 1); PG8_STAGE(PG8_SB(1, 0), b3, voffB); PG8_STAGE(PG8_SB(1, 1), b3 + hstep, voffB); PG8_STAGE(PG8_SA(1, 0), a3, voffA);
            PG8_WAIT_V(8); PG8_WAIT_L(0); PG8_BAR; PG8_MMA(1, 0, At, B0); PG8_MMA(1, 1, At, B1); PG8_BAR; PG8_SCHED;
            } else {
            PG8_LDB(B0, 0, 0); PG8_SCHED; PG8_LDA(At, 0, 0); PG8_STAGE(PG8_SA(1, 1), a1 + hstep, voffA);
            PG8_WAIT_L(8); PG8_BAR; PG8_WAIT_L(0); PG8_MMA(0, 0, At, B0); PG8_BAR; PG8_SCHED;
            PG8_LDB(B1, 0, 1); PG8_STAGE(PG8_SB(0, 0), b2, voffB);
            PG8_BAR; PG8_WAIT_L(0); PG8_MMA(0, 1, At, B1); PG8_BAR;
            PG8_LDA(At, 0, 1); PG8_STAGE(PG8_SA(0, 0), a2, voffA);
            PG8_BAR; PG8_WAIT_L(0); PG8_MMA(1, 0, At, B0); PG8_BAR; PG8_SCHED;
            PG8_STAGE(PG8_SB(0, 1), b2 + hstep, voffB);
            PG8_WAIT_V(6); PG8_BAR; PG8_MMA(1, 1, At, B1); PG8_BAR;
            PG8_LDB(B0, 1, 0); PG8_SCHED; PG8_LDA(At, 1, 0); PG8_STAGE(PG8_SA(0, 1), a2 + hstep, voffA);
            PG8_WAIT_L(8); PG8_BAR; PG8_WAIT_L(0); PG8_MMA(0, 0, At, B0); PG8_BAR; PG8_SCHED;
            PG8_LDB(B1, 1, 1); PG8_STAGE(PG8_SB(1, 0), b3, voffB);
            PG8_BAR; PG8_WAIT_L(0); PG8_MMA(0, 1, At, B1); PG8_BAR;
            PG8_LDA(At, 1, 1); PG8_STAGE(PG8_SA(1, 0), a3, voffA);
            PG8_BAR; PG8_WAIT_L(0); PG8_MMA(1, 0, At, B0); PG8_BAR; PG8_SCHED;
            PG8_STAGE(PG8_SB(1, 1), b3 + hstep, voffB);
            PG8_WAIT_V(6); PG8_BAR; PG8_MMA(1, 1, At, B1); PG8_BAR;
            }
        }
        if constexpr (ALIGN_EPI) { if (wr == 0) PG8_BAR; }
        if constexpr (!Epi::AFTER_DRAIN) { E(acc, cur, wr, wc, fr, fq); S.done(cur); }
        if (!has_next) break;
#pragma unroll
        for (int a = 0; a < 2; ++a)
#pragma unroll
            for (int b = 0; b < 2; ++b)
#pragma unroll
                for (int m = 0; m < 4; ++m)
#pragma unroll
                    for (int n = 0; n < 2; ++n) acc[a][b][m][n] = (f32x4){0.f, 0.f, 0.f, 0.f};
        cur = nxt; cA = nA; cB = nB; ++ui;
        if constexpr (ALIGN_EPI) { if (wr == 1) PG8_BAR; }
    }
    PG8_WAIT_V(0);
    if constexpr (!ALIGN_EPI) { if (wr == 0) PG8_BAR; }
    PG8_BAR;
    if constexpr (Epi::AFTER_DRAIN) { E.fused(acc, cur, wr, wc, fr, fq, lds, wid, lane); S.done(cur); }
#undef PG8_SA
#undef PG8_SB
#undef PG8_STAGE
#undef PG8_LDA
#undef PG8_LDB
#undef PG8_MMA
#undef PG8_WAIT_V
#undef PG8_WAIT_L
#undef PG8_BAR
#undef PG8_SCHED
}
}

namespace mk {
using pg8::bf16_t; using pg8::bf16x8; using pg8::f32x4; using pg8::u32x4; using pg8::cvt_pk_bf16; using pg8::fsigmoid;
#define LAS __attribute__((address_space(3)))
typedef unsigned u32x2 __attribute__((ext_vector_type(2)));
typedef float f32x2 __attribute__((ext_vector_type(2)));
typedef short bf16x4 __attribute__((ext_vector_type(4)));
constexpr int NWAVES = 8, NT = 512;
constexpr int D = 1024, BATCH = 8, SEQ = 4096, M = BATCH * SEQ, DCONV = 512, CW = 31, DH = 512, NH = 4, HD = 128, DIN = 3072, NQ = 2048, NEXP = 16384;
constexpr int SEGS = 8, SEGLEN = SEQ / SEGS, NCH = SEGLEN / 64;
constexpr float EPS = 1e-6f;
constexpr size_t MiB = 1u << 20;
constexpr size_t WS_WIN = 2 * MiB, WS_WOUT = 8 * MiB, WS_WEFF = 10 * MiB, WS_HS = 14 * MiB, WS_HLD = 30 * MiB, WS_USC = 31 * MiB, WS_VSC = 31 * MiB + 65536, WS_SSQ = 48 * MiB, WS_U = 32 * MiB, WS_V = 64 * MiB, WS_XN = 96 * MiB,
                 WS_GLU = 160 * MiB, WS_HG = 192 * MiB, WS_Y = 320 * MiB, WS_EIDX = 416 * MiB, WS_GATE = 432 * MiB, WS_END = 448 * MiB;
constexpr int LDS_BYTES = 163840;
#ifndef PEER_V4_DEF
#define PEER_V4_DEF true
#endif
constexpr bool PEER_V4 = PEER_V4_DEF;
#ifndef U_NIBSWAP_DEF
#define U_NIBSWAP_DEF false
#endif
constexpr bool U_NIBSWAP = U_NIBSWAP_DEF;

#define LDS_WAIT() asm volatile("s_waitcnt lgkmcnt(0)" ::: "memory")
#define BLOCK_BAR() do { asm volatile("s_waitcnt lgkmcnt(0)" ::: "memory"); __builtin_amdgcn_s_barrier(); asm volatile("" ::: "memory"); } while (0)
__device__ __forceinline__ float wave_sum(float v) {
#pragma unroll
    for (int o = 1; o < 64; o <<= 1) v += __shfl_xor(v, o);
    return v;
}
__device__ __forceinline__ float wave_sum_dpp(float v) {
    v += __builtin_bit_cast(float, __builtin_amdgcn_update_dpp(0, __builtin_bit_cast(int, v), 0x111, 0xf, 0xf, false));
    v += __builtin_bit_cast(float, __builtin_amdgcn_update_dpp(0, __builtin_bit_cast(int, v), 0x112, 0xf, 0xf, false));
    v += __builtin_bit_cast(float, __builtin_amdgcn_update_dpp(0, __builtin_bit_cast(int, v), 0x114, 0xf, 0xf, false));
    v += __builtin_bit_cast(float, __builtin_amdgcn_update_dpp(0, __builtin_bit_cast(int, v), 0x118, 0xf, 0xf, false));
    v += __builtin_bit_cast(float, __builtin_amdgcn_update_dpp(0, __builtin_bit_cast(int, v), 0x142, 0xa, 0xf, false));
    v += __builtin_bit_cast(float, __builtin_amdgcn_update_dpp(0, __builtin_bit_cast(int, v), 0x143, 0xc, 0xf, false));
    return __builtin_bit_cast(float, __builtin_amdgcn_readlane(__builtin_bit_cast(int, v), 63));
}
__device__ __forceinline__ float wave_max_dpp(float v) {
    v = fmaxf(v, __builtin_bit_cast(float, __builtin_amdgcn_update_dpp(0, __builtin_bit_cast(int, v), 0x111, 0xf, 0xf, false)));
    v = fmaxf(v, __builtin_bit_cast(float, __builtin_amdgcn_update_dpp(0, __builtin_bit_cast(int, v), 0x112, 0xf, 0xf, false)));
    v = fmaxf(v, __builtin_bit_cast(float, __builtin_amdgcn_update_dpp(0, __builtin_bit_cast(int, v), 0x114, 0xf, 0xf, false)));
    v = fmaxf(v, __builtin_bit_cast(float, __builtin_amdgcn_update_dpp(0, __builtin_bit_cast(int, v), 0x118, 0xf, 0xf, false)));
    v = fmaxf(v, __builtin_bit_cast(float, __builtin_amdgcn_update_dpp(0, __builtin_bit_cast(int, v), 0x142, 0xa, 0xf, false)));
    v = fmaxf(v, __builtin_bit_cast(float, __builtin_amdgcn_update_dpp(0, __builtin_bit_cast(int, v), 0x143, 0xc, 0xf, false)));
    return __builtin_bit_cast(float, __builtin_amdgcn_readlane(__builtin_bit_cast(int, v), 63));
}
__device__ __forceinline__ float bf_lo(unsigned u) { return __builtin_bit_cast(float, u << 16); }
__device__ __forceinline__ float bf_hi(unsigned u) { return __builtin_bit_cast(float, u & 0xffff0000u); }
__device__ __forceinline__ float bf1(bf16_t u) { return __builtin_bit_cast(float, (unsigned)u << 16); }
__device__ __forceinline__ float fsilu(float x) { return x * fsigmoid(x); }

struct Args { const float* in[16]; float* out; unsigned char* ws; int ph_lo, ph_hi; };

__device__ __forceinline__ void p0_transpose_item(const float* __restrict__ W, int K, int N, bf16_t* __restrict__ WT, int out_row0, const float* __restrict__ gk, LAS float* scr, int k0, int n0, int lane) {
#pragma unroll 8
    for (int i = 0; i < 32; ++i) { const int kk = 2 * i + (lane >> 5); const float s = gk ? gk[k0 + kk] : 1.f; scr[kk * 33 + (lane & 31)] = W[(size_t)(k0 + kk) * N + n0 + (lane & 31)] * s; }
    LDS_WAIT();
    const int c = lane & 7;
#pragma unroll
    for (int j = 0; j < 4; ++j) { const int n = (lane >> 3) + 8 * j; const LAS float* s = scr + (8 * c) * 33 + n;
        u32x4 o; o.x = cvt_pk_bf16(s[0 * 33], s[1 * 33]); o.y = cvt_pk_bf16(s[2 * 33], s[3 * 33]); o.z = cvt_pk_bf16(s[4 * 33], s[5 * 33]); o.w = cvt_pk_bf16(s[6 * 33], s[7 * 33]);
        *(u32x4*)(WT + (size_t)(out_row0 + n) * K + k0 + 8 * c) = o; }
    LDS_WAIT();
}
__device__ __forceinline__ void row_to_bf16(const float* __restrict__ src, bf16_t* __restrict__ dst, const float* __restrict__ gv, bool norm, int lane) {
    const f32x4* xr = (const f32x4*)src + lane;
    f32x4 v[4]; float s = 0.f;
#pragma unroll
    for (int j = 0; j < 4; ++j) { v[j] = xr[64 * j]; s += (v[j].x * v[j].x + v[j].y * v[j].y) + (v[j].z * v[j].z + v[j].w * v[j].w); }
    float r = 1.f;
    if (norm) r = rsqrtf(wave_sum(s) * (1.f / D) + EPS);
    u32x2* o8 = (u32x2*)dst + lane;
#pragma unroll
    for (int j = 0; j < 4; ++j) {
        f32x4 t = v[j] * r;
        if (gv) t = t * ((const f32x4*)gv)[lane + 64 * j];
        u32x2 w; w.x = cvt_pk_bf16(t.x, t.y); w.y = cvt_pk_bf16(t.z, t.w); o8[64 * j] = w;
    }
}
__device__ __forceinline__ void row_to_fp8(const float* __restrict__ src, unsigned char* __restrict__ dst, const float* __restrict__ gv, float sc, int lane) {
    const f32x4* xr = (const f32x4*)src + lane;
    unsigned* o4 = (unsigned*)dst + lane;
#pragma unroll
    for (int j = 0; j < 4; ++j) {
        f32x4 t = xr[64 * j] * sc;
        if (gv) t = t * ((const f32x4*)gv)[lane + 64 * j];
        int w = __builtin_amdgcn_cvt_pk_fp8_f32(t.x, t.y, 0, false); w = __builtin_amdgcn_cvt_pk_fp8_f32(t.z, t.w, w, true);
        o4[64 * j] = (unsigned)w;
    }
}
template <int MODE>
__device__ __forceinline__ void rows_convert(const float* __restrict__ src, unsigned char* __restrict__ dst, const float* __restrict__ gv, float sc, int nrows, int gw, int NGW, int lane) {
    if (nrows % (4 * NGW) != 0) {
        for (int r = gw; r < nrows; r += NGW) { if (MODE == 0) row_to_bf16(src + (size_t)r * D, (bf16_t*)dst + (size_t)r * D, nullptr, true, lane); else row_to_fp8(src + (size_t)r * D, dst + (size_t)r * D, MODE == 1 ? gv : nullptr, sc, lane); }
        return;
    }
    f32x4 gq[4];
    if (MODE == 1) {
#pragma unroll
        for (int j = 0; j < 4; ++j) gq[j] = ((const f32x4*)gv)[lane + 64 * j] * sc;
    }
    for (int r = gw; r < nrows; r += 4 * NGW) {
        f32x4 v[4][4];
#pragma unroll
        for (int k = 0; k < 4; ++k)
#pragma unroll
            for (int j = 0; j < 4; ++j) v[k][j] = ((const f32x4*)(src + (size_t)(r + k * NGW) * D))[lane + 64 * j];
#pragma unroll
        for (int k = 0; k < 4; ++k) {
            if (MODE == 0) {
                float s = 0.f;
#pragma unroll
                for (int j = 0; j < 4; ++j) s += (v[k][j].x * v[k][j].x + v[k][j].y * v[k][j].y) + (v[k][j].z * v[k][j].z + v[k][j].w * v[k][j].w);
                const float rr = rsqrtf(wave_sum(s) * (1.f / D) + EPS);
                u32x2* o8 = (u32x2*)((bf16_t*)dst + (size_t)(r + k * NGW) * D) + lane;
#pragma unroll
                for (int j = 0; j < 4; ++j) { const f32x4 t = v[k][j] * rr; u32x2 w; w.x = cvt_pk_bf16(t.x, t.y); w.y = cvt_pk_bf16(t.z, t.w); o8[64 * j] = w; }
            } else {
                unsigned* o4 = (unsigned*)(dst + (size_t)(r + k * NGW) * D) + lane;
#pragma unroll
                for (int j = 0; j < 4; ++j) { const f32x4 t = (MODE == 1) ? v[k][j] * gq[j] : v[k][j] * sc;
                    int w = __builtin_amdgcn_cvt_pk_fp8_f32(t.x, t.y, 0, false); w = __builtin_amdgcn_cvt_pk_fp8_f32(t.z, t.w, w, true); o4[64 * j] = (unsigned)w; }
            }
        }
    }
}
template <bool FP4, bool NATURAL = false, bool NIBSWAP = false>
__device__ __forceinline__ void rows_quant(const float* __restrict__ src, unsigned char* __restrict__ dst, float* __restrict__ scales, const float* __restrict__ gv, int nrows, int gw, int NGW, int lane) {
    f32x4 gq[4];
#pragma unroll
    for (int j = 0; j < 4; ++j) gq[j] = gv ? ((const f32x4*)gv)[NATURAL ? 4 * lane + j : lane + 64 * j] : (f32x4){1.f, 1.f, 1.f, 1.f};
    for (int r0 = gw; r0 < nrows; r0 += 4 * NGW) {
        f32x4 v[4][4];
#pragma unroll
        for (int k = 0; k < 4; ++k) { const int r = (r0 + k * NGW < nrows) ? r0 + k * NGW : r0;
#pragma unroll
            for (int j = 0; j < 4; ++j) v[k][j] = ((const f32x4*)(src + (size_t)r * D))[NATURAL ? 4 * lane + j : lane + 64 * j] * gq[j]; }
#pragma unroll
        for (int k = 0; k < 4; ++k) {
            const int r = r0 + k * NGW; if (r >= nrows) break;
            float am = 0.f;
#pragma unroll
            for (int j = 0; j < 4; ++j) am = fmaxf(am, fmaxf(fmaxf(fabsf(v[k][j].x), fabsf(v[k][j].y)), fmaxf(fabsf(v[k][j].z), fabsf(v[k][j].w))));
            am = wave_max_dpp(am);
            const float fmx = FP4 ? 6.f : 240.f;
            const float sc = am > 0.f ? am * (1.f / fmx) : 1.f, inv = am > 0.f ? fmx / am : 1.f;
            if (lane == 0) scales[r] = sc;
            if constexpr (FP4) {
                unsigned w0 = 0u, w1 = 0u;
                { const f32x4 t0 = v[k][0] * inv, t1 = v[k][1] * inv, t2 = v[k][2] * inv, t3 = v[k][3] * inv;
#define Q4(wd, a_, b_, sel) wd = NIBSWAP ? __builtin_amdgcn_cvt_scalef32_pk_fp4_f32(wd, b_, a_, 1.0f, sel) : __builtin_amdgcn_cvt_scalef32_pk_fp4_f32(wd, a_, b_, 1.0f, sel)
                  Q4(w0, t0.x, t0.y, 0); Q4(w0, t0.z, t0.w, 1); Q4(w0, t1.x, t1.y, 2); Q4(w0, t1.z, t1.w, 3);
                  Q4(w1, t2.x, t2.y, 0); Q4(w1, t2.z, t2.w, 1); Q4(w1, t3.x, t3.y, 2); Q4(w1, t3.z, t3.w, 3);
#undef Q4
                }
                ((u32x2*)(dst + (size_t)r * 512))[NATURAL ? lane : 2 * (lane & 31) + (lane >> 5)] = (u32x2){w0, w1};
            } else {
                u32x4 w;
#pragma unroll
                for (int j = 0; j < 4; ++j) { const f32x4 t = v[k][j] * inv; int q = __builtin_amdgcn_cvt_pk_fp8_f32(t.x, t.y, 0, false); q = __builtin_amdgcn_cvt_pk_fp8_f32(t.z, t.w, q, true); w[j] = (unsigned)q; }
                ((u32x4*)(dst + (size_t)r * 1024))[lane] = w;
            }
        }
    }
}
__device__ __forceinline__ void weff_unit(LAS unsigned char* lds, const float* __restrict__ wq, const float* __restrict__ sk, const float* __restrict__ g2, bf16_t* __restrict__ WE, int unit, int tid) {
    LAS float* SK = (LAS float*)lds;
    LAS float* WQ = (LAS float*)(lds + 128 * 129 * 4);
    const int hp = unit >> 5, d0 = (unit & 31) * 32;
#pragma unroll 4
    for (int i = 0; i < 32; ++i) { const int idx = tid + i * NT; SK[(idx >> 7) * 129 + (idx & 127)] = sk[(size_t)hp * 16384 + idx]; }
#pragma unroll
    for (int i = 0; i < 8; ++i) { const int idx = tid + i * NT; WQ[idx] = wq[(size_t)(d0 + (idx >> 7)) * NQ + hp * 128 + (idx & 127)]; }
    __syncthreads();
    const int n = tid & 127, dq = tid >> 7;
    float acc[8];
#pragma unroll
    for (int e = 0; e < 8; ++e) acc[e] = 0.f;
    for (int j4 = 0; j4 < 32; ++j4) {
        float s[4];
#pragma unroll
        for (int q = 0; q < 4; ++q) s[q] = SK[n * 129 + 4 * j4 + q];
#pragma unroll
        for (int e = 0; e < 8; ++e) { const f32x4 w = *(const LAS f32x4*)(WQ + (dq * 8 + e) * 128 + 4 * j4); acc[e] = fmaf(s[0], w.x, acc[e]); acc[e] = fmaf(s[1], w.y, acc[e]); acc[e] = fmaf(s[2], w.z, acc[e]); acc[e] = fmaf(s[3], w.w, acc[e]); }
    }
    const float* gp = g2 + d0 + dq * 8;
    u32x4 o; o.x = cvt_pk_bf16(acc[0] * gp[0], acc[1] * gp[1]); o.y = cvt_pk_bf16(acc[2] * gp[2], acc[3] * gp[3]); o.z = cvt_pk_bf16(acc[4] * gp[4], acc[5] * gp[5]); o.w = cvt_pk_bf16(acc[6] * gp[6], acc[7] * gp[7]);
    *(u32x4*)(WE + (size_t)(hp * 128 + n) * D + d0 + dq * 8) = o;
    __syncthreads();
}
__device__ __forceinline__ void p0_prologue(const Args& a, LAS unsigned char* lds, int tid, int lane, int wave, int G) {
    unsigned char* ws = a.ws;
    for (int u = blockIdx.x; u < 512; u += G) weff_unit(lds, a.in[11], a.in[12], a.in[10], (bf16_t*)(ws + WS_WEFF), u, tid);
    LAS float* scr = (LAS float*)(lds + wave * 16384);
    const int gw = blockIdx.x * NWAVES + wave, NGW = G * NWAVES;
    constexpr int I_IN = (D / 64) * (DIN / 32), I_OUT = (D / 64) * (D / 32);
    for (int it = gw; it < I_IN + I_OUT; it += NGW) {
        if (it < I_IN) {
            const int kb = it / (DIN / 32), nb = it % (DIN / 32), n0 = nb * 32;
            int r0;
            if (n0 < 512) r0 = 256 * (n0 >> 7) + (n0 & 127); else if (n0 < 1024) r0 = 256 * ((n0 - 512) >> 7) + 128 + ((n0 - 512) & 127); else r0 = n0;
            p0_transpose_item(a.in[2], D, DIN, (bf16_t*)(ws + WS_WIN), r0, a.in[1], scr, kb * 64, n0, lane);
        } else {
            const int r = it - I_IN, kb = r / (D / 32), nb = r % (D / 32);
            p0_transpose_item(a.in[9], D, D, (bf16_t*)(ws + WS_WOUT), nb * 32, nullptr, scr, kb * 64, nb * 32, lane);
        }
    }
    rows_quant<true, true, U_NIBSWAP>(a.in[13], ws + WS_U, (float*)(ws + WS_USC), a.in[10], NEXP, gw, NGW, lane);
    rows_quant<PEER_V4>(a.in[14], ws + WS_V, (float*)(ws + WS_VSC), nullptr, NEXP, gw, NGW, lane);
    rows_convert<0>(a.in[0], ws + WS_XN, nullptr, 1.f, M, gw, NGW, lane);
}

__device__ __forceinline__ void conv_wave_unit(const bf16_t* __restrict__ GLU, const float* __restrict__ cw, const float* __restrict__ cb, const float* __restrict__ ng, const float* __restrict__ nb,
                                               bf16_t* __restrict__ Y, int wu, int lane) {
    const int grp = wu & 7, tb = wu >> 3, b = tb >> 5, s0 = (tb & 31) * 128, c = grp * 64 + lane;
    float w[CW];
#pragma unroll
    for (int j = 0; j < CW; ++j) w[j] = cw[j * DCONV + c];
    const float bias = cb[c], gam = ng[c], bet = nb[c];
    const size_t rowb = (size_t)b * SEQ;
    const bf16_t* GLUp = GLU + (size_t)grp * M * 64 + lane;
    float win[38];
#pragma unroll
    for (int i = 0; i < 30; ++i) { const int s = s0 - 30 + i; win[i] = (s >= 0) ? bf1(GLUp[(rowb + s) * 64]) : 0.f; }
    bf16_t nx[8];
#pragma unroll
    for (int i = 0; i < 8; ++i) nx[i] = GLUp[(rowb + s0 + i) * 64];
#pragma unroll 1
    for (int it = 0; it < 16; ++it) {
        const int s = s0 + it * 8;
#pragma unroll
        for (int i = 0; i < 8; ++i) win[30 + i] = bf1(nx[i]);
        const int sn = (it < 15) ? s + 8 : s;
#pragma unroll
        for (int i = 0; i < 8; ++i) nx[i] = GLUp[(rowb + sn + i) * 64];
        float acc[8];
#pragma unroll
        for (int i = 0; i < 8; ++i) {
            float t = bias;
#pragma unroll
            for (int j = 0; j < CW; ++j) t = fmaf(w[j], win[i + j], t);
            acc[i] = t;
        }
#pragma unroll
        for (int i = 0; i < 8; ++i) {
            const float mu = wave_sum_dpp(acc[i]) * (1.f / 64.f), m2 = wave_sum_dpp(acc[i] * acc[i]) * (1.f / 64.f);
            const float var = fmaxf(m2 - mu * mu, 0.f);
            const float hn = (acc[i] - mu) * rsqrtf(var + EPS) * gam + bet;
            Y[(rowb + s + i) * D + c] = (bf16_t)(cvt_pk_bf16(fsilu(hn), 0.f) & 0xffffu);
        }
#pragma unroll
        for (int i = 0; i < 30; ++i) win[i] = win[i + 8];
    }
}

constexpr int HQ_OFF = 0, HK_OFF = 17408, HKH_OFF = 34816, HV_OFF = 53248, HP_OFF = 71680, HDC_OFF = 80896, HTOT_OFF = 81408, HO_OFF = 85504;
template <bool P3, int DG = 0>
__device__ __forceinline__ void hgrn_unit(LAS unsigned char* lds, int unit, const bf16_t* __restrict__ HG, const float* __restrict__ lbl, const float* __restrict__ hng, float* __restrict__ HS, float* __restrict__ HLD,
                                          bf16_t* __restrict__ Y, int tid, int lane, int w) {
    const int seg = unit & (SEGS - 1), bh = unit >> 3, h = bh & 3, b = bh >> 2;
    const int g = lane >> 4, fr = lane & 15, kp = lane;
    const int c0 = h * HD + 2 * kp;
    const float lb0 = __builtin_amdgcn_rcpf(1.f + __expf(lbl[DH + c0] - lbl[c0])), lb1 = __builtin_amdgcn_rcpf(1.f + __expf(lbl[DH + c0 + 1] - lbl[c0 + 1]));
    f32x4 S[8];
#pragma unroll
    for (int i = 0; i < 8; ++i) S[i] = (f32x4){0.f, 0.f, 0.f, 0.f};
    if (P3 && !(DG & 1)) {
        for (int i = 0; i < seg; ++i) {
            const float* sp = HS + (size_t)(bh * SEGS + i) * 16384 + w * 2048 + lane;
            const float* ld = HLD + (size_t)(bh * SEGS + i) * 128 + 4 * g;
#pragma unroll
            for (int t = 0; t < 8; ++t) { const f32x4 dd = *(const f32x4*)(ld + 16 * t);
#pragma unroll
                for (int r = 0; r < 4; ++r) S[t][r] = fmaf(dd[r], S[t][r], sp[(t * 4 + r) * 64]); }
        }
    }
    float ldsum0 = 1.f, ldsum1 = 1.f;
    const size_t row_base = (size_t)b * SEQ + (size_t)seg * SEGLEN;
    const unsigned* HGw = (const unsigned*)HG;
    constexpr size_t PLANE_DW = (size_t)M * 64;
    unsigned zq[8], qq[8], vq[8];
#define HG_LOAD(c) do { if (DG & 2) { _Pragma("unroll") for (int i = 0; i < 8; ++i) { zq[i] = 0x3c003c00u + (unsigned)((c) + i + w); vq[i] = 0x3e003d00u + (unsigned)i; qq[i] = 0x3d003e00u + (unsigned)(c); } break; } _Pragma("unroll") for (int i = 0; i < 8; ++i) { const size_t ro = (row_base + (c) * 64 + 8 * w + i) * 64 + kp; \
        zq[i] = HGw[(size_t)(4 + h) * PLANE_DW + ro]; vq[i] = HGw[(size_t)(8 + h) * PLANE_DW + ro]; if (P3) qq[i] = HGw[(size_t)h * PLANE_DW + ro]; } } while (0)
    HG_LOAD(0);
    float gn[16];
    const int nt_t = tid >> 3, nt_v = (tid & 7) * 16;
    if (P3) {
#pragma unroll
        for (int e = 0; e < 16; ++e) gn[e] = hng[h * HD + nt_v + e];
    }
#pragma unroll 1
    for (int c = 0; c < NCH; ++c) {
        float cs0[8], cs1[8], kk0[8], kk1[8];
        float cum0 = 1.f, cum1 = 1.f;
        if (DG & 16) {
#pragma unroll
            for (int i = 0; i < 8; ++i) { cs0[i] = cs1[i] = 1.f - 0.01f * i; kk0[i] = kk1[i] = 0.5f; }
        } else
#pragma unroll
        for (int i = 0; i < 8; ++i) {
            const float sg0 = fsigmoid(bf_lo(zq[i])), sg1 = fsigmoid(bf_hi(zq[i]));
            cum0 *= lb0 + (1.f - lb0) * sg0; cum1 *= lb1 + (1.f - lb1) * sg1;
            cs0[i] = cum0; cs1[i] = cum1; kk0[i] = (1.f - lb0) * (1.f - sg0); kk1[i] = (1.f - lb1) * (1.f - sg1);
        }
        LAS float* tot = (LAS float*)(lds + HTOT_OFF);
        *(LAS f32x2*)(tot + w * 128 + 2 * kp) = (f32x2){cum0, cum1};
        BLOCK_BAR();
        float off0 = 1.f, off1 = 1.f, all0 = 1.f, all1 = 1.f;
#pragma unroll
        for (int ww = 0; ww < 8; ++ww) { const f32x2 tt = *(const LAS f32x2*)(tot + ww * 128 + 2 * kp); if (ww < w) { off0 *= tt.x; off1 *= tt.y; } all0 *= tt.x; all1 *= tt.y; }
        ldsum0 *= all0; ldsum1 *= all1;
        unsigned kh0[4], kh1[4], vt0[4], vt1[4];
        if (DG & 16) {
#pragma unroll
            for (int i = 0; i < 4; ++i) { kh0[i] = kh1[i] = 0x3c003c00u; vt0[i] = vq[2 * i]; vt1[i] = vq[2 * i + 1]; }
        } else
#pragma unroll
        for (int i = 0; i < 8; i += 2) {
            float a0[2], a1[2];
#pragma unroll
            for (int e = 0; e < 2; ++e) {
                const float E0 = off0 * cs0[i + e], E1 = off1 * cs1[i + e];
                const float k0 = kk0[i + e] * __builtin_amdgcn_rcpf(E0), k1 = kk1[i + e] * __builtin_amdgcn_rcpf(E1);
                if (P3) {
                    *(LAS unsigned*)(lds + HQ_OFF + (8 * w + i + e) * 272 + 4 * kp) = cvt_pk_bf16(bf_lo(qq[i + e]) * E0, bf_hi(qq[i + e]) * E1);
                    *(LAS unsigned*)(lds + HK_OFF + (8 * w + i + e) * 272 + 4 * kp) = cvt_pk_bf16(k0, k1);
                }
                a0[e] = k0 * all0; a1[e] = k1 * all1;
            }
            kh0[i >> 1] = cvt_pk_bf16(a0[0], a0[1]); kh1[i >> 1] = cvt_pk_bf16(a1[0], a1[1]);
            vt0[i >> 1] = (vq[i] & 0xffffu) | (vq[i + 1] << 16); vt1[i >> 1] = (vq[i] >> 16) | (vq[i + 1] & 0xffff0000u);
        }
        *(LAS u32x4*)(lds + HKH_OFF + (2 * kp) * 144 + 16 * w) = (u32x4){kh0[0], kh0[1], kh0[2], kh0[3]};
        *(LAS u32x4*)(lds + HKH_OFF + (2 * kp + 1) * 144 + 16 * w) = (u32x4){kh1[0], kh1[1], kh1[2], kh1[3]};
        *(LAS u32x4*)(lds + HV_OFF + (2 * kp) * 144 + 16 * w) = (u32x4){vt0[0], vt0[1], vt0[2], vt0[3]};
        *(LAS u32x4*)(lds + HV_OFF + (2 * kp + 1) * 144 + 16 * w) = (u32x4){vt1[0], vt1[1], vt1[2], vt1[3]};
        if (w == 0) *(LAS f32x2*)(lds + HDC_OFF + 8 * kp) = (f32x2){all0, all1};
        BLOCK_BAR();
        if (c + 1 < NCH) HG_LOAD(c + 1);
        bf16x8 vfrag[2];
#pragma unroll
        for (int ks = 0; ks < 2; ++ks) vfrag[ks] = *(const LAS bf16x8*)(lds + HV_OFF + (16 * w + fr) * 144 + 64 * ks + 16 * g);
        if (P3) {
            u32x4 gq[2];
            if (DG & 2) { gq[0] = (u32x4){0x3c003c00u, 0x3c003c00u, 0x3c003c00u, 0x3c003c00u}; gq[1] = gq[0]; } else
            { const u32x4* gp = (const u32x4*)(HG + (size_t)(12 + h) * M * 128 + (row_base + c * 64 + nt_t) * 128 + nt_v); gq[0] = gp[0]; gq[1] = gp[1]; }
            {
                const int mt = w >> 1;
#pragma unroll
                for (int nti = 0; nti < 2; ++nti) {
                    const int nt = 2 * (w & 1) + nti;
                    f32x4 p = (f32x4){0.f, 0.f, 0.f, 0.f};
                    if (nt <= mt && !(DG & 4)) {
#pragma unroll
                        for (int ks = 0; ks < 4; ++ks) {
                            const bf16x8 af = *(const LAS bf16x8*)(lds + HQ_OFF + (16 * mt + fr) * 272 + 64 * ks + 16 * g);
                            const bf16x8 bf = *(const LAS bf16x8*)(lds + HK_OFF + (16 * nt + fr) * 272 + 64 * ks + 16 * g);
                            p = __builtin_amdgcn_mfma_f32_16x16x32_bf16(af, bf, p, 0, 0, 0);
                        }
                    }
#pragma unroll
                    for (int r = 0; r < 4; ++r) {
                        const int t = 16 * mt + 4 * g + r, s = 16 * nt + fr;
                        const float pv = (s <= t) ? p[r] : 0.f;
                        *(LAS bf16_t*)(lds + HP_OFF + t * 144 + 2 * s) = (bf16_t)(cvt_pk_bf16(pv, 0.f) & 0xffffu);
                    }
                }
            }
            BLOCK_BAR();
            f32x4 o[4];
#pragma unroll
            for (int mt = 0; mt < 4; ++mt) o[mt] = (f32x4){0.f, 0.f, 0.f, 0.f};
            if (!(DG & 4))
#pragma unroll
            for (int ks = 0; ks < 4; ++ks) {
                u32x4 sb; sb.x = cvt_pk_bf16(S[2 * ks][0], S[2 * ks][1]); sb.y = cvt_pk_bf16(S[2 * ks][2], S[2 * ks][3]); sb.z = cvt_pk_bf16(S[2 * ks + 1][0], S[2 * ks + 1][1]); sb.w = cvt_pk_bf16(S[2 * ks + 1][2], S[2 * ks + 1][3]);
                const bf16x8 bfrag = __builtin_bit_cast(bf16x8, sb);
#pragma unroll
                for (int mt = 0; mt < 4; ++mt) {
                    const u32x2 alo = *(const LAS u32x2*)(lds + HQ_OFF + (16 * mt + fr) * 272 + 64 * ks + 8 * g);
                    const u32x2 ahi = *(const LAS u32x2*)(lds + HQ_OFF + (16 * mt + fr) * 272 + 64 * ks + 32 + 8 * g);
                    const bf16x8 af = __builtin_bit_cast(bf16x8, (u32x4){alo.x, alo.y, ahi.x, ahi.y});
                    o[mt] = __builtin_amdgcn_mfma_f32_16x16x32_bf16(af, bfrag, o[mt], 0, 0, 0);
                }
            }
            if (!(DG & 4))
#pragma unroll
            for (int ks = 0; ks < 2; ++ks)
#pragma unroll
                for (int mt = 0; mt < 4; ++mt) {
                    const bf16x8 af = *(const LAS bf16x8*)(lds + HP_OFF + (16 * mt + fr) * 144 + 64 * ks + 16 * g);
                    o[mt] = __builtin_amdgcn_mfma_f32_16x16x32_bf16(af, vfrag[ks], o[mt], 0, 0, 0);
                }
#pragma unroll
            for (int mt = 0; mt < 4; ++mt)
#pragma unroll
                for (int r = 0; r < 4; ++r) *(LAS float*)(lds + HO_OFF + ((16 * mt + 4 * g + r) * 132 + 16 * w + fr) * 4) = o[mt][r];
            if (!(DG & 4))
#pragma unroll
            for (int i = 0; i < 8; ++i) {
                const f32x4 dd = *(const LAS f32x4*)(lds + HDC_OFF + (16 * i + 4 * g) * 4);
                S[i] = S[i] * dd;
#pragma unroll
                for (int ks = 0; ks < 2; ++ks) { const bf16x8 af = *(const LAS bf16x8*)(lds + HKH_OFF + (16 * i + fr) * 144 + 64 * ks + 16 * g); S[i] = __builtin_amdgcn_mfma_f32_16x16x32_bf16(af, vfrag[ks], S[i], 0, 0, 0); }
            }
            BLOCK_BAR();
            if (!(DG & 8)) {
                f32x4 ov[4]; float ss = 0.f;
#pragma unroll
                for (int q = 0; q < 4; ++q) { ov[q] = *(const LAS f32x4*)(lds + HO_OFF + (nt_t * 132 + nt_v + 4 * q) * 4); ss += (ov[q].x * ov[q].x + ov[q].y * ov[q].y) + (ov[q].z * ov[q].z + ov[q].w * ov[q].w); }
                ss += __shfl_xor(ss, 1); ss += __shfl_xor(ss, 2); ss += __shfl_xor(ss, 4);
                const float rs = rsqrtf(ss * (1.f / HD) + EPS);
                u32x4 ow[2];
#pragma unroll
                for (int q = 0; q < 4; ++q) {
                    const unsigned g01 = (q & 1) ? gq[q >> 1].z : gq[q >> 1].x, g23 = (q & 1) ? gq[q >> 1].w : gq[q >> 1].y;
                    const float y0 = ov[q].x * rs * gn[4 * q] * bf_lo(g01), y1 = ov[q].y * rs * gn[4 * q + 1] * bf_hi(g01), y2 = ov[q].z * rs * gn[4 * q + 2] * bf_lo(g23), y3 = ov[q].w * rs * gn[4 * q + 3] * bf_hi(g23);
                    if (q & 1) { ow[q >> 1].z = cvt_pk_bf16(y0, y1); ow[q >> 1].w = cvt_pk_bf16(y2, y3); } else { ow[q >> 1].x = cvt_pk_bf16(y0, y1); ow[q >> 1].y = cvt_pk_bf16(y2, y3); }
                }
                u32x4* yp = (u32x4*)(Y + (row_base + c * 64 + nt_t) * D + DCONV + h * HD + nt_v); yp[0] = ow[0]; yp[1] = ow[1];
            }
        } else {
            if (!(DG & 4))
#pragma unroll
            for (int i = 0; i < 8; ++i) {
                const f32x4 dd = *(const LAS f32x4*)(lds + HDC_OFF + (16 * i + 4 * g) * 4);
                S[i] = S[i] * dd;
#pragma unroll
                for (int ks = 0; ks < 2; ++ks) { const bf16x8 af = *(const LAS bf16x8*)(lds + HKH_OFF + (16 * i + fr) * 144 + 64 * ks + 16 * g); S[i] = __builtin_amdgcn_mfma_f32_16x16x32_bf16(af, vfrag[ks], S[i], 0, 0, 0); }
            }
        }
    }
#undef HG_LOAD
    if (!P3 && !(DG & 8)) {
        float* sp = HS + (size_t)unit * 16384 + w * 2048 + lane;
#pragma unroll
        for (int t = 0; t < 8; ++t)
#pragma unroll
            for (int r = 0; r < 4; ++r) sp[(t * 4 + r) * 64] = S[t][r];
        if (w == 0) *(f32x2*)(HLD + (size_t)unit * 128 + 2 * kp) = (f32x2){ldsum0, ldsum1};
    }
    BLOCK_BAR();
}

__device__ __forceinline__ float gelu_as(float v) {
    const float av = fabsf(v), t = __builtin_amdgcn_rcpf(fmaf(av, 0.2316418882f, 1.0f));
    float q = fmaf(t, 0.5307027145f, -0.7265760135f); q = fmaf(q, t, 0.7107068705f); q = fmaf(q, t, -0.142248368f); q = fmaf(q, t, 0.127414796f); q = q * t;
    const float e = __builtin_amdgcn_exp2f(v * v * -0.72134752044f), m = v * (q * e);
    return v < 0.f ? m : v - m;
}
__device__ __forceinline__ float dot16_fp4(const unsigned w0, const unsigned w1, const f32x2 (&x2)[8]) {
    f32x2 acc = __builtin_amdgcn_cvt_scalef32_pk_f32_fp4(w0, 1.0f, 0) * x2[0];
    acc = __builtin_elementwise_fma(__builtin_amdgcn_cvt_scalef32_pk_f32_fp4(w0, 1.0f, 1), x2[1], acc);
    acc = __builtin_elementwise_fma(__builtin_amdgcn_cvt_scalef32_pk_f32_fp4(w0, 1.0f, 2), x2[2], acc);
    acc = __builtin_elementwise_fma(__builtin_amdgcn_cvt_scalef32_pk_f32_fp4(w0, 1.0f, 3), x2[3], acc);
    acc = __builtin_elementwise_fma(__builtin_amdgcn_cvt_scalef32_pk_f32_fp4(w1, 1.0f, 0), x2[4], acc);
    acc = __builtin_elementwise_fma(__builtin_amdgcn_cvt_scalef32_pk_f32_fp4(w1, 1.0f, 1), x2[5], acc);
    acc = __builtin_elementwise_fma(__builtin_amdgcn_cvt_scalef32_pk_f32_fp4(w1, 1.0f, 2), x2[6], acc);
    acc = __builtin_elementwise_fma(__builtin_amdgcn_cvt_scalef32_pk_f32_fp4(w1, 1.0f, 3), x2[7], acc);
    return acc.x + acc.y;
}
__device__ __forceinline__ void axpy16_fp4(const unsigned w0, const unsigned w1, const float s, f32x2 (&y2)[8]) {
    const f32x2 s2 = (f32x2){s, s};
    y2[0] = __builtin_elementwise_fma(__builtin_amdgcn_cvt_scalef32_pk_f32_fp4(w0, 1.0f, 0), s2, y2[0]);
    y2[1] = __builtin_elementwise_fma(__builtin_amdgcn_cvt_scalef32_pk_f32_fp4(w0, 1.0f, 1), s2, y2[1]);
    y2[2] = __builtin_elementwise_fma(__builtin_amdgcn_cvt_scalef32_pk_f32_fp4(w0, 1.0f, 2), s2, y2[2]);
    y2[3] = __builtin_elementwise_fma(__builtin_amdgcn_cvt_scalef32_pk_f32_fp4(w0, 1.0f, 3), s2, y2[3]);
    y2[4] = __builtin_elementwise_fma(__builtin_amdgcn_cvt_scalef32_pk_f32_fp4(w1, 1.0f, 0), s2, y2[4]);
    y2[5] = __builtin_elementwise_fma(__builtin_amdgcn_cvt_scalef32_pk_f32_fp4(w1, 1.0f, 1), s2, y2[5]);
    y2[6] = __builtin_elementwise_fma(__builtin_amdgcn_cvt_scalef32_pk_f32_fp4(w1, 1.0f, 2), s2, y2[6]);
    y2[7] = __builtin_elementwise_fma(__builtin_amdgcn_cvt_scalef32_pk_f32_fp4(w1, 1.0f, 3), s2, y2[7]);
}
__device__ __forceinline__ void axpy16_fp8(const u32x4 w, const float s, f32x2 (&y2)[8]) {
    const f32x2 s2 = (f32x2){s, s};
    y2[0] = __builtin_elementwise_fma(__builtin_amdgcn_cvt_pk_f32_fp8(w.x, false), s2, y2[0]);
    y2[1] = __builtin_elementwise_fma(__builtin_amdgcn_cvt_pk_f32_fp8(w.x, true), s2, y2[1]);
    y2[2] = __builtin_elementwise_fma(__builtin_amdgcn_cvt_pk_f32_fp8(w.y, false), s2, y2[2]);
    y2[3] = __builtin_elementwise_fma(__builtin_amdgcn_cvt_pk_f32_fp8(w.y, true), s2, y2[3]);
    y2[4] = __builtin_elementwise_fma(__builtin_amdgcn_cvt_pk_f32_fp8(w.z, false), s2, y2[4]);
    y2[5] = __builtin_elementwise_fma(__builtin_amdgcn_cvt_pk_f32_fp8(w.z, true), s2, y2[5]);
    y2[6] = __builtin_elementwise_fma(__builtin_amdgcn_cvt_pk_f32_fp8(w.w, false), s2, y2[6]);
    y2[7] = __builtin_elementwise_fma(__builtin_amdgcn_cvt_pk_f32_fp8(w.w, true), s2, y2[7]);
}
__device__ __forceinline__ f32x2 cvt4(unsigned w, int) { return (f32x2){0.f, 0.f}; }
#define C4(w, k) __builtin_amdgcn_cvt_scalef32_pk_f32_fp4((w), 1.0f, (k))
__device__ __forceinline__ float dot32_fp4(const u32x4 w, const f32x2 (&x2)[16]) {
    f32x2 a0 = C4(w.x, 0) * x2[0], a1 = C4(w.y, 0) * x2[4];
    a0 = __builtin_elementwise_fma(C4(w.x, 1), x2[1], a0); a1 = __builtin_elementwise_fma(C4(w.y, 1), x2[5], a1);
    a0 = __builtin_elementwise_fma(C4(w.x, 2), x2[2], a0); a1 = __builtin_elementwise_fma(C4(w.y, 2), x2[6], a1);
    a0 = __builtin_elementwise_fma(C4(w.x, 3), x2[3], a0); a1 = __builtin_elementwise_fma(C4(w.y, 3), x2[7], a1);
    a0 = __builtin_elementwise_fma(C4(w.z, 0), x2[8], a0); a1 = __builtin_elementwise_fma(C4(w.w, 0), x2[12], a1);
    a0 = __builtin_elementwise_fma(C4(w.z, 1), x2[9], a0); a1 = __builtin_elementwise_fma(C4(w.w, 1), x2[13], a1);
    a0 = __builtin_elementwise_fma(C4(w.z, 2), x2[10], a0); a1 = __builtin_elementwise_fma(C4(w.w, 2), x2[14], a1);
    a0 = __builtin_elementwise_fma(C4(w.z, 3), x2[11], a0); a1 = __builtin_elementwise_fma(C4(w.w, 3), x2[15], a1);
    a0 = a0 + a1;
    return a0.x + a0.y;
}
typedef _Float16 h16x2 __attribute__((ext_vector_type(2)));
#define C4H(w, k) __builtin_bit_cast(h16x2, __builtin_amdgcn_cvt_scalef32_pk_f16_fp4((w), 1.0f, (k)))
__device__ __forceinline__ void axpy32_fp4(const u32x4 w, const float s, h16x2 (&y2)[16]) {
    const _Float16 sh = (_Float16)s; const h16x2 s2 = (h16x2){sh, sh};
    y2[0] = __builtin_elementwise_fma(C4H(w.x, 0), s2, y2[0]); y2[1] = __builtin_elementwise_fma(C4H(w.x, 1), s2, y2[1]); y2[2] = __builtin_elementwise_fma(C4H(w.x, 2), s2, y2[2]); y2[3] = __builtin_elementwise_fma(C4H(w.x, 3), s2, y2[3]);
    y2[4] = __builtin_elementwise_fma(C4H(w.y, 0), s2, y2[4]); y2[5] = __builtin_elementwise_fma(C4H(w.y, 1), s2, y2[5]); y2[6] = __builtin_elementwise_fma(C4H(w.y, 2), s2, y2[6]); y2[7] = __builtin_elementwise_fma(C4H(w.y, 3), s2, y2[7]);
    y2[8] = __builtin_elementwise_fma(C4H(w.z, 0), s2, y2[8]); y2[9] = __builtin_elementwise_fma(C4H(w.z, 1), s2, y2[9]); y2[10] = __builtin_elementwise_fma(C4H(w.z, 2), s2, y2[10]); y2[11] = __builtin_elementwise_fma(C4H(w.z, 3), s2, y2[11]);
    y2[12] = __builtin_elementwise_fma(C4H(w.w, 0), s2, y2[12]); y2[13] = __builtin_elementwise_fma(C4H(w.w, 1), s2, y2[13]); y2[14] = __builtin_elementwise_fma(C4H(w.w, 2), s2, y2[14]); y2[15] = __builtin_elementwise_fma(C4H(w.w, 3), s2, y2[15]);
}
#undef C4H
__device__ __forceinline__ float half_sum_dpp(float v) {
    v += __builtin_bit_cast(float, __builtin_amdgcn_update_dpp(0, __builtin_bit_cast(int, v), 0x111, 0xf, 0xf, false));
    v += __builtin_bit_cast(float, __builtin_amdgcn_update_dpp(0, __builtin_bit_cast(int, v), 0x112, 0xf, 0xf, false));
    v += __builtin_bit_cast(float, __builtin_amdgcn_update_dpp(0, __builtin_bit_cast(int, v), 0x114, 0xf, 0xf, false));
    v += __builtin_bit_cast(float, __builtin_amdgcn_update_dpp(0, __builtin_bit_cast(int, v), 0x118, 0xf, 0xf, false));
    v += __builtin_bit_cast(float, __builtin_amdgcn_update_dpp(0, __builtin_bit_cast(int, v), 0x142, 0xa, 0xf, false));
    return v;
}
typedef int i32x8 __attribute__((ext_vector_type(8)));
#define P7_EMASK ((DGP & 8) ? 15 : (DGP & 1) ? 1023 : 0x7fffffff)
#define P7_LOAD2(dst, evv, slot) do { const int ea_ = __builtin_amdgcn_readlane((evv), (slot)) & P7_EMASK, eb_ = __builtin_amdgcn_readlane((evv), (slot) + 1) & P7_EMASK; \
        dst = __builtin_amdgcn_raw_buffer_load_b128(RV, ((hi ? eb_ : ea_) << 9) + l16, 0, 0); } while (0)
#define P7_AXPY2(BANK, q, r) do { const float wa_ = __builtin_bit_cast(float, __builtin_amdgcn_readlane(__builtin_bit_cast(int, wvec), (q) * 16 + 2 * (r))), wb_ = __builtin_bit_cast(float, __builtin_amdgcn_readlane(__builtin_bit_cast(int, wvec), (q) * 16 + 2 * (r) + 1)); \
        axpy32_fp4(BANK[r], hi ? wb_ : wa_, y2); } while (0)
#define P7_UBASE(evv, g) ((((__shfl((evv), 16 * (g) + li)) & P7_EMASK) << 9) + 16 * lq)
#define P7_LOADU1(dst, ubase, s) do { dst = __builtin_amdgcn_raw_buffer_load_b128(RU, (ubase) + 64 * (s), 0, 0); } while (0)
#define P7_MFMA_STEP(abuf, xb, s, D1, D2) do { \
        const u32x4 b1_ = *(const LAS u32x4*)((xb) + 64 * (s) + 16 * lq), b2_ = *(const LAS u32x4*)((xb) + 512 + 64 * (s) + 16 * lq); \
        const i32x8 av_ = (i32x8){(int)abuf.x, (int)abuf.y, (int)abuf.z, (int)abuf.w, 0, 0, 0, 0}; \
        D1 = __builtin_amdgcn_mfma_scale_f32_16x16x128_f8f6f4(av_, (i32x8){(int)b1_.x, (int)b1_.y, (int)b1_.z, (int)b1_.w, 0, 0, 0, 0}, D1, 4, 4, 0, 0x7f7f7f7f, 0, 0x7f7f7f7f); \
        D2 = __builtin_amdgcn_mfma_scale_f32_16x16x128_f8f6f4(av_, (i32x8){(int)b2_.x, (int)b2_.y, (int)b2_.z, (int)b2_.w, 0, 0, 0, 0}, D2, 4, 4, 0, 0x7f7f7f7f, 0, 0x7f7f7f7f); } while (0)
#define P7_DV(g, dg, dv) do { const float tmp_ = (lane & 3) == 0 ? dg[0] : (lane & 3) == 1 ? dg[1] : (lane & 3) == 2 ? dg[2] : dg[3]; const float val_ = __shfl(tmp_, srcl); dv = (lq == (g)) ? val_ : dv; } while (0)
__device__ __forceinline__ void x_to_fp4x2(const u32x2 (&xq)[8], LAS unsigned char* xb, int l32, float& s1, float& s2) {
    float am = 0.f;
#pragma unroll
    for (int j = 0; j < 8; ++j) am = fmaxf(am, fmaxf(fmaxf(fabsf(bf_lo(xq[j].x)), fabsf(bf_hi(xq[j].x))), fmaxf(fabsf(bf_lo(xq[j].y)), fabsf(bf_hi(xq[j].y)))));
#pragma unroll
    for (int o = 1; o < 64; o <<= 1) am = fmaxf(am, __shfl_xor(am, o));
    s1 = am > 0.f ? am * (1.f / 6.f) : 1.f; const float i1 = am > 0.f ? 6.f / am : 1.f;
    float am2 = 0.f;
#pragma unroll
    for (int j = 0; j < 8; ++j) {
        const float x0 = bf_lo(xq[j].x), x1 = bf_hi(xq[j].x), x2_ = bf_lo(xq[j].y), x3 = bf_hi(xq[j].y);
        unsigned w = 0u;
        w = __builtin_amdgcn_cvt_scalef32_pk_fp4_f32(w, x0 * i1, x1 * i1, 1.0f, 0); w = __builtin_amdgcn_cvt_scalef32_pk_fp4_f32(w, x2_ * i1, x3 * i1, 1.0f, 1);
        *(LAS unsigned short*)(xb + 2 * (l32 + 32 * j)) = (unsigned short)w;
        const f32x2 d0 = __builtin_amdgcn_cvt_scalef32_pk_f32_fp4(w, 1.0f, 0), d1 = __builtin_amdgcn_cvt_scalef32_pk_f32_fp4(w, 1.0f, 1);
        am2 = fmaxf(am2, fmaxf(fmaxf(fabsf(x0 - s1 * d0.x), fabsf(x1 - s1 * d0.y)), fmaxf(fabsf(x2_ - s1 * d1.x), fabsf(x3 - s1 * d1.y))));
    }
#pragma unroll
    for (int o = 1; o < 64; o <<= 1) am2 = fmaxf(am2, __shfl_xor(am2, o));
    s2 = am2 > 0.f ? am2 * (1.f / 6.f) : 1.f; const float i2 = am2 > 0.f ? 6.f / am2 : 1.f;
    asm volatile("s_waitcnt lgkmcnt(0)" ::: "memory");
#pragma unroll
    for (int j = 0; j < 8; ++j) {
        const float x0 = bf_lo(xq[j].x), x1 = bf_hi(xq[j].x), x2_ = bf_lo(xq[j].y), x3 = bf_hi(xq[j].y);
        const unsigned w1 = *(const LAS unsigned short*)(xb + 2 * (l32 + 32 * j));
        const f32x2 d0 = __builtin_amdgcn_cvt_scalef32_pk_f32_fp4(w1, 1.0f, 0), d1 = __builtin_amdgcn_cvt_scalef32_pk_f32_fp4(w1, 1.0f, 1);
        unsigned w = 0u;
        w = __builtin_amdgcn_cvt_scalef32_pk_fp4_f32(w, (x0 - s1 * d0.x) * i2, (x1 - s1 * d0.y) * i2, 1.0f, 0); w = __builtin_amdgcn_cvt_scalef32_pk_fp4_f32(w, (x2_ - s1 * d1.x) * i2, (x3 - s1 * d1.y) * i2, 1.0f, 1);
        *(LAS unsigned short*)(xb + 512 + 2 * (l32 + 32 * j)) = (unsigned short)w;
    }
    asm volatile("s_waitcnt lgkmcnt(0)" ::: "memory");
}
template <bool V4, int DGP = 0>
__device__ __forceinline__ void peer_phase(LAS unsigned char* lds, int wave, const bf16_t* __restrict__ XN2, const int* __restrict__ EIDX, const float* __restrict__ GATE, const unsigned char* __restrict__ Up, const unsigned char* __restrict__ Vp,
                                           const float* __restrict__ USC, const float* __restrict__ VSC, const float* __restrict__ SSQ, const float* __restrict__ fg, float* __restrict__ out, int gw, int NGW, int lane) {
    static_assert(V4, "this build of the PEER phase streams fp4 value rows");
    if (gw >= M) return;
    LAS unsigned char* xbase = lds + wave * 2048;
    const __amdgpu_buffer_rsrc_t RU = __builtin_amdgcn_make_buffer_rsrc((void*)Up, 0, NEXP * 512, 0x00020000);
    const __amdgpu_buffer_rsrc_t RV = __builtin_amdgcn_make_buffer_rsrc((void*)Vp, 0, NEXP * 512, 0x00020000);
    const bool hi = lane >= 32; const int l32 = lane & 31, l16 = l32 * 16, li = lane & 15, lq = lane >> 4, srcl = 16 * (li >> 2) + li;
    u32x4 UA[8], UB[8], VA[4], VB[4];
    int t = gw, par = 0;
    u32x2 xq[8];
#pragma unroll
    for (int j = 0; j < 8; ++j) xq[j] = ((const u32x2*)(XN2 + (size_t)t * D))[l32 + 32 * j];
    int evc = EIDX[(size_t)t * 128 + lane], evn = EIDX[(size_t)t * 128 + 64 + lane];
    float gvn = GATE[(size_t)t * 128 + 64 + lane];
    float xs1, xs2;
    x_to_fp4x2(xq, xbase, l32, xs1, xs2);
    float rstd_t = rsqrtf(wave_sum_dpp(lane < 16 ? SSQ[(size_t)t * 16 + lane] : 0.f) * (1.f / D) + EPS);
    float wvec;
    {
        float dvec = 0.f;
#pragma unroll 1
        for (int g = 0; g < 4; ++g) {
            const int ub = P7_UBASE(evc, g);
#pragma unroll
            for (int s = 0; s < 8; ++s) P7_LOADU1(UA[s], ub, s);
            f32x4 D1 = (f32x4){0.f, 0.f, 0.f, 0.f}, D2 = D1;
#pragma unroll
            for (int s = 0; s < 8; ++s) P7_MFMA_STEP(UA[s], xbase, s, D1, D2);
            const f32x4 dd = D1 * xs1 + D2 * xs2;
            if (g == 0) P7_DV(0, dd, dvec); else if (g == 1) P7_DV(1, dd, dvec); else if (g == 2) P7_DV(2, dd, dvec); else P7_DV(3, dd, dvec);
        }
        wvec = GATE[(size_t)t * 128 + lane] * VSC[evc] * gelu_as(dvec * (USC[evc] * rstd_t));
    }
    {
#pragma unroll
        for (int r = 0; r < 4; ++r) P7_LOAD2(VA[r], evc, 2 * r);
#pragma unroll
        for (int r = 0; r < 4; ++r) P7_LOAD2(VB[r], evc, 8 + 2 * r);
        const int ub0 = P7_UBASE(evn, 0), ub1 = P7_UBASE(evn, 1);
#pragma unroll
        for (int s = 0; s < 8; ++s) P7_LOADU1(UA[s], ub0, s);
#pragma unroll
        for (int s = 0; s < 8; ++s) P7_LOADU1(UB[s], ub1, s);
    }
    h16x2 y2[16];
#pragma unroll
    for (int j = 0; j < 16; ++j) y2[j] = (h16x2){(_Float16)0.f, (_Float16)0.f};
    int h = 0;
    int tn = t + NGW; bool has_next = tn < M; int tl = has_next ? tn : t;
    int nev0 = EIDX[(size_t)tl * 128 + lane], nev1 = EIDX[(size_t)tl * 128 + 64 + lane];
    float ngv0 = GATE[(size_t)tl * 128 + lane], ngv1 = GATE[(size_t)tl * 128 + 64 + lane];
    u32x2 nxq[8];
#pragma unroll
    for (int j = 0; j < 8; ++j) nxq[j] = ((const u32x2*)(XN2 + (size_t)tl * D))[l32 + 32 * j];
    float nxs1 = 1.f, nxs2 = 1.f, nrstd = 1.f;
#pragma unroll 1
    for (;;) {
        if (h == 1) {
            x_to_fp4x2(nxq, xbase + (par ^ 1) * 1024, l32, nxs1, nxs2);
            nrstd = rsqrtf(wave_sum_dpp(lane < 16 ? SSQ[(size_t)tl * 16 + lane] : 0.f) * (1.f / D) + EPS);
        }
        const LAS unsigned char* xbn = xbase + (h ? (par ^ 1) : par) * 1024;
        const float s1n = h ? nxs1 : xs1, s2n = h ? nxs2 : xs2, rsn = h ? nrstd : rstd_t;
        const int evnn = h ? nev1 : nev0;
        const float uscn = USC[evn] * rsn, vscn = VSC[evn];
        float dvec = 0.f;
#define P7_PIPE(g, UBUF, UREFILL, evr, slotr) do { \
            f32x4 D1 = (f32x4){0.f, 0.f, 0.f, 0.f}, D2 = D1; \
            _Pragma("unroll") for (int r = 0; r < 8; ++r) { \
                P7_MFMA_STEP(UBUF[r], xbn, r, D1, D2); __builtin_amdgcn_sched_barrier(0); UREFILL; __builtin_amdgcn_sched_barrier(0); \
                if (r < 4) { P7_AXPY2X(VA[r], (g) * 16 + 2 * r); __builtin_amdgcn_sched_barrier(0); P7_LOAD2(VA[r], evr, (slotr) + 2 * r); } \
                else { P7_AXPY2X(VB[r - 4], (g) * 16 + 2 * r); __builtin_amdgcn_sched_barrier(0); P7_LOAD2(VB[r - 4], evr, (slotr) + 2 * r); } \
                __builtin_amdgcn_sched_barrier(0); } \
            const f32x4 dd = D1 * s1n + D2 * s2n; P7_DV(g, dd, dvec); } while (0)
#define P7_AXPY2X(ROW, slot) do { const float wa_ = __builtin_bit_cast(float, __builtin_amdgcn_readlane(__builtin_bit_cast(int, wvec), (slot))), wb_ = __builtin_bit_cast(float, __builtin_amdgcn_readlane(__builtin_bit_cast(int, wvec), (slot) + 1)); \
        axpy32_fp4(ROW, hi ? wb_ : wa_, y2); \
        asm volatile("" : "+v"(y2[0]), "+v"(y2[1]), "+v"(y2[2]), "+v"(y2[3]), "+v"(y2[4]), "+v"(y2[5]), "+v"(y2[6]), "+v"(y2[7]), "+v"(y2[8]), "+v"(y2[9]), "+v"(y2[10]), "+v"(y2[11]), "+v"(y2[12]), "+v"(y2[13]), "+v"(y2[14]), "+v"(y2[15])); } while (0)
        { const int ub = P7_UBASE(evn, 2);  P7_PIPE(0, UA, P7_LOADU1(UA[r], ub, r), evc, 16); }
        { const int ub = P7_UBASE(evn, 3);  P7_PIPE(1, UB, P7_LOADU1(UB[r], ub, r), evc, 32); }
        { const int ub = P7_UBASE(evnn, 0); P7_PIPE(2, UA, P7_LOADU1(UA[r], ub, r), evc, 48); }
        { const int ub = P7_UBASE(evnn, 1); P7_PIPE(3, UB, P7_LOADU1(UB[r], ub, r), evn, 0); }
#undef P7_AXPY2X
#undef P7_PIPE
        const float wnext = gvn * vscn * gelu_as(dvec * uscn);
        if (h == 1) {
            f32x4 z[4]; float sq = 0.f;
#pragma unroll
            for (int jj = 0; jj < 4; ++jj) {
                const u32x2 xe = xq[2 * jj], xo = xq[2 * jj + 1];
                const f32x4 ye = (f32x4){(float)y2[2 * jj].x, (float)y2[2 * jj].y, (float)y2[2 * jj + 1].x, (float)y2[2 * jj + 1].y}, yo = (f32x4){(float)y2[8 + 2 * jj].x, (float)y2[8 + 2 * jj].y, (float)y2[8 + 2 * jj + 1].x, (float)y2[8 + 2 * jj + 1].y};
                const f32x4 mine = hi ? yo : ye, give = hi ? ye : yo;
                f32x4 got; got.x = __shfl_xor(give.x, 32); got.y = __shfl_xor(give.y, 32); got.z = __shfl_xor(give.z, 32); got.w = __shfl_xor(give.w, 32);
                const u32x2 xm = hi ? xo : xe;
                z[jj] = mine + got + (f32x4){bf_lo(xm.x), bf_hi(xm.x), bf_lo(xm.y), bf_hi(xm.y)};
                sq += (z[jj].x * z[jj].x + z[jj].y * z[jj].y) + (z[jj].z * z[jj].z + z[jj].w * z[jj].w);
            }
            const float rr = rsqrtf(wave_sum_dpp(sq) * (1.f / D) + EPS);
            const int hb = hi ? 1 : 0;
#pragma unroll
            for (int jj = 0; jj < 4; ++jj) { const int G = l32 + 32 * (hb + 2 * jj); __builtin_nontemporal_store(z[jj] * rr * ((const f32x4*)fg)[G], (f32x4*)(out + (size_t)t * D) + G); }
            if (!has_next) break;
            t = tn; par ^= 1; xs1 = nxs1; xs2 = nxs2; rstd_t = nrstd;
#pragma unroll
            for (int j = 0; j < 8; ++j) xq[j] = nxq[j];
#pragma unroll
            for (int j = 0; j < 16; ++j) y2[j] = (h16x2){(_Float16)0.f, (_Float16)0.f};
            evc = evn; evn = nev1; gvn = ngv1;
            tn = t + NGW; has_next = tn < M; tl = has_next ? tn : t;
            nev0 = EIDX[(size_t)tl * 128 + lane]; nev1 = EIDX[(size_t)tl * 128 + 64 + lane]; ngv0 = GATE[(size_t)tl * 128 + lane]; ngv1 = GATE[(size_t)tl * 128 + 64 + lane];
#pragma unroll
            for (int j = 0; j < 8; ++j) nxq[j] = ((const u32x2*)(XN2 + (size_t)tl * D))[l32 + 32 * j];
            h = 0;
        } else {
            evc = evn; evn = nev0; gvn = ngv0; h = 1;
        }
        wvec = wnext;
    }
}
#undef P7_LOAD2
#undef P7_AXPY2
#undef P7_UBASE
#undef P7_LOADU1
#undef P7_MFMA_STEP
#undef P7_DV
#undef P7_EMASK
#undef C4

#define XB_TMO      128
#define XB_XCNT(j)  (256  + 64 * (j))
#define XB_XSUB(j)  (1280 + 64 * (j))
#define XB_XGEN(j)  (2304 + 64 * (j))
#define XB_TOP      3328
#define XB_TOPGEN   3392
#define XCD_BAR_WORDS 3456
#define XB_SPIN_CAP (1u << 18)

__device__ __forceinline__ unsigned xb_ld(unsigned* p)              { return __hip_atomic_load(p, __ATOMIC_RELAXED, __HIP_MEMORY_SCOPE_AGENT); }
__device__ __forceinline__ unsigned xb_add(unsigned* p, unsigned v) { return __hip_atomic_fetch_add(p, v, __ATOMIC_RELAXED, __HIP_MEMORY_SCOPE_AGENT); }
__device__ __forceinline__ unsigned xb_xcc_id() { return (unsigned)__builtin_amdgcn_s_getreg((3 << 11) | 20) & 0xFu; }
#define XB_SPIN(cond, bar) do { unsigned _sp = 0; while (cond) { __builtin_amdgcn_s_sleep(1); \
    if ((++_sp & 255u) == 0u) { if (xb_ld(&(bar)[XB_TMO])) break; if (_sp > XB_SPIN_CAP) { atomicAdd(&(bar)[XB_TMO], 1u); break; } } } } while (0)


struct XcdBar { unsigned* bar; unsigned x, nloc, nx; };
__device__ __forceinline__ void xcd_bar_post(unsigned* bar, unsigned x) { (void)xb_add(&bar[XB_XCNT(x)], 1u); }
__device__ __forceinline__ void xcd_bar_census(XcdBar& b) {
    unsigned cnt = 0u, mine = 0u;
#pragma unroll
    for (unsigned j = 0; j < 16; ++j) { const unsigned c = xb_ld(&b.bar[XB_XCNT(j)]); cnt += (c > 0u) ? 1u : 0u; mine = (j == b.x) ? c : mine; }
    b.nloc = mine > 0u ? mine : 1u; b.nx = cnt > 0u ? cnt : 1u;
}
__device__ __forceinline__ void xcd_barrier(const XcdBar& b, bool leader_thread) {
    asm volatile("s_waitcnt vmcnt(0)" ::: "memory");
    __syncthreads();
    if (leader_thread) {
        unsigned* bar = b.bar;
        __builtin_amdgcn_s_waitcnt(0);
        const unsigned nloc = b.nloc, nx = b.nx;
        const unsigned old = xb_add(&bar[XB_XSUB(b.x)], 1u);
        const unsigned gen = old / nloc;
        if (old + 1u == (gen + 1u) * nloc) {
            __builtin_amdgcn_fence(__ATOMIC_RELEASE, "agent");
            asm volatile("s_waitcnt vmcnt(0)" ::: "memory");
            const unsigned og = xb_add(&bar[XB_TOP], 1u);
            const unsigned tg = og / nx;
            if (og + 1u == (tg + 1u) * nx) xb_add(&bar[XB_TOPGEN], 1u);
            else XB_SPIN(xb_ld(&bar[XB_TOPGEN]) == tg, bar);
            __builtin_amdgcn_fence(__ATOMIC_ACQUIRE, "agent");
            xb_add(&bar[XB_XGEN(b.x)], 1u);
            asm volatile("s_waitcnt vmcnt(0)" ::: "memory");
        } else {
            XB_SPIN(xb_ld(&bar[XB_XGEN(b.x)]) == gen, bar);
            __builtin_amdgcn_fence(__ATOMIC_ACQUIRE, "agent");
            asm volatile("s_waitcnt vmcnt(0)" ::: "memory");
        }
    }
    __syncthreads();
}

__global__ void __launch_bounds__(NT, 2) mega(Args a) {
    extern __shared__ __attribute__((aligned(16))) unsigned char lds_raw[];
    LAS unsigned char* lds = (LAS unsigned char*)lds_raw;
    cg::grid_group grid = cg::this_grid();
    const int wave = __builtin_amdgcn_readfirstlane(threadIdx.x >> 6), G = gridDim.x;
#define PH_IDS() const int lane = pg8::lane_id_v(), tid = wave * 64 + lane; (void)tid; (void)lane
    unsigned char* ws = a.ws;
    const int lo = a.ph_lo, hi = a.ph_hi;
    bf16_t* WIN = (bf16_t*)(ws + WS_WIN); bf16_t* WOUT = (bf16_t*)(ws + WS_WOUT); bf16_t* WEFF = (bf16_t*)(ws + WS_WEFF);
    bf16_t* XN = (bf16_t*)(ws + WS_XN);
    bf16_t* GLU = (bf16_t*)(ws + WS_GLU); bf16_t* HG = (bf16_t*)(ws + WS_HG); bf16_t* Y = (bf16_t*)(ws + WS_Y);
    float* HS = (float*)(ws + WS_HS); float* HLD = (float*)(ws + WS_HLD);
    int* EIDX = (int*)(ws + WS_EIDX); float* GATE = (float*)(ws + WS_GATE);
    const int gw = blockIdx.x * NWAVES + wave, NGW = G * NWAVES;
#ifndef PH_MASK
#define PH_MASK 0xff
#endif
#define IN(k) (((PH_MASK >> (k)) & 1) && lo <= (k) && (k) < hi)
    XcdBar xb; xb.bar = (unsigned*)ws; xb.x = xb_xcc_id(); xb.nloc = 1u; xb.nx = 1u;
    const bool xb_leader = (wave == 0) && (pg8::lane_id_v() == 0);
    if (lo == 0 && xb_leader) xcd_bar_post(xb.bar, xb.x);
#define SEAM(k) do { if (IN(k) && IN((k) + 1)) { if ((k) == 0) { grid.sync(); if (xb_leader) xcd_bar_census(xb); } else xcd_barrier(xb, xb_leader); } } while (0)
    if (IN(0)) { PH_IDS(); p0_prologue(a, lds, tid, lane, wave, G); }
    SEAM(0);
    if (IN(1)) {
        pg8::Gemm g{XN, WIN, M, DIN, D}; pg8::StaticOrder S; S.init(M, DIN, G, (int)blockIdx.x);
        pg8::EpiProj E{GLU, HG};
        pg8::gemm_phase<pg8::EpiProj, pg8::StaticOrder, true, true>(lds, g, S, E, wave);
    }
    SEAM(1);
    if (IN(2)) { PH_IDS();
        for (int u = blockIdx.x; u < BATCH * NH * SEGS; u += G) hgrn_unit<false>(lds, u, HG, a.in[7], a.in[8], HS, HLD, Y, tid, lane, wave);
        for (int wu = gw; wu < 2048; wu += NGW) conv_wave_unit(GLU, a.in[3], a.in[4], a.in[5], a.in[6], Y, wu, lane);
    }
    SEAM(2);
    if (IN(3)) { PH_IDS();
        for (int u = blockIdx.x; u < BATCH * NH * SEGS; u += G) hgrn_unit<true>(lds, u, HG, a.in[7], a.in[8], HS, HLD, Y, tid, lane, wave);
    }
    SEAM(3);
    if (IN(4)) {
        pg8::Gemm g{Y, WOUT, M, D, D}; pg8::StaticOrder S; S.init(M, D, G, (int)blockIdx.x);
        pg8::EpiResBf16 E{XN, a.in[0], (float*)(ws + WS_SSQ)};
        pg8::gemm_phase<pg8::EpiResBf16, pg8::StaticOrder, true, true>(lds, g, S, E, wave);
    }
    SEAM(4);
    if (IN(6)) {
        pg8::Gemm g{XN, WEFF, M, NQ, D}; pg8::StaticOrder S; S.init(M, NQ, G, (int)blockIdx.x);
        pg8::EpiTopK E{EIDX, GATE, (const float*)(ws + WS_SSQ)};
        for (int i = 0;; ++i) { pg8::OneUnit O; if (!S.next(i, O.u)) break; pg8::gemm_phase<pg8::EpiTopK, pg8::OneUnit, false, true>(lds, g, O, E, wave); }
    }
    SEAM(6);
    if (IN(7)) { PH_IDS();
        peer_phase<PEER_V4>(lds, wave, XN, EIDX, GATE, ws + WS_U, ws + WS_V, (const float*)(ws + WS_USC), (const float*)(ws + WS_VSC), (const float*)(ws + WS_SSQ), a.in[15], a.out, gw, NGW, lane);
    }
#undef IN
#undef SEAM
}
}

extern "C" void kernel_launch(void* const* d_in, const int* in_sizes, int n_in, void* d_out, int out_size, void* d_ws, size_t ws_size, hipStream_t stream) {
    static int grid = 0;
    if (grid == 0) {
        if (n_in != 16 || out_size != mk::M * mk::D || ws_size < (size_t)mk::WS_END) { fprintf(stderr, "kernel_launch: unexpected shapes (n_in %d out %d ws %zu)\n", n_in, out_size, ws_size); grid = -1; return; }
        int dev = 0, cus = 0, per_cu = 0;
        (void)hipGetDevice(&dev);
        (void)hipDeviceGetAttribute(&cus, hipDeviceAttributeMultiprocessorCount, dev);
        if (hipFuncSetAttribute((const void*)mk::mega, hipFuncAttributeMaxDynamicSharedMemorySize, mk::LDS_BYTES) != hipSuccess) { fprintf(stderr, "kernel_launch: hipFuncSetAttribute failed\n"); grid = -1; return; }
        if (hipOccupancyMaxActiveBlocksPerMultiprocessor(&per_cu, (const void*)mk::mega, mk::NT, mk::LDS_BYTES) != hipSuccess || per_cu < 1) { fprintf(stderr, "kernel_launch: occupancy query says %d\n", per_cu); per_cu = 1; }
        (void)hipGetLastError();
        grid = cus;
    }
    if (grid < 0) return;
    if (hipMemsetAsync(d_ws, 0, 16384, stream) != hipSuccess) { fprintf(stderr, "kernel_launch: memset failed\n"); return; }
    mk::Args a{};
    for (int i = 0; i < 16; ++i) a.in[i] = (const float*)d_in[i];
    a.out = (float*)d_out; a.ws = (unsigned char*)d_ws;
    a.ph_lo = 0; a.ph_hi = 8;
    void* args[] = {&a};
#ifdef PROBE_PHASE
    const int plo[3] = {0, PROBE_PHASE == 0 ? 0 : PROBE_PHASE, 7}, phi[3] = {PROBE_PHASE == 0 ? 1 : 7, PROBE_PHASE == 0 ? 8 : PROBE_PHASE + 1, 8};
    for (int li = 0; li < 3; ++li) { if ((li == 1 && PROBE_PHASE < 0) || (li == 2 && PROBE_PHASE == 0)) continue; a.ph_lo = plo[li]; a.ph_hi = phi[li];
        if (li) (void)hipMemsetAsync(d_ws, 0, 16384, stream);
        hipError_t e = hipLaunchCooperativeKernel((const void*)mk::mega, dim3(grid), dim3(mk::NT), args, mk::LDS_BYTES, stream);
        if (e != hipSuccess) fprintf(stderr, "cooperative launch failed: %s (grid %d)\n", hipGetErrorString(e), grid); }
#else
    hipError_t e = hipLaunchCooperativeKernel((const void*)mk::mega, dim3(grid), dim3(mk::NT), args, mk::LDS_BYTES, stream);
    if (e != hipSuccess) fprintf(stderr, "cooperative launch failed: %s (grid %d)\n", hipGetErrorString(e), grid);
#endif
}
```

```cpp
#include <hip/hip_runtime.h>
#include <hip/hip_cooperative_groups.h>
#include <cstdio>
#include <cstdint>
#include <cmath>
#include <type_traits>
namespace cg = cooperative_groups;
namespace pg8 {
#define PG8_LAS __attribute__((address_space(3)))
typedef unsigned short bf16_t;
typedef short bf16x8 __attribute__((ext_vector_type(8)));
typedef float f32x4 __attribute__((ext_vector_type(4)));
typedef unsigned u32x4 __attribute__((ext_vector_type(4)));
constexpr int BM = 256, BK = 64, HALF = 128, HTB = HALF * BK * 2  , STAGE_BYTES = 8 * HTB, NXCD = 8, WGM = 8;

__host__ __device__ __forceinline__ int lds_byte(int r, int c) { const int st = (r >> 4) * 2 + (c >> 5), rr = r & 15, cc = c & 31, ob = rr * 64 + cc * 2; return st * 1024 + (ob ^ (((ob >> 9) & 1) << 5)); }
__host__ __device__ __forceinline__ void stage_rc(int b, int& R, int& C) { const int st = b / 1024, sb = b % 1024, swz = sb ^ (((sb >> 9) & 1) << 5); R = (st >> 1) * 16 + swz / 64; C = (st & 1) * 32 + (swz % 64) / 2; }
__host__ __device__ __forceinline__ int perm32(int rho) { const int n = rho >> 4, i = rho & 15; return 8 * (i >> 2) + 4 * n + (i & 3); }

struct Unit { int pm, pn; };
struct Gemm { const bf16_t* A; const bf16_t* Bt; int M, N, K; };

struct StaticOrder {
    int nM, nN, nwg, G, c;
    __host__ __device__ void init(int M, int N, int G_, int c_) { nM = M / BM; nN = N / BM; nwg = nM * nN; G = G_; c = c_; }
    __host__ __device__ bool next(int i, Unit& u) const {
        const long L = (long)i * G + c; if (L >= nwg) return false;
        int wgid = (int)L; { const int q = nwg / NXCD, r = nwg % NXCD, xcd = wgid % NXCD, off = wgid / NXCD; wgid = (xcd < r ? xcd * (q + 1) : r * (q + 1) + (xcd - r) * q) + off; }
        const int nig = WGM * nN, gid = wgid / nig, fm = gid * WGM, gsz = (nM - fm) < WGM ? (nM - fm) : WGM;
        u.pm = fm + ((wgid % nig) % gsz); u.pn = (wgid % nig) / gsz; return true;
    }
    __device__ __forceinline__ void a_ready(const Unit&) const {}
    __device__ __forceinline__ void done(const Unit&) const {}
};

__device__ __forceinline__ unsigned cvt_pk_bf16(float lo, float hi) { unsigned r; asm volatile("v_cvt_pk_bf16_f32 %0, %1, %2" : "=v"(r) : "v"(lo), "v"(hi)); return r; }
__device__ __forceinline__ int lane_id_v() { int l; asm volatile("v_mbcnt_lo_u32_b32 %0, -1, 0\n\tv_mbcnt_hi_u32_b32 %0, -1, %0" : "=v"(l)); return l; }
__device__ __forceinline__ float fsigmoid(float x) { return __builtin_amdgcn_rcpf(1.f + __builtin_amdgcn_exp2f(-1.4426950408889634f * x)); }

struct EpiProj {
    static constexpr bool PERM = true, AFTER_DRAIN = false;
    bf16_t* GLU; bf16_t* HG;
    static constexpr size_t MROWS = 32768;
    __device__ __forceinline__ void operator()(const f32x4 (&acc)[2][2][4][2], const Unit& u, int wr, int wc, int fr, int fq) const {
        const int row0 = u.pm * BM + wr * 64 + fr;
        if (u.pn < 4) {
            const int col = u.pn * 128 + wc * 32 + 8 * fq;
#pragma unroll
            for (int ai = 0; ai < 2; ++ai)
#pragma unroll
                for (int m = 0; m < 4; ++m) {
                    const f32x4 a0 = acc[ai][0][m][0], a1 = acc[ai][0][m][1], g0 = acc[ai][1][m][0], g1 = acc[ai][1][m][1];
                    u32x4 w;
                    w.x = cvt_pk_bf16(a0[0] * fsigmoid(g0[0]), a0[1] * fsigmoid(g0[1])); w.y = cvt_pk_bf16(a0[2] * fsigmoid(g0[2]), a0[3] * fsigmoid(g0[3]));
                    w.z = cvt_pk_bf16(a1[0] * fsigmoid(g1[0]), a1[1] * fsigmoid(g1[1])); w.w = cvt_pk_bf16(a1[2] * fsigmoid(g1[2]), a1[3] * fsigmoid(g1[3]));
                    *(u32x4*)(GLU + ((size_t)(col >> 6) * MROWS + (row0 + ai * HALF + m * 16)) * 64 + (col & 63)) = w;
                }
        } else {
            const int t = u.pn - 4;
            const bool act = (t < 2) || (t >= 6);
            const int col = t * 256 + wc * 32 + 8 * fq;
#pragma unroll
            for (int ai = 0; ai < 2; ++ai)
#pragma unroll
                for (int m = 0; m < 4; ++m) {
                    const int hcol = (t & 1) * 256 + wc * 32 + 8 * fq;
                    bf16_t* rowp = HG + ((size_t)((t >> 1) * 4 + (hcol >> 7)) * MROWS + (row0 + ai * HALF + m * 16)) * 128 + (hcol & 127);
#pragma unroll
                    for (int bj = 0; bj < 2; ++bj) {
                        f32x4 v0 = acc[ai][bj][m][0], v1 = acc[ai][bj][m][1];
                        if (act) {
#pragma unroll
                            for (int i = 0; i < 4; ++i) { v0[i] = v0[i] * fsigmoid(v0[i]); v1[i] = v1[i] * fsigmoid(v1[i]); }
                        }
                        u32x4 w; w.x = cvt_pk_bf16(v0[0], v0[1]); w.y = cvt_pk_bf16(v0[2], v0[3]); w.z = cvt_pk_bf16(v1[0], v1[1]); w.w = cvt_pk_bf16(v1[2], v1[3]);
                        *(u32x4*)(rowp + (size_t)bj * MROWS * 128) = w;
                    }
                }
        }
    }
};

struct EpiResBf16 {
    static constexpr bool PERM = true, AFTER_DRAIN = false;
    bf16_t* O; const float* R; float* SSQ;
    __device__ __forceinline__ void operator()(const f32x4 (&acc)[2][2][4][2], const Unit& u, int wr, int wc, int fr, int fq) const {
        const int row0 = u.pm * BM + wr * 64 + fr, col0 = u.pn * BM + wc * 32 + 8 * fq;
#pragma unroll
        for (int ai = 0; ai < 2; ++ai) {
            f32x4 rv[4][2][2];
#pragma unroll
            for (int m = 0; m < 4; ++m) { const size_t off = (size_t)(row0 + ai * HALF + m * 16) * 1024 + col0;
#pragma unroll
                for (int bj = 0; bj < 2; ++bj) { rv[m][bj][0] = *(const f32x4*)(R + off + bj * HALF); rv[m][bj][1] = *(const f32x4*)(R + off + bj * HALF + 4); } }
#pragma unroll
            for (int m = 0; m < 4; ++m) {
                const int row = row0 + ai * HALF + m * 16; const size_t off = (size_t)row * 1024 + col0;
                float ss = 0.f;
#pragma unroll
                for (int bj = 0; bj < 2; ++bj) {
                    const f32x4 v0 = acc[ai][bj][m][0] + rv[m][bj][0], v1 = acc[ai][bj][m][1] + rv[m][bj][1];
                    ss += (v0[0] * v0[0] + v0[1] * v0[1]) + (v0[2] * v0[2] + v0[3] * v0[3]) + (v1[0] * v1[0] + v1[1] * v1[1]) + (v1[2] * v1[2] + v1[3] * v1[3]);
                    u32x4 w; w.x = cvt_pk_bf16(v0[0], v0[1]); w.y = cvt_pk_bf16(v0[2], v0[3]); w.z = cvt_pk_bf16(v1[0], v1[1]); w.w = cvt_pk_bf16(v1[2], v1[3]);
                    *(u32x4*)(O + off + bj * HALF) = w;
                }
                ss += __shfl_xor(ss, 16); ss += __shfl_xor(ss, 32);
                if (fq == 0) SSQ[(size_t)row * 16 + u.pn * 4 + wc] = ss;
            }
        }
    }
};

__device__ __forceinline__ unsigned f2key(float f) { const unsigned u = __builtin_bit_cast(unsigned, f); return (u & 0x80000000u) ? ~u : (u | 0x80000000u); }
__device__ __forceinline__ float key2f(unsigned k) { const unsigned u = (k & 0x80000000u) ? (k & 0x7fffffffu) : ~k; return __builtin_bit_cast(float, u); }
__device__ __forceinline__ unsigned umax_(unsigned a, unsigned b) { return a > b ? a : b; }
__device__ __forceinline__ unsigned umin_(unsigned a, unsigned b) { return a < b ? a : b; }
__device__ __forceinline__ void sort16_desc(unsigned (&v)[16]) {
#pragma unroll
    for (int k = 2; k <= 16; k <<= 1)
#pragma unroll
        for (int j = k >> 1; j > 0; j >>= 1)
#pragma unroll
            for (int i = 0; i < 16; ++i) { const int l = i ^ j; if (l > i) { const unsigned hi = umax_(v[i], v[l]), lo = umin_(v[i], v[l]); if ((i & k) == 0) { v[i] = hi; v[l] = lo; } else { v[i] = lo; v[l] = hi; } } }
}
__device__ __forceinline__ void bmerge16_desc(unsigned (&v)[16]) {
#pragma unroll
    for (int j = 8; j > 0; j >>= 1)
#pragma unroll
        for (int i = 0; i < 16; ++i) { const int l = i ^ j; if (l > i) { const unsigned hi = umax_(v[i], v[l]), lo = umin_(v[i], v[l]); v[i] = hi; v[l] = lo; } }
}
struct EpiTopK {
    static constexpr bool PERM = false, AFTER_DRAIN = true;
    int* EIDX; float* GATE; const float* SSQ;
    __device__ __forceinline__ void fused(f32x4 (&acc)[2][2][4][2], const Unit& u, int wr, int wc, int fr, int fq, PG8_LAS unsigned char* lds, int wid, int lane) const {
        PG8_LAS unsigned* T = (PG8_LAS unsigned*)lds;
        PG8_LAS unsigned* LB = (PG8_LAS unsigned*)(lds + 131072);
        const int h = u.pn;
#pragma unroll
        for (int ai = 0; ai < 2; ++ai) {
            const int rl = wr * 64 + fr;
#pragma unroll
            for (int bj = 0; bj < 2; ++bj)
#pragma unroll
                for (int m = 0; m < 4; ++m)
#pragma unroll
                    for (int n = 0; n < 2; ++n)
#pragma unroll
                        for (int i = 0; i < 4; ++i) {
                            const int c = bj * 128 + wc * 32 + n * 16 + fq * 4 + i;
                            const float v = acc[ai][bj][m][n][i];
                            T[c * 128 + rl + m * 16] = (f2key(v) & ~127u) | (unsigned)(127 - (c & 127));
                        }
            asm volatile("s_waitcnt lgkmcnt(0)" ::: "memory"); __builtin_amdgcn_s_barrier(); asm volatile("" ::: "memory");
            {
                const int p = wid >> 2, q = (wid >> 1) & 1, r = (wid & 1) * 64 + lane, base = p * 128 + q * 64;
                unsigned run[16], grp[16];
#pragma unroll
                for (int j = 0; j < 16; ++j) run[j] = T[(base + j) * 128 + r];
                sort16_desc(run);
#pragma unroll
                for (int gI = 1; gI < 4; ++gI) {
#pragma unroll
                    for (int j = 0; j < 16; ++j) grp[j] = T[(base + 16 * gI + j) * 128 + r];
                    sort16_desc(grp);
#pragma unroll
                    for (int j = 0; j < 16; ++j) run[j] = umax_(run[j], grp[15 - j]);
                    bmerge16_desc(run);
                }
#pragma unroll
                for (int j = 0; j < 16; ++j) LB[((p * 2 + q) * 16 + j) * 128 + r] = run[j];
            }
            asm volatile("s_waitcnt lgkmcnt(0)" ::: "memory"); __builtin_amdgcn_s_barrier(); asm volatile("" ::: "memory");
            if (wid < 4) {
                const int p = wid >> 1, r = (wid & 1) * 64 + lane;
                unsigned a[16];
#pragma unroll
                for (int j = 0; j < 16; ++j) a[j] = umax_(LB[((p * 2) * 16 + j) * 128 + r], LB[((p * 2 + 1) * 16 + (15 - j)) * 128 + r]);
                bmerge16_desc(a);
#pragma unroll
                for (int j = 0; j < 16; ++j) LB[((p * 2) * 16 + j) * 128 + r] = a[j];
            }
            asm volatile("s_waitcnt lgkmcnt(0)" ::: "memory"); __builtin_amdgcn_s_barrier(); asm volatile("" ::: "memory");
            if (wid < 2) {
                const int r = wid * 64 + lane;
                float v1[16], v2[16];
#pragma unroll
                for (int j = 0; j < 16; ++j) { v1[j] = key2f(LB[j * 128 + r] & ~127u); v2[j] = key2f(LB[(32 + j) * 128 + r] & ~127u); }
                unsigned lst[16];
#pragma unroll
                for (int j = 0; j < 16; ++j) lst[j] = (f2key(v1[0] + v2[j]) & ~255u) | (unsigned)(255 - j);
#pragma unroll
                for (int i = 1; i < 16; ++i)
#pragma unroll
                    for (int j = 0; j < 16; ++j) if ((i + 1) * (j + 1) <= 16) {
                        unsigned x = (f2key(v1[i] + v2[j]) & ~255u) | (unsigned)(255 - (i * 16 + j));
#pragma unroll
                        for (int t = 0; t < 16; ++t) if (t >= (i + 1) * (j + 1) - 1) { const unsigned hi = umax_(lst[t], x); x = umin_(lst[t], x); lst[t] = hi; }
                    }
                float rstd;
                { const f32x4* sq = (const f32x4*)(SSQ + (size_t)(u.pm * BM + ai * 128 + r) * 16); const f32x4 q0 = sq[0], q1 = sq[1], q2 = sq[2], q3 = sq[3];
                  const float tot = ((q0[0] + q0[1]) + (q0[2] + q0[3])) + ((q1[0] + q1[1]) + (q1[2] + q1[3])) + ((q2[0] + q2[1]) + (q2[2] + q2[3])) + ((q3[0] + q3[1]) + (q3[2] + q3[3]));
                  rstd = rsqrtf(tot * (1.f / 1024.f) + 1e-6f); }
                float e[16]; float sum = 0.f; const float mx = key2f(lst[0] & ~255u);
                int ex[16];
#pragma unroll
                for (int t = 0; t < 16; ++t) {
                    e[t] = __expf((key2f(lst[t] & ~255u) - mx) * rstd); sum += e[t];
                    const int ci = 255 - (int)(lst[t] & 255u), a = ci >> 4, b = ci & 15;
                    const int i1 = 127 - (int)(LB[a * 128 + r] & 127u), i2 = 127 - (int)(LB[(32 + b) * 128 + r] & 127u);
                    ex[t] = i1 * 128 + i2;
                }
                const float inv = 1.f / sum;
                const size_t o = (size_t)(u.pm * BM + ai * 128 + r) * 128 + h * 16;
#pragma unroll
                for (int t4 = 0; t4 < 4; ++t4) {
                    *(f32x4*)(GATE + o + 4 * t4) = (f32x4){e[4 * t4] * inv, e[4 * t4 + 1] * inv, e[4 * t4 + 2] * inv, e[4 * t4 + 3] * inv};
                    *(u32x4*)(EIDX + o + 4 * t4) = (u32x4){(unsigned)ex[4 * t4], (unsigned)ex[4 * t4 + 1], (unsigned)ex[4 * t4 + 2], (unsigned)ex[4 * t4 + 3]};
                }
            }
            asm volatile("s_waitcnt lgkmcnt(0)" ::: "memory"); __builtin_amdgcn_s_barrier(); asm volatile("" ::: "memory");
        }
    }
};
struct OneUnit {
    Unit u;
    __device__ __forceinline__ bool next(int i, Unit& o) const { if (i) return false; o = u; return true; }
    __device__ __forceinline__ void a_ready(const Unit&) const {}
    __device__ __forceinline__ void done(const Unit&) const {}
};

template <class Epi, class Sched, bool ALIGN_EPI = false, bool SP2 = false>
__device__ __forceinline__ void gemm_phase(PG8_LAS unsigned char* lds, const Gemm g, const Sched& S, const Epi& E, const int wid) {
    const int lane = lane_id_v(), tid = wid * 64 + lane, wr = wid >> 2, wc = wid & 3, fr = lane & 15, fq = lane >> 4;
    const int K = g.K, nt = K / BK;
    unsigned voffA[2], voffB[2];
#pragma unroll
    for (int i = 0; i < 2; ++i) { int R, C; stage_rc(tid * 16 + i * 8192, R, C); const int Rb = Epi::PERM ? ((R & ~31) + perm32(R & 31)) : R;
        voffA[i] = (unsigned)(R * K + C) * 2u; voffB[i] = (unsigned)(Rb * K + C) * 2u; }
    const size_t kstep = (size_t)(BK * 2);
    const size_t hstep = (size_t)HALF * K * 2;
    const size_t tstep = 2 * hstep;
    const unsigned ldsw = (unsigned)wid * 1024u;
    const int aoff = lds_byte(wr * 64 + fr, fq * 8), boff = lds_byte(wc * 32 + fr, fq * 8);
#define PG8_SA(b, h) (((b) * 2 + (h)) * HTB)
#define PG8_SB(b, h) ((4 + (b) * 2 + (h)) * HTB)
#define PG8_STAGE(bufoff, gbase, voff) do { _Pragma("unroll") for (int _i = 0; _i < 2; ++_i) \
        __builtin_amdgcn_global_load_lds((const unsigned*)((const char*)(gbase) + (voff)[_i]), (PG8_LAS unsigned*)(lds + (bufoff) + ldsw + _i * 8192), 16, 0, 0); } while (0)
#define PG8_LDA(dst, b, h) do { _Pragma("unroll") for (int m = 0; m < 4; ++m) _Pragma("unroll") for (int k = 0; k < 2; ++k) dst[m][k] = *(const PG8_LAS bf16x8*)(lds + PG8_SA(b, h) + aoff + m * 2048 + k * 1024); } while (0)
#define PG8_LDB(dst, b, h) do { _Pragma("unroll") for (int n = 0; n < 2; ++n) _Pragma("unroll") for (int k = 0; k < 2; ++k) dst[n][k] = *(const PG8_LAS bf16x8*)(lds + PG8_SB(b, h) + boff + n * 2048 + k * 1024); } while (0)
#define PG8_MMA(ai, bj, At, Bt) do { __builtin_amdgcn_s_setprio(1); _Pragma("unroll") for (int m = 0; m < 4; ++m) _Pragma("unroll") for (int n = 0; n < 2; ++n) _Pragma("unroll") for (int k = 0; k < 2; ++k) \
        acc[ai][bj][m][n] = __builtin_amdgcn_mfma_f32_16x16x32_bf16(Bt[n][k], At[m][k], acc[ai][bj][m][n], 0, 0, 0); __builtin_amdgcn_s_setprio(0); } while (0)
#define PG8_WAIT_V(n) asm volatile("s_waitcnt vmcnt(" #n ")" ::: "memory")
#define PG8_WAIT_L(n) asm volatile("s_waitcnt lgkmcnt(" #n ")" ::: "memory")
#define PG8_BAR __builtin_amdgcn_s_barrier()
#define PG8_SCHED __builtin_amdgcn_sched_barrier(0)
    Unit cur, nxt; int ui = 0;
    if (!S.next(0, cur)) return;
    f32x4 acc[2][2][4][2];
#pragma unroll
    for (int a = 0; a < 2; ++a)
#pragma unroll
        for (int b = 0; b < 2; ++b)
#pragma unroll
            for (int m = 0; m < 4; ++m)
#pragma unroll
                for (int n = 0; n < 2; ++n) acc[a][b][m][n] = (f32x4){0.f, 0.f, 0.f, 0.f};
    bf16x8 At[4][2], B0[2][2], B1[2][2];
    const char* cA = (const char*)g.A + (size_t)cur.pm * tstep; const char* cB = (const char*)g.Bt + (size_t)cur.pn * tstep;
    S.a_ready(cur);
    if constexpr (SP2) {
        PG8_STAGE(PG8_SB(0, 0), cB, voffB); PG8_STAGE(PG8_SB(0, 1), cB + hstep, voffB); PG8_STAGE(PG8_SA(0, 0), cA, voffA); PG8_STAGE(PG8_SA(0, 1), cA + hstep, voffA);
        if (wr == 1) PG8_BAR;
        PG8_WAIT_V(2); PG8_BAR;
        PG8_STAGE(PG8_SB(1, 0), cB + kstep, voffB); PG8_STAGE(PG8_SA(1, 0), cA + kstep, voffA); PG8_STAGE(PG8_SB(1, 1), cB + hstep + kstep, voffB);
        PG8_WAIT_V(6); PG8_BAR;
    } else {
        PG8_STAGE(PG8_SB(0, 0), cB, voffB); PG8_STAGE(PG8_SA(0, 0), cA, voffA); PG8_STAGE(PG8_SB(0, 1), cB + hstep, voffB); PG8_STAGE(PG8_SA(0, 1), cA + hstep, voffA);
        if (wr == 1) PG8_BAR;
        PG8_WAIT_V(4); PG8_BAR;
        PG8_STAGE(PG8_SB(1, 0), cB + kstep, voffB); PG8_STAGE(PG8_SA(1, 0), cA + kstep, voffA); PG8_STAGE(PG8_SB(1, 1), cB + hstep + kstep, voffB);
        PG8_WAIT_V(6); PG8_BAR;
    }
    for (;;) {
        const bool has_next = S.next(ui + 1, nxt);
        const char* nA = has_next ? (const char*)g.A + (size_t)nxt.pm * tstep : cA; const char* nB = has_next ? (const char*)g.Bt + (size_t)nxt.pn * tstep : cB;
        for (int t = 0; t < nt; t += 2) {
            const bool last = (t == nt - 2);
            const char* a1 = cA + (size_t)(t + 1) * kstep;
            const char* a2 = last ? nA : cA + (size_t)(t + 2) * kstep; const char* b2 = last ? nB : cB + (size_t)(t + 2) * kstep;
            const char* a3 = a2 + kstep; const char* b3 = b2 + kstep;
            if (last && has_next) S.a_ready(nxt);
            if constexpr (SP2) {
            PG8_LDB(B0, 0, 0); PG8_LDB(B1, 0, 1); PG8_SCHED; PG8_LDA(At, 0, 0); PG8_STAGE(PG8_SA(1, 1), a1 + hstep, voffA);
            PG8_WAIT_V(8); PG8_WAIT_L(0); PG8_BAR; PG8_MMA(0, 0, At, B0); PG8_MMA(0, 1, At, B1); PG8_BAR; PG8_SCHED;
            PG8_LDA(At, 0, 1); PG8_STAGE(PG8_SB(0, 0), b2, voffB); PG8_STAGE(PG8_SB(0, 1), b2 + hstep, voffB); PG8_STAGE(PG8_SA(0, 0), a2, voffA);
            PG8_WAIT_V(8); PG8_WAIT_L(0); PG8_BAR; PG8_MMA(1, 0, At, B0); PG8_MMA(1, 1, At, B1); PG8_BAR; PG8_SCHED;
            PG8_LDB(B0, 1, 0); PG8_LDB(B1, 1, 1); PG8_SCHED; PG8_LDA(At, 1, 0); PG8_STAGE(PG8_SA(0, 1), a2 + hstep, voffA);
            PG8_WAIT_V(8); PG8_WAIT_L(0); PG8_BAR; PG8_MMA(0, 0, At, B0); PG8_MMA(0, 1, At, B1); PG8_BAR; PG8_SCHED;
            PG8_LDA(At, 1, 1); PG8_STAGE(PG8_SB(1, 0), b3, voffB); PG8_STAGE(PG8_SB(1, 1), b3 + hstep, voffB); PG8_STAGE(PG8_SA(1, 0), a3, voffA);
            PG8_WAIT_V(8); PG8_WAIT_L(0); PG8_BAR; PG8_MMA(1, 0, At, B0); PG8_MMA(1, 1, At, B1); PG8_BAR; PG8_SCHED;
            } else {
            PG8_LDB(B0, 0, 0); PG8_SCHED; PG8_LDA(At, 0, 0); PG8_STAGE(PG8_SA(1, 1), a1 + hstep, voffA);
            PG8_WAIT_L(8); PG8_BAR; PG8_WAIT_L(0); PG8_MMA(0, 0, At, B0); PG8_BAR; PG8_SCHED;
            PG8_LDB(B1, 0, 1); PG8_STAGE(PG8_SB(0, 0), b2, voffB);
            PG8_BAR; PG8_WAIT_L(0); PG8_MMA(0, 1, At, B1); PG8_BAR;
            PG8_LDA(At, 0, 1); PG8_STAGE(PG8_SA(0, 0), a2, voffA);
            PG8_BAR; PG8_WAIT_L(0); PG8_MMA(1, 0, At, B0); PG8_BAR; PG8_SCHED;
            PG8_STAGE(PG8_SB(0, 1), b2 + hstep, voffB);
            PG8_WAIT_V(6); PG8_BAR; PG8_MMA(1, 1, At, B1); PG8_BAR;
            PG8_LDB(B0, 1, 0); PG8_SCHED; PG8_LDA(At, 1, 0); PG8_STAGE(PG8_SA(0, 1), a2 + hstep, voffA);
            PG8_WAIT_L(8); PG8_BAR; PG8_WAIT_L(0); PG8_MMA(0, 0, At, B0); PG8_BAR; PG8_SCHED;
            PG8_LDB(B1, 1, 1); PG8_STAGE(PG8_SB(1, 0), b3, voffB);
            PG8_BAR; PG8_WAIT_L(0); PG8_MMA(0, 1, At, B1); PG8_BAR;
            PG8_LDA(At, 1, 1); PG8_STAGE(PG8_SA(1, 0), a3, voffA);
            PG8_BAR; PG8_WAIT_L(0); PG8_MMA(1, 0, At, B0); PG8_BAR; PG8_SCHED;
            PG8_STAGE(PG8_SB(1, 1), b3 + hstep, voffB);
            PG8_WAIT_V(6); PG8_BAR; PG8_MMA(1, 1, At, B1); PG8_BAR;
            }
        }
        if constexpr (ALIGN_EPI) { if (wr == 0) PG8_BAR; }
        if constexpr (!Epi::AFTER_DRAIN) { E(acc, cur, wr, wc, fr, fq); S.done(cur); }
        if (!has_next) break;
#pragma unroll
        for (int a = 0; a < 2; ++a)
#pragma unroll
            for (int b = 0; b < 2; ++b)
#pragma unroll
                for (int m = 0; m < 4; ++m)
#pragma unroll
                    for (int n = 0; n < 2; ++n) acc[a][b][m][n] = (f32x4){0.f, 0.f, 0.f, 0.f};
        cur = nxt; cA = nA; cB = nB; ++ui;
        if constexpr (ALIGN_EPI) { if (wr == 1) PG8_BAR; }
    }
    PG8_WAIT_V(0);
    if constexpr (!ALIGN_EPI) { if (wr == 0) PG8_BAR; }
    PG8_BAR;
    if constexpr (Epi::AFTER_DRAIN) { E.fused(acc, cur, wr, wc, fr, fq, lds, wid, lane); S.done(cur); }
#undef PG8_SA
#undef PG8_SB
#undef PG8_STAGE
#undef PG8_LDA
#undef PG8_LDB
#undef PG8_MMA
#undef PG8_WAIT_V
#undef PG8_WAIT_L
#undef PG8_BAR
#undef PG8_SCHED
}
}

namespace mk {
using pg8::bf16_t; using pg8::bf16x8; using pg8::f32x4; using pg8::u32x4; using pg8::cvt_pk_bf16; using pg8::fsigmoid;
#define LAS __attribute__((address_space(3)))
typedef unsigned u32x2 __attribute__((ext_vector_type(2)));
typedef float f32x2 __attribute__((ext_vector_type(2)));
typedef short bf16x4 __attribute__((ext_vector_type(4)));
constexpr int NWAVES = 8, NT = 512;
constexpr int D = 1024, BATCH = 8, SEQ = 4096, M = BATCH * SEQ, DCONV = 512, CW = 31, DH = 512, NH = 4, HD = 128, DIN = 3072, NQ = 2048, NEXP = 16384;
constexpr int SEGS = 8, SEGLEN = SEQ / SEGS, NCH = SEGLEN / 64;
constexpr float EPS = 1e-6f;
constexpr size_t MiB = 1u << 20;
constexpr size_t WS_WIN = 2 * MiB, WS_WOUT = 8 * MiB, WS_WEFF = 10 * MiB, WS_HS = 14 * MiB, WS_HLD = 30 * MiB, WS_USC = 31 * MiB, WS_VSC = 31 * MiB + 65536, WS_SSQ = 48 * MiB, WS_U = 32 * MiB, WS_V = 64 * MiB, WS_XN = 96 * MiB,
                 WS_GLU = 160 * MiB, WS_HG = 192 * MiB, WS_Y = 320 * MiB, WS_EIDX = 416 * MiB, WS_GATE = 432 * MiB, WS_END = 448 * MiB;
constexpr int LDS_BYTES = 163840;
#ifndef PEER_V4_DEF
#define PEER_V4_DEF true
#endif
constexpr bool PEER_V4 = PEER_V4_DEF;
#ifndef U_NIBSWAP_DEF
#define U_NIBSWAP_DEF false
#endif
constexpr bool U_NIBSWAP = U_NIBSWAP_DEF;

#define LDS_WAIT() asm volatile("s_waitcnt lgkmcnt(0)" ::: "memory")
#define BLOCK_BAR() do { asm volatile("s_waitcnt lgkmcnt(0)" ::: "memory"); __builtin_amdgcn_s_barrier(); asm volatile("" ::: "memory"); } while (0)
__device__ __forceinline__ float wave_sum(float v) {
#pragma unroll
    for (int o = 1; o < 64; o <<= 1) v += __shfl_xor(v, o);
    return v;
}
__device__ __forceinline__ float wave_sum_dpp(float v) {
    v += __builtin_bit_cast(float, __builtin_amdgcn_update_dpp(0, __builtin_bit_cast(int, v), 0x111, 0xf, 0xf, false));
    v += __builtin_bit_cast(float, __builtin_amdgcn_update_dpp(0, __builtin_bit_cast(int, v), 0x112, 0xf, 0xf, false));
    v += __builtin_bit_cast(float, __builtin_amdgcn_update_dpp(0, __builtin_bit_cast(int, v), 0x114, 0xf, 0xf, false));
    v += __builtin_bit_cast(float, __builtin_amdgcn_update_dpp(0, __builtin_bit_cast(int, v), 0x118, 0xf, 0xf, false));
    v += __builtin_bit_cast(float, __builtin_amdgcn_update_dpp(0, __builtin_bit_cast(int, v), 0x142, 0xa, 0xf, false));
    v += __builtin_bit_cast(float, __builtin_amdgcn_update_dpp(0, __builtin_bit_cast(int, v), 0x143, 0xc, 0xf, false));
    return __builtin_bit_cast(float, __builtin_amdgcn_readlane(__builtin_bit_cast(int, v), 63));
}
__device__ __forceinline__ float wave_max_dpp(float v) {
    v = fmaxf(v, __builtin_bit_cast(float, __builtin_amdgcn_update_dpp(0, __builtin_bit_cast(int, v), 0x111, 0xf, 0xf, false)));
    v = fmaxf(v, __builtin_bit_cast(float, __builtin_amdgcn_update_dpp(0, __builtin_bit_cast(int, v), 0x112, 0xf, 0xf, false)));
    v = fmaxf(v, __builtin_bit_cast(float, __builtin_amdgcn_update_dpp(0, __builtin_bit_cast(int, v), 0x114, 0xf, 0xf, false)));
    v = fmaxf(v, __builtin_bit_cast(float, __builtin_amdgcn_update_dpp(0, __builtin_bit_cast(int, v), 0x118, 0xf, 0xf, false)));
    v = fmaxf(v, __builtin_bit_cast(float, __builtin_amdgcn_update_dpp(0, __builtin_bit_cast(int, v), 0x142, 0xa, 0xf, false)));
    v = fmaxf(v, __builtin_bit_cast(float, __builtin_amdgcn_update_dpp(0, __builtin_bit_cast(int, v), 0x143, 0xc, 0xf, false)));
    return __builtin_bit_cast(float, __builtin_amdgcn_readlane(__builtin_bit_cast(int, v), 63));
}
__device__ __forceinline__ float bf_lo(unsigned u) { return __builtin_bit_cast(float, u << 16); }
__device__ __forceinline__ float bf_hi(unsigned u) { return __builtin_bit_cast(float, u & 0xffff0000u); }
__device__ __forceinline__ float bf1(bf16_t u) { return __builtin_bit_cast(float, (unsigned)u << 16); }
__device__ __forceinline__ float fsilu(float x) { return x * fsigmoid(x); }

struct Args { const float* in[16]; float* out; unsigned char* ws; int ph_lo, ph_hi, sub, pad; };

__device__ __forceinline__ void p0_transpose_item(const float* __restrict__ W, int K, int N, bf16_t* __restrict__ WT, int out_row0, const float* __restrict__ gk, LAS float* scr, int k0, int n0, int lane) {
#pragma unroll 8
    for (int i = 0; i < 32; ++i) { const int kk = 2 * i + (lane >> 5); const float s = gk ? gk[k0 + kk] : 1.f; scr[kk * 33 + (lane & 31)] = W[(size_t)(k0 + kk) * N + n0 + (lane & 31)] * s; }
    LDS_WAIT();
    const int c = lane & 7;
#pragma unroll
    for (int j = 0; j < 4; ++j) { const int n = (lane >> 3) + 8 * j; const LAS float* s = scr + (8 * c) * 33 + n;
        u32x4 o; o.x = cvt_pk_bf16(s[0 * 33], s[1 * 33]); o.y = cvt_pk_bf16(s[2 * 33], s[3 * 33]); o.z = cvt_pk_bf16(s[4 * 33], s[5 * 33]); o.w = cvt_pk_bf16(s[6 * 33], s[7 * 33]);
        *(u32x4*)(WT + (size_t)(out_row0 + n) * K + k0 + 8 * c) = o; }
    LDS_WAIT();
}
__device__ __forceinline__ void row_to_bf16(const float* __restrict__ src, bf16_t* __restrict__ dst, const float* __restrict__ gv, bool norm, int lane) {
    const f32x4* xr = (const f32x4*)src + lane;
    f32x4 v[4]; float s = 0.f;
#pragma unroll
    for (int j = 0; j < 4; ++j) { v[j] = xr[64 * j]; s += (v[j].x * v[j].x + v[j].y * v[j].y) + (v[j].z * v[j].z + v[j].w * v[j].w); }
    float r = 1.f;
    if (norm) r = rsqrtf(wave_sum(s) * (1.f / D) + EPS);
    u32x2* o8 = (u32x2*)dst + lane;
#pragma unroll
    for (int j = 0; j < 4; ++j) {
        f32x4 t = v[j] * r;
        if (gv) t = t * ((const f32x4*)gv)[lane + 64 * j];
        u32x2 w; w.x = cvt_pk_bf16(t.x, t.y); w.y = cvt_pk_bf16(t.z, t.w); o8[64 * j] = w;
    }
}
__device__ __forceinline__ void row_to_fp8(const float* __restrict__ src, unsigned char* __restrict__ dst, const float* __restrict__ gv, float sc, int lane) {
    const f32x4* xr = (const f32x4*)src + lane;
    unsigned* o4 = (unsigned*)dst + lane;
#pragma unroll
    for (int j = 0; j < 4; ++j) {
        f32x4 t = xr[64 * j] * sc;
        if (gv) t = t * ((const f32x4*)gv)[lane + 64 * j];
        int w = __builtin_amdgcn_cvt_pk_fp8_f32(t.x, t.y, 0, false); w = __builtin_amdgcn_cvt_pk_fp8_f32(t.z, t.w, w, true);
        o4[64 * j] = (unsigned)w;
    }
}
template <int MODE>
__device__ __forceinline__ void rows_convert(const float* __restrict__ src, unsigned char* __restrict__ dst, const float* __restrict__ gv, float sc, int nrows, int gw, int NGW, int lane) {
    if (nrows % (4 * NGW) != 0) {
        for (int r = gw; r < nrows; r += NGW) { if (MODE == 0) row_to_bf16(src + (size_t)r * D, (bf16_t*)dst + (size_t)r * D, nullptr, true, lane); else row_to_fp8(src + (size_t)r * D, dst + (size_t)r * D, MODE == 1 ? gv : nullptr, sc, lane); }
        return;
    }
    f32x4 gq[4];
    if (MODE == 1) {
#pragma unroll
        for (int j = 0; j < 4; ++j) gq[j] = ((const f32x4*)gv)[lane + 64 * j] * sc;
    }
    for (int r = gw; r < nrows; r += 4 * NGW) {
        f32x4 v[4][4];
#pragma unroll
        for (int k = 0; k < 4; ++k)
#pragma unroll
            for (int j = 0; j < 4; ++j) v[k][j] = ((const f32x4*)(src + (size_t)(r + k * NGW) * D))[lane + 64 * j];
#pragma unroll
        for (int k = 0; k < 4; ++k) {
            if (MODE == 0) {
                float s = 0.f;
#pragma unroll
                for (int j = 0; j < 4; ++j) s += (v[k][j].x * v[k][j].x + v[k][j].y * v[k][j].y) + (v[k][j].z * v[k][j].z + v[k][j].w * v[k][j].w);
                const float rr = rsqrtf(wave_sum(s) * (1.f / D) + EPS);
                u32x2* o8 = (u32x2*)((bf16_t*)dst + (size_t)(r + k * NGW) * D) + lane;
#pragma unroll
                for (int j = 0; j < 4; ++j) { const f32x4 t = v[k][j] * rr; u32x2 w; w.x = cvt_pk_bf16(t.x, t.y); w.y = cvt_pk_bf16(t.z, t.w); o8[64 * j] = w; }
            } else {
                unsigned* o4 = (unsigned*)(dst + (size_t)(r + k * NGW) * D) + lane;
#pragma unroll
                for (int j = 0; j < 4; ++j) { const f32x4 t = (MODE == 1) ? v[k][j] * gq[j] : v[k][j] * sc;
                    int w = __builtin_amdgcn_cvt_pk_fp8_f32(t.x, t.y, 0, false); w = __builtin_amdgcn_cvt_pk_fp8_f32(t.z, t.w, w, true); o4[64 * j] = (unsigned)w; }
            }
        }
    }
}
template <bool FP4, bool NATURAL = false, bool NIBSWAP = false>
__device__ __forceinline__ void rows_quant(const float* __restrict__ src, unsigned char* __restrict__ dst, float* __restrict__ scales, const float* __restrict__ gv, int nrows, int gw, int NGW, int lane) {
    f32x4 gq[4];
#pragma unroll
    for (int j = 0; j < 4; ++j) gq[j] = gv ? ((const f32x4*)gv)[NATURAL ? 4 * lane + j : lane + 64 * j] : (f32x4){1.f, 1.f, 1.f, 1.f};
    for (int r0 = gw; r0 < nrows; r0 += 4 * NGW) {
        f32x4 v[4][4];
#pragma unroll
        for (int k = 0; k < 4; ++k) { const int r = (r0 + k * NGW < nrows) ? r0 + k * NGW : r0;
#pragma unroll
            for (int j = 0; j < 4; ++j) v[k][j] = ((const f32x4*)(src + (size_t)r * D))[NATURAL ? 4 * lane + j : lane + 64 * j] * gq[j]; }
#pragma unroll
        for (int k = 0; k < 4; ++k) {
            const int r = r0 + k * NGW; if (r >= nrows) break;
            float am = 0.f;
#pragma unroll
            for (int j = 0; j < 4; ++j) am = fmaxf(am, fmaxf(fmaxf(fabsf(v[k][j].x), fabsf(v[k][j].y)), fmaxf(fabsf(v[k][j].z), fabsf(v[k][j].w))));
            am = wave_max_dpp(am);
            const float fmx = FP4 ? 6.f : 240.f;
            const float sc = am > 0.f ? am * (1.f / fmx) : 1.f, inv = am > 0.f ? fmx / am : 1.f;
            if (lane == 0) scales[r] = sc;
            if constexpr (FP4) {
                unsigned w0 = 0u, w1 = 0u;
                { const f32x4 t0 = v[k][0] * inv, t1 = v[k][1] * inv, t2 = v[k][2] * inv, t3 = v[k][3] * inv;
#define Q4(wd, a_, b_, sel) wd = NIBSWAP ? __builtin_amdgcn_cvt_scalef32_pk_fp4_f32(wd, b_, a_, 1.0f, sel) : __builtin_amdgcn_cvt_scalef32_pk_fp4_f32(wd, a_, b_, 1.0f, sel)
                  Q4(w0, t0.x, t0.y, 0); Q4(w0, t0.z, t0.w, 1); Q4(w0, t1.x, t1.y, 2); Q4(w0, t1.z, t1.w, 3);
                  Q4(w1, t2.x, t2.y, 0); Q4(w1, t2.z, t2.w, 1); Q4(w1, t3.x, t3.y, 2); Q4(w1, t3.z, t3.w, 3);
#undef Q4
                }
                ((u32x2*)(dst + (size_t)r * 512))[NATURAL ? lane : 2 * (lane & 31) + (lane >> 5)] = (u32x2){w0, w1};
            } else {
                u32x4 w;
#pragma unroll
                for (int j = 0; j < 4; ++j) { const f32x4 t = v[k][j] * inv; int q = __builtin_amdgcn_cvt_pk_fp8_f32(t.x, t.y, 0, false); q = __builtin_amdgcn_cvt_pk_fp8_f32(t.z, t.w, q, true); w[j] = (unsigned)q; }
                ((u32x4*)(dst + (size_t)r * 1024))[lane] = w;
            }
        }
    }
}
__device__ __forceinline__ void weff_unit(LAS unsigned char* lds, const float* __restrict__ wq, const float* __restrict__ sk, const float* __restrict__ g2, bf16_t* __restrict__ WE, int unit, int tid) {
    LAS float* SK = (LAS float*)lds;
    LAS float* WQ = (LAS float*)(lds + 128 * 129 * 4);
    const int hp = unit >> 5, d0 = (unit & 31) * 32;
#pragma unroll 4
    for (int i = 0; i < 32; ++i) { const int idx = tid + i * NT; SK[(idx >> 7) * 129 + (idx & 127)] = sk[(size_t)hp * 16384 + idx]; }
#pragma unroll
    for (int i = 0; i < 8; ++i) { const int idx = tid + i * NT; WQ[idx] = wq[(size_t)(d0 + (idx >> 7)) * NQ + hp * 128 + (idx & 127)]; }
    __syncthreads();
    const int n = tid & 127, dq = tid >> 7;
    float acc[8];
#pragma unroll
    for (int e = 0; e < 8; ++e) acc[e] = 0.f;
    for (int j4 = 0; j4 < 32; ++j4) {
        float s[4];
#pragma unroll
        for (int q = 0; q < 4; ++q) s[q] = SK[n * 129 + 4 * j4 + q];
#pragma unroll
        for (int e = 0; e < 8; ++e) { const f32x4 w = *(const LAS f32x4*)(WQ + (dq * 8 + e) * 128 + 4 * j4); acc[e] = fmaf(s[0], w.x, acc[e]); acc[e] = fmaf(s[1], w.y, acc[e]); acc[e] = fmaf(s[2], w.z, acc[e]); acc[e] = fmaf(s[3], w.w, acc[e]); }
    }
    const float* gp = g2 + d0 + dq * 8;
    u32x4 o; o.x = cvt_pk_bf16(acc[0] * gp[0], acc[1] * gp[1]); o.y = cvt_pk_bf16(acc[2] * gp[2], acc[3] * gp[3]); o.z = cvt_pk_bf16(acc[4] * gp[4], acc[5] * gp[5]); o.w = cvt_pk_bf16(acc[6] * gp[6], acc[7] * gp[7]);
    *(u32x4*)(WE + (size_t)(hp * 128 + n) * D + d0 + dq * 8) = o;
    __syncthreads();
}
__device__ __forceinline__ void weff_tile_mfma(const float* __restrict__ wq, const float* __restrict__ sk, const float* __restrict__ g2, bf16_t* __restrict__ WE, int tile, int lane) {
    const int hp = tile >> 9, rem = tile & 511, d0 = (rem >> 3) * 16, n0 = (rem & 7) * 16;
    const int li = lane & 15, kq = lane >> 4;
    const f32x4* ap = (const f32x4*)(wq + (size_t)(d0 + li) * NQ + hp * 128 + 32 * kq);
    const f32x4* bp = (const f32x4*)(sk + ((size_t)hp * 128 + n0 + li) * 128 + 32 * kq);
    f32x4 av[8], bv[8];
#pragma unroll
    for (int q = 0; q < 8; ++q) { av[q] = ap[q]; bv[q] = bp[q]; }
    f32x4 acc = (f32x4){0.f, 0.f, 0.f, 0.f};
#pragma unroll
    for (int q = 0; q < 8; ++q)
#pragma unroll
        for (int e = 0; e < 4; ++e) acc = __builtin_amdgcn_mfma_f32_16x16x4f32(av[q][e], bv[q][e], acc, 0, 0, 0);
    const f32x4 gg = *(const f32x4*)(g2 + d0 + 4 * kq);
    u32x2 o; o.x = cvt_pk_bf16(acc[0] * gg[0], acc[1] * gg[1]); o.y = cvt_pk_bf16(acc[2] * gg[2], acc[3] * gg[3]);
    *(u32x2*)(WE + (size_t)(hp * 128 + n0 + li) * D + d0 + 4 * kq) = o;
}
__device__ __forceinline__ void p0_prologue(const Args& a, LAS unsigned char* lds, int tid, int lane, int wave, int G) {
    unsigned char* ws = a.ws;
    LAS float* scr = (LAS float*)(lds + wave * 16384);
    const int gw = blockIdx.x * NWAVES + wave, NGW = G * NWAVES;
    if (!(a.sub & 1)) for (int tl = gw; tl < 8192; tl += NGW) weff_tile_mfma(a.in[11], a.in[12], a.in[10], (bf16_t*)(ws + WS_WEFF), tl, lane);
    constexpr int I_IN = (D / 64) * (DIN / 32), I_OUT = (D / 64) * (D / 32);
    if (!(a.sub & 2)) for (int it = gw; it < I_IN + I_OUT; it += NGW) {
        if (it < I_IN) {
            const int kb = it / (DIN / 32), nb = it % (DIN / 32), n0 = nb * 32;
            int r0;
            if (n0 < 512) r0 = 256 * (n0 >> 7) + (n0 & 127); else if (n0 < 1024) r0 = 256 * ((n0 - 512) >> 7) + 128 + ((n0 - 512) & 127); else r0 = n0;
            p0_transpose_item(a.in[2], D, DIN, (bf16_t*)(ws + WS_WIN), r0, a.in[1], scr, kb * 64, n0, lane);
        } else {
            const int r = it - I_IN, kb = r / (D / 32), nb = r % (D / 32);
            p0_transpose_item(a.in[9], D, D, (bf16_t*)(ws + WS_WOUT), nb * 32, nullptr, scr, kb * 64, nb * 32, lane);
        }
    }
    if (!(a.sub & 4)) rows_quant<true, true, U_NIBSWAP>(a.in[13], ws + WS_U, (float*)(ws + WS_USC), a.in[10], NEXP, gw, NGW, lane);
    if (!(a.sub & 4)) rows_quant<PEER_V4>(a.in[14], ws + WS_V, (float*)(ws + WS_VSC), nullptr, NEXP, gw, NGW, lane);
    if (!(a.sub & 8)) rows_convert<0>(a.in[0], ws + WS_XN, nullptr, 1.f, M, gw, NGW, lane);
}

__device__ __forceinline__ void conv_wave_unit(const bf16_t* __restrict__ GLU, const float* __restrict__ cw, const float* __restrict__ cb, const float* __restrict__ ng, const float* __restrict__ nb,
                                               bf16_t* __restrict__ Y, int wu, int lane) {
    const int grp = wu & 7, tb = wu >> 3, b = tb >> 5, s0 = (tb & 31) * 128, c = grp * 64 + lane;
    float w[CW];
#pragma unroll
    for (int j = 0; j < CW; ++j) w[j] = cw[j * DCONV + c];
    const float bias = cb[c], gam = ng[c], bet = nb[c];
    const size_t rowb = (size_t)b * SEQ;
    const bf16_t* GLUp = GLU + (size_t)grp * M * 64 + lane;
    float win[38];
#pragma unroll
    for (int i = 0; i < 30; ++i) { const int s = s0 - 30 + i; const bf16_t hv = GLUp[(rowb + (s >= 0 ? s : 0)) * 64]; win[i] = bf1(hv) * ((s >= 0) ? 1.f : 0.f); }
    bf16_t nx[8];
#pragma unroll
    for (int i = 0; i < 8; ++i) nx[i] = GLUp[(rowb + s0 + i) * 64];
#pragma unroll 1
    for (int it = 0; it < 16; ++it) {
        const int s = s0 + it * 8;
#pragma unroll
        for (int i = 0; i < 8; ++i) win[30 + i] = bf1(nx[i]);
        const int sn = (it < 15) ? s + 8 : s;
#pragma unroll
        for (int i = 0; i < 8; ++i) nx[i] = GLUp[(rowb + sn + i) * 64];
        float acc[8];
#pragma unroll
        for (int i = 0; i < 8; ++i) {
            float t = bias;
#pragma unroll
            for (int j = 0; j < CW; ++j) t = fmaf(w[j], win[i + j], t);
            acc[i] = t;
        }
#pragma unroll
        for (int i = 0; i < 8; ++i) {
            const float mu = wave_sum_dpp(acc[i]) * (1.f / 64.f), m2 = wave_sum_dpp(acc[i] * acc[i]) * (1.f / 64.f);
            const float var = fmaxf(m2 - mu * mu, 0.f);
            const float hn = (acc[i] - mu) * rsqrtf(var + EPS) * gam + bet;
            Y[(rowb + s + i) * D + c] = (bf16_t)(cvt_pk_bf16(fsilu(hn), 0.f) & 0xffffu);
        }
#pragma unroll
        for (int i = 0; i < 30; ++i) win[i] = win[i + 8];
    }
}

constexpr int HQ_OFF = 0, HK_OFF = 17408, HKH_OFF = 34816, HV_OFF = 53248, HP_OFF = 71680, HDC_OFF = 80896, HTOT_OFF = 81408, HO_OFF = 85504;
template <bool P3, int DG = 0>
__device__ __forceinline__ void hgrn_unit(LAS unsigned char* lds, int unit, const bf16_t* __restrict__ HG, const float* __restrict__ lbl, const float* __restrict__ hng, float* __restrict__ HS, float* __restrict__ HLD,
                                          bf16_t* __restrict__ Y, int tid, int lane, int w) {
    const int seg = unit & (SEGS - 1), bh = unit >> 3, h = bh & 3, b = bh >> 2;
    const int g = lane >> 4, fr = lane & 15, kp = lane;
    const int c0 = h * HD + 2 * kp;
    const float lb0 = __builtin_amdgcn_rcpf(1.f + __expf(lbl[DH + c0] - lbl[c0])), lb1 = __builtin_amdgcn_rcpf(1.f + __expf(lbl[DH + c0 + 1] - lbl[c0 + 1]));
    f32x4 S[8];
#pragma unroll
    for (int i = 0; i < 8; ++i) S[i] = (f32x4){0.f, 0.f, 0.f, 0.f};
    if (P3 && !(DG & 1)) {
        for (int i = 0; i < seg; ++i) {
            const float* sp = HS + (size_t)(bh * SEGS + i) * 16384 + w * 2048 + lane;
            const float* ld = HLD + (size_t)(bh * SEGS + i) * 128 + 4 * g;
#pragma unroll
            for (int t = 0; t < 8; ++t) { const f32x4 dd = *(const f32x4*)(ld + 16 * t);
#pragma unroll
                for (int r = 0; r < 4; ++r) S[t][r] = fmaf(dd[r], S[t][r], sp[(t * 4 + r) * 64]); }
        }
    }
    float ldsum0 = 1.f, ldsum1 = 1.f;
    const size_t row_base = (size_t)b * SEQ + (size_t)seg * SEGLEN;
    const unsigned* HGw = (const unsigned*)HG;
    constexpr size_t PLANE_DW = (size_t)M * 64;
    unsigned zq[8], qq[8], vq[8];
#define HG_LOAD(c) do { if (DG & 2) { _Pragma("unroll") for (int i = 0; i < 8; ++i) { zq[i] = 0x3c003c00u + (unsigned)((c) + i + w); vq[i] = 0x3e003d00u + (unsigned)i; qq[i] = 0x3d003e00u + (unsigned)(c); } break; } _Pragma("unroll") for (int i = 0; i < 8; ++i) { const size_t ro = (row_base + (c) * 64 + 8 * w + i) * 64 + kp; \
        zq[i] = HGw[(size_t)(4 + h) * PLANE_DW + ro]; vq[i] = HGw[(size_t)(8 + h) * PLANE_DW + ro]; if (P3) qq[i] = HGw[(size_t)h * PLANE_DW + ro]; } } while (0)
    HG_LOAD(0);
    float gn[16];
    const int nt_t = tid >> 3, nt_v = (tid & 7) * 16;
    if (P3) {
#pragma unroll
        for (int e = 0; e < 16; ++e) gn[e] = hng[h * HD + nt_v + e];
    }
#pragma unroll 1
    for (int c = 0; c < NCH; ++c) {
        float cs0[8], cs1[8], kk0[8], kk1[8];
        float cum0 = 1.f, cum1 = 1.f;
        if (DG & 16) {
#pragma unroll
            for (int i = 0; i < 8; ++i) { cs0[i] = cs1[i] = 1.f - 0.01f * i; kk0[i] = kk1[i] = 0.5f; }
        } else
#pragma unroll
        for (int i = 0; i < 8; ++i) {
            const float sg0 = fsigmoid(bf_lo(zq[i])), sg1 = fsigmoid(bf_hi(zq[i]));
            cum0 *= lb0 + (1.f - lb0) * sg0; cum1 *= lb1 + (1.f - lb1) * sg1;
            cs0[i] = cum0; cs1[i] = cum1; kk0[i] = (1.f - lb0) * (1.f - sg0); kk1[i] = (1.f - lb1) * (1.f - sg1);
        }
        LAS float* tot = (LAS float*)(lds + HTOT_OFF);
        *(LAS f32x2*)(tot + w * 128 + 2 * kp) = (f32x2){cum0, cum1};
        BLOCK_BAR();
        float off0 = 1.f, off1 = 1.f, all0 = 1.f, all1 = 1.f;
#pragma unroll
        for (int ww = 0; ww < 8; ++ww) { const f32x2 tt = *(const LAS f32x2*)(tot + ww * 128 + 2 * kp); if (ww < w) { off0 *= tt.x; off1 *= tt.y; } all0 *= tt.x; all1 *= tt.y; }
        ldsum0 *= all0; ldsum1 *= all1;
        unsigned kh0[4], kh1[4], vt0[4], vt1[4];
        if (DG & 16) {
#pragma unroll
            for (int i = 0; i < 4; ++i) { kh0[i] = kh1[i] = 0x3c003c00u; vt0[i] = vq[2 * i]; vt1[i] = vq[2 * i + 1]; }
        } else
#pragma unroll
        for (int i = 0; i < 8; i += 2) {
            float a0[2], a1[2];
#pragma unroll
            for (int e = 0; e < 2; ++e) {
                const float E0 = off0 * cs0[i + e], E1 = off1 * cs1[i + e];
                const float k0 = kk0[i + e] * __builtin_amdgcn_rcpf(E0), k1 = kk1[i + e] * __builtin_amdgcn_rcpf(E1);
                if (P3) {
                    *(LAS unsigned*)(lds + HQ_OFF + (8 * w + i + e) * 272 + 4 * kp) = cvt_pk_bf16(bf_lo(qq[i + e]) * E0, bf_hi(qq[i + e]) * E1);
                    *(LAS unsigned*)(lds + HK_OFF + (8 * w + i + e) * 272 + 4 * kp) = cvt_pk_bf16(k0, k1);
                }
                a0[e] = k0 * all0; a1[e] = k1 * all1;
            }
            kh0[i >> 1] = cvt_pk_bf16(a0[0], a0[1]); kh1[i >> 1] = cvt_pk_bf16(a1[0], a1[1]);
            vt0[i >> 1] = (vq[i] & 0xffffu) | (vq[i + 1] << 16); vt1[i >> 1] = (vq[i] >> 16) | (vq[i + 1] & 0xffff0000u);
        }
        *(LAS u32x4*)(lds + HKH_OFF + (2 * kp) * 144 + 16 * w) = (u32x4){kh0[0], kh0[1], kh0[2], kh0[3]};
        *(LAS u32x4*)(lds + HKH_OFF + (2 * kp + 1) * 144 + 16 * w) = (u32x4){kh1[0], kh1[1], kh1[2], kh1[3]};
        *(LAS u32x4*)(lds + HV_OFF + (2 * kp) * 144 + 16 * w) = (u32x4){vt0[0], vt0[1], vt0[2], vt0[3]};
        *(LAS u32x4*)(lds + HV_OFF + (2 * kp + 1) * 144 + 16 * w) = (u32x4){vt1[0], vt1[1], vt1[2], vt1[3]};
        if (w == 0) *(LAS f32x2*)(lds + HDC_OFF + 8 * kp) = (f32x2){all0, all1};
        BLOCK_BAR();
        if (c + 1 < NCH) HG_LOAD(c + 1);
        bf16x8 vfrag[2];
#pragma unroll
        for (int ks = 0; ks < 2; ++ks) vfrag[ks] = *(const LAS bf16x8*)(lds + HV_OFF + (16 * w + fr) * 144 + 64 * ks + 16 * g);
        if (P3) {
            u32x4 gq[2];
            if (DG & 2) { gq[0] = (u32x4){0x3c003c00u, 0x3c003c00u, 0x3c003c00u, 0x3c003c00u}; gq[1] = gq[0]; } else
            { const u32x4* gp = (const u32x4*)(HG + (size_t)(12 + h) * M * 128 + (row_base + c * 64 + nt_t) * 128 + nt_v); gq[0] = gp[0]; gq[1] = gp[1]; }
            {
                const int mt = w >> 1;
#pragma unroll
                for (int nti = 0; nti < 2; ++nti) {
                    const int nt = 2 * (w & 1) + nti;
                    f32x4 p = (f32x4){0.f, 0.f, 0.f, 0.f};
                    if (nt <= mt && !(DG & 4)) {
#pragma unroll
                        for (int ks = 0; ks < 4; ++ks) {
                            const bf16x8 af = *(const LAS bf16x8*)(lds + HQ_OFF + (16 * mt + fr) * 272 + 64 * ks + 16 * g);
                            const bf16x8 bf = *(const LAS bf16x8*)(lds + HK_OFF + (16 * nt + fr) * 272 + 64 * ks + 16 * g);
                            p = __builtin_amdgcn_mfma_f32_16x16x32_bf16(af, bf, p, 0, 0, 0);
                        }
                    }
#pragma unroll
                    for (int r = 0; r < 4; ++r) {
                        const int t = 16 * mt + 4 * g + r, s = 16 * nt + fr;
                        const float pv = (s <= t) ? p[r] : 0.f;
                        *(LAS bf16_t*)(lds + HP_OFF + t * 144 + 2 * s) = (bf16_t)(cvt_pk_bf16(pv, 0.f) & 0xffffu);
                    }
                }
            }
            BLOCK_BAR();
            f32x4 o[4];
#pragma unroll
            for (int mt = 0; mt < 4; ++mt) o[mt] = (f32x4){0.f, 0.f, 0.f, 0.f};
            if (!(DG & 4))
#pragma unroll
            for (int ks = 0; ks < 4; ++ks) {
                u32x4 sb; sb.x = cvt_pk_bf16(S[2 * ks][0], S[2 * ks][1]); sb.y = cvt_pk_bf16(S[2 * ks][2], S[2 * ks][3]); sb.z = cvt_pk_bf16(S[2 * ks + 1][0], S[2 * ks + 1][1]); sb.w = cvt_pk_bf16(S[2 * ks + 1][2], S[2 * ks + 1][3]);
                const bf16x8 bfrag = __builtin_bit_cast(bf16x8, sb);
#pragma unroll
                for (int mt = 0; mt < 4; ++mt) {
                    const u32x2 alo = *(const LAS u32x2*)(lds + HQ_OFF + (16 * mt + fr) * 272 + 64 * ks + 8 * g);
                    const u32x2 ahi = *(const LAS u32x2*)(lds + HQ_OFF + (16 * mt + fr) * 272 + 64 * ks + 32 + 8 * g);
                    const bf16x8 af = __builtin_bit_cast(bf16x8, (u32x4){alo.x, alo.y, ahi.x, ahi.y});
                    o[mt] = __builtin_amdgcn_mfma_f32_16x16x32_bf16(af, bfrag, o[mt], 0, 0, 0);
                }
            }
            if (!(DG & 4))
#pragma unroll
            for (int ks = 0; ks < 2; ++ks)
#pragma unroll
                for (int mt = 0; mt < 4; ++mt) {
                    const bf16x8 af = *(const LAS bf16x8*)(lds + HP_OFF + (16 * mt + fr) * 144 + 64 * ks + 16 * g);
                    o[mt] = __builtin_amdgcn_mfma_f32_16x16x32_bf16(af, vfrag[ks], o[mt], 0, 0, 0);
                }
#pragma unroll
            for (int mt = 0; mt < 4; ++mt)
#pragma unroll
                for (int r = 0; r < 4; ++r) *(LAS float*)(lds + HO_OFF + ((16 * mt + 4 * g + r) * 132 + 16 * w + fr) * 4) = o[mt][r];
            if (!(DG & 4))
#pragma unroll
            for (int i = 0; i < 8; ++i) {
                const f32x4 dd = *(const LAS f32x4*)(lds + HDC_OFF + (16 * i + 4 * g) * 4);
                S[i] = S[i] * dd;
#pragma unroll
                for (int ks = 0; ks < 2; ++ks) { const bf16x8 af = *(const LAS bf16x8*)(lds + HKH_OFF + (16 * i + fr) * 144 + 64 * ks + 16 * g); S[i] = __builtin_amdgcn_mfma_f32_16x16x32_bf16(af, vfrag[ks], S[i], 0, 0, 0); }
            }
            BLOCK_BAR();
            if (!(DG & 8)) {
                f32x4 ov[4]; float ss = 0.f;
#pragma unroll
                for (int q = 0; q < 4; ++q) { ov[q] = *(const LAS f32x4*)(lds + HO_OFF + (nt_t * 132 + nt_v + 4 * q) * 4); ss += (ov[q].x * ov[q].x + ov[q].y * ov[q].y) + (ov[q].z * ov[q].z + ov[q].w * ov[q].w); }
                ss += __shfl_xor(ss, 1); ss += __shfl_xor(ss, 2); ss += __shfl_xor(ss, 4);
                const float rs = rsqrtf(ss * (1.f / HD) + EPS);
                u32x4 ow[2];
#pragma unroll
                for (int q = 0; q < 4; ++q) {
                    const unsigned g01 = (q & 1) ? gq[q >> 1].z : gq[q >> 1].x, g23 = (q & 1) ? gq[q >> 1].w : gq[q >> 1].y;
                    const float y0 = ov[q].x * rs * gn[4 * q] * bf_lo(g01), y1 = ov[q].y * rs * gn[4 * q + 1] * bf_hi(g01), y2 = ov[q].z * rs * gn[4 * q + 2] * bf_lo(g23), y3 = ov[q].w * rs * gn[4 * q + 3] * bf_hi(g23);
                    if (q & 1) { ow[q >> 1].z = cvt_pk_bf16(y0, y1); ow[q >> 1].w = cvt_pk_bf16(y2, y3); } else { ow[q >> 1].x = cvt_pk_bf16(y0, y1); ow[q >> 1].y = cvt_pk_bf16(y2, y3); }
                }
                u32x4* yp = (u32x4*)(Y + (row_base + c * 64 + nt_t) * D + DCONV + h * HD + nt_v); yp[0] = ow[0]; yp[1] = ow[1];
            }
        } else {
            if (!(DG & 4))
#pragma unroll
            for (int i = 0; i < 8; ++i) {
                const f32x4 dd = *(const LAS f32x4*)(lds + HDC_OFF + (16 * i + 4 * g) * 4);
                S[i] = S[i] * dd;
#pragma unroll
                for (int ks = 0; ks < 2; ++ks) { const bf16x8 af = *(const LAS bf16x8*)(lds + HKH_OFF + (16 * i + fr) * 144 + 64 * ks + 16 * g); S[i] = __builtin_amdgcn_mfma_f32_16x16x32_bf16(af, vfrag[ks], S[i], 0, 0, 0); }
            }
        }
    }
#undef HG_LOAD
    if (!P3 && !(DG & 8)) {
        float* sp = HS + (size_t)unit * 16384 + w * 2048 + lane;
#pragma unroll
        for (int t = 0; t < 8; ++t)
#pragma unroll
            for (int r = 0; r < 4; ++r) sp[(t * 4 + r) * 64] = S[t][r];
        if (w == 0) *(f32x2*)(HLD + (size_t)unit * 128 + 2 * kp) = (f32x2){ldsum0, ldsum1};
    }
    BLOCK_BAR();
}

__device__ __forceinline__ float gelu_as(float v) {
    const float av = fabsf(v), t = __builtin_amdgcn_rcpf(fmaf(av, 0.2316418882f, 1.0f));
    float q = fmaf(t, 0.5307027145f, -0.7265760135f); q = fmaf(q, t, 0.7107068705f); q = fmaf(q, t, -0.142248368f); q = fmaf(q, t, 0.127414796f); q = q * t;
    const float e = __builtin_amdgcn_exp2f(v * v * -0.72134752044f), m = v * (q * e);
    return v < 0.f ? m : v - m;
}
__device__ __forceinline__ float dot16_fp4(const unsigned w0, const unsigned w1, const f32x2 (&x2)[8]) {
    f32x2 acc = __builtin_amdgcn_cvt_scalef32_pk_f32_fp4(w0, 1.0f, 0) * x2[0];
    acc = __builtin_elementwise_fma(__builtin_amdgcn_cvt_scalef32_pk_f32_fp4(w0, 1.0f, 1), x2[1], acc);
    acc = __builtin_elementwise_fma(__builtin_amdgcn_cvt_scalef32_pk_f32_fp4(w0, 1.0f, 2), x2[2], acc);
    acc = __builtin_elementwise_fma(__builtin_amdgcn_cvt_scalef32_pk_f32_fp4(w0, 1.0f, 3), x2[3], acc);
    acc = __builtin_elementwise_fma(__builtin_amdgcn_cvt_scalef32_pk_f32_fp4(w1, 1.0f, 0), x2[4], acc);
    acc = __builtin_elementwise_fma(__builtin_amdgcn_cvt_scalef32_pk_f32_fp4(w1, 1.0f, 1), x2[5], acc);
    acc = __builtin_elementwise_fma(__builtin_amdgcn_cvt_scalef32_pk_f32_fp4(w1, 1.0f, 2), x2[6], acc);
    acc = __builtin_elementwise_fma(__builtin_amdgcn_cvt_scalef32_pk_f32_fp4(w1, 1.0f, 3), x2[7], acc);
    return acc.x + acc.y;
}
__device__ __forceinline__ void axpy16_fp4(const unsigned w0, const unsigned w1, const float s, f32x2 (&y2)[8]) {
    const f32x2 s2 = (f32x2){s, s};
    y2[0] = __builtin_elementwise_fma(__builtin_amdgcn_cvt_scalef32_pk_f32_fp4(w0, 1.0f, 0), s2, y2[0]);
    y2[1] = __builtin_elementwise_fma(__builtin_amdgcn_cvt_scalef32_pk_f32_fp4(w0, 1.0f, 1), s2, y2[1]);
    y2[2] = __builtin_elementwise_fma(__builtin_amdgcn_cvt_scalef32_pk_f32_fp4(w0, 1.0f, 2), s2, y2[2]);
    y2[3] = __builtin_elementwise_fma(__builtin_amdgcn_cvt_scalef32_pk_f32_fp4(w0, 1.0f, 3), s2, y2[3]);
    y2[4] = __builtin_elementwise_fma(__builtin_amdgcn_cvt_scalef32_pk_f32_fp4(w1, 1.0f, 0), s2, y2[4]);
    y2[5] = __builtin_elementwise_fma(__builtin_amdgcn_cvt_scalef32_pk_f32_fp4(w1, 1.0f, 1), s2, y2[5]);
    y2[6] = __builtin_elementwise_fma(__builtin_amdgcn_cvt_scalef32_pk_f32_fp4(w1, 1.0f, 2), s2, y2[6]);
    y2[7] = __builtin_elementwise_fma(__builtin_amdgcn_cvt_scalef32_pk_f32_fp4(w1, 1.0f, 3), s2, y2[7]);
}
__device__ __forceinline__ void axpy16_fp8(const u32x4 w, const float s, f32x2 (&y2)[8]) {
    const f32x2 s2 = (f32x2){s, s};
    y2[0] = __builtin_elementwise_fma(__builtin_amdgcn_cvt_pk_f32_fp8(w.x, false), s2, y2[0]);
    y2[1] = __builtin_elementwise_fma(__builtin_amdgcn_cvt_pk_f32_fp8(w.x, true), s2, y2[1]);
    y2[2] = __builtin_elementwise_fma(__builtin_amdgcn_cvt_pk_f32_fp8(w.y, false), s2, y2[2]);
    y2[3] = __builtin_elementwise_fma(__builtin_amdgcn_cvt_pk_f32_fp8(w.y, true), s2, y2[3]);
    y2[4] = __builtin_elementwise_fma(__builtin_amdgcn_cvt_pk_f32_fp8(w.z, false), s2, y2[4]);
    y2[5] = __builtin_elementwise_fma(__builtin_amdgcn_cvt_pk_f32_fp8(w.z, true), s2, y2[5]);
    y2[6] = __builtin_elementwise_fma(__builtin_amdgcn_cvt_pk_f32_fp8(w.w, false), s2, y2[6]);
    y2[7] = __builtin_elementwise_fma(__builtin_amdgcn_cvt_pk_f32_fp8(w.w, true), s2, y2[7]);
}
__device__ __forceinline__ f32x2 cvt4(unsigned w, int) { return (f32x2){0.f, 0.f}; }
#define C4(w, k) __builtin_amdgcn_cvt_scalef32_pk_f32_fp4((w), 1.0f, (k))
__device__ __forceinline__ float dot32_fp4(const u32x4 w, const f32x2 (&x2)[16]) {
    f32x2 a0 = C4(w.x, 0) * x2[0], a1 = C4(w.y, 0) * x2[4];
    a0 = __builtin_elementwise_fma(C4(w.x, 1), x2[1], a0); a1 = __builtin_elementwise_fma(C4(w.y, 1), x2[5], a1);
    a0 = __builtin_elementwise_fma(C4(w.x, 2), x2[2], a0); a1 = __builtin_elementwise_fma(C4(w.y, 2), x2[6], a1);
    a0 = __builtin_elementwise_fma(C4(w.x, 3), x2[3], a0); a1 = __builtin_elementwise_fma(C4(w.y, 3), x2[7], a1);
    a0 = __builtin_elementwise_fma(C4(w.z, 0), x2[8], a0); a1 = __builtin_elementwise_fma(C4(w.w, 0), x2[12], a1);
    a0 = __builtin_elementwise_fma(C4(w.z, 1), x2[9], a0); a1 = __builtin_elementwise_fma(C4(w.w, 1), x2[13], a1);
    a0 = __builtin_elementwise_fma(C4(w.z, 2), x2[10], a0); a1 = __builtin_elementwise_fma(C4(w.w, 2), x2[14], a1);
    a0 = __builtin_elementwise_fma(C4(w.z, 3), x2[11], a0); a1 = __builtin_elementwise_fma(C4(w.w, 3), x2[15], a1);
    a0 = a0 + a1;
    return a0.x + a0.y;
}
typedef _Float16 h16x2 __attribute__((ext_vector_type(2)));
#define C4H(w, k) __builtin_bit_cast(h16x2, __builtin_amdgcn_cvt_scalef32_pk_f16_fp4((w), 1.0f, (k)))
__device__ __forceinline__ void axpy32_fp4(const u32x4 w, const float s, h16x2 (&y2)[16]) {
    const _Float16 sh = (_Float16)s; const h16x2 s2 = (h16x2){sh, sh};
    y2[0] = __builtin_elementwise_fma(C4H(w.x, 0), s2, y2[0]); y2[1] = __builtin_elementwise_fma(C4H(w.x, 1), s2, y2[1]); y2[2] = __builtin_elementwise_fma(C4H(w.x, 2), s2, y2[2]); y2[3] = __builtin_elementwise_fma(C4H(w.x, 3), s2, y2[3]);
    y2[4] = __builtin_elementwise_fma(C4H(w.y, 0), s2, y2[4]); y2[5] = __builtin_elementwise_fma(C4H(w.y, 1), s2, y2[5]); y2[6] = __builtin_elementwise_fma(C4H(w.y, 2), s2, y2[6]); y2[7] = __builtin_elementwise_fma(C4H(w.y, 3), s2, y2[7]);
    y2[8] = __builtin_elementwise_fma(C4H(w.z, 0), s2, y2[8]); y2[9] = __builtin_elementwise_fma(C4H(w.z, 1), s2, y2[9]); y2[10] = __builtin_elementwise_fma(C4H(w.z, 2), s2, y2[10]); y2[11] = __builtin_elementwise_fma(C4H(w.z, 3), s2, y2[11]);
    y2[12] = __builtin_elementwise_fma(C4H(w.w, 0), s2, y2[12]); y2[13] = __builtin_elementwise_fma(C4H(w.w, 1), s2, y2[13]); y2[14] = __builtin_elementwise_fma(C4H(w.w, 2), s2, y2[14]); y2[15] = __builtin_elementwise_fma(C4H(w.w, 3), s2, y2[15]);
}
#undef C4H
__device__ __forceinline__ float half_sum_dpp(float v) {
    v += __builtin_bit_cast(float, __builtin_amdgcn_update_dpp(0, __builtin_bit_cast(int, v), 0x111, 0xf, 0xf, false));
    v += __builtin_bit_cast(float, __builtin_amdgcn_update_dpp(0, __builtin_bit_cast(int, v), 0x112, 0xf, 0xf, false));
    v += __builtin_bit_cast(float, __builtin_amdgcn_update_dpp(0, __builtin_bit_cast(int, v), 0x114, 0xf, 0xf, false));
    v += __builtin_bit_cast(float, __builtin_amdgcn_update_dpp(0, __builtin_bit_cast(int, v), 0x118, 0xf, 0xf, false));
    v += __builtin_bit_cast(float, __builtin_amdgcn_update_dpp(0, __builtin_bit_cast(int, v), 0x142, 0xa, 0xf, false));
    return v;
}
typedef int i32x8 __attribute__((ext_vector_type(8)));
#define P7_EMASK ((DGP & 8) ? 15 : (DGP & 1) ? 1023 : 0x7fffffff)
#define P7_LOAD2(dst, evv, slot) do { const int ea_ = __builtin_amdgcn_readlane((evv), (slot)) & P7_EMASK, eb_ = __builtin_amdgcn_readlane((evv), (slot) + 1) & P7_EMASK; \
        dst = __builtin_amdgcn_raw_buffer_load_b128(RV, ((hi ? eb_ : ea_) << 9) + l16, 0, 0); } while (0)
#define P7_AXPY2(BANK, q, r) do { const float wa_ = __builtin_bit_cast(float, __builtin_amdgcn_readlane(__builtin_bit_cast(int, wvec), (q) * 16 + 2 * (r))), wb_ = __builtin_bit_cast(float, __builtin_amdgcn_readlane(__builtin_bit_cast(int, wvec), (q) * 16 + 2 * (r) + 1)); \
        axpy32_fp4(BANK[r], hi ? wb_ : wa_, y2); } while (0)
#define P7_UBASE(evv, g) ((((__shfl((evv), 16 * (g) + li)) & P7_EMASK) << 9) + 16 * lq)
#define P7_LOADU1(dst, ubase, s) do { dst = __builtin_amdgcn_raw_buffer_load_b128(RU, (ubase) + 64 * (s), 0, 0); } while (0)
#define P7_MFMA_STEP(abuf, xb, s, D1, D2) do { \
        const u32x4 b1_ = *(const LAS u32x4*)((xb) + 64 * (s) + 16 * lq), b2_ = *(const LAS u32x4*)((xb) + 512 + 64 * (s) + 16 * lq); \
        const i32x8 av_ = (i32x8){(int)abuf.x, (int)abuf.y, (int)abuf.z, (int)abuf.w, 0, 0, 0, 0}; \
        D1 = __builtin_amdgcn_mfma_scale_f32_16x16x128_f8f6f4(av_, (i32x8){(int)b1_.x, (int)b1_.y, (int)b1_.z, (int)b1_.w, 0, 0, 0, 0}, D1, 4, 4, 0, 0x7f7f7f7f, 0, 0x7f7f7f7f); \
        D2 = __builtin_amdgcn_mfma_scale_f32_16x16x128_f8f6f4(av_, (i32x8){(int)b2_.x, (int)b2_.y, (int)b2_.z, (int)b2_.w, 0, 0, 0, 0}, D2, 4, 4, 0, 0x7f7f7f7f, 0, 0x7f7f7f7f); } while (0)
#define P7_DV(g, dg, dv) do { const float tmp_ = (lane & 3) == 0 ? dg[0] : (lane & 3) == 1 ? dg[1] : (lane & 3) == 2 ? dg[2] : dg[3]; const float val_ = __shfl(tmp_, srcl); dv = (lq == (g)) ? val_ : dv; } while (0)
__device__ __forceinline__ void x_to_fp4x2(const u32x2 (&xq)[8], LAS unsigned char* xb, int l32, float& s1, float& s2) {
    float am = 0.f;
#pragma unroll
    for (int j = 0; j < 8; ++j) am = fmaxf(am, fmaxf(fmaxf(fabsf(bf_lo(xq[j].x)), fabsf(bf_hi(xq[j].x))), fmaxf(fabsf(bf_lo(xq[j].y)), fabsf(bf_hi(xq[j].y)))));
#pragma unroll
    for (int o = 1; o < 64; o <<= 1) am = fmaxf(am, __shfl_xor(am, o));
    s1 = am > 0.f ? am * (1.f / 6.f) : 1.f; const float i1 = am > 0.f ? 6.f / am : 1.f;
    float am2 = 0.f;
#pragma unroll
    for (int j = 0; j < 8; ++j) {
        const float x0 = bf_lo(xq[j].x), x1 = bf_hi(xq[j].x), x2_ = bf_lo(xq[j].y), x3 = bf_hi(xq[j].y);
        unsigned w = 0u;
        w = __builtin_amdgcn_cvt_scalef32_pk_fp4_f32(w, x0 * i1, x1 * i1, 1.0f, 0); w = __builtin_amdgcn_cvt_scalef32_pk_fp4_f32(w, x2_ * i1, x3 * i1, 1.0f, 1);
        *(LAS unsigned short*)(xb + 2 * (l32 + 32 * j)) = (unsigned short)w;
        const f32x2 d0 = __builtin_amdgcn_cvt_scalef32_pk_f32_fp4(w, 1.0f, 0), d1 = __builtin_amdgcn_cvt_scalef32_pk_f32_fp4(w, 1.0f, 1);
        am2 = fmaxf(am2, fmaxf(fmaxf(fabsf(x0 - s1 * d0.x), fabsf(x1 - s1 * d0.y)), fmaxf(fabsf(x2_ - s1 * d1.x), fabsf(x3 - s1 * d1.y))));
    }
#pragma unroll
    for (int o = 1; o < 64; o <<= 1) am2 = fmaxf(am2, __shfl_xor(am2, o));
    s2 = am2 > 0.f ? am2 * (1.f / 6.f) : 1.f; const float i2 = am2 > 0.f ? 6.f / am2 : 1.f;
    asm volatile("s_waitcnt lgkmcnt(0)" ::: "memory");
#pragma unroll
    for (int j = 0; j < 8; ++j) {
        const float x0 = bf_lo(xq[j].x), x1 = bf_hi(xq[j].x), x2_ = bf_lo(xq[j].y), x3 = bf_hi(xq[j].y);
        const unsigned w1 = *(const LAS unsigned short*)(xb + 2 * (l32 + 32 * j));
        const f32x2 d0 = __builtin_amdgcn_cvt_scalef32_pk_f32_fp4(w1, 1.0f, 0), d1 = __builtin_amdgcn_cvt_scalef32_pk_f32_fp4(w1, 1.0f, 1);
        unsigned w = 0u;
        w = __builtin_amdgcn_cvt_scalef32_pk_fp4_f32(w, (x0 - s1 * d0.x) * i2, (x1 - s1 * d0.y) * i2, 1.0f, 0); w = __builtin_amdgcn_cvt_scalef32_pk_fp4_f32(w, (x2_ - s1 * d1.x) * i2, (x3 - s1 * d1.y) * i2, 1.0f, 1);
        *(LAS unsigned short*)(xb + 512 + 2 * (l32 + 32 * j)) = (unsigned short)w;
    }
    asm volatile("s_waitcnt lgkmcnt(0)" ::: "memory");
}
template <bool V4, int DGP = 0>
__device__ __forceinline__ void peer_phase(LAS unsigned char* lds, int wave, const bf16_t* __restrict__ XN2, const int* __restrict__ EIDX, const float* __restrict__ GATE, const unsigned char* __restrict__ Up, const unsigned char* __restrict__ Vp,
                                           const float* __restrict__ USC, const float* __restrict__ VSC, const float* __restrict__ SSQ, const float* __restrict__ fg, float* __restrict__ out, int gw, int NGW, int lane) {
    static_assert(V4, "this build of the PEER phase streams fp4 value rows");
    if (gw >= M) return;
    LAS unsigned char* xbase = lds + wave * 2048;
    const __amdgpu_buffer_rsrc_t RU = __builtin_amdgcn_make_buffer_rsrc((void*)Up, 0, NEXP * 512, 0x00020000);
    const __amdgpu_buffer_rsrc_t RV = __builtin_amdgcn_make_buffer_rsrc((void*)Vp, 0, NEXP * 512, 0x00020000);
    const bool hi = lane >= 32; const int l32 = lane & 31, l16 = l32 * 16, li = lane & 15, lq = lane >> 4, srcl = 16 * (li >> 2) + li;
    u32x4 UA[8], UB[8], VA[4], VB[4];
    int t = gw, par = 0;
    u32x2 xq[8];
#pragma unroll
    for (int j = 0; j < 8; ++j) xq[j] = ((const u32x2*)(XN2 + (size_t)t * D))[l32 + 32 * j];
    int evc = EIDX[(size_t)t * 128 + lane], evn = EIDX[(size_t)t * 128 + 64 + lane];
    float gvn = GATE[(size_t)t * 128 + 64 + lane];
    float xs1, xs2;
    x_to_fp4x2(xq, xbase, l32, xs1, xs2);
    float rstd_t = rsqrtf(wave_sum_dpp(lane < 16 ? SSQ[(size_t)t * 16 + lane] : 0.f) * (1.f / D) + EPS);
    float wvec;
    {
        float dvec = 0.f;
#pragma unroll 1
        for (int g = 0; g < 4; ++g) {
            const int ub = P7_UBASE(evc, g);
#pragma unroll
            for (int s = 0; s < 8; ++s) P7_LOADU1(UA[s], ub, s);
            f32x4 D1 = (f32x4){0.f, 0.f, 0.f, 0.f}, D2 = D1;
#pragma unroll
            for (int s = 0; s < 8; ++s) P7_MFMA_STEP(UA[s], xbase, s, D1, D2);
            const f32x4 dd = D1 * xs1 + D2 * xs2;
            if (g == 0) P7_DV(0, dd, dvec); else if (g == 1) P7_DV(1, dd, dvec); else if (g == 2) P7_DV(2, dd, dvec); else P7_DV(3, dd, dvec);
        }
        wvec = GATE[(size_t)t * 128 + lane] * VSC[evc] * gelu_as(dvec * (USC[evc] * rstd_t));
    }
    {
#pragma unroll
        for (int r = 0; r < 4; ++r) P7_LOAD2(VA[r], evc, 2 * r);
#pragma unroll
        for (int r = 0; r < 4; ++r) P7_LOAD2(VB[r], evc, 8 + 2 * r);
        const int ub0 = P7_UBASE(evn, 0), ub1 = P7_UBASE(evn, 1);
#pragma unroll
        for (int s = 0; s < 8; ++s) P7_LOADU1(UA[s], ub0, s);
#pragma unroll
        for (int s = 0; s < 8; ++s) P7_LOADU1(UB[s], ub1, s);
    }
    h16x2 y2[16];
#pragma unroll
    for (int j = 0; j < 16; ++j) y2[j] = (h16x2){(_Float16)0.f, (_Float16)0.f};
    int h = 0;
    int tn = t + NGW; bool has_next = tn < M; int tl = has_next ? tn : t;
    int nev0 = EIDX[(size_t)tl * 128 + lane], nev1 = EIDX[(size_t)tl * 128 + 64 + lane];
    float ngv0 = GATE[(size_t)tl * 128 + lane], ngv1 = GATE[(size_t)tl * 128 + 64 + lane];
    u32x2 nxq[8];
#pragma unroll
    for (int j = 0; j < 8; ++j) nxq[j] = ((const u32x2*)(XN2 + (size_t)tl * D))[l32 + 32 * j];
    float nxs1 = 1.f, nxs2 = 1.f, nrstd = 1.f;
#pragma unroll 1
    for (;;) {
        if (h == 1) {
            x_to_fp4x2(nxq, xbase + (par ^ 1) * 1024, l32, nxs1, nxs2);
            nrstd = rsqrtf(wave_sum_dpp(lane < 16 ? SSQ[(size_t)tl * 16 + lane] : 0.f) * (1.f / D) + EPS);
        }
        const LAS unsigned char* xbn = xbase + (h ? (par ^ 1) : par) * 1024;
        const float s1n = h ? nxs1 : xs1, s2n = h ? nxs2 : xs2, rsn = h ? nrstd : rstd_t;
        const int evnn = h ? nev1 : nev0;
        const float uscn = USC[evn] * rsn, vscn = VSC[evn];
        float dvec = 0.f;
#define P7_PIPE(g, UBUF, UREFILL, evr, slotr) do { \
            f32x4 D1 = (f32x4){0.f, 0.f, 0.f, 0.f}, D2 = D1; \
            _Pragma("unroll") for (int r = 0; r < 8; ++r) { \
                P7_MFMA_STEP(UBUF[r], xbn, r, D1, D2); __builtin_amdgcn_sched_barrier(0); UREFILL; __builtin_amdgcn_sched_barrier(0); \
                if (r < 4) { P7_AXPY2X(VA[r], (g) * 16 + 2 * r); __builtin_amdgcn_sched_barrier(0); P7_LOAD2(VA[r], evr, (slotr) + 2 * r); } \
                else { P7_AXPY2X(VB[r - 4], (g) * 16 + 2 * r); __builtin_amdgcn_sched_barrier(0); P7_LOAD2(VB[r - 4], evr, (slotr) + 2 * r); } \
                __builtin_amdgcn_sched_barrier(0); } \
            const f32x4 dd = D1 * s1n + D2 * s2n; P7_DV(g, dd, dvec); } while (0)
#define P7_AXPY2X(ROW, slot) do { const float wa_ = __builtin_bit_cast(float, __builtin_amdgcn_readlane(__builtin_bit_cast(int, wvec), (slot))), wb_ = __builtin_bit_cast(float, __builtin_amdgcn_readlane(__builtin_bit_cast(int, wvec), (slot) + 1)); \
        axpy32_fp4(ROW, hi ? wb_ : wa_, y2); \
        asm volatile("" : "+v"(y2[0]), "+v"(y2[1]), "+v"(y2[2]), "+v"(y2[3]), "+v"(y2[4]), "+v"(y2[5]), "+v"(y2[6]), "+v"(y2[7]), "+v"(y2[8]), "+v"(y2[9]), "+v"(y2[10]), "+v"(y2[11]), "+v"(y2[12]), "+v"(y2[13]), "+v"(y2[14]), "+v"(y2[15])); } while (0)
        { const int ub = P7_UBASE(evn, 2);  P7_PIPE(0, UA, P7_LOADU1(UA[r], ub, r), evc, 16); }
        { const int ub = P7_UBASE(evn, 3);  P7_PIPE(1, UB, P7_LOADU1(UB[r], ub, r), evc, 32); }
        { const int ub = P7_UBASE(evnn, 0); P7_PIPE(2, UA, P7_LOADU1(UA[r], ub, r), evc, 48); }
        { const int ub = P7_UBASE(evnn, 1); P7_PIPE(3, UB, P7_LOADU1(UB[r], ub, r), evn, 0); }
#undef P7_AXPY2X
#undef P7_PIPE
        const float wnext = gvn * vscn * gelu_as(dvec * uscn);
        if (h == 1) {
            f32x4 z[4]; float sq = 0.f;
#pragma unroll
            for (int jj = 0; jj < 4; ++jj) {
                const u32x2 xe = xq[2 * jj], xo = xq[2 * jj + 1];
                const f32x4 ye = (f32x4){(float)y2[2 * jj].x, (float)y2[2 * jj].y, (float)y2[2 * jj + 1].x, (float)y2[2 * jj + 1].y}, yo = (f32x4){(float)y2[8 + 2 * jj].x, (float)y2[8 + 2 * jj].y, (float)y2[8 + 2 * jj + 1].x, (float)y2[8 + 2 * jj + 1].y};
                const f32x4 mine = hi ? yo : ye, give = hi ? ye : yo;
                f32x4 got; got.x = __shfl_xor(give.x, 32); got.y = __shfl_xor(give.y, 32); got.z = __shfl_xor(give.z, 32); got.w = __shfl_xor(give.w, 32);
                const u32x2 xm = hi ? xo : xe;
                z[jj] = mine + got + (f32x4){bf_lo(xm.x), bf_hi(xm.x), bf_lo(xm.y), bf_hi(xm.y)};
                sq += (z[jj].x * z[jj].x + z[jj].y * z[jj].y) + (z[jj].z * z[jj].z + z[jj].w * z[jj].w);
            }
            const float rr = rsqrtf(wave_sum_dpp(sq) * (1.f / D) + EPS);
            const int hb = hi ? 1 : 0;
#pragma unroll
            for (int jj = 0; jj < 4; ++jj) { const int G = l32 + 32 * (hb + 2 * jj); __builtin_nontemporal_store(z[jj] * rr * ((const f32x4*)fg)[G], (f32x4*)(out + (size_t)t * D) + G); }
            if (!has_next) break;
            t = tn; par ^= 1; xs1 = nxs1; xs2 = nxs2; rstd_t = nrstd;
#pragma unroll
            for (int j = 0; j < 8; ++j) xq[j] = nxq[j];
#pragma unroll
            for (int j = 0; j < 16; ++j) y2[j] = (h16x2){(_Float16)0.f, (_Float16)0.f};
            evc = evn; evn = nev1; gvn = ngv1;
            tn = t + NGW; has_next = tn < M; tl = has_next ? tn : t;
            nev0 = EIDX[(size_t)tl * 128 + lane]; nev1 = EIDX[(size_t)tl * 128 + 64 + lane]; ngv0 = GATE[(size_t)tl * 128 + lane]; ngv1 = GATE[(size_t)tl * 128 + 64 + lane];
#pragma unroll
            for (int j = 0; j < 8; ++j) nxq[j] = ((const u32x2*)(XN2 + (size_t)tl * D))[l32 + 32 * j];
            h = 0;
        } else {
            evc = evn; evn = nev0; gvn = ngv0; h = 1;
        }
        wvec = wnext;
    }
}
#undef P7_LOAD2
#undef P7_AXPY2
#undef P7_UBASE
#undef P7_LOADU1
#undef P7_MFMA_STEP
#undef P7_DV
#undef P7_EMASK
#undef C4

#define XB_TMO      128
#define XB_XCNT(j)  (256  + 64 * (j))
#define XB_XSUB(j)  (1280 + 64 * (j))
#define XB_XGEN(j)  (2304 + 64 * (j))
#define XB_TOP      3328
#define XB_TOPGEN   3392
#define XCD_BAR_WORDS 3456
#define XB_SPIN_CAP (1u << 18)

__device__ __forceinline__ unsigned xb_ld(unsigned* p)              { return __hip_atomic_load(p, __ATOMIC_RELAXED, __HIP_MEMORY_SCOPE_AGENT); }
__device__ __forceinline__ unsigned xb_add(unsigned* p, unsigned v) { return __hip_atomic_fetch_add(p, v, __ATOMIC_RELAXED, __HIP_MEMORY_SCOPE_AGENT); }
__device__ __forceinline__ unsigned xb_xcc_id() { return (unsigned)__builtin_amdgcn_s_getreg((3 << 11) | 20) & 0xFu; }
#define XB_SPIN(cond, bar) do { unsigned _sp = 0; while (cond) { __builtin_amdgcn_s_sleep(1); \
    if ((++_sp & 255u) == 0u) { if (xb_ld(&(bar)[XB_TMO])) break; if (_sp > XB_SPIN_CAP) { atomicAdd(&(bar)[XB_TMO], 1u); break; } } } } while (0)


struct XcdBar { unsigned* bar; unsigned x, nloc, nx; };
__device__ __forceinline__ void xcd_bar_post(unsigned* bar, unsigned x) { (void)xb_add(&bar[XB_XCNT(x)], 1u); }
__device__ __forceinline__ void xcd_bar_census(XcdBar& b) {
    unsigned cnt = 0u, mine = 0u;
#pragma unroll
    for (unsigned j = 0; j < 16; ++j) { const unsigned c = xb_ld(&b.bar[XB_XCNT(j)]); cnt += (c > 0u) ? 1u : 0u; mine = (j == b.x) ? c : mine; }
    b.nloc = mine > 0u ? mine : 1u; b.nx = cnt > 0u ? cnt : 1u;
}
__device__ __forceinline__ void xcd_barrier(const XcdBar& b, bool leader_thread) {
    asm volatile("s_waitcnt vmcnt(0)" ::: "memory");
    __syncthreads();
    if (leader_thread) {
        unsigned* bar = b.bar;
        __builtin_amdgcn_s_waitcnt(0);
        const unsigned nloc = b.nloc, nx = b.nx;
        const unsigned old = xb_add(&bar[XB_XSUB(b.x)], 1u);
        const unsigned gen = old / nloc;
        if (old + 1u == (gen + 1u) * nloc) {
            __builtin_amdgcn_fence(__ATOMIC_RELEASE, "agent");
            asm volatile("s_waitcnt vmcnt(0)" ::: "memory");
            const unsigned og = xb_add(&bar[XB_TOP], 1u);
            const unsigned tg = og / nx;
            if (og + 1u == (tg + 1u) * nx) xb_add(&bar[XB_TOPGEN], 1u);
            else XB_SPIN(xb_ld(&bar[XB_TOPGEN]) == tg, bar);
            __builtin_amdgcn_fence(__ATOMIC_ACQUIRE, "agent");
            xb_add(&bar[XB_XGEN(b.x)], 1u);
            asm volatile("s_waitcnt vmcnt(0)" ::: "memory");
        } else {
            XB_SPIN(xb_ld(&bar[XB_XGEN(b.x)]) == gen, bar);
            __builtin_amdgcn_fence(__ATOMIC_ACQUIRE, "agent");
            asm volatile("s_waitcnt vmcnt(0)" ::: "memory");
        }
    }
    __syncthreads();
}

__global__ void __launch_bounds__(NT, 2) mega(Args a) {
    extern __shared__ __attribute__((aligned(16))) unsigned char lds_raw[];
    LAS unsigned char* lds = (LAS unsigned char*)lds_raw;
    cg::grid_group grid = cg::this_grid();
    const int wave = __builtin_amdgcn_readfirstlane(threadIdx.x >> 6), G = gridDim.x;
#define PH_IDS() const int lane = pg8::lane_id_v(), tid = wave * 64 + lane; (void)tid; (void)lane
    unsigned char* ws = a.ws;
    const int lo = a.ph_lo, hi = a.ph_hi;
    bf16_t* WIN = (bf16_t*)(ws + WS_WIN); bf16_t* WOUT = (bf16_t*)(ws + WS_WOUT); bf16_t* WEFF = (bf16_t*)(ws + WS_WEFF);
    bf16_t* XN = (bf16_t*)(ws + WS_XN);
    bf16_t* GLU = (bf16_t*)(ws + WS_GLU); bf16_t* HG = (bf16_t*)(ws + WS_HG); bf16_t* Y = (bf16_t*)(ws + WS_Y);
    float* HS = (float*)(ws + WS_HS); float* HLD = (float*)(ws + WS_HLD);
    int* EIDX = (int*)(ws + WS_EIDX); float* GATE = (float*)(ws + WS_GATE);
    const int gw = blockIdx.x * NWAVES + wave, NGW = G * NWAVES;
#ifndef PH_MASK
#define PH_MASK 0xff
#endif
#define IN(k) (((PH_MASK >> (k)) & 1) && lo <= (k) && (k) < hi)
    XcdBar xb; xb.bar = (unsigned*)ws; xb.x = xb_xcc_id(); xb.nloc = 1u; xb.nx = 1u;
    const bool xb_leader = (wave == 0) && (pg8::lane_id_v() == 0);
    if (lo == 0 && xb_leader) xcd_bar_post(xb.bar, xb.x);
#define SEAM(k) do { if (IN(k) && IN((k) + 1)) { if ((k) == 0) { grid.sync(); if (xb_leader) xcd_bar_census(xb); } else xcd_barrier(xb, xb_leader); } } while (0)
    if (IN(0)) { PH_IDS(); p0_prologue(a, lds, tid, lane, wave, G); }
    SEAM(0);
    if (IN(1)) {
        pg8::Gemm g{XN, WIN, M, DIN, D}; pg8::StaticOrder S; S.init(M, DIN, G, (int)blockIdx.x);
        pg8::EpiProj E{GLU, HG};
        pg8::gemm_phase<pg8::EpiProj, pg8::StaticOrder, true, true>(lds, g, S, E, wave);
    }
    SEAM(1);
    if (IN(2)) { PH_IDS();
        if (!(a.sub & 1)) for (int u = blockIdx.x; u < BATCH * NH * SEGS; u += G) hgrn_unit<false>(lds, u, HG, a.in[7], a.in[8], HS, HLD, Y, tid, lane, wave);
        if (!(a.sub & 2)) for (int wu = gw; wu < 2048; wu += NGW) conv_wave_unit(GLU, a.in[3], a.in[4], a.in[5], a.in[6], Y, wu, lane);
    }
    SEAM(2);
    if (IN(3)) { PH_IDS();
        for (int u = blockIdx.x; u < BATCH * NH * SEGS; u += G) hgrn_unit<true>(lds, u, HG, a.in[7], a.in[8], HS, HLD, Y, tid, lane, wave);
    }
    SEAM(3);
    if (IN(4)) {
        pg8::Gemm g{Y, WOUT, M, D, D}; pg8::StaticOrder S; S.init(M, D, G, (int)blockIdx.x);
        pg8::EpiResBf16 E{XN, a.in[0], (float*)(ws + WS_SSQ)};
        pg8::gemm_phase<pg8::EpiResBf16, pg8::StaticOrder, false, true>(lds, g, S, E, wave);
    }
    SEAM(4);
    if (IN(6)) {
        pg8::Gemm g{XN, WEFF, M, NQ, D}; pg8::StaticOrder S; S.init(M, NQ, G, (int)blockIdx.x);
        pg8::EpiTopK E{EIDX, GATE, (const float*)(ws + WS_SSQ)};
        for (int i = 0;; ++i) { pg8::OneUnit O; if (!S.next(i, O.u)) break; pg8::gemm_phase<pg8::EpiTopK, pg8::OneUnit, false, true>(lds, g, O, E, wave); }
    }
    SEAM(6);
    if (IN(7)) { PH_IDS();
        peer_phase<PEER_V4>(lds, wave, XN, EIDX, GATE, ws + WS_U, ws + WS_V, (const float*)(ws + WS_USC), (const float*)(ws + WS_VSC), (const float*)(ws + WS_SSQ), a.in[15], a.out, gw, NGW, lane);
    }
#undef IN
#undef SEAM
}
}

extern "C" void kernel_launch(void* const* d_in, const int* in_sizes, int n_in, void* d_out, int out_size, void* d_ws, size_t ws_size, hipStream_t stream) {
    static int grid = 0;
    if (grid == 0) {
        if (n_in != 16 || out_size != mk::M * mk::D || ws_size < (size_t)mk::WS_END) { fprintf(stderr, "kernel_launch: unexpected shapes (n_in %d out %d ws %zu)\n", n_in, out_size, ws_size); grid = -1; return; }
        int dev = 0, cus = 0, per_cu = 0;
        (void)hipGetDevice(&dev);
        (void)hipDeviceGetAttribute(&cus, hipDeviceAttributeMultiprocessorCount, dev);
        if (hipFuncSetAttribute((const void*)mk::mega, hipFuncAttributeMaxDynamicSharedMemorySize, mk::LDS_BYTES) != hipSuccess) { fprintf(stderr, "kernel_launch: hipFuncSetAttribute failed\n"); grid = -1; return; }
        if (hipOccupancyMaxActiveBlocksPerMultiprocessor(&per_cu, (const void*)mk::mega, mk::NT, mk::LDS_BYTES) != hipSuccess || per_cu < 1) { fprintf(stderr, "kernel_launch: occupancy query says %d\n", per_cu); per_cu = 1; }
        (void)hipGetLastError();
        grid = cus;
    }
    if (grid < 0) return;
    if (hipMemsetAsync(d_ws, 0, 16384, stream) != hipSuccess) { fprintf(stderr, "kernel_launch: memset failed\n"); return; }
    mk::Args a{};
    for (int i = 0; i < 16; ++i) a.in[i] = (const float*)d_in[i];
    a.out = (float*)d_out; a.ws = (unsigned char*)d_ws;
    a.ph_lo = 0; a.ph_hi = 8;
    void* args[] = {&a};
#ifdef PROBE_PHASE
    const int plo[3] = {0, PROBE_PHASE == 0 ? 0 : PROBE_PHASE, 7}, phi[3] = {PROBE_PHASE == 0 ? 1 : 7, PROBE_PHASE == 0 ? 8 : PROBE_PHASE + 1, 8};
    for (int li = 0; li < 3; ++li) { if ((li == 1 && PROBE_PHASE < 0) || (li == 2 && PROBE_PHASE == 0)) continue; a.ph_lo = plo[li]; a.ph_hi = phi[li];
        if (li) (void)hipMemsetAsync(d_ws, 0, 16384, stream);
#ifdef PROBE_SUB
        a.sub = (li == (PROBE_PHASE == 0 ? 0 : 1)) ? PROBE_SUB : 0;
#endif
        hipError_t e = hipLaunchCooperativeKernel((const void*)mk::mega, dim3(grid), dim3(mk::NT), args, mk::LDS_BYTES, stream);
        if (e != hipSuccess) fprintf(stderr, "cooperative launch failed: %s (grid %d)\n", hipGetErrorString(e), grid); }
#else
    hipError_t e = hipLaunchCooperativeKernel((const void*)mk::mega, dim3(grid), dim3(mk::NT), args, mk::LDS_BYTES, stream);
    if (e != hipSuccess) fprintf(stderr, "cooperative launch failed: %s (grid %d)\n", hipGetErrorString(e), grid);
#endif
}
```

```cpp
#include <hip/hip_runtime.h>
#include <hip/hip_cooperative_groups.h>
#include <cstdio>
#include <cstdint>
#include <cmath>
#include <type_traits>
namespace cg = cooperative_groups;
namespace pg8 {
#define PG8_LAS __attribute__((address_space(3)))
typedef unsigned short bf16_t;
typedef short bf16x8 __attribute__((ext_vector_type(8)));
typedef float f32x4 __attribute__((ext_vector_type(4)));
typedef unsigned u32x4 __attribute__((ext_vector_type(4)));
constexpr int BM = 256, BK = 64, HALF = 128, HTB = HALF * BK * 2  , STAGE_BYTES = 8 * HTB, NXCD = 8, WGM = 8;

__host__ __device__ __forceinline__ int lds_byte(int r, int c) { const int st = (r >> 4) * 2 + (c >> 5), rr = r & 15, cc = c & 31, ob = rr * 64 + cc * 2; return st * 1024 + (ob ^ (((ob >> 9) & 1) << 5)); }
__host__ __device__ __forceinline__ void stage_rc(int b, int& R, int& C) { const int st = b / 1024, sb = b % 1024, swz = sb ^ (((sb >> 9) & 1) << 5); R = (st >> 1) * 16 + swz / 64; C = (st & 1) * 32 + (swz % 64) / 2; }
__host__ __device__ __forceinline__ int perm32(int rho) { const int n = rho >> 4, i = rho & 15; return 8 * (i >> 2) + 4 * n + (i & 3); }

struct Unit { int pm, pn; };
struct Gemm { const bf16_t* A; const bf16_t* Bt; int M, N, K; };

struct StaticOrder {
    int nM, nN, nwg, G, c;
    __host__ __device__ void init(int M, int N, int G_, int c_) { nM = M / BM; nN = N / BM; nwg = nM * nN; G = G_; c = c_; }
    __host__ __device__ bool next(int i, Unit& u) const {
        const long L = (long)i * G + c; if (L >= nwg) return false;
        int wgid = (int)L; { const int q = nwg / NXCD, r = nwg % NXCD, xcd = wgid % NXCD, off = wgid / NXCD; wgid = (xcd < r ? xcd * (q + 1) : r * (q + 1) + (xcd - r) * q) + off; }
        const int nig = WGM * nN, gid = wgid / nig, fm = gid * WGM, gsz = (nM - fm) < WGM ? (nM - fm) : WGM;
        u.pm = fm + ((wgid % nig) % gsz); u.pn = (wgid % nig) / gsz; return true;
    }
    __device__ __forceinline__ void a_ready(const Unit&) const {}
    __device__ __forceinline__ void done(const Unit&) const {}
};

__device__ __forceinline__ unsigned cvt_pk_bf16(float lo, float hi) { unsigned r; asm volatile("v_cvt_pk_bf16_f32 %0, %1, %2" : "=v"(r) : "v"(lo), "v"(hi)); return r; }
__device__ __forceinline__ int lane_id_v() { int l; asm volatile("v_mbcnt_lo_u32_b32 %0, -1, 0\n\tv_mbcnt_hi_u32_b32 %0, -1, %0" : "=v"(l)); return l; }
__device__ __forceinline__ float fsigmoid(float x) { return __builtin_amdgcn_rcpf(1.f + __builtin_amdgcn_exp2f(-1.4426950408889634f * x)); }

struct EpiProj {
    static constexpr bool PERM = true, AFTER_DRAIN = false;
    bf16_t* GLU; bf16_t* HG;
    static constexpr size_t MROWS = 32768;
    __device__ __forceinline__ void operator()(const f32x4 (&acc)[2][2][4][2], const Unit& u, int wr, int wc, int fr, int fq) const {
        const int row0 = u.pm * BM + wr * 64 + fr;
        if (u.pn < 4) {
            const int col = u.pn * 128 + wc * 32 + 8 * fq;
#pragma unroll
            for (int ai = 0; ai < 2; ++ai)
#pragma unroll
                for (int m = 0; m < 4; ++m) {
                    const f32x4 a0 = acc[ai][0][m][0], a1 = acc[ai][0][m][1], g0 = acc[ai][1][m][0], g1 = acc[ai][1][m][1];
                    u32x4 w;
                    w.x = cvt_pk_bf16(a0[0] * fsigmoid(g0[0]), a0[1] * fsigmoid(g0[1])); w.y = cvt_pk_bf16(a0[2] * fsigmoid(g0[2]), a0[3] * fsigmoid(g0[3]));
                    w.z = cvt_pk_bf16(a1[0] * fsigmoid(g1[0]), a1[1] * fsigmoid(g1[1])); w.w = cvt_pk_bf16(a1[2] * fsigmoid(g1[2]), a1[3] * fsigmoid(g1[3]));
                    *(u32x4*)(GLU + ((size_t)(col >> 6) * MROWS + (row0 + ai * HALF + m * 16)) * 64 + (col & 63)) = w;
                }
        } else {
            const int t = u.pn - 4;
            const bool act = (t < 2) || (t >= 6);
            const int col = t * 256 + wc * 32 + 8 * fq;
#pragma unroll
            for (int ai = 0; ai < 2; ++ai)
#pragma unroll
                for (int m = 0; m < 4; ++m) {
                    const int hcol = (t & 1) * 256 + wc * 32 + 8 * fq;
                    bf16_t* rowp = HG + ((size_t)((t >> 1) * 4 + (hcol >> 7)) * MROWS + (row0 + ai * HALF + m * 16)) * 128 + (hcol & 127);
#pragma unroll
                    for (int bj = 0; bj < 2; ++bj) {
                        f32x4 v0 = acc[ai][bj][m][0], v1 = acc[ai][bj][m][1];
                        if (act) {
#pragma unroll
                            for (int i = 0; i < 4; ++i) { v0[i] = v0[i] * fsigmoid(v0[i]); v1[i] = v1[i] * fsigmoid(v1[i]); }
                        }
                        u32x4 w; w.x = cvt_pk_bf16(v0[0], v0[1]); w.y = cvt_pk_bf16(v0[2], v0[3]); w.z = cvt_pk_bf16(v1[0], v1[1]); w.w = cvt_pk_bf16(v1[2], v1[3]);
                        *(u32x4*)(rowp + (size_t)bj * MROWS * 128) = w;
                    }
                }
        }
    }
};

struct EpiResBf16 {
    static constexpr bool PERM = true, AFTER_DRAIN = false;
    bf16_t* O; const float* XR; float* SSQ;
    __device__ __forceinline__ void operator()(const f32x4 (&acc)[2][2][4][2], const Unit& u, int wr, int wc, int fr, int fq) const {
        const int row0 = u.pm * BM + wr * 64 + fr, col0 = u.pn * BM + wc * 32 + 8 * fq;
        u32x4 rb[4][2][2]; float xs[4][2];
#define PG8_RES_LOAD(g) do { _Pragma("unroll") for (int mm = 0; mm < 2; ++mm) { const int rr = row0 + ((g) >> 1) * HALF + (2 * ((g) & 1) + mm) * 16; xs[g][mm] = XR[rr]; \
            _Pragma("unroll") for (int bj = 0; bj < 2; ++bj) rb[g][mm][bj] = __builtin_nontemporal_load((const u32x4*)(O + (size_t)rr * 1024 + col0 + bj * HALF)); } } while (0)
        PG8_RES_LOAD(0); PG8_RES_LOAD(1); PG8_RES_LOAD(2);
#pragma unroll
        for (int g = 0; g < 4; ++g) {
            const int ai = g >> 1;
#pragma unroll
            for (int mm = 0; mm < 2; ++mm) {
                const int m = 2 * (g & 1) + mm, row = row0 + ai * HALF + m * 16; const size_t off = (size_t)row * 1024 + col0;
                float ss = 0.f;
#pragma unroll
                for (int bj = 0; bj < 2; ++bj) {
                    const u32x4 q = rb[g][mm][bj]; const float sc = xs[g][mm];
                    const f32x4 r0 = (f32x4){__builtin_bit_cast(float, q.x << 16), __builtin_bit_cast(float, q.x & 0xffff0000u), __builtin_bit_cast(float, q.y << 16), __builtin_bit_cast(float, q.y & 0xffff0000u)};
                    const f32x4 r1 = (f32x4){__builtin_bit_cast(float, q.z << 16), __builtin_bit_cast(float, q.z & 0xffff0000u), __builtin_bit_cast(float, q.w << 16), __builtin_bit_cast(float, q.w & 0xffff0000u)};
                    const f32x4 v0 = acc[ai][bj][m][0] + r0 * sc, v1 = acc[ai][bj][m][1] + r1 * sc;
                    ss += (v0[0] * v0[0] + v0[1] * v0[1]) + (v0[2] * v0[2] + v0[3] * v0[3]) + (v1[0] * v1[0] + v1[1] * v1[1]) + (v1[2] * v1[2] + v1[3] * v1[3]);
                    u32x4 w; w.x = cvt_pk_bf16(v0[0], v0[1]); w.y = cvt_pk_bf16(v0[2], v0[3]); w.z = cvt_pk_bf16(v1[0], v1[1]); w.w = cvt_pk_bf16(v1[2], v1[3]);
                    *(u32x4*)(O + off + bj * HALF) = w;
                }
                ss += __shfl_xor(ss, 16); ss += __shfl_xor(ss, 32);
                if (fq == 0) SSQ[(size_t)row * 16 + u.pn * 4 + wc] = ss;
            }
            if (g == 0) { asm volatile("" ::: "memory"); PG8_RES_LOAD(3); }
        }
#undef PG8_RES_LOAD
    }
};

__device__ __forceinline__ unsigned f2key(float f) { return __builtin_bit_cast(unsigned, f); }
__device__ __forceinline__ float key2f(unsigned k) { return __builtin_bit_cast(float, k); }
__device__ __forceinline__ unsigned umax_(unsigned a, unsigned b) { unsigned r; asm("v_max_f32 %0, %1, %2" : "=v"(r) : "v"(a), "v"(b)); return r; }
__device__ __forceinline__ unsigned umin_(unsigned a, unsigned b) { unsigned r; asm("v_min_f32 %0, %1, %2" : "=v"(r) : "v"(a), "v"(b)); return r; }
__device__ __forceinline__ void sort16_desc(unsigned (&v)[16]) {
#define PG8_CE(a, b) { const unsigned hi = umax_(v[a], v[b]), lo = umin_(v[a], v[b]); v[a] = hi; v[b] = lo; }
    PG8_CE(0, 13) PG8_CE(1, 12) PG8_CE(2, 15) PG8_CE(3, 14) PG8_CE(4, 8) PG8_CE(5, 6) PG8_CE(7, 11) PG8_CE(9, 10)
    PG8_CE(0, 5) PG8_CE(1, 7) PG8_CE(2, 9) PG8_CE(3, 4) PG8_CE(6, 13) PG8_CE(8, 14) PG8_CE(10, 15) PG8_CE(11, 12)
    PG8_CE(0, 1) PG8_CE(2, 3) PG8_CE(4, 5) PG8_CE(6, 8) PG8_CE(7, 9) PG8_CE(10, 11) PG8_CE(12, 13) PG8_CE(14, 15)
    PG8_CE(0, 2) PG8_CE(1, 3) PG8_CE(4, 10) PG8_CE(5, 11) PG8_CE(6, 7) PG8_CE(8, 9) PG8_CE(12, 14) PG8_CE(13, 15)
    PG8_CE(1, 2) PG8_CE(3, 12) PG8_CE(4, 6) PG8_CE(5, 7) PG8_CE(8, 10) PG8_CE(9, 11) PG8_CE(13, 14)
    PG8_CE(1, 4) PG8_CE(2, 6) PG8_CE(5, 8) PG8_CE(7, 10) PG8_CE(9, 13) PG8_CE(11, 14)
    PG8_CE(2, 4) PG8_CE(3, 6) PG8_CE(9, 12) PG8_CE(11, 13)
    PG8_CE(3, 5) PG8_CE(6, 8) PG8_CE(7, 9) PG8_CE(10, 12)
    PG8_CE(3, 4) PG8_CE(5, 6) PG8_CE(7, 8) PG8_CE(9, 10) PG8_CE(11, 12)
    PG8_CE(6, 7) PG8_CE(8, 9)
#undef PG8_CE
}
__device__ __forceinline__ void bmerge16_desc(unsigned (&v)[16]) {
#pragma unroll
    for (int j = 8; j > 0; j >>= 1)
#pragma unroll
        for (int i = 0; i < 16; ++i) { const int l = i ^ j; if (l > i) { const unsigned hi = umax_(v[i], v[l]), lo = umin_(v[i], v[l]); v[i] = hi; v[l] = lo; } }
}
struct NoHook { __device__ __forceinline__ void issue(f32x4 (&)[4], f32x4 (&)[4], int, int, int) const {} __device__ __forceinline__ void finish(f32x4 (&)[4], f32x4 (&)[4], int, int, int) const {} };
template <class Hook = NoHook>
struct EpiTopK {
    static constexpr bool PERM = false, AFTER_DRAIN = true;
    int* EIDX; float* GATE; const float* SSQ; Hook hk;
    __device__ __forceinline__ void fused(f32x4 (&acc)[2][2][4][2], const Unit& u, int wr, int wc, int fr, int fq, PG8_LAS unsigned char* lds, int wid, int lane) const {
        PG8_LAS unsigned* T = (PG8_LAS unsigned*)lds;
        PG8_LAS unsigned* LB = (PG8_LAS unsigned*)(lds + 131072);
        const int h = u.pn;
        unsigned keep[16];
        auto half = [&](auto AI) {
            constexpr int ai = decltype(AI)::value;
            const int rl = wr * 64 + fr;
            f32x4 hka[4], hkb[4]; hk.issue(hka, hkb, ai, wid, lane);
#pragma unroll
            for (int bj = 0; bj < 2; ++bj)
#pragma unroll
                for (int m = 0; m < 4; ++m)
#pragma unroll
                    for (int n = 0; n < 2; ++n)
#pragma unroll
                        for (int i = 0; i < 4; ++i) {
                            const int c = bj * 128 + wc * 32 + n * 16 + fq * 4 + i;
                            const float v = acc[ai][bj][m][n][i];
                            T[c * 128 + rl + m * 16] = (f2key(v) & ~127u) | (unsigned)(127 - (c & 127));
                        }
            asm volatile("s_waitcnt lgkmcnt(0)" ::: "memory"); __builtin_amdgcn_s_barrier(); asm volatile("" ::: "memory");
            {
                const int p = wid >> 2, q = (wid >> 1) & 1, r = (wid & 1) * 64 + lane, base = p * 128 + q * 64;
                unsigned run[16], grp[16];
#pragma unroll
                for (int j = 0; j < 16; ++j) run[j] = T[(base + j) * 128 + r];
                sort16_desc(run);
#pragma unroll
                for (int gI = 1; gI < 4; ++gI) {
#pragma unroll
                    for (int j = 0; j < 16; ++j) grp[j] = T[(base + 16 * gI + j) * 128 + r];
                    sort16_desc(grp);
#pragma unroll
                    for (int j = 0; j < 16; ++j) run[j] = umax_(run[j], grp[15 - j]);
                    bmerge16_desc(run);
                }
#pragma unroll
                for (int j = 0; j < 16; ++j) LB[((p * 2 + q) * 16 + j) * 128 + r] = run[j];
            }
            hk.finish(hka, hkb, ai, wid, lane);
            asm volatile("s_waitcnt lgkmcnt(0)" ::: "memory"); __builtin_amdgcn_s_barrier(); asm volatile("" ::: "memory");
            if (wid < 4) {
                const int p = wid >> 1, r = (wid & 1) * 64 + lane;
                unsigned a[16];
#pragma unroll
                for (int j = 0; j < 16; ++j) a[j] = umax_(LB[((p * 2) * 16 + j) * 128 + r], LB[((p * 2 + 1) * 16 + (15 - j)) * 128 + r]);
                bmerge16_desc(a);
                if constexpr (ai == 0) {
#pragma unroll
                    for (int j = 0; j < 16; ++j) keep[j] = a[j];
                } else {
#pragma unroll
                    for (int j = 0; j < 16; ++j) { T[(p * 16 + j) * 128 + r] = keep[j]; T[((2 + p) * 16 + j) * 128 + r] = a[j]; }
                }
            }
            if constexpr (ai == 1) {
            asm volatile("s_waitcnt lgkmcnt(0)" ::: "memory"); __builtin_amdgcn_s_barrier(); asm volatile("" ::: "memory");
            if (wid < 4) {
                const int r = (wid & 1) * 64 + lane, ch = wid >> 1;
                PG8_LAS unsigned* L = T + ch * 4096;
                float v1[16], v2[16];
#pragma unroll
                for (int j = 0; j < 16; ++j) { v1[j] = key2f(L[j * 128 + r] & ~127u); v2[j] = key2f(L[(16 + j) * 128 + r] & ~127u); }
                unsigned lst[16];
#pragma unroll
                for (int j = 0; j < 16; ++j) lst[j] = (f2key(v1[0] + v2[j]) & ~255u) | (unsigned)(255 - j);
#pragma unroll
                for (int i = 1; i < 16; ++i)
#pragma unroll
                    for (int j = 0; j < 16; ++j) if ((i + 1) * (j + 1) <= 16) {
                        unsigned x = (f2key(v1[i] + v2[j]) & ~255u) | (unsigned)(255 - (i * 16 + j));
#pragma unroll
                        for (int t = 0; t < 16; ++t) if (t >= (i + 1) * (j + 1) - 1) { const unsigned hi = umax_(lst[t], x); x = umin_(lst[t], x); lst[t] = hi; }
                    }
                float rstd;
                { const f32x4* sq = (const f32x4*)(SSQ + (size_t)(u.pm * BM + ch * 128 + r) * 16); const f32x4 q0 = sq[0], q1 = sq[1], q2 = sq[2], q3 = sq[3];
                  const float tot = ((q0[0] + q0[1]) + (q0[2] + q0[3])) + ((q1[0] + q1[1]) + (q1[2] + q1[3])) + ((q2[0] + q2[1]) + (q2[2] + q2[3])) + ((q3[0] + q3[1]) + (q3[2] + q3[3]));
                  rstd = rsqrtf(tot * (1.f / 1024.f) + 1e-6f); }
                float e[16]; float sum = 0.f; const float mx = key2f(lst[0] & ~255u);
                int ex[16];
#pragma unroll
                for (int t = 0; t < 16; ++t) {
                    e[t] = __expf((key2f(lst[t] & ~255u) - mx) * rstd); sum += e[t];
                    const int ci = 255 - (int)(lst[t] & 255u), a = ci >> 4, b = ci & 15;
                    const int i1 = 127 - (int)(L[a * 128 + r] & 127u), i2 = 127 - (int)(L[(16 + b) * 128 + r] & 127u);
                    ex[t] = i1 * 128 + i2;
                }
                const float inv = 1.f / sum;
                const size_t o = (size_t)(u.pm * BM + ch * 128 + r) * 128 + h * 16;
#pragma unroll
                for (int t4 = 0; t4 < 4; ++t4) {
                    *(f32x4*)(GATE + o + 4 * t4) = (f32x4){e[4 * t4] * inv, e[4 * t4 + 1] * inv, e[4 * t4 + 2] * inv, e[4 * t4 + 3] * inv};
                    *(u32x4*)(EIDX + o + 4 * t4) = (u32x4){(unsigned)ex[4 * t4], (unsigned)ex[4 * t4 + 1], (unsigned)ex[4 * t4 + 2], (unsigned)ex[4 * t4 + 3]};
                }
            }
            asm volatile("s_waitcnt lgkmcnt(0)" ::: "memory"); __builtin_amdgcn_s_barrier(); asm volatile("" ::: "memory");
            }
        };
        half(std::integral_constant<int, 0>{}); half(std::integral_constant<int, 1>{});
    }
};
struct OneUnit {
    Unit u;
    __device__ __forceinline__ bool next(int i, Unit& o) const { if (i) return false; o = u; return true; }
    __device__ __forceinline__ void a_ready(const Unit&) const {}
    __device__ __forceinline__ void done(const Unit&) const {}
};
struct GatedOrder {
    int x, j, wid; const unsigned* ready; unsigned* tmo;
    __device__ void init(int c, int wid_, const unsigned* ready_, unsigned* tmo_) { x = c & 7; j = c >> 3; wid = wid_; ready = ready_; tmo = tmo_; }
    __device__ bool converter() const { return j >= 24; }
    __device__ bool next(int i, Unit& u) const {
        int uu;
        if (j < 24) { if (i >= 7) return false; uu = j + 24 * i; } else { if (i >= 3) return false; uu = 168 + (j - 24) + 8 * i; }
        u.pm = x + 8 * (uu / 12); u.pn = uu % 12; return true;
    }
    __device__ __forceinline__ void a_ready(const Unit& u) const {
        if (wid == 0) {
            unsigned polls = 0;
            while ((unsigned)__builtin_amdgcn_readfirstlane(__hip_atomic_load(ready + 64 * u.pm, __ATOMIC_RELAXED, __HIP_MEMORY_SCOPE_AGENT)) < 256u) {
                if ((++polls & 255u) == 0u) { if (__builtin_amdgcn_readfirstlane(__hip_atomic_load(tmo, __ATOMIC_RELAXED, __HIP_MEMORY_SCOPE_AGENT)) != 0u) break;
                    if (polls > (1u << 20)) { if (lane_id_v() == 0) atomicAdd(tmo, 1u); break; } }
                __builtin_amdgcn_s_sleep(2); }
            __builtin_amdgcn_fence(__ATOMIC_ACQUIRE, "agent");
            asm volatile("s_waitcnt vmcnt(0)" ::: "memory");
        }
        asm volatile("" ::: "memory"); __builtin_amdgcn_s_barrier(); asm volatile("" ::: "memory");
    }
    __device__ __forceinline__ void done(const Unit&) const {}
};
template <class Epi, class Sched, bool ALIGN_EPI = false, bool SP2 = false>
__device__ __forceinline__ void gemm_phase(PG8_LAS unsigned char* lds, const Gemm g, const Sched& S, const Epi& E, const int wid) {
    const int lane = lane_id_v(), tid = wid * 64 + lane, wr = wid >> 2, wc = wid & 3, fr = lane & 15, fq = lane >> 4;
    const int K = g.K, nt = K / BK;
    unsigned voffA[2], voffB[2];
#pragma unroll
    for (int i = 0; i < 2; ++i) { int R, C; stage_rc(tid * 16 + i * 8192, R, C); const int Rb = Epi::PERM ? ((R & ~31) + perm32(R & 31)) : R;
        voffA[i] = (unsigned)(R * K + C) * 2u; voffB[i] = (unsigned)(Rb * K + C) * 2u; }
    const size_t kstep = (size_t)(BK * 2);
    const size_t hstep = (size_t)HALF * K * 2;
    const size_t tstep = 2 * hstep;
    const unsigned ldsw = (unsigned)wid * 1024u;
    const int aoff = lds_byte(wr * 64 + fr, fq * 8), boff = lds_byte(wc * 32 + fr, fq * 8);
#define PG8_SA(b, h) (((b) * 2 + (h)) * HTB)
#define PG8_SB(b, h) ((4 + (b) * 2 + (h)) * HTB)
#define PG8_STAGE(bufoff, gbase, voff) do { _Pragma("unroll") for (int _i = 0; _i < 2; ++_i) \
        __builtin_amdgcn_global_load_lds((const unsigned*)((const char*)(gbase) + (voff)[_i]), (PG8_LAS unsigned*)(lds + (bufoff) + ldsw + _i * 8192), 16, 0, 0); } while (0)
#define PG8_LDA(dst, b, h) do { _Pragma("unroll") for (int m = 0; m < 4; ++m) _Pragma("unroll") for (int k = 0; k < 2; ++k) dst[m][k] = *(const PG8_LAS bf16x8*)(lds + PG8_SA(b, h) + aoff + m * 2048 + k * 1024); } while (0)
#define PG8_LDB(dst, b, h) do { _Pragma("unroll") for (int n = 0; n < 2; ++n) _Pragma("unroll") for (int k = 0; k < 2; ++k) dst[n][k] = *(const PG8_LAS bf16x8*)(lds + PG8_SB(b, h) + boff + n * 2048 + k * 1024); } while (0)
#define PG8_MMA(ai, bj, At, Bt) do { __builtin_amdgcn_s_setprio(1); _Pragma("unroll") for (int m = 0; m < 4; ++m) _Pragma("unroll") for (int n = 0; n < 2; ++n) _Pragma("unroll") for (int k = 0; k < 2; ++k) \
        acc[ai][bj][m][n] = __builtin_amdgcn_mfma_f32_16x16x32_bf16(Bt[n][k], At[m][k], acc[ai][bj][m][n], 0, 0, 0); __builtin_amdgcn_s_setprio(0); } while (0)
#define PG8_WAIT_V(n) asm volatile("s_waitcnt vmcnt(" #n ")" ::: "memory")
#define PG8_WAIT_L(n) asm volatile("s_waitcnt lgkmcnt(" #n ")" ::: "memory")
#define PG8_BAR __builtin_amdgcn_s_barrier()
#define PG8_SCHED __builtin_amdgcn_sched_barrier(0)
    Unit cur, nxt; int ui = 0;
    if (!S.next(0, cur)) return;
    f32x4 acc[2][2][4][2];
#pragma unroll
    for (int a = 0; a < 2; ++a)
#pragma unroll
        for (int b = 0; b < 2; ++b)
#pragma unroll
            for (int m = 0; m < 4; ++m)
#pragma unroll
                for (int n = 0; n < 2; ++n) acc[a][b][m][n] = (f32x4){0.f, 0.f, 0.f, 0.f};
    bf16x8 At[4][2], B0[2][2], B1[2][2];
    const char* cA = (const char*)g.A + (size_t)cur.pm * tstep; const char* cB = (const char*)g.Bt + (size_t)cur.pn * tstep;
    S.a_ready(cur);
    if constexpr (SP2) {
        PG8_STAGE(PG8_SB(0, 0), cB, voffB); PG8_STAGE(PG8_SB(0, 1), cB + hstep, voffB); PG8_STAGE(PG8_SA(0, 0), cA, voffA); PG8_STAGE(PG8_SA(0, 1), cA + hstep, voffA);
        if (wr == 1) PG8_BAR;
        PG8_WAIT_V(2); PG8_BAR;
        PG8_STAGE(PG8_SB(1, 0), cB + kstep, voffB); PG8_STAGE(PG8_SA(1, 0), cA + kstep, voffA); PG8_STAGE(PG8_SB(1, 1), cB + hstep + kstep, voffB);
        PG8_WAIT_V(6); PG8_BAR;
    } else {
        PG8_STAGE(PG8_SB(0, 0), cB, voffB); PG8_STAGE(PG8_SA(0, 0), cA, voffA); PG8_STAGE(PG8_SB(0, 1), cB + hstep, voffB); PG8_STAGE(PG8_SA(0, 1), cA + hstep, voffA);
        if (wr == 1) PG8_BAR;
        PG8_WAIT_V(4); PG8_BAR;
        PG8_STAGE(PG8_SB(1, 0), cB + kstep, voffB); PG8_STAGE(PG8_SA(1, 0), cA + kstep, voffA); PG8_STAGE(PG8_SB(1, 1), cB + hstep + kstep, voffB);
        PG8_WAIT_V(6); PG8_BAR;
    }
    for (;;) {
        const bool has_next = S.next(ui + 1, nxt);
        const char* nA = has_next ? (const char*)g.A + (size_t)nxt.pm * tstep : cA; const char* nB = has_next ? (const char*)g.Bt + (size_t)nxt.pn * tstep : cB;
        for (int t = 0; t < nt; t += 2) {
            const bool last = (t == nt - 2);
            const char* a1 = cA + (size_t)(t + 1) * kstep;
            const char* a2 = last ? nA : cA + (size_t)(t + 2) * kstep; const char* b2 = last ? nB : cB + (size_t)(t + 2) * kstep;
            const char* a3 = a2 + kstep; const char* b3 = b2 + kstep;
            if (last && has_next) S.a_ready(nxt);
            if constexpr (SP2) {
            PG8_LDB(B0, 0, 0); PG8_LDB(B1, 0, 1); PG8_SCHED; PG8_LDA(At, 0, 0); PG8_STAGE(PG8_SA(1, 1), a1 + hstep, voffA);
            PG8_WAIT_V(8); PG8_WAIT_L(0); PG8_BAR; PG8_MMA(0, 0, At, B0); PG8_MMA(0, 1, At, B1); PG8_BAR; PG8_SCHED;
            PG8_LDA(At, 0, 1); PG8_STAGE(PG8_SB(0, 0), b2, voffB); PG8_STAGE(PG8_SB(0, 1), b2 + hstep, voffB); PG8_STAGE(PG8_SA(0, 0), a2, voffA);
            PG8_WAIT_V(8); PG8_WAIT_L(0); PG8_BAR; PG8_MMA(1, 0, At, B0); PG8_MMA(1, 1, At, B1); PG8_BAR; PG8_SCHED;
            PG8_LDB(B0, 1, 0); PG8_LDB(B1, 1, 1); PG8_SCHED; PG8_LDA(At, 1, 0); PG8_STAGE(PG8_SA(0, 1), a2 + hstep, voffA);
            PG8_WAIT_V(8); PG8_WAIT_L(0); PG8_BAR; PG8_MMA(0, 0, At, B0); PG8_MMA(0, 1, At, B1); PG8_BAR; PG8_SCHED;
            PG8_LDA(At, 1, 1); PG8_STAGE(PG8_SB(1, 0), b3, voffB); PG8_STAGE(PG8_SB(1, 1), b3 + hstep, voffB); PG8_STAGE(PG8_SA(1, 0), a3, voffA);
            PG8_WAIT_V(8); PG8_WAIT_L(0); PG8_BAR; PG8_MMA(1, 0, At, B0); PG8_MMA(1, 1, At, B1); PG8_BAR; PG8_SCHED;
            } else {
            PG8_LDB(B0, 0, 0); PG8_SCHED; PG8_LDA(At, 0, 0); PG8_STAGE(PG8_SA(1, 1), a1 + hstep, voffA);
            PG8_WAIT_L(8); PG8_BAR; PG8_WAIT_L(0); PG8_MMA(0, 0, At, B0); PG8_BAR; PG8_SCHED;
            PG8_LDB(B1, 0, 1); PG8_STAGE(PG8_SB(0, 0), b2, voffB);
            PG8_BAR; PG8_WAIT_L(0); PG8_MMA(0, 1, At, B1); PG8_BAR;
            PG8_LDA(At, 0, 1); PG8_STAGE(PG8_SA(0, 0), a2, voffA);
            PG8_BAR; PG8_WAIT_L(0); PG8_MMA(1, 0, At, B0); PG8_BAR; PG8_SCHED;
            PG8_STAGE(PG8_SB(0, 1), b2 + hstep, voffB);
            PG8_WAIT_V(6); PG8_BAR; PG8_MMA(1, 1, At, B1); PG8_BAR;
            PG8_LDB(B0, 1, 0); PG8_SCHED; PG8_LDA(At, 1, 0); PG8_STAGE(PG8_SA(0, 1), a2 + hstep, voffA);
            PG8_WAIT_L(8); PG8_BAR; PG8_WAIT_L(0); PG8_MMA(0, 0, At, B0); PG8_BAR; PG8_SCHED;
            PG8_LDB(B1, 1, 1); PG8_STAGE(PG8_SB(1, 0), b3, voffB);
            PG8_BAR; PG8_WAIT_L(0); PG8_MMA(0, 1, At, B1); PG8_BAR;
            PG8_LDA(At, 1, 1); PG8_STAGE(PG8_SA(1, 0), a3, voffA);
            PG8_BAR; PG8_WAIT_L(0); PG8_MMA(1, 0, At, B0); PG8_BAR; PG8_SCHED;
            PG8_STAGE(PG8_SB(1, 1), b3 + hstep, voffB);
            PG8_WAIT_V(6); PG8_BAR; PG8_MMA(1, 1, At, B1); PG8_BAR;
            }
        }
        if constexpr (ALIGN_EPI) { if (wr == 0) PG8_BAR; }
        if constexpr (!Epi::AFTER_DRAIN) { E(acc, cur, wr, wc, fr, fq); S.done(cur); }
        if (!has_next) break;
#pragma unroll
        for (int a = 0; a < 2; ++a)
#pragma unroll
            for (int b = 0; b < 2; ++b)
#pragma unroll
                for (int m = 0; m < 4; ++m)
#pragma unroll
                    for (int n = 0; n < 2; ++n) acc[a][b][m][n] = (f32x4){0.f, 0.f, 0.f, 0.f};
        cur = nxt; cA = nA; cB = nB; ++ui;
        if constexpr (ALIGN_EPI) { if (wr == 1) PG8_BAR; }
    }
    PG8_WAIT_V(0);
    if constexpr (!ALIGN_EPI) { if (wr == 0) PG8_BAR; }
    PG8_BAR;
    if constexpr (Epi::AFTER_DRAIN) { E.fused(acc, cur, wr, wc, fr, fq, lds, wid, lane); S.done(cur); }
#undef PG8_SA
#undef PG8_SB
#undef PG8_STAGE
#undef PG8_LDA
#undef PG8_LDB
#undef PG8_MMA
#undef PG8_WAIT_V
#undef PG8_WAIT_L
#undef PG8_BAR
#undef PG8_SCHED
}
}

namespace mk {
using pg8::bf16_t; using pg8::bf16x8; using pg8::f32x4; using pg8::u32x4; using pg8::cvt_pk_bf16; using pg8::fsigmoid;
#define LAS __attribute__((address_space(3)))
typedef unsigned u32x2 __attribute__((ext_vector_type(2)));
typedef float f32x2 __attribute__((ext_vector_type(2)));
typedef short bf16x4 __attribute__((ext_vector_type(4)));
constexpr int NWAVES = 8, NT = 512;
constexpr int D = 1024, BATCH = 8, SEQ = 4096, M = BATCH * SEQ, DCONV = 512, CW = 31, DH = 512, NH = 4, HD = 128, DIN = 3072, NQ = 2048, NEXP = 16384;
constexpr int SEGS = 8, SEGLEN = SEQ / SEGS, NCH = SEGLEN / 64;
constexpr float EPS = 1e-6f;
constexpr size_t MiB = 1u << 20;
constexpr size_t WS_WIN = 2 * MiB, WS_WOUT = 8 * MiB, WS_WEFF = 10 * MiB, WS_HS = 14 * MiB, WS_HLD = 30 * MiB, WS_USC = 31 * MiB, WS_VSC = 31 * MiB + 65536, WS_SSQ = 48 * MiB, WS_XRS = 56 * MiB, WS_U = 32 * MiB, WS_V = 64 * MiB, WS_XN = 96 * MiB,
                 WS_GLU = 160 * MiB, WS_HG = 192 * MiB, WS_Y = 320 * MiB, WS_EIDX = 416 * MiB, WS_GATE = 432 * MiB, WS_END = 448 * MiB;
constexpr int LDS_BYTES = 163840;
#ifndef PEER_V4_DEF
#define PEER_V4_DEF true
#endif
constexpr bool PEER_V4 = PEER_V4_DEF;
#ifndef U_NIBSWAP_DEF
#define U_NIBSWAP_DEF false
#endif
constexpr bool U_NIBSWAP = U_NIBSWAP_DEF;

#define LDS_WAIT() asm volatile("s_waitcnt lgkmcnt(0)" ::: "memory")
#define BLOCK_BAR() do { asm volatile("s_waitcnt lgkmcnt(0)" ::: "memory"); __builtin_amdgcn_s_barrier(); asm volatile("" ::: "memory"); } while (0)
__device__ __forceinline__ float wave_sum(float v) {
#pragma unroll
    for (int o = 1; o < 64; o <<= 1) v += __shfl_xor(v, o);
    return v;
}
__device__ __forceinline__ float wave_sum_dpp(float v) {
    v += __builtin_bit_cast(float, __builtin_amdgcn_update_dpp(0, __builtin_bit_cast(int, v), 0x111, 0xf, 0xf, false));
    v += __builtin_bit_cast(float, __builtin_amdgcn_update_dpp(0, __builtin_bit_cast(int, v), 0x112, 0xf, 0xf, false));
    v += __builtin_bit_cast(float, __builtin_amdgcn_update_dpp(0, __builtin_bit_cast(int, v), 0x114, 0xf, 0xf, false));
    v += __builtin_bit_cast(float, __builtin_amdgcn_update_dpp(0, __builtin_bit_cast(int, v), 0x118, 0xf, 0xf, false));
    v += __builtin_bit_cast(float, __builtin_amdgcn_update_dpp(0, __builtin_bit_cast(int, v), 0x142, 0xa, 0xf, false));
    v += __builtin_bit_cast(float, __builtin_amdgcn_update_dpp(0, __builtin_bit_cast(int, v), 0x143, 0xc, 0xf, false));
    return __builtin_bit_cast(float, __builtin_amdgcn_readlane(__builtin_bit_cast(int, v), 63));
}
__device__ __forceinline__ float wave_max_dpp(float v) {
    v = fmaxf(v, __builtin_bit_cast(float, __builtin_amdgcn_update_dpp(0, __builtin_bit_cast(int, v), 0x111, 0xf, 0xf, false)));
    v = fmaxf(v, __builtin_bit_cast(float, __builtin_amdgcn_update_dpp(0, __builtin_bit_cast(int, v), 0x112, 0xf, 0xf, false)));
    v = fmaxf(v, __builtin_bit_cast(float, __builtin_amdgcn_update_dpp(0, __builtin_bit_cast(int, v), 0x114, 0xf, 0xf, false)));
    v = fmaxf(v, __builtin_bit_cast(float, __builtin_amdgcn_update_dpp(0, __builtin_bit_cast(int, v), 0x118, 0xf, 0xf, false)));
    v = fmaxf(v, __builtin_bit_cast(float, __builtin_amdgcn_update_dpp(0, __builtin_bit_cast(int, v), 0x142, 0xa, 0xf, false)));
    v = fmaxf(v, __builtin_bit_cast(float, __builtin_amdgcn_update_dpp(0, __builtin_bit_cast(int, v), 0x143, 0xc, 0xf, false)));
    return __builtin_bit_cast(float, __builtin_amdgcn_readlane(__builtin_bit_cast(int, v), 63));
}
typedef _Float16 h16x2 __attribute__((ext_vector_type(2)));
__device__ __forceinline__ float bf_lo(unsigned u) { return __builtin_bit_cast(float, u << 16); }
__device__ __forceinline__ float bf_hi(unsigned u) { return __builtin_bit_cast(float, u & 0xffff0000u); }
__device__ __forceinline__ float bf1(bf16_t u) { return __builtin_bit_cast(float, (unsigned)u << 16); }
__device__ __forceinline__ float fsilu(float x) { return x * fsigmoid(x); }

struct Args { const float* in[16]; float* out; unsigned char* ws; int ph_lo, ph_hi, sub, pad; };

__device__ __forceinline__ void p0_transpose_item(const float* __restrict__ W, int K, int N, bf16_t* __restrict__ WT, int out_row0, const float* __restrict__ gk, LAS float* scr, int k0, int n0, int lane) {
#pragma unroll 8
    for (int i = 0; i < 32; ++i) { const int kk = 2 * i + (lane >> 5); const float s = gk ? gk[k0 + kk] : 1.f; scr[kk * 33 + (lane & 31)] = W[(size_t)(k0 + kk) * N + n0 + (lane & 31)] * s; }
    LDS_WAIT();
    const int c = lane & 7;
#pragma unroll
    for (int j = 0; j < 4; ++j) { const int n = (lane >> 3) + 8 * j; const LAS float* s = scr + (8 * c) * 33 + n;
        u32x4 o; o.x = cvt_pk_bf16(s[0 * 33], s[1 * 33]); o.y = cvt_pk_bf16(s[2 * 33], s[3 * 33]); o.z = cvt_pk_bf16(s[4 * 33], s[5 * 33]); o.w = cvt_pk_bf16(s[6 * 33], s[7 * 33]);
        *(u32x4*)(WT + (size_t)(out_row0 + n) * K + k0 + 8 * c) = o; }
    LDS_WAIT();
}
__device__ __forceinline__ void row_to_bf16(const float* __restrict__ src, bf16_t* __restrict__ dst, const float* __restrict__ gv, bool norm, int lane, float* __restrict__ xr1 = nullptr) {
    const f32x4* xr = (const f32x4*)src + lane;
    f32x4 v[4]; float s = 0.f;
#pragma unroll
    for (int j = 0; j < 4; ++j) { v[j] = xr[64 * j]; s += (v[j].x * v[j].x + v[j].y * v[j].y) + (v[j].z * v[j].z + v[j].w * v[j].w); }
    float r = 1.f;
    if (norm) r = rsqrtf(wave_sum(s) * (1.f / D) + EPS);
    if (xr1 && lane == 0) *xr1 = __builtin_amdgcn_rcpf(r);
    u32x2* o8 = (u32x2*)dst + lane;
#pragma unroll
    for (int j = 0; j < 4; ++j) {
        f32x4 t = v[j] * r;
        if (gv) t = t * ((const f32x4*)gv)[lane + 64 * j];
        u32x2 w; w.x = cvt_pk_bf16(t.x, t.y); w.y = cvt_pk_bf16(t.z, t.w); o8[64 * j] = w;
    }
}
__device__ __forceinline__ void row_to_fp8(const float* __restrict__ src, unsigned char* __restrict__ dst, const float* __restrict__ gv, float sc, int lane) {
    const f32x4* xr = (const f32x4*)src + lane;
    unsigned* o4 = (unsigned*)dst + lane;
#pragma unroll
    for (int j = 0; j < 4; ++j) {
        f32x4 t = xr[64 * j] * sc;
        if (gv) t = t * ((const f32x4*)gv)[lane + 64 * j];
        int w = __builtin_amdgcn_cvt_pk_fp8_f32(t.x, t.y, 0, false); w = __builtin_amdgcn_cvt_pk_fp8_f32(t.z, t.w, w, true);
        o4[64 * j] = (unsigned)w;
    }
}
template <int MODE>
__device__ __forceinline__ void rows_convert(const float* __restrict__ src, unsigned char* __restrict__ dst, const float* __restrict__ gv, float sc, int nrows, int gw, int NGW, int lane, float* __restrict__ xrs = nullptr) {
    if (nrows % (4 * NGW) != 0) {
        for (int r = gw; r < nrows; r += NGW) { if (MODE == 0) row_to_bf16(src + (size_t)r * D, (bf16_t*)dst + (size_t)r * D, nullptr, true, lane, xrs ? xrs + r : nullptr); else row_to_fp8(src + (size_t)r * D, dst + (size_t)r * D, MODE == 1 ? gv : nullptr, sc, lane); }
        return;
    }
    f32x4 gq[4];
    if (MODE == 1) {
#pragma unroll
        for (int j = 0; j < 4; ++j) gq[j] = ((const f32x4*)gv)[lane + 64 * j] * sc;
    }
    for (int r = gw; r < nrows; r += 4 * NGW) {
        f32x4 v[4][4];
#pragma unroll
        for (int k = 0; k < 4; ++k)
#pragma unroll
            for (int j = 0; j < 4; ++j) v[k][j] = ((const f32x4*)(src + (size_t)(r + k * NGW) * D))[lane + 64 * j];
#pragma unroll
        for (int k = 0; k < 4; ++k) {
            if (MODE == 0) {
                float s = 0.f;
#pragma unroll
                for (int j = 0; j < 4; ++j) s += (v[k][j].x * v[k][j].x + v[k][j].y * v[k][j].y) + (v[k][j].z * v[k][j].z + v[k][j].w * v[k][j].w);
                const float rr = rsqrtf(wave_sum(s) * (1.f / D) + EPS);
                if (xrs && lane == 0) xrs[r + k * NGW] = __builtin_amdgcn_rcpf(rr);
                u32x2* o8 = (u32x2*)((bf16_t*)dst + (size_t)(r + k * NGW) * D) + lane;
#pragma unroll
                for (int j = 0; j < 4; ++j) { const f32x4 t = v[k][j] * rr; u32x2 w; w.x = cvt_pk_bf16(t.x, t.y); w.y = cvt_pk_bf16(t.z, t.w); o8[64 * j] = w; }
            } else {
                unsigned* o4 = (unsigned*)(dst + (size_t)(r + k * NGW) * D) + lane;
#pragma unroll
                for (int j = 0; j < 4; ++j) { const f32x4 t = (MODE == 1) ? v[k][j] * gq[j] : v[k][j] * sc;
                    int w = __builtin_amdgcn_cvt_pk_fp8_f32(t.x, t.y, 0, false); w = __builtin_amdgcn_cvt_pk_fp8_f32(t.z, t.w, w, true); o4[64 * j] = (unsigned)w; }
            }
        }
    }
}
__device__ __forceinline__ void rows_convert_publish_head(const float* __restrict__ src, unsigned char* __restrict__ dst, float* __restrict__ xrs, unsigned* __restrict__ ready, int nrows, int gwb, int nw, int lane) {
    const __amdgpu_buffer_rsrc_t RX = __builtin_amdgcn_make_buffer_rsrc((void*)dst, 0, M * D * 2, 0x00020000);
    f32x4 v[3][4];
#pragma unroll
    for (int k = 0; k < 3; ++k) { const int r = gwb + k * nw, rl = r < nrows ? r : gwb;
#pragma unroll
        for (int j = 0; j < 4; ++j) v[k][j] = ((const f32x4*)(src + (size_t)rl * D))[lane + 64 * j]; }
#pragma unroll
    for (int k = 0; k < 3; ++k) {
        const int r = gwb + k * nw;
        if (r < nrows) {
            float sq = 0.f;
#pragma unroll
            for (int j = 0; j < 4; ++j) sq += (v[k][j].x * v[k][j].x + v[k][j].y * v[k][j].y) + (v[k][j].z * v[k][j].z + v[k][j].w * v[k][j].w);
            const float rr = rsqrtf(wave_sum(sq) * (1.f / D) + EPS);
            if (lane == 0) xrs[r] = __builtin_amdgcn_rcpf(rr);
#pragma unroll
            for (int j = 0; j < 4; ++j) { const f32x4 t = v[k][j] * rr; u32x2 w; w.x = cvt_pk_bf16(t.x, t.y); w.y = cvt_pk_bf16(t.z, t.w);
                __builtin_amdgcn_raw_buffer_store_b64(w, RX, 8 * lane + 512 * j, r * 2048,   16); }
        }
    }
    asm volatile("s_waitcnt vmcnt(0)" ::: "memory");
    if (lane == 0) {
#pragma unroll
        for (int k = 0; k < 3; ++k) { const int r = gwb + k * nw; if (r < nrows) (void)__hip_atomic_fetch_add(&ready[64 * (r >> 8)], 1u, __ATOMIC_RELAXED, __HIP_MEMORY_SCOPE_AGENT); }
    }
}
__device__ __forceinline__ void rows_convert_publish(const float* __restrict__ src, unsigned char* __restrict__ dst, float* __restrict__ xrs, unsigned* __restrict__ ready, int gwa, int lane, int s_first) {
    const __amdgpu_buffer_rsrc_t RX = __builtin_amdgcn_make_buffer_rsrc((void*)dst, 0, M * D * 2, 0x00020000);
    constexpr int NST = M / 2048;
    f32x4 va[4][4], vb[4][4];
#define RCP_LOAD(V, S) do { _Pragma("unroll") for (int k = 0; k < 4; ++k) _Pragma("unroll") for (int j = 0; j < 4; ++j) V[k][j] = ((const f32x4*)(src + (size_t)((S) * 2048 + k * 512 + gwa) * D))[lane + 64 * j]; } while (0)
#define RCP_STAGE(V, W, S) do { \
        _Pragma("unroll") for (int k = 0; k < 4; ++k) { \
            const int r = (S) * 2048 + k * 512 + gwa; \
            float sq = 0.f; \
            _Pragma("unroll") for (int j = 0; j < 4; ++j) sq += (V[k][j].x * V[k][j].x + V[k][j].y * V[k][j].y) + (V[k][j].z * V[k][j].z + V[k][j].w * V[k][j].w); \
            const float rr = rsqrtf(wave_sum(sq) * (1.f / D) + EPS); \
            if (lane == 0) xrs[r] = __builtin_amdgcn_rcpf(rr); \
            _Pragma("unroll") for (int j = 0; j < 4; ++j) { const f32x4 t = V[k][j] * rr; u32x2 w; w.x = cvt_pk_bf16(t.x, t.y); w.y = cvt_pk_bf16(t.z, t.w); \
                __builtin_amdgcn_raw_buffer_store_b64(w, RX, 8 * lane + 512 * j, r * 2048,   16); } \
        } \
        asm volatile("" ::: "memory"); \
        if ((S) + 1 < NST) { RCP_LOAD(W, (S) + 1); asm volatile("s_waitcnt vmcnt(16)" ::: "memory"); } else { asm volatile("s_waitcnt vmcnt(0)" ::: "memory"); } \
        if (lane == 0) { _Pragma("unroll") for (int k = 0; k < 4; ++k) (void)__hip_atomic_fetch_add(&ready[64 * (((S) * 2048 + k * 512 + gwa) >> 8)], 1u, __ATOMIC_RELAXED, __HIP_MEMORY_SCOPE_AGENT); } \
    } while (0)
    RCP_LOAD(va, s_first);
#pragma unroll 1
    for (int s2 = s_first; s2 < NST; s2 += 2) { RCP_STAGE(va, vb, s2); RCP_STAGE(vb, va, s2 + 1); }
#undef RCP_LOAD
#undef RCP_STAGE
}
template <bool FP4, bool NATURAL = false, bool NIBSWAP = false>
__device__ __forceinline__ void rows_quant(const float* __restrict__ src, unsigned char* __restrict__ dst, float* __restrict__ scales, const float* __restrict__ gv, int nrows, int gw, int NGW, int lane) {
    f32x4 gq[4];
#pragma unroll
    for (int j = 0; j < 4; ++j) gq[j] = gv ? ((const f32x4*)gv)[NATURAL ? 4 * lane + j : lane + 64 * j] : (f32x4){1.f, 1.f, 1.f, 1.f};
    for (int r0 = gw; r0 < nrows; r0 += 4 * NGW) {
        f32x4 v[4][4];
#pragma unroll
        for (int k = 0; k < 4; ++k) { const int r = (r0 + k * NGW < nrows) ? r0 + k * NGW : r0;
#pragma unroll
            for (int j = 0; j < 4; ++j) v[k][j] = ((const f32x4*)(src + (size_t)r * D))[NATURAL ? 4 * lane + j : lane + 64 * j] * gq[j]; }
#pragma unroll
        for (int k = 0; k < 4; ++k) {
            const int r = r0 + k * NGW; if (r >= nrows) break;
            float am = 0.f;
#pragma unroll
            for (int j = 0; j < 4; ++j) am = fmaxf(am, fmaxf(fmaxf(fabsf(v[k][j].x), fabsf(v[k][j].y)), fmaxf(fabsf(v[k][j].z), fabsf(v[k][j].w))));
            am = wave_max_dpp(am);
            const float fmx = FP4 ? 6.f : 240.f;
            const float sc = am > 0.f ? am * (1.f / fmx) : 1.f, inv = am > 0.f ? fmx / am : 1.f;
            if (lane == 0) scales[r] = sc;
            if constexpr (FP4) {
                unsigned w0 = 0u, w1 = 0u;
                { const f32x4 t0 = v[k][0] * inv, t1 = v[k][1] * inv, t2 = v[k][2] * inv, t3 = v[k][3] * inv;
#define Q4(wd, a_, b_, sel) wd = NIBSWAP ? __builtin_amdgcn_cvt_scalef32_pk_fp4_f32(wd, b_, a_, 1.0f, sel) : __builtin_amdgcn_cvt_scalef32_pk_fp4_f32(wd, a_, b_, 1.0f, sel)
                  Q4(w0, t0.x, t0.y, 0); Q4(w0, t0.z, t0.w, 1); Q4(w0, t1.x, t1.y, 2); Q4(w0, t1.z, t1.w, 3);
                  Q4(w1, t2.x, t2.y, 0); Q4(w1, t2.z, t2.w, 1); Q4(w1, t3.x, t3.y, 2); Q4(w1, t3.z, t3.w, 3);
#undef Q4
                }
                ((u32x2*)(dst + (size_t)r * 512))[NATURAL ? lane : 2 * (lane & 31) + (lane >> 5)] = (u32x2){w0, w1};
            } else {
                u32x4 w;
#pragma unroll
                for (int j = 0; j < 4; ++j) { const f32x4 t = v[k][j] * inv; int q = __builtin_amdgcn_cvt_pk_fp8_f32(t.x, t.y, 0, false); q = __builtin_amdgcn_cvt_pk_fp8_f32(t.z, t.w, q, true); w[j] = (unsigned)q; }
                ((u32x4*)(dst + (size_t)r * 1024))[lane] = w;
            }
        }
    }
}
__device__ __forceinline__ void weff_unit(LAS unsigned char* lds, const float* __restrict__ wq, const float* __restrict__ sk, const float* __restrict__ g2, bf16_t* __restrict__ WE, int unit, int tid) {
    LAS float* SK = (LAS float*)lds;
    LAS float* WQ = (LAS float*)(lds + 128 * 129 * 4);
    const int hp = unit >> 5, d0 = (unit & 31) * 32;
#pragma unroll 4
    for (int i = 0; i < 32; ++i) { const int idx = tid + i * NT; SK[(idx >> 7) * 129 + (idx & 127)] = sk[(size_t)hp * 16384 + idx]; }
#pragma unroll
    for (int i = 0; i < 8; ++i) { const int idx = tid + i * NT; WQ[idx] = wq[(size_t)(d0 + (idx >> 7)) * NQ + hp * 128 + (idx & 127)]; }
    __syncthreads();
    const int n = tid & 127, dq = tid >> 7;
    float acc[8];
#pragma unroll
    for (int e = 0; e < 8; ++e) acc[e] = 0.f;
    for (int j4 = 0; j4 < 32; ++j4) {
        float s[4];
#pragma unroll
        for (int q = 0; q < 4; ++q) s[q] = SK[n * 129 + 4 * j4 + q];
#pragma unroll
        for (int e = 0; e < 8; ++e) { const f32x4 w = *(const LAS f32x4*)(WQ + (dq * 8 + e) * 128 + 4 * j4); acc[e] = fmaf(s[0], w.x, acc[e]); acc[e] = fmaf(s[1], w.y, acc[e]); acc[e] = fmaf(s[2], w.z, acc[e]); acc[e] = fmaf(s[3], w.w, acc[e]); }
    }
    const float* gp = g2 + d0 + dq * 8;
    u32x4 o; o.x = cvt_pk_bf16(acc[0] * gp[0], acc[1] * gp[1]); o.y = cvt_pk_bf16(acc[2] * gp[2], acc[3] * gp[3]); o.z = cvt_pk_bf16(acc[4] * gp[4], acc[5] * gp[5]); o.w = cvt_pk_bf16(acc[6] * gp[6], acc[7] * gp[7]);
    *(u32x4*)(WE + (size_t)(hp * 128 + n) * D + d0 + dq * 8) = o;
    __syncthreads();
}
__device__ __forceinline__ void weff_tile_mfma(const float* __restrict__ wq, const float* __restrict__ sk, const float* __restrict__ g2, bf16_t* __restrict__ WE, int tile, int lane) {
    const int hp = tile >> 9, rem = tile & 511, d0 = (rem >> 3) * 16, n0 = (rem & 7) * 16;
    const int li = lane & 15, kq = lane >> 4;
    const f32x4* ap = (const f32x4*)(wq + (size_t)(d0 + li) * NQ + hp * 128 + 32 * kq);
    const f32x4* bp = (const f32x4*)(sk + ((size_t)hp * 128 + n0 + li) * 128 + 32 * kq);
    f32x4 acc = (f32x4){0.f, 0.f, 0.f, 0.f};
#pragma unroll
    for (int hf = 0; hf < 2; ++hf) {
        f32x4 av[4], bv[4];
#pragma unroll
        for (int q = 0; q < 4; ++q) { av[q] = ap[4 * hf + q]; bv[q] = bp[4 * hf + q]; }
#pragma unroll
        for (int q = 0; q < 4; ++q)
#pragma unroll
            for (int e = 0; e < 4; ++e) acc = __builtin_amdgcn_mfma_f32_16x16x4f32(av[q][e], bv[q][e], acc, 0, 0, 0);
    }
    const f32x4 gg = *(const f32x4*)(g2 + d0 + 4 * kq);
    u32x2 o; o.x = cvt_pk_bf16(acc[0] * gg[0], acc[1] * gg[1]); o.y = cvt_pk_bf16(acc[2] * gg[2], acc[3] * gg[3]);
    *(u32x2*)(WE + (size_t)(hp * 128 + n0 + li) * D + d0 + 4 * kq) = o;
}
__device__ __forceinline__ void p0_prologue(const Args& a, LAS unsigned char* lds, int lane, int wave, int what, int gw, int NGW) {
    unsigned char* ws = a.ws;
    LAS float* scr = (LAS float*)(lds + wave * 16384);
    constexpr int I_IN = (D / 64) * (DIN / 32), I_OUT = (D / 64) * (D / 32);
    if (what & 1) for (int it = gw; it < I_IN; it += NGW) {
        const int kb = it / (DIN / 32), nb = it % (DIN / 32), n0 = nb * 32;
        int r0;
        if (n0 < 512) r0 = 256 * (n0 >> 7) + (n0 & 127); else if (n0 < 1024) r0 = 256 * ((n0 - 512) >> 7) + 128 + ((n0 - 512) & 127); else r0 = n0;
        p0_transpose_item(a.in[2], D, DIN, (bf16_t*)(ws + WS_WIN), r0, a.in[1], scr, kb * 64, n0, lane);
    }
    if (what & 8) for (int r = gw; r < I_OUT; r += NGW) { const int kb = r / (D / 32), nb = r % (D / 32); p0_transpose_item(a.in[9], D, D, (bf16_t*)(ws + WS_WOUT), nb * 32, nullptr, scr, kb * 64, nb * 32, lane); }
    if (what & 4) rows_convert<0>(a.in[0], ws + WS_XN, nullptr, 1.f, M, gw, NGW, lane, (float*)(ws + WS_XRS));
}

__device__ __forceinline__ void conv_wave_unit(const bf16_t* __restrict__ GLU, const float* __restrict__ cw, const float* __restrict__ cb, const float* __restrict__ ng, const float* __restrict__ nb,
                                               bf16_t* __restrict__ Y, int wu, int lane) {
    const int grp = wu & 7, tb = wu >> 3, b = tb >> 5, s0 = (tb & 31) * 128, c = grp * 64 + lane;
    h16x2 W2[16], EV[20], OD[19];
#pragma unroll
    for (int q = 0; q < 16; ++q) { W2[q][0] = (_Float16)cw[(2 * q) * DCONV + c]; W2[q][1] = (2 * q + 1 < CW) ? (_Float16)cw[(2 * q + 1) * DCONV + c] : (_Float16)0.f; }
    const float bias = cb[c], gam = ng[c], bet = nb[c];
    const size_t rowb = (size_t)b * SEQ;
    const bf16_t* GLUp = GLU + (size_t)grp * M * 64 + lane;
#pragma unroll
    for (int i = 0; i < 30; ++i) { const int s = s0 - 30 + i; const bf16_t hv = GLUp[(rowb + (s >= 0 ? s : 0)) * 64]; EV[i >> 1][i & 1] = (_Float16)(bf1(hv) * ((s >= 0) ? 1.f : 0.f)); }
    EV[19] = (h16x2){(_Float16)0.f, (_Float16)0.f};
#pragma unroll
    for (int k = 0; k < 14; ++k) OD[k] = (h16x2){EV[k][1], EV[k + 1][0]};
    bf16_t nx[8];
#pragma unroll
    for (int i = 0; i < 8; ++i) nx[i] = GLUp[(rowb + s0 + i) * 64];
#pragma unroll 1
    for (int it = 0; it < 16; ++it) {
        const int s = s0 + it * 8;
#pragma unroll
        for (int i = 0; i < 8; ++i) EV[15 + (i >> 1)][i & 1] = (_Float16)bf1(nx[i]);
#pragma unroll
        for (int k = 14; k < 19; ++k) OD[k] = (h16x2){EV[k][1], EV[k + 1][0]};
        const int sn = (it < 15) ? s + 8 : s;
#pragma unroll
        for (int i = 0; i < 8; ++i) nx[i] = GLUp[(rowb + sn + i) * 64];
        float acc[8];
#pragma unroll
        for (int i = 0; i < 8; ++i) {
            float t = bias;
#pragma unroll
            for (int q = 0; q < 16; ++q) t = __builtin_amdgcn_fdot2(W2[q], (i & 1) ? OD[(i >> 1) + q] : EV[(i >> 1) + q], t, false);
            acc[i] = t;
        }
#pragma unroll
        for (int i = 0; i < 8; ++i) {
            const float mu = wave_sum_dpp(acc[i]) * (1.f / 64.f), m2 = wave_sum_dpp(acc[i] * acc[i]) * (1.f / 64.f);
            const float var = fmaxf(m2 - mu * mu, 0.f);
            const float hn = (acc[i] - mu) * rsqrtf(var + EPS) * gam + bet;
            Y[(rowb + s + i) * D + c] = (bf16_t)(cvt_pk_bf16(fsilu(hn), 0.f) & 0xffffu);
        }
#pragma unroll
        for (int k = 0; k < 15; ++k) EV[k] = EV[k + 4];
#pragma unroll
        for (int k = 0; k < 14; ++k) OD[k] = OD[k + 4];
    }
}

template <bool KEYS>
__device__ __forceinline__ void qrow_issue(f32x4 (&qv)[4], const float* __restrict__ src, int r, int lane) {
#pragma unroll
    for (int j = 0; j < 4; ++j) qv[j] = ((const f32x4*)(src + (size_t)r * D))[KEYS ? 4 * lane + j : lane + 64 * j];
}
template <bool KEYS>
__device__ __forceinline__ void qrow_finish(f32x4 (&qv)[4], unsigned char* __restrict__ dst, float* __restrict__ scales, const float* __restrict__ gv, int r, int lane) {
    if (KEYS) {
#pragma unroll
        for (int j = 0; j < 4; ++j) qv[j] = qv[j] * ((const f32x4*)gv)[4 * lane + j];
    }
    float am = 0.f;
#pragma unroll
    for (int j = 0; j < 4; ++j) am = fmaxf(am, fmaxf(fmaxf(fabsf(qv[j].x), fabsf(qv[j].y)), fmaxf(fabsf(qv[j].z), fabsf(qv[j].w))));
    am = wave_max_dpp(am);
    const float sc = am > 0.f ? am * (1.f / 6.f) : 1.f, inv = am > 0.f ? 6.f / am : 1.f;
    if (lane == 0) scales[r] = sc;
    unsigned w0 = 0u, w1 = 0u;
    { const f32x4 t0 = qv[0] * inv, t1 = qv[1] * inv, t2 = qv[2] * inv, t3 = qv[3] * inv;
      w0 = __builtin_amdgcn_cvt_scalef32_pk_fp4_f32(w0, t0.x, t0.y, 1.0f, 0); w0 = __builtin_amdgcn_cvt_scalef32_pk_fp4_f32(w0, t0.z, t0.w, 1.0f, 1);
      w0 = __builtin_amdgcn_cvt_scalef32_pk_fp4_f32(w0, t1.x, t1.y, 1.0f, 2); w0 = __builtin_amdgcn_cvt_scalef32_pk_fp4_f32(w0, t1.z, t1.w, 1.0f, 3);
      w1 = __builtin_amdgcn_cvt_scalef32_pk_fp4_f32(w1, t2.x, t2.y, 1.0f, 0); w1 = __builtin_amdgcn_cvt_scalef32_pk_fp4_f32(w1, t2.z, t2.w, 1.0f, 1);
      w1 = __builtin_amdgcn_cvt_scalef32_pk_fp4_f32(w1, t3.x, t3.y, 1.0f, 2); w1 = __builtin_amdgcn_cvt_scalef32_pk_fp4_f32(w1, t3.z, t3.w, 1.0f, 3); }
    ((u32x2*)(dst + (size_t)r * 512))[KEYS ? lane : 2 * (lane & 31) + (lane >> 5)] = (u32x2){w0, w1};
}
struct QuantHook {
    const float* usrc; const float* vsrc; unsigned char* udst; unsigned char* vdst; float* usc; float* vsc; const float* g2; int L;
    __device__ __forceinline__ void issue(f32x4 (&qa)[4], f32x4 (&qb)[4], int ai, int wid, int lane) const {
        const int r0 = ((L * 2 + ai) * 2) * NWAVES + wid, r1 = r0 + NWAVES;
        if (r0 < NEXP) { qrow_issue<true>(qa, usrc, r0, lane); qrow_issue<true>(qb, usrc, r1, lane); } else { qrow_issue<false>(qa, vsrc, r0 - NEXP, lane); qrow_issue<false>(qb, vsrc, r1 - NEXP, lane); }
    }
    __device__ __forceinline__ void finish(f32x4 (&qa)[4], f32x4 (&qb)[4], int ai, int wid, int lane) const {
        const int r0 = ((L * 2 + ai) * 2) * NWAVES + wid, r1 = r0 + NWAVES;
        if (r0 < NEXP) { qrow_finish<true>(qa, udst, usc, g2, r0, lane); qrow_finish<true>(qb, udst, usc, g2, r1, lane); } else { qrow_finish<false>(qa, vdst, vsc, nullptr, r0 - NEXP, lane); qrow_finish<false>(qb, vdst, vsc, nullptr, r1 - NEXP, lane); }
    }
};
constexpr int HQ_OFF = 0, HK_OFF = 17408, HKH_OFF = 34816, HV_OFF = 53248, HP_OFF = 71680, HDC_OFF = 80896, HTOT_OFF = 81408, HO_OFF = 85504;
template <bool P3, int DG = 0>
__device__ __forceinline__ void hgrn_unit(LAS unsigned char* lds, int unit, const bf16_t* __restrict__ HG, const float* __restrict__ lbl, const float* __restrict__ hng, float* __restrict__ HS, float* __restrict__ HLD,
                                          bf16_t* __restrict__ Y, int tid, int lane, int w, const float* __restrict__ qsrc, unsigned char* __restrict__ qdst, float* __restrict__ qscales, const float* __restrict__ qgain,
                                          const float* __restrict__ wqry, const float* __restrict__ skeys, const float* __restrict__ g2v, bf16_t* __restrict__ WE) {
    const int seg = unit & (SEGS - 1), bh = unit >> 3, h = bh & 3, b = bh >> 2;
    const int g = lane >> 4, fr = lane & 15, kp = lane;
    const int c0 = h * HD + 2 * kp;
    const float lb0 = __builtin_amdgcn_rcpf(1.f + __expf(lbl[DH + c0] - lbl[c0])), lb1 = __builtin_amdgcn_rcpf(1.f + __expf(lbl[DH + c0 + 1] - lbl[c0 + 1]));
    f32x4 S[8];
#pragma unroll
    for (int i = 0; i < 8; ++i) S[i] = (f32x4){0.f, 0.f, 0.f, 0.f};
    if (P3 && !(DG & 1)) {
        for (int i = 0; i < seg; ++i) {
            const float* sp = HS + (size_t)(bh * SEGS + i) * 16384 + w * 2048 + lane;
            const float* ld = HLD + (size_t)(bh * SEGS + i) * 128 + 4 * g;
#pragma unroll
            for (int t = 0; t < 8; ++t) {
                f32x4 dd;
#pragma unroll
                for (int r = 0; r < 4; ++r) dd[r] = __hip_atomic_load((float*)ld + 16 * t + r, __ATOMIC_RELAXED, __HIP_MEMORY_SCOPE_AGENT);
#pragma unroll
                for (int r = 0; r < 4; ++r) S[t][r] = fmaf(dd[r], S[t][r], __hip_atomic_load((float*)sp + (t * 4 + r) * 64, __ATOMIC_RELAXED, __HIP_MEMORY_SCOPE_AGENT)); }
        }
    }
    float ldsum0 = 1.f, ldsum1 = 1.f;
    const size_t row_base = (size_t)b * SEQ + (size_t)seg * SEGLEN;
    const unsigned* HGw = (const unsigned*)HG;
    constexpr size_t PLANE_DW = (size_t)M * 64;
    unsigned zq[8], qq[8], vq[8];
#define HG_LOAD(c) do { if (DG & 2) { _Pragma("unroll") for (int i = 0; i < 8; ++i) { zq[i] = 0x3c003c00u + (unsigned)((c) + i + w); vq[i] = 0x3e003d00u + (unsigned)i; qq[i] = 0x3d003e00u + (unsigned)(c); } break; } _Pragma("unroll") for (int i = 0; i < 8; ++i) { const size_t ro = (row_base + (c) * 64 + 8 * w + i) * 64 + kp; \
        zq[i] = HGw[(size_t)(4 + h) * PLANE_DW + ro]; vq[i] = HGw[(size_t)(8 + h) * PLANE_DW + ro]; if (P3) qq[i] = HGw[(size_t)h * PLANE_DW + ro]; } } while (0)
    HG_LOAD(0);
    float gn[16];
    const int nt_t = tid >> 3, nt_v = (tid & 7) * 16;
    if (P3) {
#pragma unroll
        for (int e = 0; e < 16; ++e) gn[e] = hng[h * HD + nt_v + e];
    }
#pragma unroll 1
    for (int c = 0; c < NCH; ++c) {
        float cs0[8], cs1[8], kk0[8], kk1[8];
        float cum0 = 1.f, cum1 = 1.f;
        if (DG & 16) {
#pragma unroll
            for (int i = 0; i < 8; ++i) { cs0[i] = cs1[i] = 1.f - 0.01f * i; kk0[i] = kk1[i] = 0.5f; }
        } else
#pragma unroll
        for (int i = 0; i < 8; ++i) {
            const float sg0 = fsigmoid(bf_lo(zq[i])), sg1 = fsigmoid(bf_hi(zq[i]));
            cum0 *= lb0 + (1.f - lb0) * sg0; cum1 *= lb1 + (1.f - lb1) * sg1;
            cs0[i] = cum0; cs1[i] = cum1; kk0[i] = (1.f - lb0) * (1.f - sg0); kk1[i] = (1.f - lb1) * (1.f - sg1);
        }
        LAS float* tot = (LAS float*)(lds + HTOT_OFF);
        *(LAS f32x2*)(tot + w * 128 + 2 * kp) = (f32x2){cum0, cum1};
        BLOCK_BAR();
        float off0 = 1.f, off1 = 1.f, all0 = 1.f, all1 = 1.f;
#pragma unroll
        for (int ww = 0; ww < 8; ++ww) { const f32x2 tt = *(const LAS f32x2*)(tot + ww * 128 + 2 * kp); if (ww < w) { off0 *= tt.x; off1 *= tt.y; } all0 *= tt.x; all1 *= tt.y; }
        ldsum0 *= all0; ldsum1 *= all1;
        unsigned kh0[4], kh1[4], vt0[4], vt1[4];
        if (DG & 16) {
#pragma unroll
            for (int i = 0; i < 4; ++i) { kh0[i] = kh1[i] = 0x3c003c00u; vt0[i] = vq[2 * i]; vt1[i] = vq[2 * i + 1]; }
        } else
#pragma unroll
        for (int i = 0; i < 8; i += 2) {
            float a0[2], a1[2];
#pragma unroll
            for (int e = 0; e < 2; ++e) {
                const float E0 = off0 * cs0[i + e], E1 = off1 * cs1[i + e];
                const float k0 = kk0[i + e] * __builtin_amdgcn_rcpf(E0), k1 = kk1[i + e] * __builtin_amdgcn_rcpf(E1);
                if (P3) {
                    *(LAS unsigned*)(lds + HQ_OFF + (8 * w + i + e) * 272 + 4 * kp) = cvt_pk_bf16(bf_lo(qq[i + e]) * E0, bf_hi(qq[i + e]) * E1);
                    *(LAS unsigned*)(lds + HK_OFF + (8 * w + i + e) * 272 + 4 * kp) = cvt_pk_bf16(k0, k1);
                }
                a0[e] = k0 * all0; a1[e] = k1 * all1;
            }
            kh0[i >> 1] = cvt_pk_bf16(a0[0], a0[1]); kh1[i >> 1] = cvt_pk_bf16(a1[0], a1[1]);
            vt0[i >> 1] = (vq[i] & 0xffffu) | (vq[i + 1] << 16); vt1[i >> 1] = (vq[i] >> 16) | (vq[i + 1] & 0xffff0000u);
        }
        *(LAS u32x4*)(lds + HKH_OFF + (2 * kp) * 144 + 16 * w) = (u32x4){kh0[0], kh0[1], kh0[2], kh0[3]};
        *(LAS u32x4*)(lds + HKH_OFF + (2 * kp + 1) * 144 + 16 * w) = (u32x4){kh1[0], kh1[1], kh1[2], kh1[3]};
        *(LAS u32x4*)(lds + HV_OFF + (2 * kp) * 144 + 16 * w) = (u32x4){vt0[0], vt0[1], vt0[2], vt0[3]};
        *(LAS u32x4*)(lds + HV_OFF + (2 * kp + 1) * 144 + 16 * w) = (u32x4){vt1[0], vt1[1], vt1[2], vt1[3]};
        if (w == 0) *(LAS f32x2*)(lds + HDC_OFF + 8 * kp) = (f32x2){all0, all1};
        BLOCK_BAR();
        if (c + 1 < NCH) HG_LOAD(c + 1);
        f32x4 qv[4]; const int qr = (unit * NCH + c) * NWAVES + w;
        (void)qr; (void)qv;
        bf16x8 vfrag[2];
#pragma unroll
        for (int ks = 0; ks < 2; ++ks) vfrag[ks] = *(const LAS bf16x8*)(lds + HV_OFF + (16 * w + fr) * 144 + 64 * ks + 16 * g);
        if (P3) {
            u32x4 gq[2];
            if (DG & 2) { gq[0] = (u32x4){0x3c003c00u, 0x3c003c00u, 0x3c003c00u, 0x3c003c00u}; gq[1] = gq[0]; } else
            { const u32x4* gp = (const u32x4*)(HG + (size_t)(12 + h) * M * 128 + (row_base + c * 64 + nt_t) * 128 + nt_v); gq[0] = gp[0]; gq[1] = gp[1]; }
            {
                const int mt = w >> 1;
#pragma unroll
                for (int nti = 0; nti < 2; ++nti) {
                    const int nt = 2 * (w & 1) + nti;
                    f32x4 p = (f32x4){0.f, 0.f, 0.f, 0.f};
                    if (nt <= mt && !(DG & 4)) {
#pragma unroll
                        for (int ks = 0; ks < 4; ++ks) {
                            const bf16x8 af = *(const LAS bf16x8*)(lds + HQ_OFF + (16 * mt + fr) * 272 + 64 * ks + 16 * g);
                            const bf16x8 bf = *(const LAS bf16x8*)(lds + HK_OFF + (16 * nt + fr) * 272 + 64 * ks + 16 * g);
                            p = __builtin_amdgcn_mfma_f32_16x16x32_bf16(af, bf, p, 0, 0, 0);
                        }
                    }
#pragma unroll
                    for (int r = 0; r < 4; ++r) {
                        const int t = 16 * mt + 4 * g + r, s = 16 * nt + fr;
                        const float pv = (s <= t) ? p[r] : 0.f;
                        *(LAS bf16_t*)(lds + HP_OFF + t * 144 + 2 * s) = (bf16_t)(cvt_pk_bf16(pv, 0.f) & 0xffffu);
                    }
                }
            }
            BLOCK_BAR();
            f32x4 o[4];
#pragma unroll
            for (int mt = 0; mt < 4; ++mt) o[mt] = (f32x4){0.f, 0.f, 0.f, 0.f};
            if (!(DG & 4))
#pragma unroll
            for (int ks = 0; ks < 4; ++ks) {
                u32x4 sb; sb.x = cvt_pk_bf16(S[2 * ks][0], S[2 * ks][1]); sb.y = cvt_pk_bf16(S[2 * ks][2], S[2 * ks][3]); sb.z = cvt_pk_bf16(S[2 * ks + 1][0], S[2 * ks + 1][1]); sb.w = cvt_pk_bf16(S[2 * ks + 1][2], S[2 * ks + 1][3]);
                const bf16x8 bfrag = __builtin_bit_cast(bf16x8, sb);
#pragma unroll
                for (int mt = 0; mt < 4; ++mt) {
                    const u32x2 alo = *(const LAS u32x2*)(lds + HQ_OFF + (16 * mt + fr) * 272 + 64 * ks + 8 * g);
                    const u32x2 ahi = *(const LAS u32x2*)(lds + HQ_OFF + (16 * mt + fr) * 272 + 64 * ks + 32 + 8 * g);
                    const bf16x8 af = __builtin_bit_cast(bf16x8, (u32x4){alo.x, alo.y, ahi.x, ahi.y});
                    o[mt] = __builtin_amdgcn_mfma_f32_16x16x32_bf16(af, bfrag, o[mt], 0, 0, 0);
                }
            }
            if (!(DG & 4))
#pragma unroll
            for (int ks = 0; ks < 2; ++ks)
#pragma unroll
                for (int mt = 0; mt < 4; ++mt) {
                    const bf16x8 af = *(const LAS bf16x8*)(lds + HP_OFF + (16 * mt + fr) * 144 + 64 * ks + 16 * g);
                    o[mt] = __builtin_amdgcn_mfma_f32_16x16x32_bf16(af, vfrag[ks], o[mt], 0, 0, 0);
                }
#pragma unroll
            for (int mt = 0; mt < 4; ++mt)
#pragma unroll
                for (int r = 0; r < 4; ++r) *(LAS float*)(lds + HO_OFF + ((16 * mt + 4 * g + r) * 132 + 16 * w + fr) * 4) = o[mt][r];
            if (!(DG & 4))
#pragma unroll
            for (int i = 0; i < 8; ++i) {
                const f32x4 dd = *(const LAS f32x4*)(lds + HDC_OFF + (16 * i + 4 * g) * 4);
                S[i] = S[i] * dd;
#pragma unroll
                for (int ks = 0; ks < 2; ++ks) { const bf16x8 af = *(const LAS bf16x8*)(lds + HKH_OFF + (16 * i + fr) * 144 + 64 * ks + 16 * g); S[i] = __builtin_amdgcn_mfma_f32_16x16x32_bf16(af, vfrag[ks], S[i], 0, 0, 0); }
            }
            BLOCK_BAR();
            if (!(DG & 8)) {
                f32x4 ov[4]; float ss = 0.f;
#pragma unroll
                for (int q = 0; q < 4; ++q) { ov[q] = *(const LAS f32x4*)(lds + HO_OFF + (nt_t * 132 + nt_v + 4 * q) * 4); ss += (ov[q].x * ov[q].x + ov[q].y * ov[q].y) + (ov[q].z * ov[q].z + ov[q].w * ov[q].w); }
                ss += __shfl_xor(ss, 1); ss += __shfl_xor(ss, 2); ss += __shfl_xor(ss, 4);
                const float rs = rsqrtf(ss * (1.f / HD) + EPS);
                u32x4 ow[2];
#pragma unroll
                for (int q = 0; q < 4; ++q) {
                    const unsigned g01 = (q & 1) ? gq[q >> 1].z : gq[q >> 1].x, g23 = (q & 1) ? gq[q >> 1].w : gq[q >> 1].y;
                    const float y0 = ov[q].x * rs * gn[4 * q] * bf_lo(g01), y1 = ov[q].y * rs * gn[4 * q + 1] * bf_hi(g01), y2 = ov[q].z * rs * gn[4 * q + 2] * bf_lo(g23), y3 = ov[q].w * rs * gn[4 * q + 3] * bf_hi(g23);
                    if (q & 1) { ow[q >> 1].z = cvt_pk_bf16(y0, y1); ow[q >> 1].w = cvt_pk_bf16(y2, y3); } else { ow[q >> 1].x = cvt_pk_bf16(y0, y1); ow[q >> 1].y = cvt_pk_bf16(y2, y3); }
                }
                u32x4* yp = (u32x4*)(Y + (row_base + c * 64 + nt_t) * D + DCONV + h * HD + nt_v); yp[0] = ow[0]; yp[1] = ow[1];
            }
        } else {
            if (!(DG & 4))
#pragma unroll
            for (int i = 0; i < 8; ++i) {
                const f32x4 dd = *(const LAS f32x4*)(lds + HDC_OFF + (16 * i + 4 * g) * 4);
                S[i] = S[i] * dd;
#pragma unroll
                for (int ks = 0; ks < 2; ++ks) { const bf16x8 af = *(const LAS bf16x8*)(lds + HKH_OFF + (16 * i + fr) * 144 + 64 * ks + 16 * g); S[i] = __builtin_amdgcn_mfma_f32_16x16x32_bf16(af, vfrag[ks], S[i], 0, 0, 0); }
            }
        }
        if (P3 && !(qr & 1)) weff_tile_mfma(wqry, skeys, g2v, WE, qr >> 1, lane);
    }
#undef HG_LOAD
    if (!P3 && !(DG & 8)) {
        float* sp = HS + (size_t)unit * 16384 + w * 2048 + lane;
#pragma unroll
        for (int t = 0; t < 8; ++t)
#pragma unroll
            for (int r = 0; r < 4; ++r) __hip_atomic_store(&sp[(t * 4 + r) * 64], S[t][r], __ATOMIC_RELAXED, __HIP_MEMORY_SCOPE_AGENT);
        if (w == 0) { __hip_atomic_store(HLD + (size_t)unit * 128 + 2 * kp, ldsum0, __ATOMIC_RELAXED, __HIP_MEMORY_SCOPE_AGENT); __hip_atomic_store(HLD + (size_t)unit * 128 + 2 * kp + 1, ldsum1, __ATOMIC_RELAXED, __HIP_MEMORY_SCOPE_AGENT); }
    }
    BLOCK_BAR();
}

constexpr int P1_KH = 0, P1_V = 34816, P1_DC = 69632, P1_TOT = 70144;
__device__ __forceinline__ void hgrn_pass1_unit(LAS unsigned char* lds, int unit, const bf16_t* __restrict__ HG, const float* __restrict__ lbl, float* __restrict__ HS, float* __restrict__ HLD, int lane, int w,
                                                const float* __restrict__ qsrc, unsigned char* __restrict__ qdst, float* __restrict__ qscales, const float* __restrict__ qgain) {
    const int seg = unit & (SEGS - 1), bh = unit >> 3, h = bh & 3, b = bh >> 2;
    const int g = lane >> 4, fr = lane & 15, kp = lane;
    const int c0 = h * HD + 2 * kp;
    const float lb0 = __builtin_amdgcn_rcpf(1.f + __expf(lbl[DH + c0] - lbl[c0])), lb1 = __builtin_amdgcn_rcpf(1.f + __expf(lbl[DH + c0 + 1] - lbl[c0 + 1]));
    f32x4 S[8];
#pragma unroll
    for (int i = 0; i < 8; ++i) S[i] = (f32x4){0.f, 0.f, 0.f, 0.f};
    float ldsum0 = 1.f, ldsum1 = 1.f;
    const size_t row_base = (size_t)b * SEQ + (size_t)seg * SEGLEN;
    const unsigned* HGw = (const unsigned*)HG;
    constexpr size_t PLANE_DW = (size_t)M * 64;
    unsigned zq[16], vq[16];
#define P1_LOAD(c) do { _Pragma("unroll") for (int i = 0; i < 16; ++i) { const size_t ro = (row_base + (c) * 128 + 16 * w + i) * 64 + kp; zq[i] = HGw[(size_t)(4 + h) * PLANE_DW + ro]; vq[i] = HGw[(size_t)(8 + h) * PLANE_DW + ro]; } } while (0)
    P1_LOAD(0);
#pragma unroll 1
    for (int c = 0; c < SEGLEN / 128; ++c) {
        float a0[16], a1[16], suf0 = 1.f, suf1 = 1.f;
#pragma unroll
        for (int i = 15; i >= 0; --i) {
            const float sg0 = fsigmoid(bf_lo(zq[i])), sg1 = fsigmoid(bf_hi(zq[i]));
            a0[i] = (1.f - lb0) * (1.f - sg0) * suf0; a1[i] = (1.f - lb1) * (1.f - sg1) * suf1;
            suf0 *= lb0 + (1.f - lb0) * sg0; suf1 *= lb1 + (1.f - lb1) * sg1;
        }
        LAS float* tot = (LAS float*)(lds + P1_TOT);
        *(LAS f32x2*)(tot + w * 128 + 2 * kp) = (f32x2){suf0, suf1};
        BLOCK_BAR();
        float aft0 = 1.f, aft1 = 1.f, all0 = 1.f, all1 = 1.f;
#pragma unroll
        for (int ww = 0; ww < 8; ++ww) { const f32x2 tt = *(const LAS f32x2*)(tot + ww * 128 + 2 * kp); if (ww > w) { aft0 *= tt.x; aft1 *= tt.y; } all0 *= tt.x; all1 *= tt.y; }
        ldsum0 *= all0; ldsum1 *= all1;
        unsigned kh0[8], kh1[8], vt0[8], vt1[8];
#pragma unroll
        for (int i = 0; i < 16; i += 2) {
            kh0[i >> 1] = cvt_pk_bf16(a0[i] * aft0, a0[i + 1] * aft0); kh1[i >> 1] = cvt_pk_bf16(a1[i] * aft1, a1[i + 1] * aft1);
            vt0[i >> 1] = (vq[i] & 0xffffu) | (vq[i + 1] << 16); vt1[i >> 1] = (vq[i] >> 16) | (vq[i + 1] & 0xffff0000u);
        }
#pragma unroll
        for (int q = 0; q < 2; ++q) {
            *(LAS u32x4*)(lds + P1_KH + (2 * kp) * 272 + 32 * w + 16 * q) = (u32x4){kh0[4 * q], kh0[4 * q + 1], kh0[4 * q + 2], kh0[4 * q + 3]};
            *(LAS u32x4*)(lds + P1_KH + (2 * kp + 1) * 272 + 32 * w + 16 * q) = (u32x4){kh1[4 * q], kh1[4 * q + 1], kh1[4 * q + 2], kh1[4 * q + 3]};
            *(LAS u32x4*)(lds + P1_V + (2 * kp) * 272 + 32 * w + 16 * q) = (u32x4){vt0[4 * q], vt0[4 * q + 1], vt0[4 * q + 2], vt0[4 * q + 3]};
            *(LAS u32x4*)(lds + P1_V + (2 * kp + 1) * 272 + 32 * w + 16 * q) = (u32x4){vt1[4 * q], vt1[4 * q + 1], vt1[4 * q + 2], vt1[4 * q + 3]};
        }
        if (w == 0) *(LAS f32x2*)(lds + P1_DC + 8 * kp) = (f32x2){all0, all1};
        BLOCK_BAR();
        if (c + 1 < SEGLEN / 128) P1_LOAD(c + 1);
        f32x4 qva[4], qvb[4]; const int qr0 = (unit * NCH + 2 * c) * NWAVES + w, qr1 = qr0 + NWAVES;
        (void)qr0; (void)qr1; (void)qva; (void)qvb;
        bf16x8 vfrag[4];
#pragma unroll
        for (int ks = 0; ks < 4; ++ks) vfrag[ks] = *(const LAS bf16x8*)(lds + P1_V + (16 * w + fr) * 272 + 64 * ks + 16 * g);
#pragma unroll
        for (int i = 0; i < 8; ++i) {
            const f32x4 dd = *(const LAS f32x4*)(lds + P1_DC + (16 * i + 4 * g) * 4);
            S[i] = S[i] * dd;
#pragma unroll
            for (int ks = 0; ks < 4; ++ks) { const bf16x8 af = *(const LAS bf16x8*)(lds + P1_KH + (16 * i + fr) * 272 + 64 * ks + 16 * g); S[i] = __builtin_amdgcn_mfma_f32_16x16x32_bf16(af, vfrag[ks], S[i], 0, 0, 0); }
        }
    }
#undef P1_LOAD
    {
        float* sp = HS + (size_t)unit * 16384 + w * 2048 + lane;
#pragma unroll
        for (int t = 0; t < 8; ++t)
#pragma unroll
            for (int r = 0; r < 4; ++r) __hip_atomic_store(&sp[(t * 4 + r) * 64], S[t][r], __ATOMIC_RELAXED, __HIP_MEMORY_SCOPE_AGENT);
        if (w == 0) { __hip_atomic_store(HLD + (size_t)unit * 128 + 2 * kp, ldsum0, __ATOMIC_RELAXED, __HIP_MEMORY_SCOPE_AGENT); __hip_atomic_store(HLD + (size_t)unit * 128 + 2 * kp + 1, ldsum1, __ATOMIC_RELAXED, __HIP_MEMORY_SCOPE_AGENT); }
    }
    BLOCK_BAR();
}

__device__ __forceinline__ float gelu_as(float v) {
    const float av = fabsf(v), t = __builtin_amdgcn_rcpf(fmaf(av, 0.2316418882f, 1.0f));
    float q = fmaf(t, 0.5307027145f, -0.7265760135f); q = fmaf(q, t, 0.7107068705f); q = fmaf(q, t, -0.142248368f); q = fmaf(q, t, 0.127414796f); q = q * t;
    const float e = __builtin_amdgcn_exp2f(v * v * -0.72134752044f), m = v * (q * e);
    return v < 0.f ? m : v - m;
}
__device__ __forceinline__ float dot16_fp4(const unsigned w0, const unsigned w1, const f32x2 (&x2)[8]) {
    f32x2 acc = __builtin_amdgcn_cvt_scalef32_pk_f32_fp4(w0, 1.0f, 0) * x2[0];
    acc = __builtin_elementwise_fma(__builtin_amdgcn_cvt_scalef32_pk_f32_fp4(w0, 1.0f, 1), x2[1], acc);
    acc = __builtin_elementwise_fma(__builtin_amdgcn_cvt_scalef32_pk_f32_fp4(w0, 1.0f, 2), x2[2], acc);
    acc = __builtin_elementwise_fma(__builtin_amdgcn_cvt_scalef32_pk_f32_fp4(w0, 1.0f, 3), x2[3], acc);
    acc = __builtin_elementwise_fma(__builtin_amdgcn_cvt_scalef32_pk_f32_fp4(w1, 1.0f, 0), x2[4], acc);
    acc = __builtin_elementwise_fma(__builtin_amdgcn_cvt_scalef32_pk_f32_fp4(w1, 1.0f, 1), x2[5], acc);
    acc = __builtin_elementwise_fma(__builtin_amdgcn_cvt_scalef32_pk_f32_fp4(w1, 1.0f, 2), x2[6], acc);
    acc = __builtin_elementwise_fma(__builtin_amdgcn_cvt_scalef32_pk_f32_fp4(w1, 1.0f, 3), x2[7], acc);
    return acc.x + acc.y;
}
__device__ __forceinline__ void axpy16_fp4(const unsigned w0, const unsigned w1, const float s, f32x2 (&y2)[8]) {
    const f32x2 s2 = (f32x2){s, s};
    y2[0] = __builtin_elementwise_fma(__builtin_amdgcn_cvt_scalef32_pk_f32_fp4(w0, 1.0f, 0), s2, y2[0]);
    y2[1] = __builtin_elementwise_fma(__builtin_amdgcn_cvt_scalef32_pk_f32_fp4(w0, 1.0f, 1), s2, y2[1]);
    y2[2] = __builtin_elementwise_fma(__builtin_amdgcn_cvt_scalef32_pk_f32_fp4(w0, 1.0f, 2), s2, y2[2]);
    y2[3] = __builtin_elementwise_fma(__builtin_amdgcn_cvt_scalef32_pk_f32_fp4(w0, 1.0f, 3), s2, y2[3]);
    y2[4] = __builtin_elementwise_fma(__builtin_amdgcn_cvt_scalef32_pk_f32_fp4(w1, 1.0f, 0), s2, y2[4]);
    y2[5] = __builtin_elementwise_fma(__builtin_amdgcn_cvt_scalef32_pk_f32_fp4(w1, 1.0f, 1), s2, y2[5]);
    y2[6] = __builtin_elementwise_fma(__builtin_amdgcn_cvt_scalef32_pk_f32_fp4(w1, 1.0f, 2), s2, y2[6]);
    y2[7] = __builtin_elementwise_fma(__builtin_amdgcn_cvt_scalef32_pk_f32_fp4(w1, 1.0f, 3), s2, y2[7]);
}
__device__ __forceinline__ void axpy16_fp8(const u32x4 w, const float s, f32x2 (&y2)[8]) {
    const f32x2 s2 = (f32x2){s, s};
    y2[0] = __builtin_elementwise_fma(__builtin_amdgcn_cvt_pk_f32_fp8(w.x, false), s2, y2[0]);
    y2[1] = __builtin_elementwise_fma(__builtin_amdgcn_cvt_pk_f32_fp8(w.x, true), s2, y2[1]);
    y2[2] = __builtin_elementwise_fma(__builtin_amdgcn_cvt_pk_f32_fp8(w.y, false), s2, y2[2]);
    y2[3] = __builtin_elementwise_fma(__builtin_amdgcn_cvt_pk_f32_fp8(w.y, true), s2, y2[3]);
    y2[4] = __builtin_elementwise_fma(__builtin_amdgcn_cvt_pk_f32_fp8(w.z, false), s2, y2[4]);
    y2[5] = __builtin_elementwise_fma(__builtin_amdgcn_cvt_pk_f32_fp8(w.z, true), s2, y2[5]);
    y2[6] = __builtin_elementwise_fma(__builtin_amdgcn_cvt_pk_f32_fp8(w.w, false), s2, y2[6]);
    y2[7] = __builtin_elementwise_fma(__builtin_amdgcn_cvt_pk_f32_fp8(w.w, true), s2, y2[7]);
}
__device__ __forceinline__ f32x2 cvt4(unsigned w, int) { return (f32x2){0.f, 0.f}; }
#define C4(w, k) __builtin_amdgcn_cvt_scalef32_pk_f32_fp4((w), 1.0f, (k))
__device__ __forceinline__ float dot32_fp4(const u32x4 w, const f32x2 (&x2)[16]) {
    f32x2 a0 = C4(w.x, 0) * x2[0], a1 = C4(w.y, 0) * x2[4];
    a0 = __builtin_elementwise_fma(C4(w.x, 1), x2[1], a0); a1 = __builtin_elementwise_fma(C4(w.y, 1), x2[5], a1);
    a0 = __builtin_elementwise_fma(C4(w.x, 2), x2[2], a0); a1 = __builtin_elementwise_fma(C4(w.y, 2), x2[6], a1);
    a0 = __builtin_elementwise_fma(C4(w.x, 3), x2[3], a0); a1 = __builtin_elementwise_fma(C4(w.y, 3), x2[7], a1);
    a0 = __builtin_elementwise_fma(C4(w.z, 0), x2[8], a0); a1 = __builtin_elementwise_fma(C4(w.w, 0), x2[12], a1);
    a0 = __builtin_elementwise_fma(C4(w.z, 1), x2[9], a0); a1 = __builtin_elementwise_fma(C4(w.w, 1), x2[13], a1);
    a0 = __builtin_elementwise_fma(C4(w.z, 2), x2[10], a0); a1 = __builtin_elementwise_fma(C4(w.w, 2), x2[14], a1);
    a0 = __builtin_elementwise_fma(C4(w.z, 3), x2[11], a0); a1 = __builtin_elementwise_fma(C4(w.w, 3), x2[15], a1);
    a0 = a0 + a1;
    return a0.x + a0.y;
}
#define C4H(w, k) __builtin_bit_cast(h16x2, __builtin_amdgcn_cvt_scalef32_pk_f16_fp4((w), 1.0f, (k)))
__device__ __forceinline__ void axpy32_fp4(const u32x4 w, const float s, h16x2 (&y2)[16]) {
    const _Float16 sh = (_Float16)s; const h16x2 s2 = (h16x2){sh, sh};
    y2[0] = __builtin_elementwise_fma(C4H(w.x, 0), s2, y2[0]); y2[1] = __builtin_elementwise_fma(C4H(w.x, 1), s2, y2[1]); y2[2] = __builtin_elementwise_fma(C4H(w.x, 2), s2, y2[2]); y2[3] = __builtin_elementwise_fma(C4H(w.x, 3), s2, y2[3]);
    y2[4] = __builtin_elementwise_fma(C4H(w.y, 0), s2, y2[4]); y2[5] = __builtin_elementwise_fma(C4H(w.y, 1), s2, y2[5]); y2[6] = __builtin_elementwise_fma(C4H(w.y, 2), s2, y2[6]); y2[7] = __builtin_elementwise_fma(C4H(w.y, 3), s2, y2[7]);
    y2[8] = __builtin_elementwise_fma(C4H(w.z, 0), s2, y2[8]); y2[9] = __builtin_elementwise_fma(C4H(w.z, 1), s2, y2[9]); y2[10] = __builtin_elementwise_fma(C4H(w.z, 2), s2, y2[10]); y2[11] = __builtin_elementwise_fma(C4H(w.z, 3), s2, y2[11]);
    y2[12] = __builtin_elementwise_fma(C4H(w.w, 0), s2, y2[12]); y2[13] = __builtin_elementwise_fma(C4H(w.w, 1), s2, y2[13]); y2[14] = __builtin_elementwise_fma(C4H(w.w, 2), s2, y2[14]); y2[15] = __builtin_elementwise_fma(C4H(w.w, 3), s2, y2[15]);
}
__device__ __forceinline__ void axpy32_fp4_h(const u32x4 w, const h16x2 s2, h16x2 (&y2)[16]) {
    y2[0] = __builtin_elementwise_fma(C4H(w.x, 0), s2, y2[0]); y2[1] = __builtin_elementwise_fma(C4H(w.x, 1), s2, y2[1]); y2[2] = __builtin_elementwise_fma(C4H(w.x, 2), s2, y2[2]); y2[3] = __builtin_elementwise_fma(C4H(w.x, 3), s2, y2[3]);
    y2[4] = __builtin_elementwise_fma(C4H(w.y, 0), s2, y2[4]); y2[5] = __builtin_elementwise_fma(C4H(w.y, 1), s2, y2[5]); y2[6] = __builtin_elementwise_fma(C4H(w.y, 2), s2, y2[6]); y2[7] = __builtin_elementwise_fma(C4H(w.y, 3), s2, y2[7]);
    y2[8] = __builtin_elementwise_fma(C4H(w.z, 0), s2, y2[8]); y2[9] = __builtin_elementwise_fma(C4H(w.z, 1), s2, y2[9]); y2[10] = __builtin_elementwise_fma(C4H(w.z, 2), s2, y2[10]); y2[11] = __builtin_elementwise_fma(C4H(w.z, 3), s2, y2[11]);
    y2[12] = __builtin_elementwise_fma(C4H(w.w, 0), s2, y2[12]); y2[13] = __builtin_elementwise_fma(C4H(w.w, 1), s2, y2[13]); y2[14] = __builtin_elementwise_fma(C4H(w.w, 2), s2, y2[14]); y2[15] = __builtin_elementwise_fma(C4H(w.w, 3), s2, y2[15]);
}
#undef C4H
__device__ __forceinline__ float half_sum_dpp(float v) {
    v += __builtin_bit_cast(float, __builtin_amdgcn_update_dpp(0, __builtin_bit_cast(int, v), 0x111, 0xf, 0xf, false));
    v += __builtin_bit_cast(float, __builtin_amdgcn_update_dpp(0, __builtin_bit_cast(int, v), 0x112, 0xf, 0xf, false));
    v += __builtin_bit_cast(float, __builtin_amdgcn_update_dpp(0, __builtin_bit_cast(int, v), 0x114, 0xf, 0xf, false));
    v += __builtin_bit_cast(float, __builtin_amdgcn_update_dpp(0, __builtin_bit_cast(int, v), 0x118, 0xf, 0xf, false));
    v += __builtin_bit_cast(float, __builtin_amdgcn_update_dpp(0, __builtin_bit_cast(int, v), 0x142, 0xa, 0xf, false));
    return v;
}
typedef int i32x8 __attribute__((ext_vector_type(8)));
#define P7_EMASK ((DGP & 8) ? 15 : (DGP & 1) ? 1023 : 0x7fffffff)
#define P7_LOAD2(dst, evv, slot) do { const int ea_ = __builtin_amdgcn_readlane((evv), (slot)) & P7_EMASK, eb_ = __builtin_amdgcn_readlane((evv), (slot) + 1) & P7_EMASK; \
        dst = __builtin_amdgcn_raw_buffer_load_b128(RV, ((hi ? eb_ : ea_) << 9) + l16, 0, 0); } while (0)
#define P7_AXPY2(BANK, q, r) do { const float wa_ = __builtin_bit_cast(float, __builtin_amdgcn_readlane(__builtin_bit_cast(int, wvec), (q) * 16 + 2 * (r))), wb_ = __builtin_bit_cast(float, __builtin_amdgcn_readlane(__builtin_bit_cast(int, wvec), (q) * 16 + 2 * (r) + 1)); \
        axpy32_fp4(BANK[r], hi ? wb_ : wa_, y2); } while (0)
#define P7_UBASE(evv, g) ((((__shfl((evv), 16 * (g) + li)) & P7_EMASK) << 9) + 16 * lq)
#define P7_LOADU1(dst, ubase, s) do { dst = __builtin_amdgcn_raw_buffer_load_b128(RU, (ubase) + 64 * (s), 0, 0); } while (0)
#define P7_MFMA_STEP(abuf, xb, s, D1, D2) do { \
        const u32x4 b1_ = *(const LAS u32x4*)((xb) + 64 * (s) + 16 * lq), b2_ = *(const LAS u32x4*)((xb) + 512 + 64 * (s) + 16 * lq); \
        const i32x8 av_ = (i32x8){(int)abuf.x, (int)abuf.y, (int)abuf.z, (int)abuf.w, 0, 0, 0, 0}; \
        D1 = __builtin_amdgcn_mfma_scale_f32_16x16x128_f8f6f4(av_, (i32x8){(int)b1_.x, (int)b1_.y, (int)b1_.z, (int)b1_.w, 0, 0, 0, 0}, D1, 4, 4, 0, 0x7f7f7f7f, 0, 0x7f7f7f7f); \
        D2 = __builtin_amdgcn_mfma_scale_f32_16x16x128_f8f6f4(av_, (i32x8){(int)b2_.x, (int)b2_.y, (int)b2_.z, (int)b2_.w, 0, 0, 0, 0}, D2, 4, 4, 0, 0x7f7f7f7f, 0, 0x7f7f7f7f); } while (0)
#define P7_DV(g, dg, dv) do { const float tmp_ = (lane & 3) == 0 ? dg[0] : (lane & 3) == 1 ? dg[1] : (lane & 3) == 2 ? dg[2] : dg[3]; const float val_ = __shfl(tmp_, srcl); dv = (lq == (g)) ? val_ : dv; } while (0)
__device__ __forceinline__ void x_to_fp4x2(const u32x2 (&xq)[8], LAS unsigned char* xb, int l32, float& s1, float& s2) {
    float am = 0.f;
#pragma unroll
    for (int j = 0; j < 8; ++j) am = fmaxf(am, fmaxf(fmaxf(fabsf(bf_lo(xq[j].x)), fabsf(bf_hi(xq[j].x))), fmaxf(fabsf(bf_lo(xq[j].y)), fabsf(bf_hi(xq[j].y)))));
    am = wave_max_dpp(am);
    s1 = am > 0.f ? am * (1.f / 6.f) : 1.f; const float i1 = am > 0.f ? 6.f / am : 1.f;
    float am2 = 0.f;
#pragma unroll
    for (int j = 0; j < 8; ++j) {
        const float x0 = bf_lo(xq[j].x), x1 = bf_hi(xq[j].x), x2_ = bf_lo(xq[j].y), x3 = bf_hi(xq[j].y);
        unsigned w = 0u;
        w = __builtin_amdgcn_cvt_scalef32_pk_fp4_f32(w, x0 * i1, x1 * i1, 1.0f, 0); w = __builtin_amdgcn_cvt_scalef32_pk_fp4_f32(w, x2_ * i1, x3 * i1, 1.0f, 1);
        *(LAS unsigned short*)(xb + 2 * (l32 + 32 * j)) = (unsigned short)w;
        const f32x2 d0 = __builtin_amdgcn_cvt_scalef32_pk_f32_fp4(w, 1.0f, 0), d1 = __builtin_amdgcn_cvt_scalef32_pk_f32_fp4(w, 1.0f, 1);
        am2 = fmaxf(am2, fmaxf(fmaxf(fabsf(x0 - s1 * d0.x), fabsf(x1 - s1 * d0.y)), fmaxf(fabsf(x2_ - s1 * d1.x), fabsf(x3 - s1 * d1.y))));
    }
    am2 = wave_max_dpp(am2);
    s2 = am2 > 0.f ? am2 * (1.f / 6.f) : 1.f; const float i2 = am2 > 0.f ? 6.f / am2 : 1.f;
    asm volatile("s_waitcnt lgkmcnt(0)" ::: "memory");
#pragma unroll
    for (int j = 0; j < 8; ++j) {
        const float x0 = bf_lo(xq[j].x), x1 = bf_hi(xq[j].x), x2_ = bf_lo(xq[j].y), x3 = bf_hi(xq[j].y);
        const unsigned w1 = *(const LAS unsigned short*)(xb + 2 * (l32 + 32 * j));
        const f32x2 d0 = __builtin_amdgcn_cvt_scalef32_pk_f32_fp4(w1, 1.0f, 0), d1 = __builtin_amdgcn_cvt_scalef32_pk_f32_fp4(w1, 1.0f, 1);
        unsigned w = 0u;
        w = __builtin_amdgcn_cvt_scalef32_pk_fp4_f32(w, (x0 - s1 * d0.x) * i2, (x1 - s1 * d0.y) * i2, 1.0f, 0); w = __builtin_amdgcn_cvt_scalef32_pk_fp4_f32(w, (x2_ - s1 * d1.x) * i2, (x3 - s1 * d1.y) * i2, 1.0f, 1);
        *(LAS unsigned short*)(xb + 512 + 2 * (l32 + 32 * j)) = (unsigned short)w;
    }
    asm volatile("s_waitcnt lgkmcnt(0)" ::: "memory");
}
template <bool V4, int DGP = 0>
__device__ __forceinline__ void peer_phase(LAS unsigned char* lds, int wave, const bf16_t* __restrict__ XN2, const int* __restrict__ EIDX, const float* __restrict__ GATE, const unsigned char* __restrict__ Up, const unsigned char* __restrict__ Vp,
                                           const float* __restrict__ USC, const float* __restrict__ VSC, const float* __restrict__ SSQ, const float* __restrict__ fg, float* __restrict__ out, int gw, int NGW, int lane) {
    static_assert(V4, "this build of the PEER phase streams fp4 value rows");
    if (gw >= M) return;
    LAS unsigned char* xbase = lds + wave * 2048;
    const __amdgpu_buffer_rsrc_t RU = __builtin_amdgcn_make_buffer_rsrc((void*)Up, 0, NEXP * 512, 0x00020000);
    const __amdgpu_buffer_rsrc_t RV = __builtin_amdgcn_make_buffer_rsrc((void*)Vp, 0, NEXP * 512, 0x00020000);
    const bool hi = lane >= 32; const int l32 = lane & 31, l16 = l32 * 16, li = lane & 15, lq = lane >> 4, srcl = 16 * (li >> 2) + li;
    u32x4 UA[8], UB[8], VA[4], VB[4];
    int t = gw, par = 0;
    u32x2 xq[8];
#pragma unroll
    for (int j = 0; j < 8; ++j) xq[j] = __builtin_nontemporal_load((const u32x2*)(XN2 + (size_t)t * D) + l32 + 32 * j);
    int evc = __builtin_nontemporal_load(EIDX + (size_t)t * 128 + lane), evn = __builtin_nontemporal_load(EIDX + (size_t)t * 128 + 64 + lane);
    float gvn = __builtin_nontemporal_load(GATE + (size_t)t * 128 + 64 + lane);
    float xs1, xs2;
    x_to_fp4x2(xq, xbase, l32, xs1, xs2);
    float rstd_t = rsqrtf(wave_sum_dpp(lane < 16 ? SSQ[(size_t)t * 16 + lane] : 0.f) * (1.f / D) + EPS);
    float wvec;
    {
        float dvec = 0.f;
#define P7_PRO_LOAD(BUF, g) do { const int ub_ = P7_UBASE(evc, g); _Pragma("unroll") for (int s = 0; s < 8; ++s) P7_LOADU1(BUF[s], ub_, s); } while (0)
#define P7_PRO_MMA(BUF, g) do { f32x4 D1 = (f32x4){0.f, 0.f, 0.f, 0.f}, D2 = D1; _Pragma("unroll") for (int s = 0; s < 8; ++s) P7_MFMA_STEP(BUF[s], xbase, s, D1, D2); const f32x4 dd = D1 * xs1 + D2 * xs2; P7_DV(g, dd, dvec); } while (0)
        P7_PRO_LOAD(UA, 0); P7_PRO_LOAD(UB, 1);
        P7_PRO_MMA(UA, 0); P7_PRO_LOAD(UA, 2);
        P7_PRO_MMA(UB, 1); P7_PRO_LOAD(UB, 3);
        P7_PRO_MMA(UA, 2); P7_PRO_MMA(UB, 3);
#undef P7_PRO_LOAD
#undef P7_PRO_MMA
        wvec = __builtin_nontemporal_load(GATE + (size_t)t * 128 + lane) * VSC[evc] * gelu_as(dvec * (USC[evc] * rstd_t));
    }
    {
#pragma unroll
        for (int r = 0; r < 4; ++r) P7_LOAD2(VA[r], evc, 2 * r);
#pragma unroll
        for (int r = 0; r < 4; ++r) P7_LOAD2(VB[r], evc, 8 + 2 * r);
        const int ub0 = P7_UBASE(evn, 0), ub1 = P7_UBASE(evn, 1);
#pragma unroll
        for (int s = 0; s < 8; ++s) P7_LOADU1(UA[s], ub0, s);
#pragma unroll
        for (int s = 0; s < 8; ++s) P7_LOADU1(UB[s], ub1, s);
    }
    h16x2 y2[16];
#pragma unroll
    for (int j = 0; j < 16; ++j) y2[j] = (h16x2){(_Float16)0.f, (_Float16)0.f};
    int h = 0;
    int tn = t + NGW; bool has_next = tn < M; int tl = has_next ? tn : t;
    int nev0 = __builtin_nontemporal_load(EIDX + (size_t)tl * 128 + lane), nev1 = __builtin_nontemporal_load(EIDX + (size_t)tl * 128 + 64 + lane);
    float ngv0 = __builtin_nontemporal_load(GATE + (size_t)tl * 128 + lane), ngv1 = __builtin_nontemporal_load(GATE + (size_t)tl * 128 + 64 + lane);
    u32x2 nxq[8];
#pragma unroll
    for (int j = 0; j < 8; ++j) nxq[j] = __builtin_nontemporal_load((const u32x2*)(XN2 + (size_t)tl * D) + l32 + 32 * j);
    float nxs1 = 1.f, nxs2 = 1.f, nrstd = 1.f;
#pragma unroll 1
    for (;;) {
        if (h == 1) {
            x_to_fp4x2(nxq, xbase + (par ^ 1) * 1024, l32, nxs1, nxs2);
            nrstd = rsqrtf(wave_sum_dpp(lane < 16 ? SSQ[(size_t)tl * 16 + lane] : 0.f) * (1.f / D) + EPS);
        }
        const LAS unsigned char* xbn = xbase + (h ? (par ^ 1) : par) * 1024;
        const float s1n = h ? nxs1 : xs1, s2n = h ? nxs2 : xs2, rsn = h ? nrstd : rstd_t;
        const int evnn = h ? nev1 : nev0;
        const float uscn = USC[evn] * rsn, vscn = VSC[evn];
        float dvec = 0.f;
#define P7_PIPE(g, UBUF, UBV, evr, slotr) do { \
            f32x4 D1 = (f32x4){0.f, 0.f, 0.f, 0.f}, D2 = D1; \
            _Pragma("unroll") for (int r = 0; r < 8; ++r) { \
                P7_MFMA_STEP(UBUF[r], xbn, r, D1, D2); __builtin_amdgcn_sched_barrier(0); \
                if (r & 1) { P7_LOADU1(UBUF[r - 1], UBV, r - 1); P7_LOADU1(UBUF[r], UBV, r); }        \
                __builtin_amdgcn_sched_barrier(0); \
                if (r < 4) { P7_AXPY2X(VA[r], (g) * 16 + 2 * r); __builtin_amdgcn_sched_barrier(0); P7_LOAD2(VA[r], evr, (slotr) + 2 * r); } \
                else { P7_AXPY2X(VB[r - 4], (g) * 16 + 2 * r); __builtin_amdgcn_sched_barrier(0); P7_LOAD2(VB[r - 4], evr, (slotr) + 2 * r); } \
                __builtin_amdgcn_sched_barrier(0); } \
            const f32x4 dd = D1 * s1n + D2 * s2n; P7_DV(g, dd, dvec); } while (0)
#define P7_AXPY2X(ROW, slot) do { const float wa_ = __builtin_bit_cast(float, __builtin_amdgcn_readlane(__builtin_bit_cast(int, wvec), (slot))), wb_ = __builtin_bit_cast(float, __builtin_amdgcn_readlane(__builtin_bit_cast(int, wvec), (slot) + 1)); \
        axpy32_fp4(ROW, hi ? wb_ : wa_, y2); \
        asm volatile("" : "+v"(y2[0]), "+v"(y2[1]), "+v"(y2[2]), "+v"(y2[3]), "+v"(y2[4]), "+v"(y2[5]), "+v"(y2[6]), "+v"(y2[7]), "+v"(y2[8]), "+v"(y2[9]), "+v"(y2[10]), "+v"(y2[11]), "+v"(y2[12]), "+v"(y2[13]), "+v"(y2[14]), "+v"(y2[15])); } while (0)
        { const int ub = P7_UBASE(evn, 2);  P7_PIPE(0, UA, ub, evc, 16); }
        { const int ub = P7_UBASE(evn, 3);  P7_PIPE(1, UB, ub, evc, 32); }
        { const int ub = P7_UBASE(evnn, 0); P7_PIPE(2, UA, ub, evc, 48); }
        { const int ub = P7_UBASE(evnn, 1); P7_PIPE(3, UB, ub, evn, 0); }
#undef P7_AXPY2X
#undef P7_PIPE
        const float wnext = gvn * vscn * gelu_as(dvec * uscn);
        if (h == 1) {
            f32x4 z[4]; float sq = 0.f;
#pragma unroll
            for (int jj = 0; jj < 4; ++jj) {
                const u32x2 xe = xq[2 * jj], xo = xq[2 * jj + 1];
                const f32x4 ye = (f32x4){(float)y2[2 * jj].x, (float)y2[2 * jj].y, (float)y2[2 * jj + 1].x, (float)y2[2 * jj + 1].y}, yo = (f32x4){(float)y2[8 + 2 * jj].x, (float)y2[8 + 2 * jj].y, (float)y2[8 + 2 * jj + 1].x, (float)y2[8 + 2 * jj + 1].y};
                const f32x4 mine = hi ? yo : ye, give = hi ? ye : yo;
                f32x4 got; got.x = __shfl_xor(give.x, 32); got.y = __shfl_xor(give.y, 32); got.z = __shfl_xor(give.z, 32); got.w = __shfl_xor(give.w, 32);
                const u32x2 xm = hi ? xo : xe;
                z[jj] = mine + got + (f32x4){bf_lo(xm.x), bf_hi(xm.x), bf_lo(xm.y), bf_hi(xm.y)};
                sq += (z[jj].x * z[jj].x + z[jj].y * z[jj].y) + (z[jj].z * z[jj].z + z[jj].w * z[jj].w);
            }
            const float rr = rsqrtf(wave_sum_dpp(sq) * (1.f / D) + EPS);
            const int hb = hi ? 1 : 0;
#pragma unroll
            for (int jj = 0; jj < 4; ++jj) { const int G = l32 + 32 * (hb + 2 * jj); __builtin_nontemporal_store(z[jj] * rr * ((const f32x4*)fg)[G], (f32x4*)(out + (size_t)t * D) + G); }
            if (!has_next) break;
            t = tn; par ^= 1; xs1 = nxs1; xs2 = nxs2; rstd_t = nrstd;
#pragma unroll
            for (int j = 0; j < 8; ++j) xq[j] = nxq[j];
#pragma unroll
            for (int j = 0; j < 16; ++j) y2[j] = (h16x2){(_Float16)0.f, (_Float16)0.f};
            evc = evn; evn = nev1; gvn = ngv1;
            tn = t + NGW; has_next = tn < M; tl = has_next ? tn : t;
            nev0 = __builtin_nontemporal_load(EIDX + (size_t)tl * 128 + lane); nev1 = __builtin_nontemporal_load(EIDX + (size_t)tl * 128 + 64 + lane); ngv0 = __builtin_nontemporal_load(GATE + (size_t)tl * 128 + lane); ngv1 = __builtin_nontemporal_load(GATE + (size_t)tl * 128 + 64 + lane);
#pragma unroll
            for (int j = 0; j < 8; ++j) nxq[j] = __builtin_nontemporal_load((const u32x2*)(XN2 + (size_t)tl * D) + l32 + 32 * j);
            h = 0;
        } else {
            evc = evn; evn = nev0; gvn = ngv0; h = 1;
        }
        wvec = wnext;
    }
}
#define P7_LOADK(dst, evv, slot) do { const int ea_ = __builtin_amdgcn_readlane((evv), (slot)) & P7_EMASK, eb_ = __builtin_amdgcn_readlane((evv), (slot) + 1) & P7_EMASK; \
        dst = __builtin_amdgcn_raw_buffer_load_b128(RU, ((hi ? eb_ : ea_) << 9) + l16, 0, 0); } while (0)
#define P7_STAGE(UBUF) do { _Pragma("unroll") for (int r_ = 0; r_ < 8; ++r_) *(LAS u32x4*)(kst + (2 * r_ + (lane >> 5)) * 528 + l16) = UBUF[r_]; } while (0)
#define P7_AOP(s) (*(const LAS u32x4*)(kst + li * 528 + 64 * (s) + 16 * lq))
template <int DGP = 0>
__device__ __forceinline__ void peer_keys(LAS unsigned char* lds, int wave, const bf16_t* __restrict__ XN2, const int* __restrict__ EIDX, float* __restrict__ GATE, const unsigned char* __restrict__ Up,
                                          const float* __restrict__ USC, const float* __restrict__ VSC, const float* __restrict__ SSQ, int gw, int NGW, int lane) {
    if (gw >= M) return;
    LAS unsigned char* xbase = lds + wave * 2048;
    LAS unsigned char* kst = lds + 16384 + wave * 16384;
    const __amdgpu_buffer_rsrc_t RU = __builtin_amdgcn_make_buffer_rsrc((void*)Up, 0, NEXP * 512, 0x00020000);
    const bool hi = lane >= 32; const int l32 = lane & 31, li = lane & 15, lq = lane >> 4, srcl = 16 * (li >> 2) + li;
#define P7_DMA(evv, g, bufi) do { _Pragma("unroll") for (int s_ = 0; s_ < 8; ++s_) { \
        const int ea_ = __builtin_amdgcn_readlane((evv), 16 * (g) + 2 * s_) & P7_EMASK, eb_ = __builtin_amdgcn_readlane((evv), 16 * (g) + 2 * s_ + 1) & P7_EMASK; \
        const int rowi_ = 2 * s_ + (lane >> 5); \
        __builtin_amdgcn_raw_ptr_buffer_load_lds(RU, (LAS void*)(kst + (bufi) * 8192 + 1024 * s_), 16, ((hi ? eb_ : ea_) << 9) + 16 * (l32 ^ (rowi_ & 15)), 0, 0, 0); } } while (0)
#define P7_EFETCH(E, evv, g) do { _Pragma("unroll") for (int s_ = 0; s_ < 8; ++s_) E[s_] = __builtin_amdgcn_ds_bpermute(hb4 + 4 * (16 * (g) + 2 * s_), (evv)); } while (0)
#define P7_DMAE(E, bufi) do { _Pragma("unroll") for (int s_ = 0; s_ < 8; ++s_) { const int rowi_ = 2 * s_ + (lane >> 5); \
        __builtin_amdgcn_raw_ptr_buffer_load_lds(RU, (LAS void*)(kst + (bufi) * 8192 + 1024 * s_), 16, ((E[s_] & P7_EMASK) << 9) + 16 * (l32 ^ (rowi_ & 15)), 0, 0, 0); } } while (0)
#define P7_AOPD(bufi, s) (*(const LAS u32x4*)(kst + (bufi) * 8192 + li * 512 + 16 * ((4 * (s) + lq) ^ li)))
    int t = gw, par = 0;
    u32x2 xq[8];
#pragma unroll
    for (int j = 0; j < 8; ++j) xq[j] = __builtin_nontemporal_load((const u32x2*)(XN2 + (size_t)t * D) + l32 + 32 * j);
    int ev0 = EIDX[(size_t)t * 128 + lane], ev1 = EIDX[(size_t)t * 128 + 64 + lane];
    float xs1, xs2;
    x_to_fp4x2(xq, xbase, l32, xs1, xs2);
    float rstd_t = rsqrtf(wave_sum_dpp(lane < 16 ? SSQ[(size_t)t * 16 + lane] : 0.f) * (1.f / D) + EPS);
    const int hb4 = hi ? 4 : 0;
    int EA[8], EB[8];
    P7_DMA(ev0, 0, 0);
    P7_EFETCH(EB, ev0, 1);
#pragma unroll 1
    for (;;) {
        const int tn = t + NGW; const bool has_next = tn < M; const int tl = has_next ? tn : t;
        const int nev0 = EIDX[(size_t)tl * 128 + lane], nev1 = EIDX[(size_t)tl * 128 + 64 + lane];
        u32x2 nxq[8];
#pragma unroll
        for (int j = 0; j < 8; ++j) nxq[j] = __builtin_nontemporal_load((const u32x2*)(XN2 + (size_t)tl * D) + l32 + 32 * j);
        float nxs1 = 1.f, nxs2 = 1.f;
        u32x4 B1[8], B2[8];
#pragma unroll
        for (int s = 0; s < 8; ++s) { B1[s] = *(const LAS u32x4*)(xbase + par * 1024 + 64 * s + 16 * lq); B2[s] = *(const LAS u32x4*)(xbase + par * 1024 + 512 + 64 * s + 16 * lq); }
#pragma unroll 1
        for (int half = 0; half < 2; ++half) {
            const int evh = half ? ev1 : ev0, evx = half ? nev0 : ev1;
            const float gt = GATE[(size_t)t * 128 + half * 64 + lane];
            const float usc = USC[evh] * rstd_t, vsc = VSC[evh];
            if (half == 1) x_to_fp4x2(nxq, xbase + (par ^ 1) * 1024, l32, nxs1, nxs2);
            const LAS unsigned char* xb = xbase + par * 1024;
            float dvec = 0.f;
#define P7_KGROUP(g, EN, EF) do { f32x4 D1 = (f32x4){0.f, 0.f, 0.f, 0.f}, D2 = D1; \
            P7_DMAE(EN, ((g) + 1) & 1); \
            if ((g) < 2) P7_EFETCH(EF, evh, (g) + 2); else P7_EFETCH(EF, evx, (g) - 2); \
            asm volatile("s_waitcnt vmcnt(8)" ::: "memory"); \
            u32x4 A_[8]; \
            _Pragma("unroll") for (int s = 0; s < 8; ++s) A_[s] = P7_AOPD((g) & 1, s); \
            __builtin_amdgcn_sched_barrier(0);            \
            _Pragma("unroll") for (int s = 0; s < 8; ++s) { const i32x8 av_ = (i32x8){(int)A_[s].x, (int)A_[s].y, (int)A_[s].z, (int)A_[s].w, 0, 0, 0, 0}; \
                D1 = __builtin_amdgcn_mfma_scale_f32_16x16x128_f8f6f4(av_, (i32x8){(int)B1[s].x, (int)B1[s].y, (int)B1[s].z, (int)B1[s].w, 0, 0, 0, 0}, D1, 4, 4, 0, 0x7f7f7f7f, 0, 0x7f7f7f7f); \
                D2 = __builtin_amdgcn_mfma_scale_f32_16x16x128_f8f6f4(av_, (i32x8){(int)B2[s].x, (int)B2[s].y, (int)B2[s].z, (int)B2[s].w, 0, 0, 0, 0}, D2, 4, 4, 0, 0x7f7f7f7f, 0, 0x7f7f7f7f); } \
            asm volatile("" ::: "memory"); \
            const f32x4 dd = D1 * xs1 + D2 * xs2; P7_DV(g, dd, dvec); } while (0)
            P7_KGROUP(0, EB, EA); P7_KGROUP(1, EA, EB); P7_KGROUP(2, EB, EA); P7_KGROUP(3, EA, EB);
#undef P7_KGROUP
            { const _Float16 wh_ = (_Float16)(gt * vsc * gelu_as(dvec * usc));
              GATE[(size_t)t * 128 + half * 64 + lane] = __builtin_bit_cast(float, (h16x2){wh_, wh_}); }
        }
        if (!has_next) break;
        t = tn; par ^= 1; xs1 = nxs1; xs2 = nxs2; ev0 = nev0; ev1 = nev1;
        rstd_t = rsqrtf(wave_sum_dpp(lane < 16 ? SSQ[(size_t)t * 16 + lane] : 0.f) * (1.f / D) + EPS);
    }
    asm volatile("s_waitcnt vmcnt(0)" ::: "memory");
#undef P7_DMA
#undef P7_DMAE
#undef P7_EFETCH
#undef P7_AOPD
}
template <int DGP = 0>
__device__ __forceinline__ void peer_values(const bf16_t* __restrict__ XN2, const int* __restrict__ EIDX, const float* __restrict__ WGT, const unsigned char* __restrict__ Vp,
                                            const float* __restrict__ fg, float* __restrict__ out, int gw, int NGW, int lane) {
    if (gw >= M) return;
    const __amdgpu_buffer_rsrc_t RV = __builtin_amdgcn_make_buffer_rsrc((void*)Vp, 0, NEXP * 512, 0x00020000);
    const bool hi = lane >= 32; const int l32 = lane & 31, l16 = l32 * 16, hb4 = hi ? 4 : 0;
    u32x4 V0[8], V1[8], V2[8], V3[8];
    int t = gw;
    int evc = EIDX[(size_t)t * 128 + lane], evn = EIDX[(size_t)t * 128 + 64 + lane];
#pragma unroll
    for (int r = 0; r < 8; ++r) { P7_LOAD2(V0[r], evc, 2 * r); P7_LOAD2(V1[r], evc, 16 + 2 * r); P7_LOAD2(V2[r], evc, 32 + 2 * r); P7_LOAD2(V3[r], evc, 48 + 2 * r); }
    h16x2 y2[16];
#pragma unroll
    for (int j = 0; j < 16; ++j) y2[j] = (h16x2){(_Float16)0.f, (_Float16)0.f};
    int h = 0; u32x2 xres[4] = {(u32x2){0u, 0u}, (u32x2){0u, 0u}, (u32x2){0u, 0u}, (u32x2){0u, 0u}};
    int tn = t + NGW; bool has_next = tn < M; int tl = has_next ? tn : t;
    int nev0 = EIDX[(size_t)tl * 128 + lane], nev1 = EIDX[(size_t)tl * 128 + 64 + lane];
    float wvec = WGT[(size_t)t * 128 + lane];
#pragma unroll 1
    for (;;) {
        const float wnext = WGT[(size_t)(h ? tl : t) * 128 + (h ? 0 : 64) + lane];
        if (h == 1) {
#pragma unroll
            for (int jj = 0; jj < 4; ++jj) xres[jj] = __builtin_nontemporal_load((const u32x2*)(XN2 + (size_t)t * D) + l32 + 32 * ((hi ? 1 : 0) + 2 * jj));
        }
#define P7_VCHUNK(q, BANK) do { int wsel_[8], isel_[8]; \
            _Pragma("unroll") for (int r = 0; r < 8; ++r) { wsel_[r] = __builtin_amdgcn_ds_bpermute(hb4 + 4 * ((q) * 16 + 2 * r), __builtin_bit_cast(int, wvec)); isel_[r] = __builtin_amdgcn_ds_bpermute(hb4 + 4 * ((q) * 16 + 2 * r), evn); } \
            _Pragma("unroll") for (int r = 0; r < 8; ++r) { \
            axpy32_fp4_h(BANK[r], __builtin_bit_cast(h16x2, wsel_[r]), y2); \
            asm volatile("" : "+v"(y2[0]), "+v"(y2[1]), "+v"(y2[2]), "+v"(y2[3]), "+v"(y2[4]), "+v"(y2[5]), "+v"(y2[6]), "+v"(y2[7]), "+v"(y2[8]), "+v"(y2[9]), "+v"(y2[10]), "+v"(y2[11]), "+v"(y2[12]), "+v"(y2[13]), "+v"(y2[14]), "+v"(y2[15])); \
            __builtin_amdgcn_sched_barrier(0); BANK[r] = __builtin_amdgcn_raw_buffer_load_b128(RV, ((isel_[r] & P7_EMASK) << 9) + l16, 0, 0); __builtin_amdgcn_sched_barrier(0); } } while (0)
        P7_VCHUNK(0, V0); P7_VCHUNK(1, V1); P7_VCHUNK(2, V2); P7_VCHUNK(3, V3);
#undef P7_VCHUNK
        if (h == 1) {
            const int hb = hi ? 1 : 0;
            f32x4 z[4]; float sq = 0.f;
#pragma unroll
            for (int jj = 0; jj < 4; ++jj) {
                const u32x2 xm = xres[jj];
                const f32x4 ye = (f32x4){(float)y2[2 * jj].x, (float)y2[2 * jj].y, (float)y2[2 * jj + 1].x, (float)y2[2 * jj + 1].y}, yo = (f32x4){(float)y2[8 + 2 * jj].x, (float)y2[8 + 2 * jj].y, (float)y2[8 + 2 * jj + 1].x, (float)y2[8 + 2 * jj + 1].y};
                const f32x4 mine = hi ? yo : ye, give = hi ? ye : yo;
                f32x4 got; got.x = __shfl_xor(give.x, 32); got.y = __shfl_xor(give.y, 32); got.z = __shfl_xor(give.z, 32); got.w = __shfl_xor(give.w, 32);
                z[jj] = mine + got + (f32x4){bf_lo(xm.x), bf_hi(xm.x), bf_lo(xm.y), bf_hi(xm.y)};
                sq += (z[jj].x * z[jj].x + z[jj].y * z[jj].y) + (z[jj].z * z[jj].z + z[jj].w * z[jj].w);
            }
            const float rr = rsqrtf(wave_sum_dpp(sq) * (1.f / D) + EPS);
#pragma unroll
            for (int jj = 0; jj < 4; ++jj) { const int G = l32 + 32 * (hb + 2 * jj); __builtin_nontemporal_store(z[jj] * rr * ((const f32x4*)fg)[G], (f32x4*)(out + (size_t)t * D) + G); }
            if (!has_next) break;
            t = tn;
#pragma unroll
            for (int j = 0; j < 16; ++j) y2[j] = (h16x2){(_Float16)0.f, (_Float16)0.f};
            evc = evn; evn = nev1;
            tn = t + NGW; has_next = tn < M; tl = has_next ? tn : t;
            nev0 = EIDX[(size_t)tl * 128 + lane]; nev1 = EIDX[(size_t)tl * 128 + 64 + lane];
            h = 0;
        } else {
            evc = evn; evn = nev0; h = 1;
        }
        wvec = wnext;
    }
}
#undef P7_LOADK
#undef P7_STAGE
#undef P7_AOP
#undef P7_LOAD2
#undef P7_AXPY2
#undef P7_UBASE
#undef P7_LOADU1
#undef P7_MFMA_STEP
#undef P7_DV
#undef P7_EMASK
#undef C4

#define XB_TMO      128
#define XB_XCNT(j)  (256  + 64 * (j))
#define XB_XSUB(j)  (1280 + 64 * (j))
#define XB_XGEN(j)  (2304 + 64 * (j))
#define XB_TOP      3328
#define XB_TOPGEN   3392
#define XCD_BAR_WORDS 3456
#define XB_SEG      12288
#define XB_RDY      4096
#define XB_SPIN_CAP (1u << 18)

__device__ __forceinline__ unsigned xb_ld(unsigned* p)              { return __hip_atomic_load(p, __ATOMIC_RELAXED, __HIP_MEMORY_SCOPE_AGENT); }
__device__ __forceinline__ unsigned xb_add(unsigned* p, unsigned v) { return __hip_atomic_fetch_add(p, v, __ATOMIC_RELAXED, __HIP_MEMORY_SCOPE_AGENT); }
__device__ __forceinline__ unsigned xb_xcc_id() { return (unsigned)__builtin_amdgcn_s_getreg((3 << 11) | 20) & 0xFu; }
#define XB_SPIN(cond, bar) do { unsigned _sp = 0; while (cond) { __builtin_amdgcn_s_sleep(1); \
    if ((++_sp & 255u) == 0u) { if (xb_ld(&(bar)[XB_TMO])) break; if (_sp > XB_SPIN_CAP) { atomicAdd(&(bar)[XB_TMO], 1u); break; } } } } while (0)


struct XcdBar { unsigned* bar; unsigned x, nloc, nx; };
__device__ __forceinline__ void xcd_bar_post(unsigned* bar, unsigned x) { (void)xb_add(&bar[XB_XCNT(x)], 1u); }
__device__ __forceinline__ void xcd_bar_census(XcdBar& b) {
    unsigned cnt = 0u, mine = 0u;
#pragma unroll
    for (unsigned j = 0; j < 16; ++j) { const unsigned c = xb_ld(&b.bar[XB_XCNT(j)]); cnt += (c > 0u) ? 1u : 0u; mine = (j == b.x) ? c : mine; }
    b.nloc = mine > 0u ? mine : 1u; b.nx = cnt > 0u ? cnt : 1u;
}
__device__ __forceinline__ void xcd_bar_census_spin(XcdBar& b) {
    const unsigned G = gridDim.x; unsigned sum, cnt, mine, sp = 0u;
    for (;;) {
        sum = 0u; cnt = 0u; mine = 0u;
#pragma unroll
        for (unsigned j = 0; j < 16; ++j) { const unsigned c = xb_ld(&b.bar[XB_XCNT(j)]); sum += c; cnt += (c > 0u) ? 1u : 0u; mine = (j == b.x) ? c : mine; }
        if (sum == G) break;
        __builtin_amdgcn_s_sleep(1);
        if ((++sp & 255u) == 0u) { if (xb_ld(&b.bar[XB_TMO])) break; if (sp > XB_SPIN_CAP) { atomicAdd(&b.bar[XB_TMO], 1u); break; } }
    }
    b.nloc = mine > 0u ? mine : 1u; b.nx = cnt > 0u ? cnt : 1u;
}
__device__ __forceinline__ void xcd_barrier(const XcdBar& b, bool leader_thread) {
    asm volatile("s_waitcnt vmcnt(0)" ::: "memory");
    __syncthreads();
    if (leader_thread) {
        unsigned* bar = b.bar;
        __builtin_amdgcn_s_waitcnt(0);
        const unsigned nloc = b.nloc, nx = b.nx;
        const unsigned old = xb_add(&bar[XB_XSUB(b.x)], 1u);
        const unsigned gen = old / nloc;
        if (old + 1u == (gen + 1u) * nloc) {
            __builtin_amdgcn_fence(__ATOMIC_RELEASE, "agent");
            asm volatile("s_waitcnt vmcnt(0)" ::: "memory");
            const unsigned og = xb_add(&bar[XB_TOP], 1u);
            const unsigned tg = og / nx;
            if (og + 1u == (tg + 1u) * nx) xb_add(&bar[XB_TOPGEN], 1u);
            else XB_SPIN(xb_ld(&bar[XB_TOPGEN]) == tg, bar);
            __builtin_amdgcn_fence(__ATOMIC_ACQUIRE, "agent");
            xb_add(&bar[XB_XGEN(b.x)], 1u);
            asm volatile("s_waitcnt vmcnt(0)" ::: "memory");
        } else {
            XB_SPIN(xb_ld(&bar[XB_XGEN(b.x)]) == gen, bar);
            __builtin_amdgcn_fence(__ATOMIC_ACQUIRE, "agent");
            asm volatile("s_waitcnt vmcnt(0)" ::: "memory");
        }
    }
    __syncthreads();
}

#define XB_LSUB(j)  (16384 + 64 * (j))
#define XB_LGEN(j)  (17408 + 64 * (j))
__device__ __forceinline__ void xcd_local_rendezvous(const XcdBar& b, bool leader_thread) {
    __syncthreads();
    if (leader_thread) {
        unsigned* bar = b.bar;
        const unsigned nloc = b.nloc;
        const unsigned old = xb_add(&bar[XB_LSUB(b.x)], 1u);
        const unsigned gen = old / nloc;
        if (old + 1u == (gen + 1u) * nloc) xb_add(&bar[XB_LGEN(b.x)], 1u);
        else XB_SPIN(xb_ld(&bar[XB_LGEN(b.x)]) == gen, bar);
    }
    __syncthreads();
}

__global__ void __launch_bounds__(NT, 2) mega(Args a) {
    extern __shared__ __attribute__((aligned(16))) unsigned char lds_raw[];
    LAS unsigned char* lds = (LAS unsigned char*)lds_raw;
    cg::grid_group grid = cg::this_grid();
    const int wave = __builtin_amdgcn_readfirstlane(threadIdx.x >> 6), G = gridDim.x;
#define PH_IDS() const int lane = pg8::lane_id_v(), tid = wave * 64 + lane; (void)tid; (void)lane
    unsigned char* ws = a.ws;
    const int lo = a.ph_lo, hi = a.ph_hi;
    bf16_t* WIN = (bf16_t*)(ws + WS_WIN); bf16_t* WOUT = (bf16_t*)(ws + WS_WOUT); bf16_t* WEFF = (bf16_t*)(ws + WS_WEFF);
    bf16_t* XN = (bf16_t*)(ws + WS_XN);
    bf16_t* GLU = (bf16_t*)(ws + WS_GLU); bf16_t* HG = (bf16_t*)(ws + WS_HG); bf16_t* Y = (bf16_t*)(ws + WS_Y);
    float* HS = (float*)(ws + WS_HS); float* HLD = (float*)(ws + WS_HLD);
    int* EIDX = (int*)(ws + WS_EIDX); float* GATE = (float*)(ws + WS_GATE);
    const int gw = blockIdx.x * NWAVES + wave, NGW = G * NWAVES;
#ifndef PH_MASK
#define PH_MASK 0xff
#endif
#define IN(k) (((PH_MASK >> (k)) & 1) && lo <= (k) && (k) < hi)
    XcdBar xb; xb.bar = (unsigned*)ws; xb.x = xb_xcc_id(); xb.nloc = 1u; xb.nx = 1u;
    const bool xb_leader = (wave == 0) && (pg8::lane_id_v() == 0);
    if (lo == 0 && xb_leader) xcd_bar_post(xb.bar, xb.x);
#ifndef SEAM0_GRIDSYNC
#define SEAM0_GRIDSYNC 0
#endif
#define SEAM(k) do { if (IN(k) && IN((k) + 1)) { if ((k) == 0) { if (SEAM0_GRIDSYNC) { grid.sync(); if (xb_leader) xcd_bar_census(xb); } else { if (xb_leader) xcd_bar_census_spin(xb); xcd_barrier(xb, xb_leader); } } else xcd_barrier(xb, xb_leader); } } while (0)
    if (lo > 1000) grid.sync();
    if (IN(0)) { PH_IDS(); p0_prologue(a, lds, lane, wave, 1 | 8, gw, NGW); }
    SEAM(0);
    if (IN(1)) {
        pg8::Gemm g{XN, WIN, M, DIN, D};
        pg8::EpiProj E{GLU, HG};
        if (G == 256) {
            pg8::GatedOrder S; S.init((int)blockIdx.x, wave, xb.bar + XB_RDY, xb.bar + XB_TMO);
            if (S.converter()) { PH_IDS(); const int gwa = ((int)blockIdx.x >> 3) - 24 + 8 * ((int)blockIdx.x & 7);
                rows_convert_publish(a.in[0], ws + WS_XN, (float*)(ws + WS_XRS), xb.bar + XB_RDY, gwa * NWAVES + wave, lane, 2);
                asm volatile("s_waitcnt vmcnt(0)" ::: "memory"); __syncthreads(); }
            else { PH_IDS(); const int gwb = ((int)blockIdx.x >> 3) + 24 * ((int)blockIdx.x & 7);
                rows_convert_publish_head(a.in[0], ws + WS_XN, (float*)(ws + WS_XRS), xb.bar + XB_RDY, 4096, gwb * NWAVES + wave, 192 * NWAVES, lane);
                asm volatile("s_waitcnt vmcnt(0)" ::: "memory"); __syncthreads(); }
            pg8::gemm_phase<pg8::EpiProj, pg8::GatedOrder, true, true>(lds, g, S, E, wave);
        } else {
            { PH_IDS(); p0_prologue(a, lds, lane, wave, 4, gw, NGW); }
            xcd_barrier(xb, xb_leader);
            pg8::StaticOrder S; S.init(M, DIN, G, (int)blockIdx.x);
            pg8::gemm_phase<pg8::EpiProj, pg8::StaticOrder, true, true>(lds, g, S, E, wave);
        }
    }
    SEAM(1);
    if (IN(2)) { PH_IDS();
        if (!(a.sub & 1)) for (int u = blockIdx.x; u < BATCH * NH * SEGS; u += G) { hgrn_pass1_unit(lds, u, HG, a.in[7], HS, HLD, lane, wave, a.in[13], ws + WS_U, (float*)(ws + WS_USC), a.in[10]);
            asm volatile("s_waitcnt vmcnt(0)" ::: "memory"); __syncthreads();
            if (xb_leader) (void)xb_add(&xb.bar[XB_SEG + 64 * (u >> 3)], 1u); }
        if (!(a.sub & 2)) for (int wu = gw; wu < 2048; wu += NGW) conv_wave_unit(GLU, a.in[3], a.in[4], a.in[5], a.in[6], Y, wu, lane);
    }
    if (IN(3)) { PH_IDS();
        for (int u = blockIdx.x; u < BATCH * NH * SEGS; u += G) {
            if (lo <= 2) {
                if (xb_leader) XB_SPIN(xb_ld(&xb.bar[XB_SEG + 64 * (u >> 3)]) < (unsigned)SEGS, xb.bar);
                __syncthreads();
            }
            hgrn_unit<true>(lds, u, HG, a.in[7], a.in[8], HS, HLD, Y, tid, lane, wave, a.in[14], ws + WS_V, (float*)(ws + WS_VSC), nullptr, a.in[11], a.in[12], a.in[10], (bf16_t*)(ws + WS_WEFF));
        }
    }
    SEAM(3);
    if (IN(4)) {
        pg8::Gemm g{Y, WOUT, M, D, D}; pg8::StaticOrder S; S.init(M, D, G, (int)blockIdx.x);
        pg8::EpiResBf16 E{XN, (const float*)(ws + WS_XRS), (float*)(ws + WS_SSQ)};
        pg8::gemm_phase<pg8::EpiResBf16, pg8::StaticOrder, false, true>(lds, g, S, E, wave);
    }
    SEAM(4);
    if (IN(6)) {
        pg8::Gemm g{XN, WEFF, M, NQ, D}; pg8::StaticOrder S; S.init(M, NQ, G, (int)blockIdx.x);
        pg8::EpiTopK<QuantHook> E{EIDX, GATE, (const float*)(ws + WS_SSQ), QuantHook{a.in[13], a.in[14], ws + WS_U, ws + WS_V, (float*)(ws + WS_USC), (float*)(ws + WS_VSC), a.in[10], 0}};
        for (int i = 0;; ++i) { pg8::OneUnit O; if (!S.next(i, O.u)) break; E.hk.L = i * G + (int)blockIdx.x; pg8::gemm_phase<pg8::EpiTopK<QuantHook>, pg8::OneUnit, false, true>(lds, g, O, E, wave); }
    }
    SEAM(6);
    if (IN(7)) { PH_IDS();
        peer_keys(lds, wave, XN, EIDX, GATE, ws + WS_U, (const float*)(ws + WS_USC), (const float*)(ws + WS_VSC), (const float*)(ws + WS_SSQ), gw, NGW, lane);
        asm volatile("s_waitcnt vmcnt(0)" ::: "memory");
        __syncthreads();
        peer_values(XN, EIDX, GATE, ws + WS_V, a.in[15], a.out, gw, NGW, lane);
    }
#undef IN
#undef SEAM
}
}

extern "C" void kernel_launch(void* const* d_in, const int* in_sizes, int n_in, void* d_out, int out_size, void* d_ws, size_t ws_size, hipStream_t stream) {
    static int grid = 0;
    if (grid == 0) {
        if (n_in != 16 || out_size != mk::M * mk::D || ws_size < (size_t)mk::WS_END) { fprintf(stderr, "kernel_launch: unexpected shapes (n_in %d out %d ws %zu)\n", n_in, out_size, ws_size); grid = -1; return; }
        int dev = 0, cus = 0, per_cu = 0;
        (void)hipGetDevice(&dev);
        (void)hipDeviceGetAttribute(&cus, hipDeviceAttributeMultiprocessorCount, dev);
        if (hipFuncSetAttribute((const void*)mk::mega, hipFuncAttributeMaxDynamicSharedMemorySize, mk::LDS_BYTES) != hipSuccess) { fprintf(stderr, "kernel_launch: hipFuncSetAttribute failed\n"); grid = -1; return; }
        if (hipOccupancyMaxActiveBlocksPerMultiprocessor(&per_cu, (const void*)mk::mega, mk::NT, mk::LDS_BYTES) != hipSuccess || per_cu < 1) { fprintf(stderr, "kernel_launch: occupancy query says %d\n", per_cu); per_cu = 1; }
        (void)hipGetLastError();
        grid = cus;
    }
    if (grid < 0) return;
    if (hipMemsetAsync(d_ws, 0, 81920, stream) != hipSuccess) { fprintf(stderr, "kernel_launch: memset failed\n"); return; }
    mk::Args a{};
    for (int i = 0; i < 16; ++i) a.in[i] = (const float*)d_in[i];
    a.out = (float*)d_out; a.ws = (unsigned char*)d_ws;
    a.ph_lo = 0; a.ph_hi = 8;
    void* args[] = {&a};
#ifdef PROBE_PHASE
    const int plo[3] = {0, PROBE_PHASE == 0 ? 0 : PROBE_PHASE, 7}, phi[3] = {PROBE_PHASE == 0 ? 1 : 7, PROBE_PHASE == 0 ? 8 : PROBE_PHASE + 1, 8};
    for (int li = 0; li < 3; ++li) { if ((li == 1 && PROBE_PHASE < 0) || (li == 2 && PROBE_PHASE == 0)) continue; a.ph_lo = plo[li]; a.ph_hi = phi[li];
        if (li) (void)hipMemsetAsync(d_ws, 0, 81920, stream);
#ifdef PROBE_SUB
        a.sub = (li == (PROBE_PHASE == 0 ? 0 : 1)) ? PROBE_SUB : 0;
#endif
        hipError_t e = hipLaunchCooperativeKernel((const void*)mk::mega, dim3(grid), dim3(mk::NT), args, mk::LDS_BYTES, stream);
        if (e != hipSuccess) fprintf(stderr, "cooperative launch failed: %s (grid %d)\n", hipGetErrorString(e), grid); }
#else
    hipError_t e = hipLaunchCooperativeKernel((const void*)mk::mega, dim3(grid), dim3(mk::NT), args, mk::LDS_BYTES, stream);
    if (e != hipSuccess) fprintf(stderr, "cooperative launch failed: %s (grid %d)\n", hipGetErrorString(e), grid);
#endif
}
```
